# Optimizing an MI355X kernel written in HIP

```python
import jax, jax.numpy as jnp
from jax import lax
import numpy as np

D_MODEL = 2048
BATCH = 8
SEQ = 2048
DEPTH = 4

N_MIXERS = 2
HEAD_DIM = 128
MIX_WIDTH = D_MODEL
N_MEM_HEADS = 4
N_MIX_HEADS = (MIX_WIDTH - N_MEM_HEADS * HEAD_DIM) // HEAD_DIM
N_KV_GROUPS = 2
HEADS_PER_GROUP = N_MIX_HEADS // N_KV_GROUPS
N_MEM = 256
Q_BLOCK = 128
CMP_LEN = 32
CMP_STRIDE = 16
CMP_HIDDEN = 2 * HEAD_DIM
SEL_BLOCK = 64
N_SEL = 16
WINDOW = 512
N_BRANCH = 3
D_FF = 5632
CONV_WIDTH = 3
ROPE_THETA = 10000.0
NORM_EPS = 1e-6
SB_COLS = 3 * N_MIX_HEADS * HEAD_DIM + N_MEM_HEADS * HEAD_DIM
NSA_COLS = (N_MIX_HEADS * HEAD_DIM + 6 * N_KV_GROUPS * HEAD_DIM
            + N_BRANCH * N_MIX_HEADS + N_MEM_HEADS * HEAD_DIM)

kernel_name = "hybrid_stickbreak_nsa_memory_convffn"


def rmsnorm(x, g):
    xf = x.astype(jnp.float32)
    y = xf * lax.rsqrt(jnp.mean(xf * xf, axis=-1, keepdims=True) + NORM_EPS)
    return (y * g.astype(jnp.float32)).astype(x.dtype)


def rope_tables(positions):
    inv_freq = jnp.power(ROPE_THETA, -jnp.arange(0, HEAD_DIM, 2, dtype=jnp.float32) / HEAD_DIM)
    ang = positions.astype(jnp.float32)[..., None] * inv_freq
    return jnp.cos(ang)[:, :, None, :], jnp.sin(ang)[:, :, None, :]


def apply_rope(u, cos, sin):
    uf = u.astype(jnp.float32)
    u1, u2 = uf[..., :HEAD_DIM // 2], uf[..., HEAD_DIM // 2:]
    return jnp.concatenate([u1 * cos - u2 * sin, u2 * cos + u1 * sin], axis=-1).astype(u.dtype)


def masked_softmax(s, mask):
    s = jnp.where(mask, s, -jnp.inf)
    m = jnp.max(s, axis=-1, keepdims=True)
    m = jnp.where(jnp.isfinite(m), m, 0.0)
    e = jnp.exp(s - m)
    return e / jnp.maximum(jnp.sum(e, axis=-1, keepdims=True), 1e-30)


def split_cols(a, sizes):
    outs, start = [], 0
    for n in sizes:
        outs.append(a[..., start:start + n])
        start += n
    return outs


def stick_breaking_attention(q, k, v):
    B, S, H, Dh = q.shape
    scale = Dh ** -0.5
    outs = []
    for blk in range(S // Q_BLOCK):
        end = (blk + 1) * Q_BLOCK
        qb = q[:, blk * Q_BLOCK:end]
        kp, vp = k[:, :end], v[:, :end]
        z = jnp.einsum('bthd,bshd->bhts', qb, kp).astype(jnp.float32) * scale
        t_pos = blk * Q_BLOCK + jnp.arange(Q_BLOCK)
        mask = jnp.arange(end)[None, :] < t_pos[:, None]
        log_keep = jnp.where(mask, jax.nn.log_sigmoid(-z), 0.0)
        log_keep_between = lax.cumsum(log_keep, axis=3, reverse=True) - log_keep
        a = jnp.where(mask, jnp.exp(jax.nn.log_sigmoid(z) + log_keep_between), 0.0)
        outs.append(jnp.einsum('bhts,bshd->bthd', a.astype(v.dtype), vp))
    return jnp.concatenate(outs, axis=1)


def stick_breaking_mixer(h, w_in):
    B, S, _ = h.shape
    q, k, v, q_mem = split_cols(h @ w_in, [N_MIX_HEADS * HEAD_DIM] * 3 + [N_MEM_HEADS * HEAD_DIM])
    shp = (B, S, N_MIX_HEADS, HEAD_DIM)
    o = stick_breaking_attention(q.reshape(shp), k.reshape(shp), v.reshape(shp))
    return o.reshape(B, S, N_MIX_HEADS * HEAD_DIM), q_mem


def compress(u, pe, w1, w2):
    B, S, G, Dh = u.shape
    ch = u.reshape(B, S // CMP_STRIDE, CMP_STRIDE, G, Dh)
    blk = jnp.concatenate([ch[:, :-1], ch[:, 1:]], axis=2) + pe[:, None, :]
    nc = blk.shape[1]
    flat = blk.transpose(0, 1, 3, 2, 4).reshape(B, nc, G, CMP_LEN * Dh)
    return jax.nn.silu(flat @ w1) @ w2


def overlap_matrix(nc, ns):
    c0 = jnp.arange(nc)[:, None] * CMP_STRIDE
    s0 = jnp.arange(ns)[None, :] * SEL_BLOCK
    ov = jnp.minimum(c0 + CMP_LEN, s0 + SEL_BLOCK) - jnp.maximum(c0, s0)
    return jnp.maximum(ov, 0).astype(jnp.float32) / CMP_STRIDE


def nsa_mixer(h, w_in, pe, w1, w2, cos, sin):
    B, S, _ = h.shape
    G, HPG, Dh = N_KV_GROUPS, HEADS_PER_GROUP, HEAD_DIM
    kvw = G * Dh
    q, kc, vc, ks, vs, kw, vw, g_logit, q_mem = split_cols(
        h @ w_in, [N_MIX_HEADS * Dh] + [kvw] * 6 + [N_BRANCH * N_MIX_HEADS, N_MEM_HEADS * Dh])
    q = apply_rope(q.reshape(B, S, N_MIX_HEADS, Dh), cos, sin)
    kc = apply_rope(kc.reshape(B, S, G, Dh), cos, sin)
    ks = apply_rope(ks.reshape(B, S, G, Dh), cos, sin)
    kw = apply_rope(kw.reshape(B, S, G, Dh), cos, sin)
    vc, vs, vw = (u.reshape(B, S, G, Dh) for u in (vc, vs, vw))
    gates = jax.nn.sigmoid(g_logit.astype(jnp.float32)).reshape(B, S, N_MIX_HEADS, N_BRANCH)
    scale = Dh ** -0.5
    t = jnp.arange(S)
    qg = q.reshape(B, S, G, HPG, Dh)

    k_cmp = compress(kc, pe[0], w1[0], w2[0])
    v_cmp = compress(vc, pe[1], w1[1], w2[1])
    nc = k_cmp.shape[1]
    s_c = jnp.einsum('btghd,bcgd->bghtc', qg, k_cmp).astype(jnp.float32) * scale
    c_end = jnp.arange(nc) * CMP_STRIDE + CMP_LEN - 1
    p_c = masked_softmax(s_c, c_end[None, :] <= t[:, None])
    o_cmp = jnp.einsum('bghtc,bcgd->btghd', p_c.astype(v_cmp.dtype), v_cmp)

    ns = S // SEL_BLOCK
    imp = jnp.einsum('bghtc,cj->bgtj', p_c, overlap_matrix(nc, ns))
    cur = t // SEL_BLOCK
    jb = jnp.arange(ns)[None, :]
    valid = jb <= cur[:, None]
    forced = (jb == 0) | (jb == cur[:, None]) | (jb == cur[:, None] - 1)
    score = jnp.where(forced, jnp.inf, jnp.where(valid, imp, -jnp.inf))
    n_sel = min(N_SEL, ns)
    _, idx = lax.top_k(score, n_sel)
    sel_ok = idx <= cur[None, None, :, None]

    ks_blocks = ks.reshape(B, ns, SEL_BLOCK, G, Dh).transpose(0, 3, 1, 2, 4)
    vs_blocks = vs.reshape(B, ns, SEL_BLOCK, G, Dh).transpose(0, 3, 1, 2, 4)
    pad = ((0, 0), (WINDOW, 0), (0, 0), (0, 0))
    kw_pad, vw_pad = jnp.pad(kw, pad), jnp.pad(vw, pad)
    gather_blocks = jax.vmap(jax.vmap(lambda kb, ib: kb[ib]))

    nqb = S // Q_BLOCK
    q_blocks = jnp.moveaxis(qg.reshape(B, nqb, Q_BLOCK, G, HPG, Dh), 1, 0)
    idx_blocks = jnp.moveaxis(idx.reshape(B, G, nqb, Q_BLOCK, n_sel), 2, 0)
    ok_blocks = jnp.moveaxis(sel_ok.reshape(B, G, nqb, Q_BLOCK, n_sel), 2, 0)

    def query_block(args):
        qb, idxb, okb, bi = args
        tq = bi * Q_BLOCK + jnp.arange(Q_BLOCK)
        kg = gather_blocks(ks_blocks, idxb)
        vg = gather_blocks(vs_blocks, idxb).reshape(B, G, Q_BLOCK, n_sel * SEL_BLOCK, Dh)
        s_s = jnp.einsum('btghd,bgtnkd->bghtnk', qb, kg).astype(jnp.float32) * scale
        s_s = s_s.reshape(B, G, HPG, Q_BLOCK, n_sel * SEL_BLOCK)
        tok = idxb[..., None] * SEL_BLOCK + jnp.arange(SEL_BLOCK)
        m_s = okb[..., None] & (tok <= tq[None, None, :, None, None])
        p_s = masked_softmax(s_s, m_s.reshape(B, G, 1, Q_BLOCK, n_sel * SEL_BLOCK))
        o_s = jnp.einsum('bghtm,bgtmd->btghd', p_s.astype(vg.dtype), vg)
        kwin = lax.dynamic_slice_in_dim(kw_pad, bi * Q_BLOCK, Q_BLOCK + WINDOW, axis=1)
        vwin = lax.dynamic_slice_in_dim(vw_pad, bi * Q_BLOCK, Q_BLOCK + WINDOW, axis=1)
        kp = bi * Q_BLOCK - WINDOW + jnp.arange(Q_BLOCK + WINDOW)
        m_w = (kp[None, :] <= tq[:, None]) & (kp[None, :] > tq[:, None] - WINDOW) & (kp[None, :] >= 0)
        s_w = jnp.einsum('btghd,bsgd->bghts', qb, kwin).astype(jnp.float32) * scale
        p_w = masked_softmax(s_w, m_w)
        o_w = jnp.einsum('bghts,bsgd->btghd', p_w.astype(vwin.dtype), vwin)
        return o_s, o_w

    o_sel, o_win = lax.map(query_block, (q_blocks, idx_blocks, ok_blocks, jnp.arange(nqb)))
    shp = (B, S, N_MIX_HEADS, Dh)
    o_sel = jnp.moveaxis(o_sel, 0, 1).reshape(shp)
    o_win = jnp.moveaxis(o_win, 0, 1).reshape(shp)
    o = (gates[..., 0:1] * o_cmp.reshape(shp) + gates[..., 1:2] * o_sel
         + gates[..., 2:3] * o_win).astype(h.dtype)
    return o.reshape(B, S, N_MIX_HEADS * Dh), q_mem


def memory_attention(q_mem, mem_n, w_kv):
    B, S, _ = q_mem.shape
    km, vm = split_cols(mem_n @ w_kv, [N_MEM_HEADS * HEAD_DIM] * 2)
    q = q_mem.reshape(B, S, N_MEM_HEADS, HEAD_DIM)
    km = km.reshape(B, -1, N_MEM_HEADS, HEAD_DIM)
    vm = vm.reshape(B, -1, N_MEM_HEADS, HEAD_DIM)
    s = jnp.einsum('bthd,bmhd->bhtm', q, km).astype(jnp.float32) * HEAD_DIM ** -0.5
    p = jax.nn.softmax(s, axis=-1)
    return jnp.einsum('bhtm,bmhd->bthd', p.astype(vm.dtype), vm).reshape(B, S, N_MEM_HEADS * HEAD_DIM)


def conv_ffn(h, w_gate, w_up, conv_w, conv_b, w_down):
    S = h.shape[1]
    g_pre = h @ w_gate
    gp = jnp.pad(g_pre, ((0, 0), (CONV_WIDTH - 1, 0), (0, 0)))
    gc = conv_b
    for k in range(CONV_WIDTH):
        gc = gc + gp[:, k:k + S] * conv_w[k]
    return (jax.nn.silu(gc) * (h @ w_up)) @ w_down


def setup_inputs(seed: int = 0) -> dict:
    key = jax.random.key(seed)
    ks = jax.random.split(key, 16)
    f32 = jnp.float32
    n_sb = len(range(0, DEPTH, N_MIXERS))
    n_nsa = len(range(1, DEPTH, N_MIXERS))

    def normal(k, shape, scale):
        return jax.random.normal(k, shape, f32) * scale

    positions = (jax.random.randint(ks[2], (BATCH, 1), 0, 4096, dtype=jnp.int32)
                 + jnp.arange(SEQ, dtype=jnp.int32)[None, :])
    return {
        "x": normal(ks[0], (BATCH, SEQ, D_MODEL), 1.0),
        "mem": normal(ks[1], (BATCH, N_MEM, D_MODEL), 1.0),
        "positions": positions,
        "norm_g": 1.0 + normal(ks[3], (DEPTH, 5, D_MODEL), 0.05),
        "w_in_sb": normal(ks[4], (n_sb, D_MODEL, SB_COLS), D_MODEL ** -0.5),
        "w_in_nsa": normal(ks[5], (n_nsa, D_MODEL, NSA_COLS), D_MODEL ** -0.5),
        "cmp_pe": normal(ks[6], (n_nsa, 2, CMP_LEN, HEAD_DIM), 0.1),
        "cmp_w1": normal(ks[7], (n_nsa, 2, CMP_LEN * HEAD_DIM, CMP_HIDDEN), (CMP_LEN * HEAD_DIM) ** -0.5),
        "cmp_w2": normal(ks[8], (n_nsa, 2, CMP_HIDDEN, HEAD_DIM), CMP_HIDDEN ** -0.5),
        "w_mem_kv": normal(ks[9], (DEPTH, D_MODEL, 2 * N_MEM_HEADS * HEAD_DIM), D_MODEL ** -0.5),
        "w_o": normal(ks[10], (DEPTH, MIX_WIDTH, D_MODEL), MIX_WIDTH ** -0.5),
        "w_ffn_gate": normal(ks[11], (DEPTH, D_MODEL, D_FF), D_MODEL ** -0.5),
        "w_ffn_up": normal(ks[12], (DEPTH, D_MODEL, D_FF), D_MODEL ** -0.5),
        "ffn_conv_w": normal(ks[13], (DEPTH, CONV_WIDTH, D_FF), CONV_WIDTH ** -0.5),
        "ffn_conv_b": normal(ks[14], (DEPTH, D_FF), 0.01),
        "w_ffn_down": normal(ks[15], (DEPTH, D_FF, D_MODEL), D_FF ** -0.5),
    }


def reference(x, mem, positions, norm_g, w_in_sb, w_in_nsa, cmp_pe, cmp_w1, cmp_w2,
              w_mem_kv, w_o, w_ffn_gate, w_ffn_up, ffn_conv_w, ffn_conv_b, w_ffn_down):
    cos, sin = rope_tables(positions)
    for i in range(DEPTH):
        j = i // N_MIXERS
        h = rmsnorm(x, norm_g[i, 0])
        if i % N_MIXERS == 0:
            o_mix, q_mem = stick_breaking_mixer(h, w_in_sb[j])
        else:
            o_mix, q_mem = nsa_mixer(h, w_in_nsa[j], cmp_pe[j], cmp_w1[j], cmp_w2[j], cos, sin)
        o_mem = memory_attention(q_mem, rmsnorm(mem, norm_g[i, 4]), w_mem_kv[i])
        attn = jnp.concatenate([o_mix, o_mem], axis=-1) @ w_o[i]
        x = x + rmsnorm(attn, norm_g[i, 1])
        h = rmsnorm(x, norm_g[i, 2])
        f = conv_ffn(h, w_ffn_gate[i], w_ffn_up[i], ffn_conv_w[i], ffn_conv_b[i], w_ffn_down[i])
        x = x + rmsnorm(f, norm_g[i, 3])
    return x
```

```cpp
#include <hip/hip_runtime.h>
#include <cstdio>
#include <cstdint>
namespace pg8 {
#define PG8_LAS __attribute__((address_space(3)))
typedef unsigned short bf16_t;
typedef short bf16x8 __attribute__((ext_vector_type(8)));
typedef float f32x4 __attribute__((ext_vector_type(4)));
typedef unsigned u32x4 __attribute__((ext_vector_type(4)));
constexpr int BM = 256, BK = 64, HALF = 128, HTB = HALF * BK * 2  , STAGE_BYTES = 8 * HTB, NXCD = 8, WGM = 8;

__host__ __device__ __forceinline__ int lds_byte(int r, int c) { const int st = (r >> 4) * 2 + (c >> 5), rr = r & 15, cc = c & 31, ob = rr * 64 + cc * 2; return st * 1024 + (ob ^ (((ob >> 9) & 1) << 5)); }
__host__ __device__ __forceinline__ void stage_rc(int b, int& R, int& C) { const int st = b / 1024, sb = b % 1024, swz = sb ^ (((sb >> 9) & 1) << 5); R = (st >> 1) * 16 + swz / 64; C = (st & 1) * 32 + (swz % 64) / 2; }
__host__ __device__ __forceinline__ int perm32(int rho) { const int n = rho >> 4, i = rho & 15; return 8 * (i >> 2) + 4 * n + (i & 3); }

struct Unit { int pm, pn; };
struct Gemm { const bf16_t* A; const bf16_t* Bt; int M, N, K; };

struct StaticOrder {
    int nM, nN, nwg, G, c;
    __host__ __device__ void init(int M, int N, int G_, int c_) { nM = M / BM; nN = N / BM; nwg = nM * nN; G = G_; c = c_; }
    __host__ __device__ bool next(int i, Unit& u) const {
        const long L = (long)i * G + c; if (L >= nwg) return false;
        int wgid = (int)L; { const int q = nwg / NXCD, r = nwg % NXCD, xcd = wgid % NXCD, off = wgid / NXCD; wgid = (xcd < r ? xcd * (q + 1) : r * (q + 1) + (xcd - r) * q) + off; }
        const int nig = WGM * nN, gid = wgid / nig, fm = gid * WGM, gsz = (nM - fm) < WGM ? (nM - fm) : WGM;
        u.pm = fm + ((wgid % nig) % gsz); u.pn = (wgid % nig) / gsz; return true;
    }
    __device__ __forceinline__ void a_ready(const Unit&) const {}
    __device__ __forceinline__ void done(const Unit&) const {}
};

__device__ __forceinline__ unsigned cvt_pk_bf16(float lo, float hi) { unsigned r; asm volatile("v_cvt_pk_bf16_f32 %0, %1, %2" : "=v"(r) : "v"(lo), "v"(hi)); return r; }
typedef float f32x2 __attribute__((ext_vector_type(2)));
struct EpiRS {
    static constexpr bool PERM = true, AFTER_DRAIN = false;
    bf16_t* O; int ldc; const float* rs;
    __device__ __forceinline__ void operator()(const f32x4 (&acc)[2][2][4][2], const Unit& u, int wr, int wc, int fr, int fq) const {
        const int row0 = u.pm * BM + wr * 64 + fr; const int col0 = u.pn * BM + wc * 32 + 8 * fq;
#pragma unroll
        for (int ai = 0; ai < 2; ++ai)
#pragma unroll
            for (int m = 0; m < 4; ++m) { const int row = row0 + ai * HALF + m * 16; const float sc = rs ? rs[row] : 1.f; bf16_t* rowp = O + (size_t)row * ldc + col0;
#pragma unroll
                for (int bj = 0; bj < 2; ++bj) { const f32x4 v0 = acc[ai][bj][m][0] * sc, v1 = acc[ai][bj][m][1] * sc;
                    u32x4 w; w.x = cvt_pk_bf16(v0[0], v0[1]); w.y = cvt_pk_bf16(v0[2], v0[3]); w.z = cvt_pk_bf16(v1[0], v1[1]); w.w = cvt_pk_bf16(v1[2], v1[3]);
                    *(u32x4*)(rowp + bj * HALF) = w; } }
    }
};
template <class Epi, class Sched, bool ALIGN_EPI = false, bool SP2 = false>
__device__ __forceinline__ void gemm_phase(PG8_LAS unsigned char* lds, const Gemm g, const Sched& S, const Epi& E) {
    int tid_ = threadIdx.x; asm volatile("" : "+v"(tid_));
    const int tid = tid_, wid = __builtin_amdgcn_readfirstlane(tid >> 6), lane = tid & 63, wr = wid >> 2, wc = wid & 3, fr = lane & 15, fq = lane >> 4;
    const int K = g.K, nt = K / BK;
    unsigned voffA[2], voffB[2];
#pragma unroll
    for (int i = 0; i < 2; ++i) { int R, C; stage_rc(tid * 16 + i * 8192, R, C); const int Rb = Epi::PERM ? ((R & ~31) + perm32(R & 31)) : R;
        voffA[i] = (unsigned)(R * K + C) * 2u; voffB[i] = (unsigned)(Rb * K + C) * 2u; }
    const size_t kstep = (size_t)(BK * 2);
    const size_t hstep = (size_t)HALF * K * 2;
    const size_t tstep = 2 * hstep;
    const unsigned ldsw = (unsigned)wid * 1024u;
    const int aoff = lds_byte(wr * 64 + fr, fq * 8), boff = lds_byte(wc * 32 + fr, fq * 8);
#define PG8_SA(b, h) (((b) * 2 + (h)) * HTB)
#define PG8_SB(b, h) ((4 + (b) * 2 + (h)) * HTB)
#define PG8_STAGE(bufoff, gbase, voff) do { _Pragma("unroll") for (int _i = 0; _i < 2; ++_i) \
        __builtin_amdgcn_global_load_lds((const unsigned*)((const char*)(gbase) + (voff)[_i]), (PG8_LAS unsigned*)(lds + (bufoff) + ldsw + _i * 8192), 16, 0, 0); } while (0)
#define PG8_LDA(dst, b, h) do { _Pragma("unroll") for (int m = 0; m < 4; ++m) _Pragma("unroll") for (int k = 0; k < 2; ++k) dst[m][k] = *(const PG8_LAS bf16x8*)(lds + PG8_SA(b, h) + aoff + m * 2048 + k * 1024); } while (0)
#define PG8_LDB(dst, b, h) do { _Pragma("unroll") for (int n = 0; n < 2; ++n) _Pragma("unroll") for (int k = 0; k < 2; ++k) dst[n][k] = *(const PG8_LAS bf16x8*)(lds + PG8_SB(b, h) + boff + n * 2048 + k * 1024); } while (0)
#define PG8_MMA(ai, bj, At, Bt) do { __builtin_amdgcn_s_setprio(1); _Pragma("unroll") for (int m = 0; m < 4; ++m) _Pragma("unroll") for (int n = 0; n < 2; ++n) _Pragma("unroll") for (int k = 0; k < 2; ++k) \
        acc[ai][bj][m][n] = __builtin_amdgcn_mfma_f32_16x16x32_bf16(Bt[n][k], At[m][k], acc[ai][bj][m][n], 0, 0, 0); __builtin_amdgcn_s_setprio(0); } while (0)
#define PG8_WAIT_V(n) asm volatile("s_waitcnt vmcnt(" #n ")" ::: "memory")
#define PG8_WAIT_L(n) asm volatile("s_waitcnt lgkmcnt(" #n ")" ::: "memory")
#define PG8_BAR __builtin_amdgcn_s_barrier()
#define PG8_SCHED __builtin_amdgcn_sched_barrier(0)
    Unit cur, nxt; int ui = 0;
    if (!S.next(0, cur)) return;
    f32x4 acc[2][2][4][2];
#pragma unroll
    for (int a = 0; a < 2; ++a)
#pragma unroll
        for (int b = 0; b < 2; ++b)
#pragma unroll
            for (int m = 0; m < 4; ++m)
#pragma unroll
                for (int n = 0; n < 2; ++n) acc[a][b][m][n] = (f32x4){0.f, 0.f, 0.f, 0.f};
    bf16x8 At[4][2], B0[2][2], B1[2][2];
    const char* cA = (const char*)g.A + (size_t)cur.pm * tstep; const char* cB = (const char*)g.Bt + (size_t)cur.pn * tstep;
    S.a_ready(cur);
    if constexpr (SP2) {
        PG8_STAGE(PG8_SB(0, 0), cB, voffB); PG8_STAGE(PG8_SB(0, 1), cB + hstep, voffB); PG8_STAGE(PG8_SA(0, 0), cA, voffA); PG8_STAGE(PG8_SA(0, 1), cA + hstep, voffA);
        if (wr == 1) PG8_BAR;
        PG8_WAIT_V(2); PG8_BAR;
        PG8_STAGE(PG8_SB(1, 0), cB + kstep, voffB); PG8_STAGE(PG8_SA(1, 0), cA + kstep, voffA); PG8_STAGE(PG8_SB(1, 1), cB + hstep + kstep, voffB);
        PG8_WAIT_V(6); PG8_BAR;
    } else {
        PG8_STAGE(PG8_SB(0, 0), cB, voffB); PG8_STAGE(PG8_SA(0, 0), cA, voffA); PG8_STAGE(PG8_SB(0, 1), cB + hstep, voffB); PG8_STAGE(PG8_SA(0, 1), cA + hstep, voffA);
        if (wr == 1) PG8_BAR;
        PG8_WAIT_V(4); PG8_BAR;
        PG8_STAGE(PG8_SB(1, 0), cB + kstep, voffB); PG8_STAGE(PG8_SA(1, 0), cA + kstep, voffA); PG8_STAGE(PG8_SB(1, 1), cB + hstep + kstep, voffB);
        PG8_WAIT_V(6); PG8_BAR;
    }
    for (;;) {
        const bool has_next = S.next(ui + 1, nxt);
        const char* nA = has_next ? (const char*)g.A + (size_t)nxt.pm * tstep : cA; const char* nB = has_next ? (const char*)g.Bt + (size_t)nxt.pn * tstep : cB;
        for (int t = 0; t < nt; t += 2) {
            const bool last = (t == nt - 2);
            const char* a1 = cA + (size_t)(t + 1) * kstep;
            const char* a2 = last ? nA : cA + (size_t)(t + 2) * kstep; const char* b2 = last ? nB : cB + (size_t)(t + 2) * kstep;
            const char* a3 = a2 + kstep; const char* b3 = b2 + kstep;
            if (last && has_next) S.a_ready(nxt);
            if constexpr (SP2) {
            PG8_LDB(B0, 0, 0); PG8_LDB(B1, 0, 1); PG8_SCHED; PG8_LDA(At, 0, 0); PG8_STAGE(PG8_SA(1, 1), a1 + hstep, voffA);
            PG8_WAIT_V(8); PG8_WAIT_L(0); PG8_BAR; PG8_MMA(0, 0, At, B0); PG8_MMA(0, 1, At, B1); PG8_BAR; PG8_SCHED;
            PG8_LDA(At, 0, 1); PG8_STAGE(PG8_SB(0, 0), b2, voffB); PG8_STAGE(PG8_SB(0, 1), b2 + hstep, voffB); PG8_STAGE(PG8_SA(0, 0), a2, voffA);
            PG8_WAIT_V(8); PG8_WAIT_L(0); PG8_BAR; PG8_MMA(1, 0, At, B0); PG8_MMA(1, 1, At, B1); PG8_BAR; PG8_SCHED;
            PG8_LDB(B0, 1, 0); PG8_LDB(B1, 1, 1); PG8_SCHED; PG8_LDA(At, 1, 0); PG8_STAGE(PG8_SA(0, 1), a2 + hstep, voffA);
            PG8_WAIT_V(8); PG8_WAIT_L(0); PG8_BAR; PG8_MMA(0, 0, At, B0); PG8_MMA(0, 1, At, B1); PG8_BAR; PG8_SCHED;
            PG8_LDA(At, 1, 1); PG8_STAGE(PG8_SB(1, 0), b3, voffB); PG8_STAGE(PG8_SB(1, 1), b3 + hstep, voffB); PG8_STAGE(PG8_SA(1, 0), a3, voffA);
            PG8_WAIT_V(8); PG8_WAIT_L(0); PG8_BAR; PG8_MMA(1, 0, At, B0); PG8_MMA(1, 1, At, B1); PG8_BAR; PG8_SCHED;
            } else {
            PG8_LDB(B0, 0, 0); PG8_SCHED; PG8_LDA(At, 0, 0); PG8_STAGE(PG8_SA(1, 1), a1 + hstep, voffA);
            PG8_WAIT_L(8); PG8_BAR; PG8_WAIT_L(0); PG8_MMA(0, 0, At, B0); PG8_BAR; PG8_SCHED;
            PG8_LDB(B1, 0, 1); PG8_STAGE(PG8_SB(0, 0), b2, voffB);
            PG8_BAR; PG8_WAIT_L(0); PG8_MMA(0, 1, At, B1); PG8_BAR;
            PG8_LDA(At, 0, 1); PG8_STAGE(PG8_SA(0, 0), a2, voffA);
            PG8_BAR; PG8_WAIT_L(0); PG8_MMA(1, 0, At, B0); PG8_BAR; PG8_SCHED;
            PG8_STAGE(PG8_SB(0, 1), b2 + hstep, voffB);
            PG8_WAIT_V(6); PG8_BAR; PG8_MMA(1, 1, At, B1); PG8_BAR;
            PG8_LDB(B0, 1, 0); PG8_SCHED; PG8_LDA(At, 1, 0); PG8_STAGE(PG8_SA(0, 1), a2 + hstep, voffA);
            PG8_WAIT_L(8); PG8_BAR; PG8_WAIT_L(0); PG8_MMA(0, 0, At, B0); PG8_BAR; PG8_SCHED;
            PG8_LDB(B1, 1, 1); PG8_STAGE(PG8_SB(1, 0), b3, voffB);
            PG8_BAR; PG8_WAIT_L(0); PG8_MMA(0, 1, At, B1); PG8_BAR;
            PG8_LDA(At, 1, 1); PG8_STAGE(PG8_SA(1, 0), a3, voffA);
            PG8_BAR; PG8_WAIT_L(0); PG8_MMA(1, 0, At, B0); PG8_BAR; PG8_SCHED;
            PG8_STAGE(PG8_SB(1, 1), b3 + hstep, voffB);
            PG8_WAIT_V(6); PG8_BAR; PG8_MMA(1, 1, At, B1); PG8_BAR;
            }
        }
        if constexpr (ALIGN_EPI) { if (wr == 0) PG8_BAR; }
        if constexpr (!Epi::AFTER_DRAIN) { E(acc, cur, wr, wc, fr, fq); S.done(cur); }
        if (!has_next) break;
#pragma unroll
        for (int a = 0; a < 2; ++a)
#pragma unroll
            for (int b = 0; b < 2; ++b)
#pragma unroll
                for (int m = 0; m < 4; ++m)
#pragma unroll
                    for (int n = 0; n < 2; ++n) acc[a][b][m][n] = (f32x4){0.f, 0.f, 0.f, 0.f};
        cur = nxt; cA = nA; cB = nB; ++ui;
        if constexpr (ALIGN_EPI) { if (wr == 1) PG8_BAR; }
    }
    PG8_WAIT_V(0);
    if constexpr (!ALIGN_EPI) { if (wr == 0) PG8_BAR; }
    PG8_BAR;
    if constexpr (Epi::AFTER_DRAIN) { E.fused(acc, cur, wr, wc, fr, fq, lds, wid, lane); S.done(cur); }
#undef PG8_SA
#undef PG8_SB
#undef PG8_STAGE
#undef PG8_LDA
#undef PG8_LDB
#undef PG8_MMA
#undef PG8_WAIT_V
#undef PG8_WAIT_L
#undef PG8_BAR
#undef PG8_SCHED
}
}

#ifndef MK_PER_PHASE
#define MK_PER_PHASE 1
#endif
constexpr int NB = 8, SEQ = 2048, DM = 2048, MTOK = NB * SEQ, DEPTH = 4, HD = 128;
constexpr int NMIX = 12, NMEMH = 4, NMEM = 256, DFF = 5632, NGU = 2 * DFF, NGRP = 2, HPG = 6;
constexpr int SB_N = 5120, NSA_N = 3840, NSA_SRC = 3620;
constexpr int SBQ = 0, SBK = 1536, SBV = 3072, SBQM = 4608;
constexpr int NQ = 0, NKC = 1536, NVC = 1792, NKS = 2048, NVS = 2304, NKW = 2560, NVW = 2816, NQM = 3072, NGL = 3584;
constexpr int NCMP = 127, CMPROWS = NB * NGRP * NCMP;
constexpr int WINDOW = 512;
constexpr float NORM_EPS = 1e-6f;
constexpr float SCALE = 0.08838834764831845f;
constexpr float LOG2E = 1.4426950408889634f;
constexpr int NWAVES = 8, NTHR = 512;

constexpr size_t MiB = 1u << 20;
constexpr size_t WS_CTL = 0, CTL_ZERO_BYTES = 1 * MiB;
constexpr size_t WS_WIN = 2 * MiB;
constexpr size_t WS_WO = 22 * MiB;
constexpr size_t WS_WGU = 30 * MiB;
constexpr size_t WS_WD = 74 * MiB;
constexpr size_t WS_WKV = 96 * MiB;
constexpr size_t WS_CW1 = 112 * MiB;
constexpr size_t WS_CW2 = 116 * MiB;
constexpr size_t WS_MEMB = 117 * MiB;
constexpr size_t WS_MEMKV = 125 * MiB;
constexpr size_t WS_COS = 141 * MiB, WS_SIN = 145 * MiB;
constexpr size_t WS_RSTD = 149 * MiB;
constexpr size_t WS_SEL = 150 * MiB;
constexpr size_t WS_KCMP = 151 * MiB;
constexpr size_t WS_XB = 152 * MiB;
constexpr size_t WS_TMP = 216 * MiB;
constexpr size_t WS_ACT = 280 * MiB;
constexpr size_t WS_GU = 456 * MiB;
constexpr size_t WS_PROJ = 456 * MiB;
constexpr size_t WS_OCAT = 616 * MiB;
constexpr size_t WS_END = 808 * MiB;
constexpr int CW_BAR = 4096;

constexpr int RING_BYTES = 131072;
constexpr int LDSCTL_OFF = 143360, MISC_OFF = LDSCTL_OFF + 320;
constexpr int LDS_BYTES = 147456;
constexpr int SHM_T = 16384;
constexpr int A_V = 0, A_K = 2 * SHM_T, A_WS = 4 * SHM_T, A_FLAGS = A_WS + NWAVES * 64 * 4, A_STASH = 67584;

#define GAS __attribute__((address_space(1)))
#define LAS __attribute__((address_space(3)))
typedef unsigned short bf16_t;
typedef unsigned v4u __attribute__((ext_vector_type(4)));
typedef unsigned v2u __attribute__((ext_vector_type(2)));
typedef float f32x4 __attribute__((ext_vector_type(4)));
typedef float f32x16 __attribute__((ext_vector_type(16)));
typedef short bf16x8 __attribute__((ext_vector_type(8)));
typedef short s16x4 __attribute__((ext_vector_type(4)));
typedef GAS unsigned gu32;
#define RLX_AGENT __ATOMIC_RELAXED, __HIP_MEMORY_SCOPE_AGENT
#define LDS_WAIT() asm volatile("s_waitcnt lgkmcnt(0)" ::: "memory")
#define VM_WAIT() asm volatile("s_waitcnt vmcnt(0)" ::: "memory")
#define SBAR() __builtin_amdgcn_sched_barrier(0)
__device__ __forceinline__ unsigned cvtpk(float lo, float hi) { unsigned r; asm volatile("v_cvt_pk_bf16_f32 %0, %1, %2" : "=v"(r) : "v"(lo), "v"(hi)); return r; }
__device__ __forceinline__ float bf2f(unsigned short b) { return __uint_as_float((unsigned)b << 16); }
__device__ __forceinline__ float bflo(unsigned w) { return __uint_as_float(w << 16); }
__device__ __forceinline__ float bfhi(unsigned w) { return __uint_as_float(w & 0xffff0000u); }
__device__ __forceinline__ bf16x8 pack8(f32x4 a, f32x4 b) { v4u w = {cvtpk(a[0], a[1]), cvtpk(a[2], a[3]), cvtpk(b[0], b[1]), cvtpk(b[2], b[3])}; return __builtin_bit_cast(bf16x8, w); }
__device__ __forceinline__ void unpack8(bf16x8 v, f32x4& a, f32x4& b) { const v4u w = __builtin_bit_cast(v4u, v); a = (f32x4){bflo(w.x), bfhi(w.x), bflo(w.y), bfhi(w.y)}; b = (f32x4){bflo(w.z), bfhi(w.z), bflo(w.w), bfhi(w.w)}; }
__device__ __forceinline__ float wave_sum(float v) {
#pragma unroll
    for (int o = 1; o < 64; o <<= 1) v += __shfl_xor(v, o);
    return v;
}
__device__ __forceinline__ float sigmoidf_(float x) { return 1.f / (1.f + __builtin_amdgcn_exp2f(-x * LOG2E)); }

__device__ const float INV_FREQ[64] = {1.000000000e+00f, 8.659643531e-01f, 7.498942018e-01f, 6.493816376e-01f, 5.623413324e-01f, 4.869675338e-01f, 4.216965139e-01f, 3.651741147e-01f, 3.162277639e-01f, 2.738419771e-01f, 2.371373773e-01f, 2.053525001e-01f, 1.778279394e-01f, 1.539926529e-01f, 1.333521456e-01f, 1.154781953e-01f, 1.000000015e-01f, 8.659642935e-02f, 7.498942316e-02f, 6.493816525e-02f, 5.623413250e-02f, 4.869675264e-02f, 4.216964915e-02f, 3.651741147e-02f, 3.162277490e-02f, 2.738419548e-02f, 2.371373773e-02f, 2.053525113e-02f, 1.778279431e-02f, 1.539926510e-02f, 1.333521400e-02f, 1.154781971e-02f, 9.999999776e-03f, 8.659643121e-03f, 7.498942316e-03f, 6.493816152e-03f, 5.623413250e-03f, 4.869675264e-03f, 4.216964822e-03f, 3.651741194e-03f, 3.162277630e-03f, 2.738419687e-03f, 2.371373819e-03f, 2.053525066e-03f, 1.778279431e-03f, 1.539926510e-03f, 1.333521446e-03f, 1.154782018e-03f, 1.000000047e-03f, 8.659643354e-04f, 7.498941850e-04f, 6.493816036e-04f, 5.623413017e-04f, 4.869675322e-04f, 4.216965172e-04f, 3.651741135e-04f, 3.162277571e-04f, 2.738419571e-04f, 2.371373703e-04f, 2.053525095e-04f, 1.778279402e-04f, 1.539926598e-04f, 1.333521504e-04f, 1.154782003e-04f};
#define XB_TMO      128
#define XB_XCNT(j)  (256  + 64 * (j))
#define XB_XSUB(j)  (1280 + 64 * (j))
#define XB_XGEN(j)  (2304 + 64 * (j))
#define XB_TOP      3328
#define XB_TOPGEN   3392
#define XCD_BAR_WORDS 3456
#define XB_SPIN_CAP (1u << 18)

__device__ __forceinline__ unsigned xb_ld(unsigned* p)              { return __hip_atomic_load(p, __ATOMIC_RELAXED, __HIP_MEMORY_SCOPE_AGENT); }
__device__ __forceinline__ unsigned xb_add(unsigned* p, unsigned v) { return __hip_atomic_fetch_add(p, v, __ATOMIC_RELAXED, __HIP_MEMORY_SCOPE_AGENT); }
__device__ __forceinline__ unsigned xb_xcc_id() { return (unsigned)__builtin_amdgcn_s_getreg((3 << 11) | 20) & 0xFu; }
#define XB_SPIN(cond, bar) do { unsigned _sp = 0; while (cond) { __builtin_amdgcn_s_sleep(1); \
    if ((++_sp & 255u) == 0u) { if (xb_ld(&(bar)[XB_TMO])) break; if (_sp > XB_SPIN_CAP) { atomicAdd(&(bar)[XB_TMO], 1u); break; } } } } while (0)

struct XcdBarrier {
    unsigned* bar; unsigned x;
    volatile LAS unsigned* st;
};

__device__ __forceinline__ XcdBarrier xcd_barrier_post(unsigned* bar, volatile LAS unsigned* st) {
    XcdBarrier b; b.bar = bar; b.x = xb_xcc_id(); b.st = st;
    if (threadIdx.x == 0) (void)xb_add(&bar[XB_XCNT(b.x)], 1u);
    return b;
}
__device__ __forceinline__ void xcd_barrier_complete(unsigned* bar, unsigned x, unsigned& nloc, unsigned& nx) {
    const unsigned G = gridDim.x * gridDim.y * gridDim.z;
    unsigned sum, cnt, mine, sp = 0u;
    for (;;) {
        sum = 0u; cnt = 0u; mine = 0u;
#pragma unroll
        for (unsigned j = 0; j < 16; ++j) { const unsigned c = xb_ld(&bar[XB_XCNT(j)]); sum += c; cnt += (c > 0u) ? 1u : 0u; mine = (j == x) ? c : mine; }
        if (sum == G) break;
        __builtin_amdgcn_s_sleep(1);
        if ((++sp & 255u) == 0u) { if (xb_ld(&bar[XB_TMO])) break; if (sp > XB_SPIN_CAP) { atomicAdd(&bar[XB_TMO], 1u); break; } }
    }
    nloc = mine > 0u ? mine : 1u; nx = cnt > 0u ? cnt : 1u;
}

__device__ __forceinline__ void xcd_barrier(const XcdBarrier& b) {
    asm volatile("s_waitcnt vmcnt(0)" ::: "memory");
    __syncthreads();
    if (threadIdx.x == 0) {
        unsigned* bar = b.bar;
        __builtin_amdgcn_s_waitcnt(0);
        unsigned nloc = b.st[0], nx = b.st[1];
        if (nloc == 0u) { xcd_barrier_complete(bar, b.x, nloc, nx); b.st[0] = nloc; b.st[1] = nx; }
        const unsigned old = xb_add(&bar[XB_XSUB(b.x)], 1u);
        const unsigned gen = old / nloc;
        if (old + 1u == (gen + 1u) * nloc) {
            __builtin_amdgcn_fence(__ATOMIC_RELEASE, "agent");
            asm volatile("s_waitcnt vmcnt(0)" ::: "memory");
            const unsigned og = xb_add(&bar[XB_TOP], 1u);
            const unsigned tg = og / nx;
            if (og + 1u == (tg + 1u) * nx) xb_add(&bar[XB_TOPGEN], 1u);
            else XB_SPIN(xb_ld(&bar[XB_TOPGEN]) == tg, bar);
            __builtin_amdgcn_fence(__ATOMIC_ACQUIRE, "agent");
            xb_add(&bar[XB_XGEN(b.x)], 1u);
            asm volatile("s_waitcnt vmcnt(0)" ::: "memory");
        } else {
            XB_SPIN(xb_ld(&bar[XB_XGEN(b.x)]) == gen, bar);
            __builtin_amdgcn_fence(__ATOMIC_ACQUIRE, "agent");
            asm volatile("s_waitcnt vmcnt(0)" ::: "memory");
        }
    }
    __syncthreads();
}

#define KSWZ(row, colB) ((row) * 256 + ((colB) ^ (((row) & 7) << 4)))
__device__ __forceinline__ int v_st(int k, int c) { const int kk = (k & ~0xC) | ((k & 4) << 1) | ((k & 8) >> 1); return ((kk >> 3) * 4 + (c >> 5)) * 512 + ((kk & 7) * 32 + (c & 31)) * 2; }
__device__ __forceinline__ int v_rd_base(int lane) { return ((lane & 3) << 3) | (((lane >> 2) & 3) << 6) | (((lane >> 4) & 1) << 5) | (((lane >> 5) & 1) << 8); }
constexpr int v_rd_off(int d0, int ks, int half) { return d0 * 512 + ks * 4096 + half * 2048; }
__device__ __forceinline__ int crow(int r, int hi) { return (r & 3) + 8 * (r >> 2) + 4 * hi; }

struct ACtx {
    LAS unsigned char* lds;
    int tid, wid, lane, r32, hi, sr, sc, kws, vst0, vst1, vb0;
    LAS float* ws;
};
__device__ __forceinline__ ACtx make_actx(LAS unsigned char* lds) {
    ACtx c; c.lds = lds; { int t_ = threadIdx.x; asm volatile("" : "+v"(t_)); c.tid = t_; } c.wid = __builtin_amdgcn_readfirstlane(c.tid >> 6); c.lane = c.tid & 63; c.r32 = c.lane & 31; c.hi = c.lane >> 5;
    c.sr = c.tid >> 4; c.sc = (c.tid & 15) * 8; c.kws = KSWZ(c.sr, c.sc * 2); c.vst0 = v_st(c.sr, c.sc); c.vst1 = v_st(32 + c.sr, c.sc);
    c.vb0 = (int)(unsigned)(size_t)(lds + A_V) + v_rd_base(c.lane);
    c.ws = (LAS float*)(lds + A_WS) + c.wid * 64;
    return c;
}
struct Stage { bf16x8 k0, k1, v0, v1; };
__device__ __forceinline__ void stage_load(Stage& S, const bf16_t* Kp, const bf16_t* Vp, int pitch, int kb, const ACtx& c) {
    S.v0 = *(const bf16x8*)(Vp + (size_t)(kb + c.sr) * pitch + c.sc); S.v1 = *(const bf16x8*)(Vp + (size_t)(kb + 32 + c.sr) * pitch + c.sc);
    S.k0 = *(const bf16x8*)(Kp + (size_t)(kb + c.sr) * pitch + c.sc); S.k1 = *(const bf16x8*)(Kp + (size_t)(kb + 32 + c.sr) * pitch + c.sc);
}
__device__ __forceinline__ void stage_write(const Stage& S, int buf, const ACtx& c) {
    LAS unsigned char* Kb = c.lds + A_K + buf * SHM_T; LAS unsigned char* Vb = c.lds + A_V + buf * SHM_T;
    *(LAS bf16x8*)(Kb + c.kws) = S.k0; *(LAS bf16x8*)(Kb + c.kws + 32 * 256) = S.k1;
    *(LAS bf16x8*)(Vb + c.vst0) = S.v0; *(LAS bf16x8*)(Vb + c.vst1) = S.v1;
}
__device__ __forceinline__ void qkt(f32x16& p0, f32x16& p1, int buf, const ACtx& c, const bf16x8* qr) {
    p0 = (f32x16){}; p1 = (f32x16){};
    const LAS unsigned char* Kb = c.lds + A_K + buf * SHM_T;
    const LAS unsigned char* kb[4];
#pragma unroll
    for (int dd = 0; dd < 4; ++dd) kb[dd] = Kb + KSWZ(c.r32, (dd * 16 + c.hi * 8) * 2);
#pragma unroll
    for (int d0 = 0; d0 < 8; ++d0) { const LAS unsigned char* a = kb[d0 & 3] + (d0 >> 2) * 128;
        const bf16x8 b0 = *(const LAS bf16x8*)a; const bf16x8 b1 = *(const LAS bf16x8*)(a + 32 * 256);
        p0 = __builtin_amdgcn_mfma_f32_32x32x16_bf16(b0, qr[d0], p0, 0, 0, 0);
        p1 = __builtin_amdgcn_mfma_f32_32x32x16_bf16(b1, qr[d0], p1, 0, 0, 0); }
}
__device__ __forceinline__ void pv_tile(f32x16* o, int buf, const ACtx& c, bf16x8 pa0, bf16x8 pa1, bf16x8 pa2, bf16x8 pa3) {
    const int vb = c.vb0 + buf * SHM_T;
#define TRRD(dst, off) asm volatile("ds_read_b64_tr_b16 %0, %1 offset:%2" : "=&v"(dst) : "v"(vb), "i"(off) : "memory")
#define PV_D0(d0) do { s16x4 l0, l1, l2, l3, h0, h1, h2, h3; constexpr int b_ = v_rd_off(d0, 0, 0); \
        TRRD(l0, b_); TRRD(h0, b_ + 2048); TRRD(l1, b_ + 4096); TRRD(h1, b_ + 6144); TRRD(l2, b_ + 8192); TRRD(h2, b_ + 10240); TRRD(l3, b_ + 12288); TRRD(h3, b_ + 14336); \
        asm volatile("s_waitcnt lgkmcnt(0)" ::: "memory"); SBAR(); \
        o[d0] = __builtin_amdgcn_mfma_f32_32x32x16_bf16(pa0, (bf16x8){l0[0], l0[1], l0[2], l0[3], h0[0], h0[1], h0[2], h0[3]}, o[d0], 0, 0, 0); \
        o[d0] = __builtin_amdgcn_mfma_f32_32x32x16_bf16(pa1, (bf16x8){l1[0], l1[1], l1[2], l1[3], h1[0], h1[1], h1[2], h1[3]}, o[d0], 0, 0, 0); \
        o[d0] = __builtin_amdgcn_mfma_f32_32x32x16_bf16(pa2, (bf16x8){l2[0], l2[1], l2[2], l2[3], h2[0], h2[1], h2[2], h2[3]}, o[d0], 0, 0, 0); \
        o[d0] = __builtin_amdgcn_mfma_f32_32x32x16_bf16(pa3, (bf16x8){l3[0], l3[1], l3[2], l3[3], h3[0], h3[1], h3[2], h3[3]}, o[d0], 0, 0, 0); } while (0)
    PV_D0(0); PV_D0(1); PV_D0(2); PV_D0(3);
#undef PV_D0
#undef TRRD
}
__device__ __forceinline__ float swap_max(float v) { auto rr = __builtin_amdgcn_permlane32_swap(__float_as_uint(v), __float_as_uint(v), false, false); return fmaxf(__uint_as_float(rr[0]), __uint_as_float(rr[1])); }
__device__ __forceinline__ float swap_sum(float v) { auto rr = __builtin_amdgcn_permlane32_swap(__float_as_uint(v), __float_as_uint(v), false, false); return __uint_as_float(rr[0]) + __uint_as_float(rr[1]); }
__device__ __forceinline__ void swap_both(float v, float& lo, float& hi) { auto rr = __builtin_amdgcn_permlane32_swap(__float_as_uint(v), __float_as_uint(v), false, false); lo = __uint_as_float(rr[0]); hi = __uint_as_float(rr[1]); }
__device__ __forceinline__ void pack_p(const f32x16& p0, const f32x16& p1, bf16x8& pa0, bf16x8& pa1, bf16x8& pa2, bf16x8& pa3) {
#define PK4(P, B_, OUT) do { unsigned a0 = cvtpk(P[B_+0], P[B_+1]), a1 = cvtpk(P[B_+2], P[B_+3]); \
        unsigned b0 = cvtpk(P[B_+4], P[B_+5]), b1 = cvtpk(P[B_+6], P[B_+7]); \
        auto r0 = __builtin_amdgcn_permlane32_swap(a0, b0, false, false); auto r1 = __builtin_amdgcn_permlane32_swap(a1, b1, false, false); \
        v4u w = {r0[0], r1[0], r0[1], r1[1]}; OUT = __builtin_bit_cast(bf16x8, w); } while (0)
    PK4(p0, 0, pa0); PK4(p0, 8, pa1); PK4(p1, 0, pa2); PK4(p1, 8, pa3);
#undef PK4
}
__device__ __forceinline__ void mask_tile(f32x16& p0, f32x16& p1, int dq, unsigned W) {
    const float NEG = -__builtin_inff();
#pragma unroll
    for (int r = 0; r < 16; ++r) { const int cc = (r & 3) + 8 * (r >> 2);
        if ((unsigned)(dq - cc) >= W) p0[r] = NEG;
        if ((unsigned)(dq - cc - 32) >= W) p1[r] = NEG; }
}
constexpr float THR = 8.f;
__device__ __forceinline__ void softmax_tile(f32x16& p0, f32x16& p1, float& m_reg, float& l_reg, f32x16* o, const ACtx& c) {
    float pmax = p0[0];
#pragma unroll
    for (int r = 1; r < 16; ++r) pmax = fmaxf(pmax, p0[r]);
#pragma unroll
    for (int r = 0; r < 16; ++r) pmax = fmaxf(pmax, p1[r]);
    pmax = swap_max(pmax);
    constexpr float C2 = LOG2E * SCALE;
    float mn, alpha;
    if (__all((pmax - m_reg) * SCALE <= THR)) { mn = m_reg; alpha = 1.f; }
    else { mn = fmaxf(m_reg, pmax); alpha = __builtin_amdgcn_exp2f((m_reg - mn) * C2); m_reg = mn; }
    const float mnL = -mn * C2;
#pragma unroll
    for (int r = 0; r < 16; ++r) { p0[r] = __builtin_amdgcn_exp2f(fmaf(p0[r], C2, mnL)); p1[r] = __builtin_amdgcn_exp2f(fmaf(p1[r], C2, mnL)); }
    float ps = 0.f;
#pragma unroll
    for (int r = 0; r < 16; ++r) ps += p0[r] + p1[r];
    ps = swap_sum(ps);
    l_reg = l_reg * alpha + ps;
    if (__any(alpha < 1.f)) {
        if (c.hi == 0) c.ws[32 + c.r32] = alpha;
        LDS_WAIT();
#pragma unroll
        for (int r = 0; r < 16; ++r) { const float a = c.ws[32 + crow(r, c.hi)];
#pragma unroll
            for (int d = 0; d < 4; ++d) o[d][r] *= a; }
    }
}
__device__ __forceinline__ void row_factors(float f, float (&fr)[16], const ACtx& c) {
    LDS_WAIT();
    if (c.hi == 0) c.ws[c.r32] = f;
    LDS_WAIT();
#pragma unroll
    for (int r = 0; r < 16; ++r) fr[r] = c.ws[crow(r, c.hi)];
    LDS_WAIT();
}
template <bool ROPE>
__device__ __forceinline__ void load_q(bf16x8 (&qr)[8], const bf16_t* qrow, const float* cosr, const float* sinr, int hi) {
#pragma unroll
    for (int d0 = 0; d0 < 8; ++d0) qr[d0] = *(const bf16x8*)(qrow + d0 * 16 + hi * 8);
    if constexpr (ROPE) {
#pragma unroll
        for (int d0 = 0; d0 < 4; ++d0) {
            const int i0 = d0 * 16 + hi * 8;
            const f32x4 c0 = *(const f32x4*)(cosr + i0), c1 = *(const f32x4*)(cosr + i0 + 4), s0 = *(const f32x4*)(sinr + i0), s1 = *(const f32x4*)(sinr + i0 + 4);
            f32x4 a0, a1, b0, b1; unpack8(qr[d0], a0, a1); unpack8(qr[d0 + 4], b0, b1);
            qr[d0] = pack8(a0 * c0 - b0 * s0, a1 * c1 - b1 * s1);
            qr[d0 + 4] = pack8(b0 * c0 + a0 * s0, b1 * c1 + a1 * s1);
        }
    }
}
__device__ __forceinline__ void store_o_bf16(const f32x16* o, bf16_t* Ow  , int pitch, const ACtx& c) {
#pragma unroll
    for (int r = 0; r < 16; ++r) { const int orow = crow(r, c.hi);
#pragma unroll
        for (int d0 = 0; d0 < 4; ++d0) { const float v = o[d0][r]; const float vn = __shfl_xor(v, 1);
            if ((c.r32 & 1) == 0) *(unsigned*)(Ow + (size_t)orow * pitch + d0 * 32 + c.r32) = cvtpk(v, vn); } }
}

template <int MODE>
__device__ __forceinline__ void softmax_sweep(const ACtx& c, const bf16x8 (&qr)[8], f32x16 (&o)[4], float& l_out, const bf16_t* Kp, const bf16_t* Vp, int pitch,
                                              int j_lo, int j_hi, int qpos, int qlo, unsigned selbits) {
    float m_reg = -1e30f, l_reg = 0.f;
#pragma unroll
    for (int d = 0; d < 4; ++d) o[d] = (f32x16){};
    Stage S; stage_load(S, Kp, Vp, pitch, j_lo * 64, c);
    for (int j = j_lo; j < j_hi; ++j) {
        const int buf = (j - j_lo) & 1;
        stage_write(S, buf, c);
        __syncthreads();
        if (j + 1 < j_hi) stage_load(S, Kp, Vp, pitch, (j + 1) * 64, c);
        const int kb = j * 64;
        bool act = true;
        if (MODE == 1) act = (kb <= qlo + 31) && (kb + 63 >= qlo - (WINDOW - 1));
        if (MODE == 2) act = (kb <= qlo + 31) && __any((int)((selbits >> j) & 1u));
        if (act) {
            f32x16 p0, p1; qkt(p0, p1, buf, c, qr);
            if (MODE == 1) mask_tile(p0, p1, qpos - kb - 4 * c.hi, (unsigned)WINDOW);
            if (MODE == 2) { mask_tile(p0, p1, qpos - kb - 4 * c.hi, 0x7fffffffu);
                if (!((selbits >> j) & 1u)) { const float NEG = -__builtin_inff();
#pragma unroll
                    for (int r = 0; r < 16; ++r) { p0[r] = NEG; p1[r] = NEG; } } }
            softmax_tile(p0, p1, m_reg, l_reg, o, c);
            bf16x8 pa0, pa1, pa2, pa3; pack_p(p0, p1, pa0, pa1, pa2, pa3);
            pv_tile(o, buf, c, pa0, pa1, pa2, pa3);
        }
    }
    __syncthreads();
    l_out = l_reg;
}

struct Params {
    const float* x; const float* mem; const int* positions; const float* norm_g; const float* w_in_sb; const float* w_in_nsa; const float* cmp_pe; const float* cmp_w1; const float* cmp_w2;
    const float* w_mem_kv; const float* w_o; const float* w_gate; const float* w_up; const float* conv_w; const float* conv_b; const float* w_down;
    float* out; unsigned char* ws; int ph_lo, ph_hi;
};
struct Frame {
    LAS unsigned char* lds; int tid, lane, wave, G, bid;
};
#define WSP(T, off) ((T*)(p.ws + (off)))

__device__ __forceinline__ void tr_item(const float* W, int K, int Nsrc, int src_col0, int ncols, const float* gain, bf16_t* WT, int dst_row0, int mode, LAS float* scr, int item, int lane) {
    const int nblk = (ncols + 31) >> 5, kb = item / nblk, nb = item - kb * nblk, k0 = 64 * kb, n0 = 32 * nb;
    const int n = n0 + (lane & 31); const bool ok = (W != nullptr) && (n < ncols);
#pragma unroll 8
    for (int i = 0; i < 32; ++i) { const int kk = 2 * i + (lane >> 5); float v = 0.f;
        if (ok) { v = W[(size_t)(k0 + kk) * Nsrc + src_col0 + n]; if (gain) v *= gain[k0 + kk]; }
        scr[kk * 33 + (lane & 31)] = v; }
    LDS_WAIT(); asm volatile("" ::: "memory");
    const int c = lane & 7;
    const int drow0 = dst_row0 + (mode == 0 ? n0 : 256 * (n0 >> 7) + (n0 & 127));
#pragma unroll
    for (int j = 0; j < 4; ++j) { const int nn = (lane >> 3) + 8 * j; const LAS float* s = scr + (8 * c) * 33 + nn;
        v4u o; o.x = cvtpk(s[0 * 33], s[1 * 33]); o.y = cvtpk(s[2 * 33], s[3 * 33]); o.z = cvtpk(s[4 * 33], s[5 * 33]); o.w = cvtpk(s[6 * 33], s[7 * 33]);
        *(v4u*)(WT + (size_t)(drow0 + nn) * K + k0 + 8 * c) = o; }
    LDS_WAIT(); asm volatile("" ::: "memory");
}
__device__ __forceinline__ void row_to_bf16_rstd(const float* xrow, bf16_t* orow, float* rstd_out, int lane) {
    const f32x4* xr = (const f32x4*)xrow + lane; f32x4 v[8]; float s = 0.f;
#pragma unroll
    for (int j = 0; j < 8; ++j) { v[j] = xr[64 * j]; s += (v[j].x * v[j].x + v[j].y * v[j].y) + (v[j].z * v[j].z + v[j].w * v[j].w); }
    s = wave_sum(s);
    v2u* o8 = (v2u*)orow + lane;
#pragma unroll
    for (int j = 0; j < 8; ++j) { v2u w; w.x = cvtpk(v[j].x, v[j].y); w.y = cvtpk(v[j].z, v[j].w); o8[64 * j] = w; }
    if (lane == 0) *rstd_out = 1.0f / sqrtf(s * (1.0f / DM) + NORM_EPS);
}
template <class PP> __device__ __forceinline__ void phase_convert(const PP& p, const Frame& F, int L) {
    LAS float* scr = (LAS float*)(F.lds + F.wave * 16384);
    const int gw = F.bid * NWAVES + F.wave, NGW = F.G * NWAVES;
    int it0 = gw;
#define TR(W, K, Nsrc, sc0, nc, gain, WT, dr0, mode) do { const int n_ = ((K) / 64) * (((nc) + 31) >> 5); for (; it0 < n_; it0 += NGW) tr_item(W, K, Nsrc, sc0, nc, gain, WT, dr0, mode, scr, it0, F.lane); it0 -= n_; } while (0)
    const float* g = p.norm_g + (size_t)L * 5 * DM;
    const int j = L >> 1;
    bf16_t* WIN = WSP(bf16_t, WS_WIN);
    if ((L & 1) == 0) {
        TR(p.w_in_sb + (size_t)j * DM * SB_N, DM, SB_N, 0, SB_N, g, WIN, 0, 0);
    } else {
        const float* W = p.w_in_nsa + (size_t)j * DM * NSA_SRC;
        TR(W, DM, NSA_SRC, 0, 3072, g, WIN, 0, 0);
        TR(W, DM, NSA_SRC, 3108, 512, g, WIN, NQM, 0);
        TR(W, DM, NSA_SRC, 3072, 36, g, WIN, NGL, 0);
        TR((const float*)nullptr, DM, NSA_SRC, 0, 192, (const float*)nullptr, WIN, NGL + 64, 0);
        for (int wh = 0; wh < 2; ++wh) {
            TR(p.cmp_w1 + (size_t)(j * 2 + wh) * 4096 * 256, 4096, 256, 0, 256, (const float*)nullptr, WSP(bf16_t, WS_CW1) + (size_t)wh * 256 * 4096, 0, 0);
            TR(p.cmp_w2 + (size_t)(j * 2 + wh) * 256 * 128, 256, 128, 0, 128, (const float*)nullptr, WSP(bf16_t, WS_CW2) + (size_t)wh * 128 * 256, 0, 0);
        }
    }
    TR(p.w_o + (size_t)L * DM * DM, DM, DM, 0, DM, (const float*)nullptr, WSP(bf16_t, WS_WO), 0, 0);
    TR(p.w_gate + (size_t)L * DM * DFF, DM, DFF, 0, DFF, g + 2 * DM, WSP(bf16_t, WS_WGU), 0, 1);
    TR(p.w_up + (size_t)L * DM * DFF, DM, DFF, 0, DFF, g + 2 * DM, WSP(bf16_t, WS_WGU), 128, 1);
    TR(p.w_down + (size_t)L * DFF * DM, DFF, DM, 0, DM, (const float*)nullptr, WSP(bf16_t, WS_WD), 0, 0);
    if (L == 0) {
        for (int l = 0; l < DEPTH; ++l)
            TR(p.w_mem_kv + (size_t)l * DM * 1024, DM, 1024, 0, 1024, p.norm_g + (size_t)(l * 5 + 4) * DM, WSP(bf16_t, WS_WKV), l * 1024, 0);
        float* rstd = WSP(float, WS_RSTD);
        for (int m = gw; m < MTOK; m += NGW) row_to_bf16_rstd(p.x + (size_t)m * DM, WSP(bf16_t, WS_XB) + (size_t)m * DM, rstd + m, F.lane);
        for (int m = gw; m < NB * NMEM; m += NGW) row_to_bf16_rstd(p.mem + (size_t)m * DM, WSP(bf16_t, WS_MEMB) + (size_t)m * DM, rstd + 16384 + m, F.lane);
        float* cosT = WSP(float, WS_COS); float* sinT = WSP(float, WS_SIN);
        for (int idx = F.bid * NTHR + F.tid; idx < MTOK * 64; idx += F.G * NTHR) {
            const int row = idx >> 6, i = idx & 63;
            const float ang = (float)p.positions[row] * INV_FREQ[i];
            double t = (double)ang * 0.15915494309189535; t -= __builtin_rint(t);
            const float fr = (float)t;
            cosT[idx] = __builtin_amdgcn_cosf(fr); sinT[idx] = __builtin_amdgcn_sinf(fr);
        }
    }
#undef TR
}

template <class PP> __device__ __forceinline__ void phase_resid(const PP& p, const Frame& F, const float* xin, const float* gpost) {
    const int gw = F.bid * NWAVES + F.wave, NGW = F.G * NWAVES;
    const bf16_t* T = WSP(bf16_t, WS_TMP); bf16_t* XB = WSP(bf16_t, WS_XB); float* rstd = WSP(float, WS_RSTD);
    for (int m = gw; m < MTOK; m += NGW) {
        const bf16x8* ar = (const bf16x8*)(T + (size_t)m * DM) + F.lane;
        f32x4 a[8]; float s = 0.f;
#pragma unroll
        for (int j = 0; j < 4; ++j) { unpack8(ar[64 * j], a[2 * j], a[2 * j + 1]); }
#pragma unroll
        for (int j = 0; j < 8; ++j) s += (a[j].x * a[j].x + a[j].y * a[j].y) + (a[j].z * a[j].z + a[j].w * a[j].w);
        const float ra = 1.0f / sqrtf(wave_sum(s) * (1.0f / DM) + NORM_EPS);
        float s2 = 0.f;
#pragma unroll
        for (int j = 0; j < 4; ++j) {
            const int e0 = (j * 64 + F.lane) * 8;
#pragma unroll
            for (int h = 0; h < 2; ++h) {
                const f32x4 xv = *(const f32x4*)(xin + (size_t)m * DM + e0 + 4 * h), gv = *(const f32x4*)(gpost + e0 + 4 * h);
                const f32x4 y = xv + a[2 * j + h] * ra * gv;
                a[2 * j + h] = y; s2 += (y.x * y.x + y.y * y.y) + (y.z * y.z + y.w * y.w);
                *(f32x4*)(p.out + (size_t)m * DM + e0 + 4 * h) = y;
            }
            *((bf16x8*)(XB + (size_t)m * DM) + 64 * j + F.lane) = pack8(a[2 * j], a[2 * j + 1]);
        }
        s2 = wave_sum(s2);
        if (F.lane == 0) rstd[m] = 1.0f / sqrtf(s2 * (1.0f / DM) + NORM_EPS);
    }
}
template <class PP> __device__ __forceinline__ void phase_conv(const PP& p, const Frame& F, int L) {
    const bf16_t* GU = WSP(bf16_t, WS_GU); bf16_t* ACT = WSP(bf16_t, WS_ACT);
    const float* cw = p.conv_w + (size_t)L * 3 * DFF; const float* cb = p.conv_b + (size_t)L * DFF;
    constexpr int NCH = DFF / 8;
    for (long it = (long)F.bid * NTHR + F.tid; it < (long)MTOK * NCH; it += (long)F.G * NTHR) {
        const int row = (int)(it / NCH), ch = (int)(it - (long)row * NCH), f0 = ch * 8, t = row & (SEQ - 1);
        const int gcol = 256 * (f0 >> 7) + (f0 & 127);
        const bf16_t* gp = GU + (size_t)row * NGU + gcol;
        f32x4 g0a, g0b, g1a = {0, 0, 0, 0}, g1b = {0, 0, 0, 0}, g2a = {0, 0, 0, 0}, g2b = {0, 0, 0, 0}, ua, ub;
        unpack8(*(const bf16x8*)gp, g0a, g0b); unpack8(*(const bf16x8*)(gp + 128), ua, ub);
        if (t >= 1) unpack8(*(const bf16x8*)(gp - NGU), g1a, g1b);
        if (t >= 2) unpack8(*(const bf16x8*)(gp - 2 * NGU), g2a, g2b);
        const f32x4 w0a = *(const f32x4*)(cw + f0), w0b = *(const f32x4*)(cw + f0 + 4), w1a = *(const f32x4*)(cw + DFF + f0), w1b = *(const f32x4*)(cw + DFF + f0 + 4);
        const f32x4 w2a = *(const f32x4*)(cw + 2 * DFF + f0), w2b = *(const f32x4*)(cw + 2 * DFF + f0 + 4), ba = *(const f32x4*)(cb + f0), bb = *(const f32x4*)(cb + f0 + 4);
        f32x4 ca = ba + g2a * w0a + g1a * w1a + g0a * w2a, cbv = bb + g2b * w0b + g1b * w1b + g0b * w2b;
#pragma unroll
        for (int e = 0; e < 4; ++e) { ca[e] = ca[e] * sigmoidf_(ca[e]) * ua[e]; cbv[e] = cbv[e] * sigmoidf_(cbv[e]) * ub[e]; }
        *(bf16x8*)(ACT + (size_t)row * DFF + f0) = pack8(ca, cbv);
    }
}

template <class PP> __device__ __forceinline__ void sb_unit(const PP& p, const ACtx& c, int b, int h, int qt) {
    const bf16_t* PR = WSP(bf16_t, WS_PROJ); bf16_t* OC = WSP(bf16_t, WS_OCAT);
    const int P0 = qt * 256, qlo = P0 + c.wid * 32, qpos = qlo + c.r32;
    const size_t rowb = (size_t)b * SEQ;
    bf16x8 qr[8]; load_q<false>(qr, PR + (rowb + qpos) * SB_N + SBQ + h * HD, nullptr, nullptr, c.hi);
    const bf16_t* Kp = PR + rowb * SB_N + SBK + h * HD; const bf16_t* Vp = PR + rowb * SB_N + SBV + h * HD;
    f32x16 o[4];
#pragma unroll
    for (int d = 0; d < 4; ++d) o[d] = (f32x16){};
    float C2 = 0.f;
    const int jt = (P0 >> 6) + 3;
    LAS int* flags = (LAS int*)(c.lds + A_FLAGS);
    int done_w = 0;
    Stage S; stage_load(S, Kp, Vp, SB_N, jt * 64, c);
    constexpr float ZS = SCALE * LOG2E;
    for (int it = 0; it <= jt; ++it) {
        const int j = jt - it, buf = it & 1;
        stage_write(S, buf, c);
        if (c.lane == 0) flags[buf * 8 + c.wid] = done_w;
        __syncthreads();
        int alld = 1;
#pragma unroll
        for (int w = 0; w < 8; ++w) alld &= flags[buf * 8 + w];
        if (alld) break;
        if (j > 0) stage_load(S, Kp, Vp, SB_N, (j - 1) * 64, c);
        const int kb = j * 64;
        if (!done_w && kb <= qlo + 30) {
            f32x16 p0, p1; qkt(p0, p1, buf, c, qr);
            const int dq = qpos - kb - 4 * c.hi;
#pragma unroll
            for (int r = 0; r < 16; ++r) { const int cc = (r & 3) + 8 * (r >> 2);
                { const float z = p0[r] * ZS; const float t = __builtin_amdgcn_exp2f(-fabsf(z)); const float v = -(fmaxf(z, 0.f) + __builtin_amdgcn_logf(1.f + t)); p0[r] = (cc < dq) ? v : 0.f; }
                { const float z = p1[r] * ZS; const float t = __builtin_amdgcn_exp2f(-fabsf(z)); const float v = -(fmaxf(z, 0.f) + __builtin_amdgcn_logf(1.f + t)); p1[r] = (cc + 32 < dq) ? v : 0.f; } }
            float E[8], Od[8];
#pragma unroll
            for (int q = 0; q < 4; ++q) { const float g0 = (p0[4 * q] + p0[4 * q + 1]) + (p0[4 * q + 2] + p0[4 * q + 3]); swap_both(g0, E[q], Od[q]);
                                          const float g1 = (p1[4 * q] + p1[4 * q + 1]) + (p1[4 * q + 2] + p1[4 * q + 3]); swap_both(g1, E[4 + q], Od[4 + q]); }
            float T = 0.f, ex[8];
#pragma unroll
            for (int q = 7; q >= 0; --q) { const float to = T; T += Od[q]; const float te = T; T += E[q]; ex[q] = c.hi ? to : te; }
#pragma unroll
            for (int q = 0; q < 4; ++q) {
                { float R = C2 + ex[q]; float ep = __builtin_amdgcn_exp2f(R);
#pragma unroll
                  for (int i = 3; i >= 0; --i) { R += p0[4 * q + i]; const float e = __builtin_amdgcn_exp2f(R); p0[4 * q + i] = ep - e; ep = e; } }
                { float R = C2 + ex[4 + q]; float ep = __builtin_amdgcn_exp2f(R);
#pragma unroll
                  for (int i = 3; i >= 0; --i) { R += p1[4 * q + i]; const float e = __builtin_amdgcn_exp2f(R); p1[4 * q + i] = ep - e; ep = e; } }
            }
            C2 += T;
            bf16x8 pa0, pa1, pa2, pa3; pack_p(p0, p1, pa0, pa1, pa2, pa3);
            pv_tile(o, buf, c, pa0, pa1, pa2, pa3);
            done_w = __all(C2 < -72.f) ? 1 : 0;
        }
    }
    __syncthreads();
    store_o_bf16(o, OC + (rowb + qlo) * DM + h * HD, DM, c);
}
template <class PP> __device__ __forceinline__ void mem_unit(const PP& p, const ACtx& c, int L, int b, int hm, int qt, int projN, int qmcol) {
    const bf16_t* PR = WSP(bf16_t, WS_PROJ); bf16_t* OC = WSP(bf16_t, WS_OCAT); const bf16_t* MKV = WSP(bf16_t, WS_MEMKV);
    const int P0 = qt * 256, qlo = P0 + c.wid * 32, qpos = qlo + c.r32;
    const size_t rowb = (size_t)b * SEQ;
    bf16x8 qr[8]; load_q<false>(qr, PR + (rowb + qpos) * projN + qmcol + hm * HD, nullptr, nullptr, c.hi);
    const bf16_t* Kp = MKV + (size_t)b * NMEM * 4096 + L * 1024 + hm * HD; const bf16_t* Vp = Kp + 512;
    f32x16 o[4]; float l;
    softmax_sweep<0>(c, qr, o, l, Kp, Vp, 4096, 0, 4, qpos, qlo, 0u);
    float fr[16]; row_factors(1.0f / l, fr, c);
#pragma unroll
    for (int d = 0; d < 4; ++d)
#pragma unroll
        for (int r = 0; r < 16; ++r) o[d][r] *= fr[r];
    store_o_bf16(o, OC + (rowb + qlo) * DM + NMIX * HD + hm * HD, DM, c);
}
template <class PP> __device__ __forceinline__ void phase_attn_sb(const PP& p, const Frame& F, int L) {
    const ACtx c = make_actx(F.lds);
    constexpr int NSBU = NB * NMIX * 8, NMU = NB * NMEMH * 8;
    for (int u = F.bid; u < NSBU + NMU; u += F.G) {
        if (u < NSBU) { const int qt = 7 - (u % 8), bh = u / 8; sb_unit(p, c, bh / NMIX, bh % NMIX, qt); }
        else { const int v = u - NSBU; const int qt = v % 8, bh = v / 8; mem_unit(p, c, L, bh / NMEMH, bh % NMEMH, qt, SB_N, SBQM); }
    }
}

template <class PP> __device__ __forceinline__ void phase_nsa_prep(const PP& p, const Frame& F, int L) {
    bf16_t* PR = WSP(bf16_t, WS_PROJ); const float* cosT = WSP(float, WS_COS); const float* sinT = WSP(float, WS_SIN);
    const int j = L >> 1;
    const int lane = F.lane, r32 = lane & 31, hi = lane >> 5;
    LAS bf16_t* hid = (LAS bf16_t*)F.lds;
    for (int u = F.bid; u < 128; u += F.G) {
        const int wh = u & 1, rt = u >> 1;
        int rho = rt * 32 + r32; if (rho > CMPROWS - 1) rho = CMPROWS - 1;
        const int bg = rho / NCMP, cc = rho - bg * NCMP, b = bg >> 1, g = bg & 1;
        const size_t tok0 = (size_t)b * SEQ + 16 * cc;
        const bf16_t* src = PR + tok0 * NSA_N + (wh ? NVC : NKC) + g * HD;
        const float* pe = p.cmp_pe + (size_t)(j * 2 + wh) * 32 * HD;
        const bf16_t* w1 = WSP(bf16_t, WS_CW1) + (size_t)wh * 256 * 4096 + (size_t)(F.wave * 32 + r32) * 4096;
        f32x16 acc = (f32x16){};
        for (int l = 0; l < 32; ++l) {
            const bf16_t* rp = src + (size_t)l * NSA_N; const float* pel = pe + l * HD;
            if (wh == 0) {
                const float* cr = cosT + (tok0 + l) * 64; const float* sr = sinT + (tok0 + l) * 64;
#pragma unroll
                for (int kk = 0; kk < 4; ++kk) { const int d = kk * 16 + hi * 8;
                    f32x4 a0, a1, b0, b1; unpack8(*(const bf16x8*)(rp + d), a0, a1); unpack8(*(const bf16x8*)(rp + 64 + d), b0, b1);
                    const f32x4 c0 = *(const f32x4*)(cr + d), c1 = *(const f32x4*)(cr + d + 4), s0 = *(const f32x4*)(sr + d), s1 = *(const f32x4*)(sr + d + 4);
                    const bf16x8 x1 = pack8(a0 * c0 - b0 * s0 + *(const f32x4*)(pel + d), a1 * c1 - b1 * s1 + *(const f32x4*)(pel + d + 4));
                    const bf16x8 x2 = pack8(b0 * c0 + a0 * s0 + *(const f32x4*)(pel + 64 + d), b1 * c1 + a1 * s1 + *(const f32x4*)(pel + 64 + d + 4));
                    acc = __builtin_amdgcn_mfma_f32_32x32x16_bf16(x1, *(const bf16x8*)(w1 + l * HD + d), acc, 0, 0, 0);
                    acc = __builtin_amdgcn_mfma_f32_32x32x16_bf16(x2, *(const bf16x8*)(w1 + l * HD + 64 + d), acc, 0, 0, 0); }
            } else {
#pragma unroll
                for (int kk = 0; kk < 8; ++kk) { const int d = kk * 16 + hi * 8;
                    f32x4 a0, a1; unpack8(*(const bf16x8*)(rp + d), a0, a1);
                    const bf16x8 x1 = pack8(a0 + *(const f32x4*)(pel + d), a1 + *(const f32x4*)(pel + d + 4));
                    acc = __builtin_amdgcn_mfma_f32_32x32x16_bf16(x1, *(const bf16x8*)(w1 + l * HD + d), acc, 0, 0, 0); }
            }
        }
#pragma unroll
        for (int r = 0; r < 16; ++r) { const float v = acc[r]; const float sv = v * sigmoidf_(v);
            hid[crow(r, hi) * 264 + F.wave * 32 + r32] = (bf16_t)(cvtpk(sv, sv) & 0xffffu); }
        __syncthreads();
        if (F.wave < 4) {
            const bf16_t* w2 = WSP(bf16_t, WS_CW2) + (size_t)wh * 128 * 256 + (size_t)(F.wave * 32 + r32) * 256;
            f32x16 a2 = (f32x16){};
#pragma unroll
            for (int kk = 0; kk < 16; ++kk) { const int k = kk * 16 + hi * 8;
                a2 = __builtin_amdgcn_mfma_f32_32x32x16_bf16(*(const LAS bf16x8*)(hid + r32 * 264 + k), *(const bf16x8*)(w2 + k), a2, 0, 0, 0); }
            bf16_t* outp = WSP(bf16_t, WS_KCMP) + (size_t)wh * 16 * 128 * 128;
#pragma unroll
            for (int r = 0; r < 16; ++r) { const int ro = rt * 32 + crow(r, hi);
                if (ro < CMPROWS) { const int bg2 = ro / NCMP, c2 = ro - bg2 * NCMP; outp[((size_t)bg2 * 128 + c2) * 128 + F.wave * 32 + r32] = (bf16_t)(cvtpk(a2[r], a2[r]) & 0xffffu); } }
        }
        if (rt == 0) { bf16_t* outp = WSP(bf16_t, WS_KCMP) + (size_t)wh * 16 * 128 * 128;
            for (int e = F.tid; e < 16 * 128; e += NTHR) outp[((size_t)(e >> 7) * 128 + 127) * 128 + (e & 127)] = 0; }
        __syncthreads();
    }
    const int gw = F.bid * NWAVES + F.wave, NGW = F.G * NWAVES;
    for (int m = gw; m < MTOK; m += NGW) {
        const float cv = cosT[(size_t)m * 64 + lane], sv = sinT[(size_t)m * 64 + lane];
#pragma unroll
        for (int q = 0; q < 4; ++q) { bf16_t* bp = PR + (size_t)m * NSA_N + ((q < 2) ? NKS : NKW) + (q & 1) * HD;
            const float x1 = bf2f(bp[lane]), x2 = bf2f(bp[64 + lane]);
            const float y1 = x1 * cv - x2 * sv, y2 = x2 * cv + x1 * sv;
            bp[lane] = (bf16_t)(cvtpk(y1, y1) & 0xffffu); bp[64 + lane] = (bf16_t)(cvtpk(y2, y2) & 0xffffu); }
    }
}

template <class PP> __device__ __forceinline__ void cmp_unit(const PP& p, const ACtx& c, int b, int g, int qt) {
    const bf16_t* PR = WSP(bf16_t, WS_PROJ); bf16_t* OC = WSP(bf16_t, WS_OCAT); const float* cosT = WSP(float, WS_COS); const float* sinT = WSP(float, WS_SIN);
    const int P0 = qt * 256, qlo = P0 + c.wid * 32, qpos = qlo + c.r32, hi = c.hi;
    const size_t rowb = (size_t)b * SEQ, row = rowb + qpos;
    const bf16_t* Kp = WSP(bf16_t, WS_KCMP) + (size_t)(b * 2 + g) * 128 * 128; const bf16_t* Vp = Kp + (size_t)16 * 128 * 128;
    { Stage S; stage_load(S, Kp, Vp, 128, 0, c); stage_write(S, 0, c); stage_load(S, Kp, Vp, 128, 64, c); stage_write(S, 1, c); }
    __syncthreads();
    const int cmax = (qpos >= 31) ? (((qpos - 31) >> 4) < 126 ? ((qpos - 31) >> 4) : 126) : -1;
    LAS float* acc_l = (LAS float*)(c.lds + A_STASH) + c.wid * 2048 + c.lane;
    const float NEG = -__builtin_inff();
    constexpr float C2 = LOG2E * SCALE;
#pragma nounroll
    for (int hh = 0; hh < HPG; ++hh) {
        const int h = g * HPG + hh;
        bf16x8 qr[8]; load_q<true>(qr, PR + row * NSA_N + NQ + h * HD, cosT + row * 64, sinT + row * 64, hi);
        f32x16 pA0, pA1, pB0, pB1; qkt(pA0, pA1, 0, c, qr); qkt(pB0, pB1, 1, c, qr);
        float mx = NEG;
#pragma unroll
        for (int r = 0; r < 16; ++r) { const int ci = crow(r, hi);
            if (ci > cmax) pA0[r] = NEG; if (ci + 32 > cmax) pA1[r] = NEG; if (ci + 64 > cmax) pB0[r] = NEG; if (ci + 96 > cmax) pB1[r] = NEG;
            mx = fmaxf(fmaxf(mx, pA0[r]), fmaxf(pA1[r], fmaxf(pB0[r], pB1[r]))); }
        mx = swap_max(mx); if (mx == NEG) mx = 0.f;
        const float mL = -mx * C2; float ls = 0.f;
#pragma unroll
        for (int r = 0; r < 16; ++r) { pA0[r] = __builtin_amdgcn_exp2f(fmaf(pA0[r], C2, mL)); pA1[r] = __builtin_amdgcn_exp2f(fmaf(pA1[r], C2, mL));
            pB0[r] = __builtin_amdgcn_exp2f(fmaf(pB0[r], C2, mL)); pB1[r] = __builtin_amdgcn_exp2f(fmaf(pB1[r], C2, mL)); ls += (pA0[r] + pA1[r]) + (pB0[r] + pB1[r]); }
        ls = swap_sum(ls);
        const float inv = ls > 0.f ? 1.0f / ls : 0.f;
#pragma unroll
        for (int r = 0; r < 16; ++r) { pA0[r] *= inv; pA1[r] *= inv; pB0[r] *= inv; pB1[r] *= inv; }
#define ACC_AB(P, Q0) do { _Pragma("unroll") for (int q = 0; q < 4; ++q) { \
            const float a_ = 2.f * (P[4 * q] + P[4 * q + 1] + P[4 * q + 2]) + P[4 * q + 3], b_ = P[4 * q + 3]; \
            LAS float* pa_ = acc_l + (2 * (Q0 + q)) * 64; \
            if (hh == 0) { pa_[0] = a_; pa_[64] = b_; } else { pa_[0] += a_; pa_[64] += b_; } } } while (0)
        ACC_AB(pA0, 0); ACC_AB(pA1, 4); ACC_AB(pB0, 8); ACC_AB(pB1, 12);
#undef ACC_AB
        f32x16 o[4];
#pragma unroll
        for (int d = 0; d < 4; ++d) o[d] = (f32x16){};
        { bf16x8 pa0, pa1, pa2, pa3; pack_p(pA0, pA1, pa0, pa1, pa2, pa3); pv_tile(o, 0, c, pa0, pa1, pa2, pa3); }
        { bf16x8 pa0, pa1, pa2, pa3; pack_p(pB0, pB1, pa0, pa1, pa2, pa3); pv_tile(o, 1, c, pa0, pa1, pa2, pa3); }
        const float gc = sigmoidf_(bf2f(PR[row * NSA_N + NGL + h * 3 + 0]));
        float fr[16]; row_factors(gc, fr, c);
#pragma unroll
        for (int d = 0; d < 4; ++d)
#pragma unroll
            for (int r = 0; r < 16; ++r) o[d][r] *= fr[r];
        store_o_bf16(o, OC + (rowb + qlo) * DM + h * HD, DM, c);
    }
    float Ie[16], Io[16];
    {
        float imp[16], Bb[16];
#pragma unroll
        for (int q = 0; q < 16; ++q) { float blo, bhi; swap_both(acc_l[(2 * q + 1) * 64], blo, bhi); Bb[q] = hi ? blo : bhi; }
#pragma unroll
        for (int q = 0; q < 16; ++q) imp[q] = acc_l[(2 * q) * 64] + (hi ? Bb[q] : (q > 0 ? Bb[q - 1] : 0.f));
#pragma unroll
        for (int q = 0; q < 16; ++q) swap_both(imp[q], Ie[q], Io[q]);
    }
    const int cur = qpos >> 6;
    unsigned bits;
    if (cur < 16) bits = (2u << cur) - 1u;
    else {
#pragma unroll
        for (int q = 0; q < 16; ++q) { const int je = 2 * q, jo = 2 * q + 1;
            if (!(je >= 1 && je <= cur - 2)) Ie[q] = -1.f; if (!(jo >= 1 && jo <= cur - 2)) Io[q] = -1.f; }
        bits = 0u;
#pragma unroll
        for (int q = 0; q < 16; ++q) {
            const int jm = 2 * q + hi; const float vj = hi ? Io[q] : Ie[q];
            int rank = 0;
#pragma unroll
            for (int q2 = 0; q2 < 16; ++q2) {
                const bool lt_e = (q2 < q) || (q2 == q && hi);
                const bool lt_o = (q2 < q);
                rank += (Ie[q2] > vj || (Ie[q2] == vj && lt_e)) ? 1 : 0;
                rank += (Io[q2] > vj || (Io[q2] == vj && lt_o)) ? 1 : 0;
            }
            const bool forced = (jm == 0) || (jm == cur) || (jm == cur - 1);
            const bool sel = forced || (vj >= 0.f && rank < 13);
            bits |= sel ? (1u << jm) : 0u;
        }
        { auto rr = __builtin_amdgcn_permlane32_swap(bits, bits, false, false); bits = rr[0] | rr[1]; }
    }
    if (hi == 0) WSP(unsigned, WS_SEL)[(size_t)(b * 2 + g) * SEQ + qpos] = bits;
    __syncthreads();
}
template <class PP> __device__ __forceinline__ void phase_attn_cmp(const PP& p, const Frame& F, int L) {
    const ACtx c = make_actx(F.lds);
    constexpr int NCU = NB * NGRP * 8, NMU = NB * NMEMH * 8;
    for (int u = F.bid; u < NCU + NMU; u += F.G) {
        if (u < NCU) { const int qt = u % 8, bg = u / 8; cmp_unit(p, c, bg >> 1, bg & 1, qt); }
        else { const int v = u - NCU; const int qt = v % 8, bh = v / 8; mem_unit(p, c, L, bh / NMEMH, bh % NMEMH, qt, NSA_N, NQM); }
    }
}
template <class PP> __device__ __forceinline__ void selwin_unit(const PP& p, const ACtx& c, int b, int h, int qt) {
    const bf16_t* PR = WSP(bf16_t, WS_PROJ); bf16_t* OC = WSP(bf16_t, WS_OCAT); const float* cosT = WSP(float, WS_COS); const float* sinT = WSP(float, WS_SIN);
    const int P0 = qt * 256, qlo = P0 + c.wid * 32, qpos = qlo + c.r32, g = h / HPG;
    const size_t rowb = (size_t)b * SEQ, row = rowb + qpos;
    bf16x8 qr[8]; load_q<true>(qr, PR + row * NSA_N + NQ + h * HD, cosT + row * 64, sinT + row * 64, c.hi);
    const unsigned selbits = WSP(unsigned, WS_SEL)[(size_t)(b * 2 + g) * SEQ + qpos];
    const float gs = sigmoidf_(bf2f(PR[row * NSA_N + NGL + h * 3 + 1])), gwn = sigmoidf_(bf2f(PR[row * NSA_N + NGL + h * 3 + 2]));
    f32x16 o[4]; float l;
    LAS unsigned* stash = (LAS unsigned*)(c.lds + A_STASH) + c.wid * 2048;
    softmax_sweep<2>(c, qr, o, l, PR + rowb * NSA_N + NKS + g * HD, PR + rowb * NSA_N + NVS + g * HD, NSA_N, 0, (P0 >> 6) + 4, qpos, qlo, selbits);
    {
        float fr[16]; row_factors(l > 0.f ? gs / l : 0.f, fr, c);
        const bf16_t* Ow = OC + (rowb + qlo) * DM + h * HD;
#pragma unroll
        for (int r = 0; r < 16; ++r) { const int orow = crow(r, c.hi);
#pragma unroll
            for (int d0 = 0; d0 < 4; ++d0) o[d0][r] = o[d0][r] * fr[r] + bf2f(Ow[(size_t)orow * DM + d0 * 32 + c.r32]); }
#pragma unroll
        for (int r = 0; r < 16; ++r)
#pragma unroll
            for (int d0 = 0; d0 < 4; d0 += 2) stash[((r * 2 + (d0 >> 1)) * 2 + c.hi) * 32 + c.r32] = cvtpk(o[d0][r], o[d0 + 1][r]);
    }
    const int jlo = (P0 - (WINDOW - 1)) > 0 ? ((P0 - (WINDOW - 1)) >> 6) : 0;
    softmax_sweep<1>(c, qr, o, l, PR + rowb * NSA_N + NKW + g * HD, PR + rowb * NSA_N + NVW + g * HD, NSA_N, jlo, (P0 >> 6) + 4, qpos, qlo, 0u);
    {
        float fr[16]; row_factors(l > 0.f ? gwn / l : 0.f, fr, c);
#pragma unroll
        for (int r = 0; r < 16; ++r)
#pragma unroll
            for (int d0 = 0; d0 < 4; d0 += 2) { const unsigned w = stash[((r * 2 + (d0 >> 1)) * 2 + c.hi) * 32 + c.r32];
                o[d0][r] = o[d0][r] * fr[r] + bflo(w); o[d0 + 1][r] = o[d0 + 1][r] * fr[r] + bfhi(w); }
    }
    store_o_bf16(o, OC + (rowb + qlo) * DM + h * HD, DM, c);
}
template <class PP> __device__ __forceinline__ void phase_attn_selwin(const PP& p, const Frame& F) {
    const ACtx c = make_actx(F.lds);
    constexpr int NU = NB * NMIX * 8;
    for (int u = F.bid; u < NU; u += F.G) { const int qt = 7 - (u / (NB * NMIX)), bh = u % (NB * NMIX); selwin_unit(p, c, bh / NMIX, bh % NMIX, qt); }
}

constexpr int NPH_SB = 9, NPH_NSA = 11, NPH = 2 * (NPH_SB + NPH_NSA);
__global__ void __launch_bounds__(NTHR, 2) mk_fwd(Params p) {
    extern __shared__ __attribute__((aligned(16))) unsigned char lds_raw[];
    LAS unsigned char* const lds0 = (LAS unsigned char*)lds_raw;
typedef const Params __attribute__((address_space(4))) KParams;
#define MKFRAME() KParams* pp_ = (KParams*)__builtin_amdgcn_kernarg_segment_ptr(); asm volatile("" : "+s"(pp_)); KParams& p = *pp_; Frame F; F.lds = lds0; { int t_ = threadIdx.x; asm volatile("" : "+v"(t_)); F.tid = t_; } F.lane = F.tid & 63; F.wave = __builtin_amdgcn_readfirstlane(F.tid >> 6); F.G = gridDim.x; F.bid = blockIdx.x
    for (int u = threadIdx.x; u < (LDS_BYTES - LDSCTL_OFF) / 4; u += NTHR) ((LAS unsigned*)(lds0 + LDSCTL_OFF))[u] = 0u;
    __syncthreads();
    gu32* ctl = (gu32*)(p.ws + WS_CTL);
    XcdBarrier bar; bar.bar = (unsigned*)(ctl + CW_BAR); bar.x = 0; bar.st = nullptr;
#if !MK_PER_PHASE
    bar = xcd_barrier_post((unsigned*)(ctl + CW_BAR), (volatile LAS unsigned*)(lds0 + MISC_OFF) + 8);
#endif
    const int lo = p.ph_lo, hi = p.ph_hi;
    int ph = 0;
#define IN() (lo <= ph && ph < hi)
#if MK_PER_PHASE
#define END_PHASE() do { ++ph; } while (0)
#else
#define END_PHASE() do { if (IN() && ph + 1 < hi) xcd_barrier(bar); ++ph; } while (0)
#endif
#define GEMM_RS(Aoff, Boff, M_, N_, K_, Ooff, ldc_, rs_) do { pg8::Gemm g{WSP(pg8::bf16_t, Aoff), WSP(pg8::bf16_t, Boff), M_, N_, K_}; pg8::StaticOrder S; S.init(M_, N_, F.G, F.bid); \
        pg8::EpiRS E{WSP(pg8::bf16_t, Ooff), ldc_, rs_}; pg8::gemm_phase<pg8::EpiRS, pg8::StaticOrder, true, true>(F.lds, g, S, E); } while (0)

    for (int lp = 0; lp < 2; ++lp) {
        {
            const int L = 2 * lp;
            if (IN()) { MKFRAME(); phase_convert(p, F, L); }
            END_PHASE();
            if (IN()) { MKFRAME(); GEMM_RS(WS_XB, WS_WIN, MTOK, SB_N, DM, WS_PROJ, SB_N, WSP(float, WS_RSTD));
                        if (L == 0) GEMM_RS(WS_MEMB, WS_WKV, NB * NMEM, 4096, DM, WS_MEMKV, 4096, WSP(float, WS_RSTD) + 16384); }
            END_PHASE();
            if (IN()) { MKFRAME(); phase_attn_sb(p, F, L); }
            END_PHASE();
            if (IN()) { MKFRAME(); GEMM_RS(WS_OCAT, WS_WO, MTOK, DM, DM, WS_TMP, DM, (const float*)nullptr); }
            END_PHASE();
            if (IN()) { MKFRAME(); phase_resid(p, F, (L == 0) ? p.x : (const float*)p.out, p.norm_g + (size_t)(L * 5 + 1) * DM); }
            END_PHASE();
            if (IN()) { MKFRAME(); GEMM_RS(WS_XB, WS_WGU, MTOK, NGU, DM, WS_GU, NGU, WSP(float, WS_RSTD)); }
            END_PHASE();
            if (IN()) { MKFRAME(); phase_conv(p, F, L); }
            END_PHASE();
            if (IN()) { MKFRAME(); GEMM_RS(WS_ACT, WS_WD, MTOK, DM, DFF, WS_TMP, DM, (const float*)nullptr); }
            END_PHASE();
            if (IN()) { MKFRAME(); phase_resid(p, F, (const float*)p.out, p.norm_g + (size_t)(L * 5 + 3) * DM); }
            END_PHASE();
        }
        {
            const int L = 2 * lp + 1;
            if (IN()) { MKFRAME(); phase_convert(p, F, L); }
            END_PHASE();
            if (IN()) { MKFRAME(); GEMM_RS(WS_XB, WS_WIN, MTOK, NSA_N, DM, WS_PROJ, NSA_N, WSP(float, WS_RSTD)); }
            END_PHASE();
            if (IN()) { MKFRAME(); phase_nsa_prep(p, F, L); }
            END_PHASE();
            if (IN()) { MKFRAME(); phase_attn_cmp(p, F, L); }
            END_PHASE();
            if (IN()) { MKFRAME(); phase_attn_selwin(p, F); }
            END_PHASE();
            if (IN()) { MKFRAME(); GEMM_RS(WS_OCAT, WS_WO, MTOK, DM, DM, WS_TMP, DM, (const float*)nullptr); }
            END_PHASE();
            if (IN()) { MKFRAME(); phase_resid(p, F, (const float*)p.out, p.norm_g + (size_t)(L * 5 + 1) * DM); }
            END_PHASE();
            if (IN()) { MKFRAME(); GEMM_RS(WS_XB, WS_WGU, MTOK, NGU, DM, WS_GU, NGU, WSP(float, WS_RSTD)); }
            END_PHASE();
            if (IN()) { MKFRAME(); phase_conv(p, F, L); }
            END_PHASE();
            if (IN()) { MKFRAME(); GEMM_RS(WS_ACT, WS_WD, MTOK, DM, DFF, WS_TMP, DM, (const float*)nullptr); }
            END_PHASE();
            if (IN()) { MKFRAME(); phase_resid(p, F, (const float*)p.out, p.norm_g + (size_t)(L * 5 + 3) * DM); }
            END_PHASE();
        }
    }
#undef IN
#undef END_PHASE
#undef GEMM_RS
}

extern "C" void kernel_launch(void* const* d_in, const int* in_sizes, int n_in, void* d_out, int out_size, void* d_ws, size_t ws_size, hipStream_t stream) {
    static int grid = 0;
    if (grid == 0) {
        if (n_in != 16 || out_size != MTOK * DM || ws_size < WS_END) { fprintf(stderr, "kernel_launch: unexpected shapes (n_in %d, out %d, ws %zu < %zu)\n", n_in, out_size, ws_size, (size_t)WS_END); grid = -1; return; }
        int dev = 0, cus = 0, per_cu = 0;
        if (hipGetDevice(&dev) != hipSuccess || hipDeviceGetAttribute(&cus, hipDeviceAttributeMultiprocessorCount, dev) != hipSuccess) { grid = -1; return; }
        if (hipFuncSetAttribute((const void*)mk_fwd, hipFuncAttributeMaxDynamicSharedMemorySize, LDS_BYTES) != hipSuccess) { fprintf(stderr, "kernel_launch: hipFuncSetAttribute failed\n"); grid = -1; return; }
        if (hipOccupancyMaxActiveBlocksPerMultiprocessor(&per_cu, (const void*)mk_fwd, NTHR, LDS_BYTES) != hipSuccess || per_cu < 1) { fprintf(stderr, "kernel_launch: occupancy query says %d\n", per_cu); (void)hipGetLastError(); }
        grid = cus;
    }
    if (grid < 0) return;
    (void)hipMemsetAsync((char*)d_ws + WS_CTL, 0, CTL_ZERO_BYTES, stream);
    Params p{};
    p.x = (const float*)d_in[0]; p.mem = (const float*)d_in[1]; p.positions = (const int*)d_in[2]; p.norm_g = (const float*)d_in[3]; p.w_in_sb = (const float*)d_in[4]; p.w_in_nsa = (const float*)d_in[5];
    p.cmp_pe = (const float*)d_in[6]; p.cmp_w1 = (const float*)d_in[7]; p.cmp_w2 = (const float*)d_in[8]; p.w_mem_kv = (const float*)d_in[9]; p.w_o = (const float*)d_in[10];
    p.w_gate = (const float*)d_in[11]; p.w_up = (const float*)d_in[12]; p.conv_w = (const float*)d_in[13]; p.conv_b = (const float*)d_in[14]; p.w_down = (const float*)d_in[15];
    p.out = (float*)d_out; p.ws = (unsigned char*)d_ws;
#if MK_PER_PHASE
    for (int ph = 0; ph < NPH; ++ph) { p.ph_lo = ph; p.ph_hi = ph + 1; hipLaunchKernelGGL(mk_fwd, dim3(grid), dim3(NTHR), LDS_BYTES, stream, p); }
#else
    p.ph_lo = 0; p.ph_hi = NPH;
    hipLaunchKernelGGL(mk_fwd, dim3(grid), dim3(NTHR), LDS_BYTES, stream, p);
#endif
}
```

```cpp
#include <hip/hip_runtime.h>
#include <cstdio>
#include <cstdint>
namespace pg8 {
#define PG8_LAS __attribute__((address_space(3)))
typedef unsigned short bf16_t;
typedef short bf16x8 __attribute__((ext_vector_type(8)));
typedef float f32x4 __attribute__((ext_vector_type(4)));
typedef unsigned u32x4 __attribute__((ext_vector_type(4)));
constexpr int BM = 256, BK = 64, HALF = 128, HTB = HALF * BK * 2  , STAGE_BYTES = 8 * HTB, NXCD = 8, WGM = 8;

__host__ __device__ __forceinline__ int lds_byte(int r, int c) { const int st = (r >> 4) * 2 + (c >> 5), rr = r & 15, cc = c & 31, ob = rr * 64 + cc * 2; return st * 1024 + (ob ^ (((ob >> 9) & 1) << 5)); }
__host__ __device__ __forceinline__ void stage_rc(int b, int& R, int& C) { const int st = b / 1024, sb = b % 1024, swz = sb ^ (((sb >> 9) & 1) << 5); R = (st >> 1) * 16 + swz / 64; C = (st & 1) * 32 + (swz % 64) / 2; }
__host__ __device__ __forceinline__ int perm32(int rho) { const int n = rho >> 4, i = rho & 15; return 8 * (i >> 2) + 4 * n + (i & 3); }

struct Unit { int pm, pn; };
struct Gemm { const bf16_t* A; const bf16_t* Bt; int M, N, K; };

struct StaticOrder {
    int nM, nN, nwg, G, c;
    __host__ __device__ void init(int M, int N, int G_, int c_) { nM = M / BM; nN = N / BM; nwg = nM * nN; G = G_; c = c_; }
    __host__ __device__ bool next(int i, Unit& u) const {
        const long L = (long)i * G + c; if (L >= nwg) return false;
        int wgid = (int)L; { const int q = nwg / NXCD, r = nwg % NXCD, xcd = wgid % NXCD, off = wgid / NXCD; wgid = (xcd < r ? xcd * (q + 1) : r * (q + 1) + (xcd - r) * q) + off; }
        const int nig = WGM * nN, gid = wgid / nig, fm = gid * WGM, gsz = (nM - fm) < WGM ? (nM - fm) : WGM;
        u.pm = fm + ((wgid % nig) % gsz); u.pn = (wgid % nig) / gsz; return true;
    }
    __device__ __forceinline__ void a_ready(const Unit&) const {}
    __device__ __forceinline__ void done(const Unit&) const {}
};

__device__ __forceinline__ unsigned cvt_pk_bf16(float lo, float hi) { unsigned r; asm volatile("v_cvt_pk_bf16_f32 %0, %1, %2" : "=v"(r) : "v"(lo), "v"(hi)); return r; }
typedef float f32x2 __attribute__((ext_vector_type(2)));
struct EpiRS {
    static constexpr bool PERM = true, AFTER_DRAIN = false;
    bf16_t* O; int ldc; const float* rs;
    __device__ __forceinline__ void operator()(const f32x4 (&acc)[2][2][4][2], const Unit& u, int wr, int wc, int fr, int fq) const {
        const int row0 = u.pm * BM + wr * 64 + fr; const int col0 = u.pn * BM + wc * 32 + 8 * fq;
#pragma unroll
        for (int ai = 0; ai < 2; ++ai)
#pragma unroll
            for (int m = 0; m < 4; ++m) { const int row = row0 + ai * HALF + m * 16; const float sc = rs ? rs[row] : 1.f; bf16_t* rowp = O + (size_t)row * ldc + col0;
#pragma unroll
                for (int bj = 0; bj < 2; ++bj) { const f32x4 v0 = acc[ai][bj][m][0] * sc, v1 = acc[ai][bj][m][1] * sc;
                    u32x4 w; w.x = cvt_pk_bf16(v0[0], v0[1]); w.y = cvt_pk_bf16(v0[2], v0[3]); w.z = cvt_pk_bf16(v1[0], v1[1]); w.w = cvt_pk_bf16(v1[2], v1[3]);
                    *(u32x4*)(rowp + bj * HALF) = w; } }
    }
};
template <class Epi, class Sched, bool ALIGN_EPI = false, bool SP2 = false>
__device__ __forceinline__ void gemm_phase(PG8_LAS unsigned char* lds, const Gemm g, const Sched& S, const Epi& E) {
    int tid_ = threadIdx.x; asm volatile("" : "+v"(tid_));
    const int tid = tid_, wid = __builtin_amdgcn_readfirstlane(tid >> 6), lane = tid & 63, wr = wid >> 2, wc = wid & 3, fr = lane & 15, fq = lane >> 4;
    const int K = g.K, nt = K / BK;
    unsigned voffA[2], voffB[2];
#pragma unroll
    for (int i = 0; i < 2; ++i) { int R, C; stage_rc(tid * 16 + i * 8192, R, C); const int Rb = Epi::PERM ? ((R & ~31) + perm32(R & 31)) : R;
        voffA[i] = (unsigned)(R * K + C) * 2u; voffB[i] = (unsigned)(Rb * K + C) * 2u; }
    const size_t kstep = (size_t)(BK * 2);
    const size_t hstep = (size_t)HALF * K * 2;
    const size_t tstep = 2 * hstep;
    const unsigned ldsw = (unsigned)wid * 1024u;
    const int aoff = lds_byte(wr * 64 + fr, fq * 8), boff = lds_byte(wc * 32 + fr, fq * 8);
#define PG8_SA(b, h) (((b) * 2 + (h)) * HTB)
#define PG8_SB(b, h) ((4 + (b) * 2 + (h)) * HTB)
#define PG8_STAGE(bufoff, gbase, voff) do { _Pragma("unroll") for (int _i = 0; _i < 2; ++_i) \
        __builtin_amdgcn_global_load_lds((const unsigned*)((const char*)(gbase) + (voff)[_i]), (PG8_LAS unsigned*)(lds + (bufoff) + ldsw + _i * 8192), 16, 0, 0); } while (0)
#define PG8_LDA(dst, b, h) do { _Pragma("unroll") for (int m = 0; m < 4; ++m) _Pragma("unroll") for (int k = 0; k < 2; ++k) dst[m][k] = *(const PG8_LAS bf16x8*)(lds + PG8_SA(b, h) + aoff + m * 2048 + k * 1024); } while (0)
#define PG8_LDB(dst, b, h) do { _Pragma("unroll") for (int n = 0; n < 2; ++n) _Pragma("unroll") for (int k = 0; k < 2; ++k) dst[n][k] = *(const PG8_LAS bf16x8*)(lds + PG8_SB(b, h) + boff + n * 2048 + k * 1024); } while (0)
#define PG8_MMA(ai, bj, At, Bt) do { __builtin_amdgcn_s_setprio(1); _Pragma("unroll") for (int m = 0; m < 4; ++m) _Pragma("unroll") for (int n = 0; n < 2; ++n) _Pragma("unroll") for (int k = 0; k < 2; ++k) \
        acc[ai][bj][m][n] = __builtin_amdgcn_mfma_f32_16x16x32_bf16(Bt[n][k], At[m][k], acc[ai][bj][m][n], 0, 0, 0); __builtin_amdgcn_s_setprio(0); } while (0)
#define PG8_WAIT_V(n) asm volatile("s_waitcnt vmcnt(" #n ")" ::: "memory")
#define PG8_WAIT_L(n) asm volatile("s_waitcnt lgkmcnt(" #n ")" ::: "memory")
#define PG8_BAR __builtin_amdgcn_s_barrier()
#define PG8_SCHED __builtin_amdgcn_sched_barrier(0)
    Unit cur, nxt; int ui = 0;
    if (!S.next(0, cur)) return;
    f32x4 acc[2][2][4][2];
#pragma unroll
    for (int a = 0; a < 2; ++a)
#pragma unroll
        for (int b = 0; b < 2; ++b)
#pragma unroll
            for (int m = 0; m < 4; ++m)
#pragma unroll
                for (int n = 0; n < 2; ++n) acc[a][b][m][n] = (f32x4){0.f, 0.f, 0.f, 0.f};
    bf16x8 At[4][2], B0[2][2], B1[2][2];
    const char* cA = (const char*)g.A + (size_t)cur.pm * tstep; const char* cB = (const char*)g.Bt + (size_t)cur.pn * tstep;
    S.a_ready(cur);
    if constexpr (SP2) {
        PG8_STAGE(PG8_SB(0, 0), cB, voffB); PG8_STAGE(PG8_SB(0, 1), cB + hstep, voffB); PG8_STAGE(PG8_SA(0, 0), cA, voffA); PG8_STAGE(PG8_SA(0, 1), cA + hstep, voffA);
        if (wr == 1) PG8_BAR;
        PG8_WAIT_V(2); PG8_BAR;
        PG8_STAGE(PG8_SB(1, 0), cB + kstep, voffB); PG8_STAGE(PG8_SA(1, 0), cA + kstep, voffA); PG8_STAGE(PG8_SB(1, 1), cB + hstep + kstep, voffB);
        PG8_WAIT_V(6); PG8_BAR;
    } else {
        PG8_STAGE(PG8_SB(0, 0), cB, voffB); PG8_STAGE(PG8_SA(0, 0), cA, voffA); PG8_STAGE(PG8_SB(0, 1), cB + hstep, voffB); PG8_STAGE(PG8_SA(0, 1), cA + hstep, voffA);
        if (wr == 1) PG8_BAR;
        PG8_WAIT_V(4); PG8_BAR;
        PG8_STAGE(PG8_SB(1, 0), cB + kstep, voffB); PG8_STAGE(PG8_SA(1, 0), cA + kstep, voffA); PG8_STAGE(PG8_SB(1, 1), cB + hstep + kstep, voffB);
        PG8_WAIT_V(6); PG8_BAR;
    }
    for (;;) {
        const bool has_next = S.next(ui + 1, nxt);
        const char* nA = has_next ? (const char*)g.A + (size_t)nxt.pm * tstep : cA; const char* nB = has_next ? (const char*)g.Bt + (size_t)nxt.pn * tstep : cB;
        for (int t = 0; t < nt; t += 2) {
            const bool last = (t == nt - 2);
            const char* a1 = cA + (size_t)(t + 1) * kstep;
            const char* a2 = last ? nA : cA + (size_t)(t + 2) * kstep; const char* b2 = last ? nB : cB + (size_t)(t + 2) * kstep;
            const char* a3 = a2 + kstep; const char* b3 = b2 + kstep;
            if (last && has_next) S.a_ready(nxt);
            if constexpr (SP2) {
            PG8_LDB(B0, 0, 0); PG8_LDB(B1, 0, 1); PG8_SCHED; PG8_LDA(At, 0, 0); PG8_STAGE(PG8_SA(1, 1), a1 + hstep, voffA);
            PG8_WAIT_V(8); PG8_WAIT_L(0); PG8_BAR; PG8_MMA(0, 0, At, B0); PG8_MMA(0, 1, At, B1); PG8_BAR; PG8_SCHED;
            PG8_LDA(At, 0, 1); PG8_STAGE(PG8_SB(0, 0), b2, voffB); PG8_STAGE(PG8_SB(0, 1), b2 + hstep, voffB); PG8_STAGE(PG8_SA(0, 0), a2, voffA);
            PG8_WAIT_V(8); PG8_WAIT_L(0); PG8_BAR; PG8_MMA(1, 0, At, B0); PG8_MMA(1, 1, At, B1); PG8_BAR; PG8_SCHED;
            PG8_LDB(B0, 1, 0); PG8_LDB(B1, 1, 1); PG8_SCHED; PG8_LDA(At, 1, 0); PG8_STAGE(PG8_SA(0, 1), a2 + hstep, voffA);
            PG8_WAIT_V(8); PG8_WAIT_L(0); PG8_BAR; PG8_MMA(0, 0, At, B0); PG8_MMA(0, 1, At, B1); PG8_BAR; PG8_SCHED;
            PG8_LDA(At, 1, 1); PG8_STAGE(PG8_SB(1, 0), b3, voffB); PG8_STAGE(PG8_SB(1, 1), b3 + hstep, voffB); PG8_STAGE(PG8_SA(1, 0), a3, voffA);
            PG8_WAIT_V(8); PG8_WAIT_L(0); PG8_BAR; PG8_MMA(1, 0, At, B0); PG8_MMA(1, 1, At, B1); PG8_BAR; PG8_SCHED;
            } else {
            PG8_LDB(B0, 0, 0); PG8_SCHED; PG8_LDA(At, 0, 0); PG8_STAGE(PG8_SA(1, 1), a1 + hstep, voffA);
            PG8_WAIT_L(8); PG8_BAR; PG8_WAIT_L(0); PG8_MMA(0, 0, At, B0); PG8_BAR; PG8_SCHED;
            PG8_LDB(B1, 0, 1); PG8_STAGE(PG8_SB(0, 0), b2, voffB);
            PG8_BAR; PG8_WAIT_L(0); PG8_MMA(0, 1, At, B1); PG8_BAR;
            PG8_LDA(At, 0, 1); PG8_STAGE(PG8_SA(0, 0), a2, voffA);
            PG8_BAR; PG8_WAIT_L(0); PG8_MMA(1, 0, At, B0); PG8_BAR; PG8_SCHED;
            PG8_STAGE(PG8_SB(0, 1), b2 + hstep, voffB);
            PG8_WAIT_V(6); PG8_BAR; PG8_MMA(1, 1, At, B1); PG8_BAR;
            PG8_LDB(B0, 1, 0); PG8_SCHED; PG8_LDA(At, 1, 0); PG8_STAGE(PG8_SA(0, 1), a2 + hstep, voffA);
            PG8_WAIT_L(8); PG8_BAR; PG8_WAIT_L(0); PG8_MMA(0, 0, At, B0); PG8_BAR; PG8_SCHED;
            PG8_LDB(B1, 1, 1); PG8_STAGE(PG8_SB(1, 0), b3, voffB);
            PG8_BAR; PG8_WAIT_L(0); PG8_MMA(0, 1, At, B1); PG8_BAR;
            PG8_LDA(At, 1, 1); PG8_STAGE(PG8_SA(1, 0), a3, voffA);
            PG8_BAR; PG8_WAIT_L(0); PG8_MMA(1, 0, At, B0); PG8_BAR; PG8_SCHED;
            PG8_STAGE(PG8_SB(1, 1), b3 + hstep, voffB);
            PG8_WAIT_V(6); PG8_BAR; PG8_MMA(1, 1, At, B1); PG8_BAR;
            }
        }
        if constexpr (ALIGN_EPI) { if (wr == 0) PG8_BAR; }
        if constexpr (!Epi::AFTER_DRAIN) { E(acc, cur, wr, wc, fr, fq); S.done(cur); }
        if (!has_next) break;
#pragma unroll
        for (int a = 0; a < 2; ++a)
#pragma unroll
            for (int b = 0; b < 2; ++b)
#pragma unroll
                for (int m = 0; m < 4; ++m)
#pragma unroll
                    for (int n = 0; n < 2; ++n) acc[a][b][m][n] = (f32x4){0.f, 0.f, 0.f, 0.f};
        cur = nxt; cA = nA; cB = nB; ++ui;
        if constexpr (ALIGN_EPI) { if (wr == 1) PG8_BAR; }
    }
    PG8_WAIT_V(0);
    if constexpr (!ALIGN_EPI) { if (wr == 0) PG8_BAR; }
    PG8_BAR;
    if constexpr (Epi::AFTER_DRAIN) { E.fused(acc, cur, wr, wc, fr, fq, lds, wid, lane); S.done(cur); }
#undef PG8_SA
#undef PG8_SB
#undef PG8_STAGE
#undef PG8_LDA
#undef PG8_LDB
#undef PG8_MMA
#undef PG8_WAIT_V
#undef PG8_WAIT_L
#undef PG8_BAR
#undef PG8_SCHED
}
}

#ifndef MK_PER_PHASE
#define MK_PER_PHASE 0
#endif
constexpr int NB = 8, SEQ = 2048, DM = 2048, MTOK = NB * SEQ, DEPTH = 4, HD = 128;
constexpr int NMIX = 12, NMEMH = 4, NMEM = 256, DFF = 5632, NGU = 2 * DFF, NGRP = 2, HPG = 6;
constexpr int SB_N = 5120, NSA_N = 3840, NSA_SRC = 3620;
constexpr int SBQ = 0, SBK = 1536, SBV = 3072, SBQM = 4608;
constexpr int NQ = 0, NKC = 1536, NVC = 1792, NKS = 2048, NVS = 2304, NKW = 2560, NVW = 2816, NQM = 3072, NGL = 3584;
constexpr int NCMP = 127, CMPROWS = NB * NGRP * NCMP;
constexpr int WINDOW = 512;
constexpr float NORM_EPS = 1e-6f;
constexpr float SCALE = 0.08838834764831845f;
constexpr float LOG2E = 1.4426950408889634f;
constexpr int NWAVES = 8, NTHR = 512;

constexpr size_t MiB = 1u << 20;
constexpr size_t WS_CTL = 0, CTL_ZERO_BYTES = 1 * MiB;
constexpr size_t WS_WIN = 2 * MiB;
constexpr size_t WS_WO = 22 * MiB;
constexpr size_t WS_WGU = 30 * MiB;
constexpr size_t WS_WD = 74 * MiB;
constexpr size_t WS_WKV = 96 * MiB;
constexpr size_t WS_CW1 = 112 * MiB;
constexpr size_t WS_CW2 = 116 * MiB;
constexpr size_t WS_MEMB = 117 * MiB;
constexpr size_t WS_MEMKV = 125 * MiB;
constexpr size_t WS_COS = 141 * MiB, WS_SIN = 145 * MiB;
constexpr size_t WS_RSTD = 149 * MiB;
constexpr size_t WS_SEL = 150 * MiB;
constexpr size_t WS_KCMP = 151 * MiB;
constexpr size_t WS_XB = 152 * MiB;
constexpr size_t WS_TMP = 216 * MiB;
constexpr size_t WS_ACT = 280 * MiB;
constexpr size_t WS_GU = 456 * MiB;
constexpr size_t WS_PROJ = 456 * MiB;
constexpr size_t WS_OCAT = 616 * MiB;
constexpr size_t WS_END = 808 * MiB;
constexpr int CW_BAR = 4096;

constexpr int RING_BYTES = 131072;
constexpr int LDSCTL_OFF = 143360, MISC_OFF = LDSCTL_OFF + 320;
constexpr int LDS_BYTES = 147456;
constexpr int SHM_T = 16384;
constexpr int A_V = 0, A_K = 2 * SHM_T, A_WS = 4 * SHM_T, A_FLAGS = A_WS + NWAVES * 64 * 4, A_STASH = 67584;

#define GAS __attribute__((address_space(1)))
#define LAS __attribute__((address_space(3)))
typedef unsigned short bf16_t;
typedef unsigned v4u __attribute__((ext_vector_type(4)));
typedef unsigned v2u __attribute__((ext_vector_type(2)));
typedef float f32x4 __attribute__((ext_vector_type(4)));
typedef float f32x16 __attribute__((ext_vector_type(16)));
typedef short bf16x8 __attribute__((ext_vector_type(8)));
typedef short s16x4 __attribute__((ext_vector_type(4)));
typedef GAS unsigned gu32;
#define RLX_AGENT __ATOMIC_RELAXED, __HIP_MEMORY_SCOPE_AGENT
#define LDS_WAIT() asm volatile("s_waitcnt lgkmcnt(0)" ::: "memory")
#define VM_WAIT() asm volatile("s_waitcnt vmcnt(0)" ::: "memory")
#define SBAR() __builtin_amdgcn_sched_barrier(0)
__device__ __forceinline__ unsigned cvtpk(float lo, float hi) { unsigned r; asm volatile("v_cvt_pk_bf16_f32 %0, %1, %2" : "=v"(r) : "v"(lo), "v"(hi)); return r; }
__device__ __forceinline__ float bf2f(unsigned short b) { return __uint_as_float((unsigned)b << 16); }
__device__ __forceinline__ float bflo(unsigned w) { return __uint_as_float(w << 16); }
__device__ __forceinline__ float bfhi(unsigned w) { return __uint_as_float(w & 0xffff0000u); }
__device__ __forceinline__ bf16x8 pack8(f32x4 a, f32x4 b) { v4u w = {cvtpk(a[0], a[1]), cvtpk(a[2], a[3]), cvtpk(b[0], b[1]), cvtpk(b[2], b[3])}; return __builtin_bit_cast(bf16x8, w); }
__device__ __forceinline__ void unpack8(bf16x8 v, f32x4& a, f32x4& b) { const v4u w = __builtin_bit_cast(v4u, v); a = (f32x4){bflo(w.x), bfhi(w.x), bflo(w.y), bfhi(w.y)}; b = (f32x4){bflo(w.z), bfhi(w.z), bflo(w.w), bfhi(w.w)}; }
__device__ __forceinline__ float wave_sum(float v) {
#pragma unroll
    for (int o = 1; o < 64; o <<= 1) v += __shfl_xor(v, o);
    return v;
}
__device__ __forceinline__ float sigmoidf_(float x) { return 1.f / (1.f + __builtin_amdgcn_exp2f(-x * LOG2E)); }

__device__ const float INV_FREQ[64] = {1.000000000e+00f, 8.659643531e-01f, 7.498942018e-01f, 6.493816376e-01f, 5.623413324e-01f, 4.869675338e-01f, 4.216965139e-01f, 3.651741147e-01f, 3.162277639e-01f, 2.738419771e-01f, 2.371373773e-01f, 2.053525001e-01f, 1.778279394e-01f, 1.539926529e-01f, 1.333521456e-01f, 1.154781953e-01f, 1.000000015e-01f, 8.659642935e-02f, 7.498942316e-02f, 6.493816525e-02f, 5.623413250e-02f, 4.869675264e-02f, 4.216964915e-02f, 3.651741147e-02f, 3.162277490e-02f, 2.738419548e-02f, 2.371373773e-02f, 2.053525113e-02f, 1.778279431e-02f, 1.539926510e-02f, 1.333521400e-02f, 1.154781971e-02f, 9.999999776e-03f, 8.659643121e-03f, 7.498942316e-03f, 6.493816152e-03f, 5.623413250e-03f, 4.869675264e-03f, 4.216964822e-03f, 3.651741194e-03f, 3.162277630e-03f, 2.738419687e-03f, 2.371373819e-03f, 2.053525066e-03f, 1.778279431e-03f, 1.539926510e-03f, 1.333521446e-03f, 1.154782018e-03f, 1.000000047e-03f, 8.659643354e-04f, 7.498941850e-04f, 6.493816036e-04f, 5.623413017e-04f, 4.869675322e-04f, 4.216965172e-04f, 3.651741135e-04f, 3.162277571e-04f, 2.738419571e-04f, 2.371373703e-04f, 2.053525095e-04f, 1.778279402e-04f, 1.539926598e-04f, 1.333521504e-04f, 1.154782003e-04f};
#define XB_TMO      128
#define XB_XCNT(j)  (256  + 64 * (j))
#define XB_XSUB(j)  (1280 + 64 * (j))
#define XB_XGEN(j)  (2304 + 64 * (j))
#define XB_TOP      3328
#define XB_TOPGEN   3392
#define XCD_BAR_WORDS 3456
#define XB_SPIN_CAP (1u << 18)

__device__ __forceinline__ unsigned xb_ld(unsigned* p)              { return __hip_atomic_load(p, __ATOMIC_RELAXED, __HIP_MEMORY_SCOPE_AGENT); }
__device__ __forceinline__ unsigned xb_add(unsigned* p, unsigned v) { return __hip_atomic_fetch_add(p, v, __ATOMIC_RELAXED, __HIP_MEMORY_SCOPE_AGENT); }
__device__ __forceinline__ unsigned xb_xcc_id() { return (unsigned)__builtin_amdgcn_s_getreg((3 << 11) | 20) & 0xFu; }
#define XB_SPIN(cond, bar) do { unsigned _sp = 0; while (cond) { __builtin_amdgcn_s_sleep(1); \
    if ((++_sp & 255u) == 0u) { if (xb_ld(&(bar)[XB_TMO])) break; if (_sp > XB_SPIN_CAP) { atomicAdd(&(bar)[XB_TMO], 1u); break; } } } } while (0)

struct XcdBarrier {
    unsigned* bar; unsigned x;
    volatile LAS unsigned* st;
};

__device__ __forceinline__ XcdBarrier xcd_barrier_post(unsigned* bar, volatile LAS unsigned* st) {
    XcdBarrier b; b.bar = bar; b.x = xb_xcc_id(); b.st = st;
    if (threadIdx.x == 0) (void)xb_add(&bar[XB_XCNT(b.x)], 1u);
    return b;
}
__device__ __forceinline__ void xcd_barrier_complete(unsigned* bar, unsigned x, unsigned& nloc, unsigned& nx) {
    const unsigned G = gridDim.x * gridDim.y * gridDim.z;
    unsigned sum, cnt, mine, sp = 0u;
    for (;;) {
        sum = 0u; cnt = 0u; mine = 0u;
#pragma unroll
        for (unsigned j = 0; j < 16; ++j) { const unsigned c = xb_ld(&bar[XB_XCNT(j)]); sum += c; cnt += (c > 0u) ? 1u : 0u; mine = (j == x) ? c : mine; }
        if (sum == G) break;
        __builtin_amdgcn_s_sleep(1);
        if ((++sp & 255u) == 0u) { if (xb_ld(&bar[XB_TMO])) break; if (sp > XB_SPIN_CAP) { atomicAdd(&bar[XB_TMO], 1u); break; } }
    }
    nloc = mine > 0u ? mine : 1u; nx = cnt > 0u ? cnt : 1u;
}

__device__ __forceinline__ void xcd_barrier(const XcdBarrier& b) {
    asm volatile("s_waitcnt vmcnt(0)" ::: "memory");
    __syncthreads();
    if (threadIdx.x == 0) {
        unsigned* bar = b.bar;
        __builtin_amdgcn_s_waitcnt(0);
        unsigned nloc = b.st[0], nx = b.st[1];
        if (nloc == 0u) { xcd_barrier_complete(bar, b.x, nloc, nx); b.st[0] = nloc; b.st[1] = nx; }
        const unsigned old = xb_add(&bar[XB_XSUB(b.x)], 1u);
        const unsigned gen = old / nloc;
        if (old + 1u == (gen + 1u) * nloc) {
            __builtin_amdgcn_fence(__ATOMIC_RELEASE, "agent");
            asm volatile("s_waitcnt vmcnt(0)" ::: "memory");
            const unsigned og = xb_add(&bar[XB_TOP], 1u);
            const unsigned tg = og / nx;
            if (og + 1u == (tg + 1u) * nx) xb_add(&bar[XB_TOPGEN], 1u);
            else XB_SPIN(xb_ld(&bar[XB_TOPGEN]) == tg, bar);
            __builtin_amdgcn_fence(__ATOMIC_ACQUIRE, "agent");
            xb_add(&bar[XB_XGEN(b.x)], 1u);
            asm volatile("s_waitcnt vmcnt(0)" ::: "memory");
        } else {
            XB_SPIN(xb_ld(&bar[XB_XGEN(b.x)]) == gen, bar);
            __builtin_amdgcn_fence(__ATOMIC_ACQUIRE, "agent");
            asm volatile("s_waitcnt vmcnt(0)" ::: "memory");
        }
    }
    __syncthreads();
}

#define KSWZ(row, colB) ((row) * 256 + ((colB) ^ (((row) & 7) << 4)))
__device__ __forceinline__ int v_st(int k, int c) { const int kk = (k & ~0xC) | ((k & 4) << 1) | ((k & 8) >> 1); return ((kk >> 3) * 4 + (c >> 5)) * 512 + ((kk & 7) * 32 + (c & 31)) * 2; }
__device__ __forceinline__ int v_rd_base(int lane) { return ((lane & 3) << 3) | (((lane >> 2) & 3) << 6) | (((lane >> 4) & 1) << 5) | (((lane >> 5) & 1) << 8); }
constexpr int v_rd_off(int d0, int ks, int half) { return d0 * 512 + ks * 4096 + half * 2048; }
__device__ __forceinline__ int crow(int r, int hi) { return (r & 3) + 8 * (r >> 2) + 4 * hi; }

struct ACtx {
    LAS unsigned char* lds;
    int tid, wid, lane, r32, hi, sr, sc, kws, vst0, vst1, vb0;
    LAS float* ws;
};
__device__ __forceinline__ ACtx make_actx(LAS unsigned char* lds) {
    ACtx c; c.lds = lds; { int t_ = threadIdx.x; asm volatile("" : "+v"(t_)); c.tid = t_; } c.wid = __builtin_amdgcn_readfirstlane(c.tid >> 6); c.lane = c.tid & 63; c.r32 = c.lane & 31; c.hi = c.lane >> 5;
    c.sr = c.tid >> 4; c.sc = (c.tid & 15) * 8; c.kws = KSWZ(c.sr, c.sc * 2); c.vst0 = v_st(c.sr, c.sc); c.vst1 = v_st(32 + c.sr, c.sc);
    c.vb0 = (int)(unsigned)(size_t)(lds + A_V) + v_rd_base(c.lane);
    c.ws = (LAS float*)(lds + A_WS) + c.wid * 64;
    return c;
}
struct Stage { bf16x8 k0, k1, v0, v1; };
__device__ __forceinline__ void stage_load(Stage& S, const bf16_t* Kp, const bf16_t* Vp, int pitch, int kb, const ACtx& c) {
    S.v0 = *(const bf16x8*)(Vp + (size_t)(kb + c.sr) * pitch + c.sc); S.v1 = *(const bf16x8*)(Vp + (size_t)(kb + 32 + c.sr) * pitch + c.sc);
    S.k0 = *(const bf16x8*)(Kp + (size_t)(kb + c.sr) * pitch + c.sc); S.k1 = *(const bf16x8*)(Kp + (size_t)(kb + 32 + c.sr) * pitch + c.sc);
}
__device__ __forceinline__ void stage_write(const Stage& S, int buf, const ACtx& c) {
    LAS unsigned char* Kb = c.lds + A_K + buf * SHM_T; LAS unsigned char* Vb = c.lds + A_V + buf * SHM_T;
    *(LAS bf16x8*)(Kb + c.kws) = S.k0; *(LAS bf16x8*)(Kb + c.kws + 32 * 256) = S.k1;
    *(LAS bf16x8*)(Vb + c.vst0) = S.v0; *(LAS bf16x8*)(Vb + c.vst1) = S.v1;
}
__device__ __forceinline__ void qkt(f32x16& p0, f32x16& p1, int buf, const ACtx& c, const bf16x8* qr) {
    p0 = (f32x16){}; p1 = (f32x16){};
    const LAS unsigned char* Kb = c.lds + A_K + buf * SHM_T;
    const LAS unsigned char* kb[4];
#pragma unroll
    for (int dd = 0; dd < 4; ++dd) kb[dd] = Kb + KSWZ(c.r32, (dd * 16 + c.hi * 8) * 2);
#pragma unroll
    for (int d0 = 0; d0 < 8; ++d0) { const LAS unsigned char* a = kb[d0 & 3] + (d0 >> 2) * 128;
        const bf16x8 b0 = *(const LAS bf16x8*)a; const bf16x8 b1 = *(const LAS bf16x8*)(a + 32 * 256);
        p0 = __builtin_amdgcn_mfma_f32_32x32x16_bf16(b0, qr[d0], p0, 0, 0, 0);
        p1 = __builtin_amdgcn_mfma_f32_32x32x16_bf16(b1, qr[d0], p1, 0, 0, 0); }
}
__device__ __forceinline__ void pv_tile(f32x16* o, int buf, const ACtx& c, bf16x8 pa0, bf16x8 pa1, bf16x8 pa2, bf16x8 pa3) {
    const int vb = c.vb0 + buf * SHM_T;
#define TRRD(dst, off) asm volatile("ds_read_b64_tr_b16 %0, %1 offset:%2" : "=&v"(dst) : "v"(vb), "i"(off) : "memory")
#define PV_D0(d0) do { s16x4 l0, l1, l2, l3, h0, h1, h2, h3; constexpr int b_ = v_rd_off(d0, 0, 0); \
        TRRD(l0, b_); TRRD(h0, b_ + 2048); TRRD(l1, b_ + 4096); TRRD(h1, b_ + 6144); TRRD(l2, b_ + 8192); TRRD(h2, b_ + 10240); TRRD(l3, b_ + 12288); TRRD(h3, b_ + 14336); \
        asm volatile("s_waitcnt lgkmcnt(0)" ::: "memory"); SBAR(); \
        o[d0] = __builtin_amdgcn_mfma_f32_32x32x16_bf16(pa0, (bf16x8){l0[0], l0[1], l0[2], l0[3], h0[0], h0[1], h0[2], h0[3]}, o[d0], 0, 0, 0); \
        o[d0] = __builtin_amdgcn_mfma_f32_32x32x16_bf16(pa1, (bf16x8){l1[0], l1[1], l1[2], l1[3], h1[0], h1[1], h1[2], h1[3]}, o[d0], 0, 0, 0); \
        o[d0] = __builtin_amdgcn_mfma_f32_32x32x16_bf16(pa2, (bf16x8){l2[0], l2[1], l2[2], l2[3], h2[0], h2[1], h2[2], h2[3]}, o[d0], 0, 0, 0); \
        o[d0] = __builtin_amdgcn_mfma_f32_32x32x16_bf16(pa3, (bf16x8){l3[0], l3[1], l3[2], l3[3], h3[0], h3[1], h3[2], h3[3]}, o[d0], 0, 0, 0); } while (0)
    PV_D0(0); PV_D0(1); PV_D0(2); PV_D0(3);
#undef PV_D0
#undef TRRD
}
__device__ __forceinline__ float swap_max(float v) { auto rr = __builtin_amdgcn_permlane32_swap(__float_as_uint(v), __float_as_uint(v), false, false); return fmaxf(__uint_as_float(rr[0]), __uint_as_float(rr[1])); }
__device__ __forceinline__ float swap_sum(float v) { auto rr = __builtin_amdgcn_permlane32_swap(__float_as_uint(v), __float_as_uint(v), false, false); return __uint_as_float(rr[0]) + __uint_as_float(rr[1]); }
__device__ __forceinline__ void swap_both(float v, float& lo, float& hi) { auto rr = __builtin_amdgcn_permlane32_swap(__float_as_uint(v), __float_as_uint(v), false, false); lo = __uint_as_float(rr[0]); hi = __uint_as_float(rr[1]); }
__device__ __forceinline__ void pack_p(const f32x16& p0, const f32x16& p1, bf16x8& pa0, bf16x8& pa1, bf16x8& pa2, bf16x8& pa3) {
#define PK4(P, B_, OUT) do { unsigned a0 = cvtpk(P[B_+0], P[B_+1]), a1 = cvtpk(P[B_+2], P[B_+3]); \
        unsigned b0 = cvtpk(P[B_+4], P[B_+5]), b1 = cvtpk(P[B_+6], P[B_+7]); \
        auto r0 = __builtin_amdgcn_permlane32_swap(a0, b0, false, false); auto r1 = __builtin_amdgcn_permlane32_swap(a1, b1, false, false); \
        v4u w = {r0[0], r1[0], r0[1], r1[1]}; OUT = __builtin_bit_cast(bf16x8, w); } while (0)
    PK4(p0, 0, pa0); PK4(p0, 8, pa1); PK4(p1, 0, pa2); PK4(p1, 8, pa3);
#undef PK4
}
__device__ __forceinline__ void mask_tile(f32x16& p0, f32x16& p1, int dq, unsigned W) {
    const float NEG = -__builtin_inff();
#pragma unroll
    for (int r = 0; r < 16; ++r) { const int cc = (r & 3) + 8 * (r >> 2);
        if ((unsigned)(dq - cc) >= W) p0[r] = NEG;
        if ((unsigned)(dq - cc - 32) >= W) p1[r] = NEG; }
}
constexpr float THR = 8.f;
__device__ __forceinline__ void softmax_tile(f32x16& p0, f32x16& p1, float& m_reg, float& l_reg, f32x16* o, const ACtx& c) {
    float pmax = p0[0];
#pragma unroll
    for (int r = 1; r < 16; ++r) pmax = fmaxf(pmax, p0[r]);
#pragma unroll
    for (int r = 0; r < 16; ++r) pmax = fmaxf(pmax, p1[r]);
    pmax = swap_max(pmax);
    constexpr float C2 = LOG2E * SCALE;
    float mn, alpha;
    if (__all((pmax - m_reg) * SCALE <= THR)) { mn = m_reg; alpha = 1.f; }
    else { mn = fmaxf(m_reg, pmax); alpha = __builtin_amdgcn_exp2f((m_reg - mn) * C2); m_reg = mn; }
    const float mnL = -mn * C2;
#pragma unroll
    for (int r = 0; r < 16; ++r) { p0[r] = __builtin_amdgcn_exp2f(fmaf(p0[r], C2, mnL)); p1[r] = __builtin_amdgcn_exp2f(fmaf(p1[r], C2, mnL)); }
    float ps = 0.f;
#pragma unroll
    for (int r = 0; r < 16; ++r) ps += p0[r] + p1[r];
    ps = swap_sum(ps);
    l_reg = l_reg * alpha + ps;
    if (__any(alpha < 1.f)) {
        if (c.hi == 0) c.ws[32 + c.r32] = alpha;
        LDS_WAIT();
#pragma unroll
        for (int r = 0; r < 16; ++r) { const float a = c.ws[32 + crow(r, c.hi)];
#pragma unroll
            for (int d = 0; d < 4; ++d) o[d][r] *= a; }
    }
}
__device__ __forceinline__ void row_factors(float f, float (&fr)[16], const ACtx& c) {
    LDS_WAIT();
    if (c.hi == 0) c.ws[c.r32] = f;
    LDS_WAIT();
#pragma unroll
    for (int r = 0; r < 16; ++r) fr[r] = c.ws[crow(r, c.hi)];
    LDS_WAIT();
}
template <bool ROPE>
__device__ __forceinline__ void load_q(bf16x8 (&qr)[8], const bf16_t* qrow, const float* cosr, const float* sinr, int hi) {
#pragma unroll
    for (int d0 = 0; d0 < 8; ++d0) qr[d0] = *(const bf16x8*)(qrow + d0 * 16 + hi * 8);
    if constexpr (ROPE) {
#pragma unroll
        for (int d0 = 0; d0 < 4; ++d0) {
            const int i0 = d0 * 16 + hi * 8;
            const f32x4 c0 = *(const f32x4*)(cosr + i0), c1 = *(const f32x4*)(cosr + i0 + 4), s0 = *(const f32x4*)(sinr + i0), s1 = *(const f32x4*)(sinr + i0 + 4);
            f32x4 a0, a1, b0, b1; unpack8(qr[d0], a0, a1); unpack8(qr[d0 + 4], b0, b1);
            qr[d0] = pack8(a0 * c0 - b0 * s0, a1 * c1 - b1 * s1);
            qr[d0 + 4] = pack8(b0 * c0 + a0 * s0, b1 * c1 + a1 * s1);
        }
    }
}
__device__ __forceinline__ void store_o_bf16(const f32x16* o, bf16_t* Ow  , int pitch, const ACtx& c) {
#pragma unroll
    for (int r = 0; r < 16; ++r) { const int orow = crow(r, c.hi);
#pragma unroll
        for (int d0 = 0; d0 < 4; ++d0) { const float v = o[d0][r]; const float vn = __shfl_xor(v, 1);
            if ((c.r32 & 1) == 0) *(unsigned*)(Ow + (size_t)orow * pitch + d0 * 32 + c.r32) = cvtpk(v, vn); } }
}

template <int MODE>
__device__ __forceinline__ void softmax_sweep(const ACtx& c, const bf16x8 (&qr)[8], f32x16 (&o)[4], float& l_out, const bf16_t* Kp, const bf16_t* Vp, int pitch,
                                              int j_lo, int j_hi, int qpos, int qlo, unsigned selbits) {
    float m_reg = -1e30f, l_reg = 0.f;
#pragma unroll
    for (int d = 0; d < 4; ++d) o[d] = (f32x16){};
    Stage S; stage_load(S, Kp, Vp, pitch, j_lo * 64, c);
    for (int j = j_lo; j < j_hi; ++j) {
        const int buf = (j - j_lo) & 1;
        stage_write(S, buf, c);
        __syncthreads();
        if (j + 1 < j_hi) stage_load(S, Kp, Vp, pitch, (j + 1) * 64, c);
        const int kb = j * 64;
        bool act = true;
        if (MODE == 1) act = (kb <= qlo + 31) && (kb + 63 >= qlo - (WINDOW - 1));
        if (MODE == 2) act = (kb <= qlo + 31) && __any((int)((selbits >> j) & 1u));
        if (act) {
            f32x16 p0, p1; qkt(p0, p1, buf, c, qr);
            if (MODE == 1) mask_tile(p0, p1, qpos - kb - 4 * c.hi, (unsigned)WINDOW);
            if (MODE == 2) { mask_tile(p0, p1, qpos - kb - 4 * c.hi, 0x7fffffffu);
                if (!((selbits >> j) & 1u)) { const float NEG = -__builtin_inff();
#pragma unroll
                    for (int r = 0; r < 16; ++r) { p0[r] = NEG; p1[r] = NEG; } } }
            softmax_tile(p0, p1, m_reg, l_reg, o, c);
            bf16x8 pa0, pa1, pa2, pa3; pack_p(p0, p1, pa0, pa1, pa2, pa3);
            pv_tile(o, buf, c, pa0, pa1, pa2, pa3);
        }
    }
    __syncthreads();
    l_out = l_reg;
}

struct Params {
    const float* x; const float* mem; const int* positions; const float* norm_g; const float* w_in_sb; const float* w_in_nsa; const float* cmp_pe; const float* cmp_w1; const float* cmp_w2;
    const float* w_mem_kv; const float* w_o; const float* w_gate; const float* w_up; const float* conv_w; const float* conv_b; const float* w_down;
    float* out; unsigned char* ws; int ph_lo, ph_hi;
};
struct Frame {
    LAS unsigned char* lds; int tid, lane, wave, G, bid;
};
#define WSP(T, off) ((T*)(p.ws + (off)))

__device__ __forceinline__ void tr_item(const float* W, int K, int Nsrc, int src_col0, int ncols, const float* gain, bf16_t* WT, int dst_row0, int mode, LAS float* scr, int item, int lane) {
    const int nblk = (ncols + 31) >> 5, kb = item / nblk, nb = item - kb * nblk, k0 = 64 * kb, n0 = 32 * nb;
    const int n = n0 + (lane & 31); const bool ok = (W != nullptr) && (n < ncols);
#pragma unroll 8
    for (int i = 0; i < 32; ++i) { const int kk = 2 * i + (lane >> 5); float v = 0.f;
        if (ok) { v = W[(size_t)(k0 + kk) * Nsrc + src_col0 + n]; if (gain) v *= gain[k0 + kk]; }
        scr[kk * 33 + (lane & 31)] = v; }
    LDS_WAIT(); asm volatile("" ::: "memory");
    const int c = lane & 7;
    const int drow0 = dst_row0 + (mode == 0 ? n0 : 256 * (n0 >> 7) + (n0 & 127));
#pragma unroll
    for (int j = 0; j < 4; ++j) { const int nn = (lane >> 3) + 8 * j; const LAS float* s = scr + (8 * c) * 33 + nn;
        v4u o; o.x = cvtpk(s[0 * 33], s[1 * 33]); o.y = cvtpk(s[2 * 33], s[3 * 33]); o.z = cvtpk(s[4 * 33], s[5 * 33]); o.w = cvtpk(s[6 * 33], s[7 * 33]);
        *(v4u*)(WT + (size_t)(drow0 + nn) * K + k0 + 8 * c) = o; }
    LDS_WAIT(); asm volatile("" ::: "memory");
}
__device__ __forceinline__ void row_to_bf16_rstd(const float* xrow, bf16_t* orow, float* rstd_out, int lane) {
    const f32x4* xr = (const f32x4*)xrow + lane; f32x4 v[8]; float s = 0.f;
#pragma unroll
    for (int j = 0; j < 8; ++j) { v[j] = xr[64 * j]; s += (v[j].x * v[j].x + v[j].y * v[j].y) + (v[j].z * v[j].z + v[j].w * v[j].w); }
    s = wave_sum(s);
    v2u* o8 = (v2u*)orow + lane;
#pragma unroll
    for (int j = 0; j < 8; ++j) { v2u w; w.x = cvtpk(v[j].x, v[j].y); w.y = cvtpk(v[j].z, v[j].w); o8[64 * j] = w; }
    if (lane == 0) *rstd_out = 1.0f / sqrtf(s * (1.0f / DM) + NORM_EPS);
}
template <class PP> __device__ __forceinline__ void phase_convert(const PP& p, const Frame& F, int L) {
    LAS float* scr = (LAS float*)(F.lds + F.wave * 16384);
    const int gw = F.bid * NWAVES + F.wave, NGW = F.G * NWAVES;
    int it0 = gw;
#define TR(W, K, Nsrc, sc0, nc, gain, WT, dr0, mode) do { const int n_ = ((K) / 64) * (((nc) + 31) >> 5); for (; it0 < n_; it0 += NGW) tr_item(W, K, Nsrc, sc0, nc, gain, WT, dr0, mode, scr, it0, F.lane); it0 -= n_; } while (0)
    const float* g = p.norm_g + (size_t)L * 5 * DM;
    const int j = L >> 1;
    bf16_t* WIN = WSP(bf16_t, WS_WIN);
    if ((L & 1) == 0) {
        TR(p.w_in_sb + (size_t)j * DM * SB_N, DM, SB_N, 0, SB_N, g, WIN, 0, 0);
    } else {
        const float* W = p.w_in_nsa + (size_t)j * DM * NSA_SRC;
        TR(W, DM, NSA_SRC, 0, 3072, g, WIN, 0, 0);
        TR(W, DM, NSA_SRC, 3108, 512, g, WIN, NQM, 0);
        TR(W, DM, NSA_SRC, 3072, 36, g, WIN, NGL, 0);
        TR((const float*)nullptr, DM, NSA_SRC, 0, 192, (const float*)nullptr, WIN, NGL + 64, 0);
        for (int wh = 0; wh < 2; ++wh) {
            TR(p.cmp_w1 + (size_t)(j * 2 + wh) * 4096 * 256, 4096, 256, 0, 256, (const float*)nullptr, WSP(bf16_t, WS_CW1) + (size_t)wh * 256 * 4096, 0, 0);
            TR(p.cmp_w2 + (size_t)(j * 2 + wh) * 256 * 128, 256, 128, 0, 128, (const float*)nullptr, WSP(bf16_t, WS_CW2) + (size_t)wh * 128 * 256, 0, 0);
        }
    }
    TR(p.w_o + (size_t)L * DM * DM, DM, DM, 0, DM, (const float*)nullptr, WSP(bf16_t, WS_WO), 0, 0);
    TR(p.w_gate + (size_t)L * DM * DFF, DM, DFF, 0, DFF, g + 2 * DM, WSP(bf16_t, WS_WGU), 0, 1);
    TR(p.w_up + (size_t)L * DM * DFF, DM, DFF, 0, DFF, g + 2 * DM, WSP(bf16_t, WS_WGU), 128, 1);
    TR(p.w_down + (size_t)L * DFF * DM, DFF, DM, 0, DM, (const float*)nullptr, WSP(bf16_t, WS_WD), 0, 0);
    if (L == 0) {
        for (int l = 0; l < DEPTH; ++l)
            TR(p.w_mem_kv + (size_t)l * DM * 1024, DM, 1024, 0, 1024, p.norm_g + (size_t)(l * 5 + 4) * DM, WSP(bf16_t, WS_WKV), l * 1024, 0);
        float* rstd = WSP(float, WS_RSTD);
        for (int m = gw; m < MTOK; m += NGW) row_to_bf16_rstd(p.x + (size_t)m * DM, WSP(bf16_t, WS_XB) + (size_t)m * DM, rstd + m, F.lane);
        for (int m = gw; m < NB * NMEM; m += NGW) row_to_bf16_rstd(p.mem + (size_t)m * DM, WSP(bf16_t, WS_MEMB) + (size_t)m * DM, rstd + 16384 + m, F.lane);
        float* cosT = WSP(float, WS_COS); float* sinT = WSP(float, WS_SIN);
        for (int idx = F.bid * NTHR + F.tid; idx < MTOK * 64; idx += F.G * NTHR) {
            const int row = idx >> 6, i = idx & 63;
            const float ang = (float)p.positions[row] * INV_FREQ[i];
            double t = (double)ang * 0.15915494309189535; t -= __builtin_rint(t);
            const float fr = (float)t;
            cosT[idx] = __builtin_amdgcn_cosf(fr); sinT[idx] = __builtin_amdgcn_sinf(fr);
        }
    }
#undef TR
}

template <class PP> __device__ __forceinline__ void phase_resid(const PP& p, const Frame& F, const float* xin, const float* gpost) {
    const int gw = F.bid * NWAVES + F.wave, NGW = F.G * NWAVES;
    const bf16_t* T = WSP(bf16_t, WS_TMP); bf16_t* XB = WSP(bf16_t, WS_XB); float* rstd = WSP(float, WS_RSTD);
    for (int m = gw; m < MTOK; m += NGW) {
        const bf16x8* ar = (const bf16x8*)(T + (size_t)m * DM) + F.lane;
        f32x4 a[8]; float s = 0.f;
#pragma unroll
        for (int j = 0; j < 4; ++j) { unpack8(ar[64 * j], a[2 * j], a[2 * j + 1]); }
#pragma unroll
        for (int j = 0; j < 8; ++j) s += (a[j].x * a[j].x + a[j].y * a[j].y) + (a[j].z * a[j].z + a[j].w * a[j].w);
        const float ra = 1.0f / sqrtf(wave_sum(s) * (1.0f / DM) + NORM_EPS);
        float s2 = 0.f;
#pragma unroll
        for (int j = 0; j < 4; ++j) {
            const int e0 = (j * 64 + F.lane) * 8;
#pragma unroll
            for (int h = 0; h < 2; ++h) {
                const f32x4 xv = *(const f32x4*)(xin + (size_t)m * DM + e0 + 4 * h), gv = *(const f32x4*)(gpost + e0 + 4 * h);
                const f32x4 y = xv + a[2 * j + h] * ra * gv;
                a[2 * j + h] = y; s2 += (y.x * y.x + y.y * y.y) + (y.z * y.z + y.w * y.w);
                *(f32x4*)(p.out + (size_t)m * DM + e0 + 4 * h) = y;
            }
            *((bf16x8*)(XB + (size_t)m * DM) + 64 * j + F.lane) = pack8(a[2 * j], a[2 * j + 1]);
        }
        s2 = wave_sum(s2);
        if (F.lane == 0) rstd[m] = 1.0f / sqrtf(s2 * (1.0f / DM) + NORM_EPS);
    }
}
template <class PP> __device__ __forceinline__ void phase_conv(const PP& p, const Frame& F, int L) {
    const bf16_t* GU = WSP(bf16_t, WS_GU); bf16_t* ACT = WSP(bf16_t, WS_ACT);
    const float* cw = p.conv_w + (size_t)L * 3 * DFF; const float* cb = p.conv_b + (size_t)L * DFF;
    constexpr int NCH = DFF / 8;
    for (long it = (long)F.bid * NTHR + F.tid; it < (long)MTOK * NCH; it += (long)F.G * NTHR) {
        const int row = (int)(it / NCH), ch = (int)(it - (long)row * NCH), f0 = ch * 8, t = row & (SEQ - 1);
        const int gcol = 256 * (f0 >> 7) + (f0 & 127);
        const bf16_t* gp = GU + (size_t)row * NGU + gcol;
        f32x4 g0a, g0b, g1a = {0, 0, 0, 0}, g1b = {0, 0, 0, 0}, g2a = {0, 0, 0, 0}, g2b = {0, 0, 0, 0}, ua, ub;
        unpack8(*(const bf16x8*)gp, g0a, g0b); unpack8(*(const bf16x8*)(gp + 128), ua, ub);
        if (t >= 1) unpack8(*(const bf16x8*)(gp - NGU), g1a, g1b);
        if (t >= 2) unpack8(*(const bf16x8*)(gp - 2 * NGU), g2a, g2b);
        const f32x4 w0a = *(const f32x4*)(cw + f0), w0b = *(const f32x4*)(cw + f0 + 4), w1a = *(const f32x4*)(cw + DFF + f0), w1b = *(const f32x4*)(cw + DFF + f0 + 4);
        const f32x4 w2a = *(const f32x4*)(cw + 2 * DFF + f0), w2b = *(const f32x4*)(cw + 2 * DFF + f0 + 4), ba = *(const f32x4*)(cb + f0), bb = *(const f32x4*)(cb + f0 + 4);
        f32x4 ca = ba + g2a * w0a + g1a * w1a + g0a * w2a, cbv = bb + g2b * w0b + g1b * w1b + g0b * w2b;
#pragma unroll
        for (int e = 0; e < 4; ++e) { ca[e] = ca[e] * sigmoidf_(ca[e]) * ua[e]; cbv[e] = cbv[e] * sigmoidf_(cbv[e]) * ub[e]; }
        *(bf16x8*)(ACT + (size_t)row * DFF + f0) = pack8(ca, cbv);
    }
}

template <class PP> __device__ __forceinline__ void sb_unit(const PP& p, const ACtx& c, int b, int h, int qt) {
    const bf16_t* PR = WSP(bf16_t, WS_PROJ); bf16_t* OC = WSP(bf16_t, WS_OCAT);
    const int P0 = qt * 256, qlo = P0 + c.wid * 32, qpos = qlo + c.r32;
    const size_t rowb = (size_t)b * SEQ;
    bf16x8 qr[8]; load_q<false>(qr, PR + (rowb + qpos) * SB_N + SBQ + h * HD, nullptr, nullptr, c.hi);
    const bf16_t* Kp = PR + rowb * SB_N + SBK + h * HD; const bf16_t* Vp = PR + rowb * SB_N + SBV + h * HD;
    f32x16 o[4];
#pragma unroll
    for (int d = 0; d < 4; ++d) o[d] = (f32x16){};
    float C2 = 0.f;
    const int jt = (P0 >> 6) + 3;
    LAS int* flags = (LAS int*)(c.lds + A_FLAGS);
    int done_w = 0;
    Stage S; stage_load(S, Kp, Vp, SB_N, jt * 64, c);
    constexpr float ZS = SCALE * LOG2E;
    for (int it = 0; it <= jt; ++it) {
        const int j = jt - it, buf = it & 1;
        stage_write(S, buf, c);
        if (c.lane == 0) flags[buf * 8 + c.wid] = done_w;
        __syncthreads();
        int alld = 1;
#pragma unroll
        for (int w = 0; w < 8; ++w) alld &= flags[buf * 8 + w];
        if (alld) break;
        if (j > 0) stage_load(S, Kp, Vp, SB_N, (j - 1) * 64, c);
        const int kb = j * 64;
        if (!done_w && kb <= qlo + 30) {
            f32x16 p0, p1; qkt(p0, p1, buf, c, qr);
            const int dq = qpos - kb - 4 * c.hi;
#pragma unroll
            for (int r = 0; r < 16; ++r) { const int cc = (r & 3) + 8 * (r >> 2);
                { const float z = p0[r] * ZS; const float t = __builtin_amdgcn_exp2f(-fabsf(z)); const float v = -(fmaxf(z, 0.f) + __builtin_amdgcn_logf(1.f + t)); p0[r] = (cc < dq) ? v : 0.f; }
                { const float z = p1[r] * ZS; const float t = __builtin_amdgcn_exp2f(-fabsf(z)); const float v = -(fmaxf(z, 0.f) + __builtin_amdgcn_logf(1.f + t)); p1[r] = (cc + 32 < dq) ? v : 0.f; } }
            float E[8], Od[8];
#pragma unroll
            for (int q = 0; q < 4; ++q) { const float g0 = (p0[4 * q] + p0[4 * q + 1]) + (p0[4 * q + 2] + p0[4 * q + 3]); swap_both(g0, E[q], Od[q]);
                                          const float g1 = (p1[4 * q] + p1[4 * q + 1]) + (p1[4 * q + 2] + p1[4 * q + 3]); swap_both(g1, E[4 + q], Od[4 + q]); }
            float T = 0.f, ex[8];
#pragma unroll
            for (int q = 7; q >= 0; --q) { const float to = T; T += Od[q]; const float te = T; T += E[q]; ex[q] = c.hi ? to : te; }
#pragma unroll
            for (int q = 0; q < 4; ++q) {
                { float R = C2 + ex[q]; float ep = __builtin_amdgcn_exp2f(R);
#pragma unroll
                  for (int i = 3; i >= 0; --i) { R += p0[4 * q + i]; const float e = __builtin_amdgcn_exp2f(R); p0[4 * q + i] = ep - e; ep = e; } }
                { float R = C2 + ex[4 + q]; float ep = __builtin_amdgcn_exp2f(R);
#pragma unroll
                  for (int i = 3; i >= 0; --i) { R += p1[4 * q + i]; const float e = __builtin_amdgcn_exp2f(R); p1[4 * q + i] = ep - e; ep = e; } }
            }
            C2 += T;
            bf16x8 pa0, pa1, pa2, pa3; pack_p(p0, p1, pa0, pa1, pa2, pa3);
            pv_tile(o, buf, c, pa0, pa1, pa2, pa3);
            done_w = __all(C2 < -72.f) ? 1 : 0;
        }
    }
    __syncthreads();
    store_o_bf16(o, OC + (rowb + qlo) * DM + h * HD, DM, c);
}
template <class PP> __device__ __forceinline__ void mem_unit(const PP& p, const ACtx& c, int L, int b, int hm, int qt, int projN, int qmcol) {
    const bf16_t* PR = WSP(bf16_t, WS_PROJ); bf16_t* OC = WSP(bf16_t, WS_OCAT); const bf16_t* MKV = WSP(bf16_t, WS_MEMKV);
    const int P0 = qt * 256, qlo = P0 + c.wid * 32, qpos = qlo + c.r32;
    const size_t rowb = (size_t)b * SEQ;
    bf16x8 qr[8]; load_q<false>(qr, PR + (rowb + qpos) * projN + qmcol + hm * HD, nullptr, nullptr, c.hi);
    const bf16_t* Kp = MKV + (size_t)b * NMEM * 4096 + L * 1024 + hm * HD; const bf16_t* Vp = Kp + 512;
    f32x16 o[4]; float l;
    softmax_sweep<0>(c, qr, o, l, Kp, Vp, 4096, 0, 4, qpos, qlo, 0u);
    float fr[16]; row_factors(1.0f / l, fr, c);
#pragma unroll
    for (int d = 0; d < 4; ++d)
#pragma unroll
        for (int r = 0; r < 16; ++r) o[d][r] *= fr[r];
    store_o_bf16(o, OC + (rowb + qlo) * DM + NMIX * HD + hm * HD, DM, c);
}
template <class PP> __device__ __forceinline__ void phase_attn_sb(const PP& p, const Frame& F, int L) {
    const ACtx c = make_actx(F.lds);
    constexpr int NSBU = NB * NMIX * 8, NMU = NB * NMEMH * 8;
    for (int u = F.bid; u < NSBU + NMU; u += F.G) {
        if (u < NSBU) { const int qt = 7 - (u % 8), bh = u / 8; sb_unit(p, c, bh / NMIX, bh % NMIX, qt); }
        else { const int v = u - NSBU; const int qt = v % 8, bh = v / 8; mem_unit(p, c, L, bh / NMEMH, bh % NMEMH, qt, SB_N, SBQM); }
    }
}

template <class PP> __device__ __forceinline__ void phase_nsa_prep(const PP& p, const Frame& F, int L) {
    bf16_t* PR = WSP(bf16_t, WS_PROJ); const float* cosT = WSP(float, WS_COS); const float* sinT = WSP(float, WS_SIN);
    const int j = L >> 1;
    const int lane = F.lane, r32 = lane & 31, hi = lane >> 5;
    LAS bf16_t* hid = (LAS bf16_t*)F.lds;
    for (int u = F.bid; u < 128; u += F.G) {
        const int wh = u & 1, rt = u >> 1;
        int rho = rt * 32 + r32; if (rho > CMPROWS - 1) rho = CMPROWS - 1;
        const int bg = rho / NCMP, cc = rho - bg * NCMP, b = bg >> 1, g = bg & 1;
        const size_t tok0 = (size_t)b * SEQ + 16 * cc;
        const bf16_t* src = PR + tok0 * NSA_N + (wh ? NVC : NKC) + g * HD;
        const float* pe = p.cmp_pe + (size_t)(j * 2 + wh) * 32 * HD;
        const bf16_t* w1 = WSP(bf16_t, WS_CW1) + (size_t)wh * 256 * 4096 + (size_t)(F.wave * 32 + r32) * 4096;
        f32x16 acc = (f32x16){};
        for (int l = 0; l < 32; ++l) {
            const bf16_t* rp = src + (size_t)l * NSA_N; const float* pel = pe + l * HD;
            if (wh == 0) {
                const float* cr = cosT + (tok0 + l) * 64; const float* sr = sinT + (tok0 + l) * 64;
#pragma unroll
                for (int kk = 0; kk < 4; ++kk) { const int d = kk * 16 + hi * 8;
                    f32x4 a0, a1, b0, b1; unpack8(*(const bf16x8*)(rp + d), a0, a1); unpack8(*(const bf16x8*)(rp + 64 + d), b0, b1);
                    const f32x4 c0 = *(const f32x4*)(cr + d), c1 = *(const f32x4*)(cr + d + 4), s0 = *(const f32x4*)(sr + d), s1 = *(const f32x4*)(sr + d + 4);
                    const bf16x8 x1 = pack8(a0 * c0 - b0 * s0 + *(const f32x4*)(pel + d), a1 * c1 - b1 * s1 + *(const f32x4*)(pel + d + 4));
                    const bf16x8 x2 = pack8(b0 * c0 + a0 * s0 + *(const f32x4*)(pel + 64 + d), b1 * c1 + a1 * s1 + *(const f32x4*)(pel + 64 + d + 4));
                    acc = __builtin_amdgcn_mfma_f32_32x32x16_bf16(x1, *(const bf16x8*)(w1 + l * HD + d), acc, 0, 0, 0);
                    acc = __builtin_amdgcn_mfma_f32_32x32x16_bf16(x2, *(const bf16x8*)(w1 + l * HD + 64 + d), acc, 0, 0, 0); }
            } else {
#pragma unroll
                for (int kk = 0; kk < 8; ++kk) { const int d = kk * 16 + hi * 8;
                    f32x4 a0, a1; unpack8(*(const bf16x8*)(rp + d), a0, a1);
                    const bf16x8 x1 = pack8(a0 + *(const f32x4*)(pel + d), a1 + *(const f32x4*)(pel + d + 4));
                    acc = __builtin_amdgcn_mfma_f32_32x32x16_bf16(x1, *(const bf16x8*)(w1 + l * HD + d), acc, 0, 0, 0); }
            }
        }
#pragma unroll
        for (int r = 0; r < 16; ++r) { const float v = acc[r]; const float sv = v * sigmoidf_(v);
            hid[crow(r, hi) * 264 + F.wave * 32 + r32] = (bf16_t)(cvtpk(sv, sv) & 0xffffu); }
        __syncthreads();
        if (F.wave < 4) {
            const bf16_t* w2 = WSP(bf16_t, WS_CW2) + (size_t)wh * 128 * 256 + (size_t)(F.wave * 32 + r32) * 256;
            f32x16 a2 = (f32x16){};
#pragma unroll
            for (int kk = 0; kk < 16; ++kk) { const int k = kk * 16 + hi * 8;
                a2 = __builtin_amdgcn_mfma_f32_32x32x16_bf16(*(const LAS bf16x8*)(hid + r32 * 264 + k), *(const bf16x8*)(w2 + k), a2, 0, 0, 0); }
            bf16_t* outp = WSP(bf16_t, WS_KCMP) + (size_t)wh * 16 * 128 * 128;
#pragma unroll
            for (int r = 0; r < 16; ++r) { const int ro = rt * 32 + crow(r, hi);
                if (ro < CMPROWS) { const int bg2 = ro / NCMP, c2 = ro - bg2 * NCMP; outp[((size_t)bg2 * 128 + c2) * 128 + F.wave * 32 + r32] = (bf16_t)(cvtpk(a2[r], a2[r]) & 0xffffu); } }
        }
        if (rt == 0) { bf16_t* outp = WSP(bf16_t, WS_KCMP) + (size_t)wh * 16 * 128 * 128;
            for (int e = F.tid; e < 16 * 128; e += NTHR) outp[((size_t)(e >> 7) * 128 + 127) * 128 + (e & 127)] = 0; }
        __syncthreads();
    }
    const int gw = F.bid * NWAVES + F.wave, NGW = F.G * NWAVES;
    for (int m = gw; m < MTOK; m += NGW) {
        const float cv = cosT[(size_t)m * 64 + lane], sv = sinT[(size_t)m * 64 + lane];
#pragma unroll
        for (int q = 0; q < 4; ++q) { bf16_t* bp = PR + (size_t)m * NSA_N + ((q < 2) ? NKS : NKW) + (q & 1) * HD;
            const float x1 = bf2f(bp[lane]), x2 = bf2f(bp[64 + lane]);
            const float y1 = x1 * cv - x2 * sv, y2 = x2 * cv + x1 * sv;
            bp[lane] = (bf16_t)(cvtpk(y1, y1) & 0xffffu); bp[64 + lane] = (bf16_t)(cvtpk(y2, y2) & 0xffffu); }
    }
}

template <class PP> __device__ __forceinline__ void cmp_unit(const PP& p, const ACtx& c, int b, int g, int qt) {
    const bf16_t* PR = WSP(bf16_t, WS_PROJ); bf16_t* OC = WSP(bf16_t, WS_OCAT); const float* cosT = WSP(float, WS_COS); const float* sinT = WSP(float, WS_SIN);
    const int P0 = qt * 256, qlo = P0 + c.wid * 32, qpos = qlo + c.r32, hi = c.hi;
    const size_t rowb = (size_t)b * SEQ, row = rowb + qpos;
    const bf16_t* Kp = WSP(bf16_t, WS_KCMP) + (size_t)(b * 2 + g) * 128 * 128; const bf16_t* Vp = Kp + (size_t)16 * 128 * 128;
    { Stage S; stage_load(S, Kp, Vp, 128, 0, c); stage_write(S, 0, c); stage_load(S, Kp, Vp, 128, 64, c); stage_write(S, 1, c); }
    __syncthreads();
    const int cmax = (qpos >= 31) ? (((qpos - 31) >> 4) < 126 ? ((qpos - 31) >> 4) : 126) : -1;
    LAS float* acc_l = (LAS float*)(c.lds + A_STASH) + c.wid * 2048 + c.lane;
    const float NEG = -__builtin_inff();
    constexpr float C2 = LOG2E * SCALE;
#pragma nounroll
    for (int hh = 0; hh < HPG; ++hh) {
        const int h = g * HPG + hh;
        bf16x8 qr[8]; load_q<true>(qr, PR + row * NSA_N + NQ + h * HD, cosT + row * 64, sinT + row * 64, hi);
        f32x16 pA0, pA1, pB0, pB1; qkt(pA0, pA1, 0, c, qr); qkt(pB0, pB1, 1, c, qr);
        float mx = NEG;
#pragma unroll
        for (int r = 0; r < 16; ++r) { const int ci = crow(r, hi);
            if (ci > cmax) pA0[r] = NEG; if (ci + 32 > cmax) pA1[r] = NEG; if (ci + 64 > cmax) pB0[r] = NEG; if (ci + 96 > cmax) pB1[r] = NEG;
            mx = fmaxf(fmaxf(mx, pA0[r]), fmaxf(pA1[r], fmaxf(pB0[r], pB1[r]))); }
        mx = swap_max(mx); if (mx == NEG) mx = 0.f;
        const float mL = -mx * C2; float ls = 0.f;
#pragma unroll
        for (int r = 0; r < 16; ++r) { pA0[r] = __builtin_amdgcn_exp2f(fmaf(pA0[r], C2, mL)); pA1[r] = __builtin_amdgcn_exp2f(fmaf(pA1[r], C2, mL));
            pB0[r] = __builtin_amdgcn_exp2f(fmaf(pB0[r], C2, mL)); pB1[r] = __builtin_amdgcn_exp2f(fmaf(pB1[r], C2, mL)); ls += (pA0[r] + pA1[r]) + (pB0[r] + pB1[r]); }
        ls = swap_sum(ls);
        const float inv = ls > 0.f ? 1.0f / ls : 0.f;
#pragma unroll
        for (int r = 0; r < 16; ++r) { pA0[r] *= inv; pA1[r] *= inv; pB0[r] *= inv; pB1[r] *= inv; }
#define ACC_AB(P, Q0) do { _Pragma("unroll") for (int q = 0; q < 4; ++q) { \
            const float a_ = 2.f * (P[4 * q] + P[4 * q + 1] + P[4 * q + 2]) + P[4 * q + 3], b_ = P[4 * q + 3]; \
            LAS float* pa_ = acc_l + (2 * (Q0 + q)) * 64; \
            if (hh == 0) { pa_[0] = a_; pa_[64] = b_; } else { pa_[0] += a_; pa_[64] += b_; } } } while (0)
        ACC_AB(pA0, 0); ACC_AB(pA1, 4); ACC_AB(pB0, 8); ACC_AB(pB1, 12);
#undef ACC_AB
        f32x16 o[4];
#pragma unroll
        for (int d = 0; d < 4; ++d) o[d] = (f32x16){};
        { bf16x8 pa0, pa1, pa2, pa3; pack_p(pA0, pA1, pa0, pa1, pa2, pa3); pv_tile(o, 0, c, pa0, pa1, pa2, pa3); }
        { bf16x8 pa0, pa1, pa2, pa3; pack_p(pB0, pB1, pa0, pa1, pa2, pa3); pv_tile(o, 1, c, pa0, pa1, pa2, pa3); }
        const float gc = sigmoidf_(bf2f(PR[row * NSA_N + NGL + h * 3 + 0]));
        float fr[16]; row_factors(gc, fr, c);
#pragma unroll
        for (int d = 0; d < 4; ++d)
#pragma unroll
            for (int r = 0; r < 16; ++r) o[d][r] *= fr[r];
        store_o_bf16(o, OC + (rowb + qlo) * DM + h * HD, DM, c);
    }
    float Ie[16], Io[16];
    {
        float imp[16], Bb[16];
#pragma unroll
        for (int q = 0; q < 16; ++q) { float blo, bhi; swap_both(acc_l[(2 * q + 1) * 64], blo, bhi); Bb[q] = hi ? blo : bhi; }
#pragma unroll
        for (int q = 0; q < 16; ++q) imp[q] = acc_l[(2 * q) * 64] + (hi ? Bb[q] : (q > 0 ? Bb[q - 1] : 0.f));
#pragma unroll
        for (int q = 0; q < 16; ++q) swap_both(imp[q], Ie[q], Io[q]);
    }
    const int cur = qpos >> 6;
    unsigned bits;
    if (cur < 16) bits = (2u << cur) - 1u;
    else {
#pragma unroll
        for (int q = 0; q < 16; ++q) { const int je = 2 * q, jo = 2 * q + 1;
            if (!(je >= 1 && je <= cur - 2)) Ie[q] = -1.f; if (!(jo >= 1 && jo <= cur - 2)) Io[q] = -1.f; }
        bits = 0u;
#pragma unroll
        for (int q = 0; q < 16; ++q) {
            const int jm = 2 * q + hi; const float vj = hi ? Io[q] : Ie[q];
            int rank = 0;
#pragma unroll
            for (int q2 = 0; q2 < 16; ++q2) {
                const bool lt_e = (q2 < q) || (q2 == q && hi);
                const bool lt_o = (q2 < q);
                rank += (Ie[q2] > vj || (Ie[q2] == vj && lt_e)) ? 1 : 0;
                rank += (Io[q2] > vj || (Io[q2] == vj && lt_o)) ? 1 : 0;
            }
            const bool forced = (jm == 0) || (jm == cur) || (jm == cur - 1);
            const bool sel = forced || (vj >= 0.f && rank < 13);
            bits |= sel ? (1u << jm) : 0u;
        }
        { auto rr = __builtin_amdgcn_permlane32_swap(bits, bits, false, false); bits = rr[0] | rr[1]; }
    }
    if (hi == 0) WSP(unsigned, WS_SEL)[(size_t)(b * 2 + g) * SEQ + qpos] = bits;
    __syncthreads();
}
template <class PP> __device__ __forceinline__ void phase_attn_cmp(const PP& p, const Frame& F, int L) {
    const ACtx c = make_actx(F.lds);
    constexpr int NCU = NB * NGRP * 8, NMU = NB * NMEMH * 8;
    for (int u = F.bid; u < NCU + NMU; u += F.G) {
        if (u < NCU) { const int qt = u % 8, bg = u / 8; cmp_unit(p, c, bg >> 1, bg & 1, qt); }
        else { const int v = u - NCU; const int qt = v % 8, bh = v / 8; mem_unit(p, c, L, bh / NMEMH, bh % NMEMH, qt, NSA_N, NQM); }
    }
}
template <class PP> __device__ __forceinline__ void selwin_unit(const PP& p, const ACtx& c, int b, int h, int qt) {
    const bf16_t* PR = WSP(bf16_t, WS_PROJ); bf16_t* OC = WSP(bf16_t, WS_OCAT); const float* cosT = WSP(float, WS_COS); const float* sinT = WSP(float, WS_SIN);
    const int P0 = qt * 256, qlo = P0 + c.wid * 32, qpos = qlo + c.r32, g = h / HPG;
    const size_t rowb = (size_t)b * SEQ, row = rowb + qpos;
    bf16x8 qr[8]; load_q<true>(qr, PR + row * NSA_N + NQ + h * HD, cosT + row * 64, sinT + row * 64, c.hi);
    const unsigned selbits = WSP(unsigned, WS_SEL)[(size_t)(b * 2 + g) * SEQ + qpos];
    const float gs = sigmoidf_(bf2f(PR[row * NSA_N + NGL + h * 3 + 1])), gwn = sigmoidf_(bf2f(PR[row * NSA_N + NGL + h * 3 + 2]));
    f32x16 o[4]; float l;
    LAS unsigned* stash = (LAS unsigned*)(c.lds + A_STASH) + c.wid * 2048;
    softmax_sweep<2>(c, qr, o, l, PR + rowb * NSA_N + NKS + g * HD, PR + rowb * NSA_N + NVS + g * HD, NSA_N, 0, (P0 >> 6) + 4, qpos, qlo, selbits);
    {
        float fr[16]; row_factors(l > 0.f ? gs / l : 0.f, fr, c);
        const bf16_t* Ow = OC + (rowb + qlo) * DM + h * HD;
#pragma unroll
        for (int r = 0; r < 16; ++r) { const int orow = crow(r, c.hi);
#pragma unroll
            for (int d0 = 0; d0 < 4; ++d0) o[d0][r] = o[d0][r] * fr[r] + bf2f(Ow[(size_t)orow * DM + d0 * 32 + c.r32]); }
#pragma unroll
        for (int r = 0; r < 16; ++r)
#pragma unroll
            for (int d0 = 0; d0 < 4; d0 += 2) stash[((r * 2 + (d0 >> 1)) * 2 + c.hi) * 32 + c.r32] = cvtpk(o[d0][r], o[d0 + 1][r]);
    }
    const int jlo = (P0 - (WINDOW - 1)) > 0 ? ((P0 - (WINDOW - 1)) >> 6) : 0;
    softmax_sweep<1>(c, qr, o, l, PR + rowb * NSA_N + NKW + g * HD, PR + rowb * NSA_N + NVW + g * HD, NSA_N, jlo, (P0 >> 6) + 4, qpos, qlo, 0u);
    {
        float fr[16]; row_factors(l > 0.f ? gwn / l : 0.f, fr, c);
#pragma unroll
        for (int r = 0; r < 16; ++r)
#pragma unroll
            for (int d0 = 0; d0 < 4; d0 += 2) { const unsigned w = stash[((r * 2 + (d0 >> 1)) * 2 + c.hi) * 32 + c.r32];
                o[d0][r] = o[d0][r] * fr[r] + bflo(w); o[d0 + 1][r] = o[d0 + 1][r] * fr[r] + bfhi(w); }
    }
    store_o_bf16(o, OC + (rowb + qlo) * DM + h * HD, DM, c);
}
template <class PP> __device__ __forceinline__ void phase_attn_selwin(const PP& p, const Frame& F) {
    const ACtx c = make_actx(F.lds);
    constexpr int NU = NB * NMIX * 8;
    for (int u = F.bid; u < NU; u += F.G) { const int qt = 7 - (u / (NB * NMIX)), bh = u % (NB * NMIX); selwin_unit(p, c, bh / NMIX, bh % NMIX, qt); }
}

constexpr int NPH_SB = 9, NPH_NSA = 11, NPH = 2 * (NPH_SB + NPH_NSA);
__global__ void __launch_bounds__(NTHR, 2) mk_fwd(Params p) {
    extern __shared__ __attribute__((aligned(16))) unsigned char lds_raw[];
    LAS unsigned char* const lds0 = (LAS unsigned char*)lds_raw;
typedef const Params __attribute__((address_space(4))) KParams;
#define MKFRAME() KParams* pp_ = (KParams*)__builtin_amdgcn_kernarg_segment_ptr(); asm volatile("" : "+s"(pp_)); KParams& p = *pp_; Frame F; F.lds = lds0; { int t_ = threadIdx.x; asm volatile("" : "+v"(t_)); F.tid = t_; } F.lane = F.tid & 63; F.wave = __builtin_amdgcn_readfirstlane(F.tid >> 6); F.G = gridDim.x; F.bid = blockIdx.x
    for (int u = threadIdx.x; u < (LDS_BYTES - LDSCTL_OFF) / 4; u += NTHR) ((LAS unsigned*)(lds0 + LDSCTL_OFF))[u] = 0u;
    __syncthreads();
    gu32* ctl = (gu32*)(p.ws + WS_CTL);
    XcdBarrier bar; bar.bar = (unsigned*)(ctl + CW_BAR); bar.x = 0; bar.st = nullptr;
#if !MK_PER_PHASE
    bar = xcd_barrier_post((unsigned*)(ctl + CW_BAR), (volatile LAS unsigned*)(lds0 + MISC_OFF) + 8);
#endif
    const int lo = p.ph_lo, hi = p.ph_hi;
    int ph = 0;
#define IN() (lo <= ph && ph < hi)
#if MK_PER_PHASE
#define END_PHASE() do { ++ph; } while (0)
#else
#define END_PHASE() do { if (IN() && ph + 1 < hi) xcd_barrier(bar); ++ph; } while (0)
#endif
#define GEMM_RS(Aoff, Boff, M_, N_, K_, Ooff, ldc_, rs_) do { pg8::Gemm g{WSP(pg8::bf16_t, Aoff), WSP(pg8::bf16_t, Boff), M_, N_, K_}; pg8::StaticOrder S; S.init(M_, N_, F.G, F.bid); \
        pg8::EpiRS E{WSP(pg8::bf16_t, Ooff), ldc_, rs_}; pg8::gemm_phase<pg8::EpiRS, pg8::StaticOrder, true, true>(F.lds, g, S, E); } while (0)

    for (int lp = 0; lp < 2; ++lp) {
        {
            const int L = 2 * lp;
            if (IN()) { MKFRAME(); phase_convert(p, F, L); }
            END_PHASE();
            if (IN()) { MKFRAME(); GEMM_RS(WS_XB, WS_WIN, MTOK, SB_N, DM, WS_PROJ, SB_N, WSP(float, WS_RSTD));
                        if (L == 0) GEMM_RS(WS_MEMB, WS_WKV, NB * NMEM, 4096, DM, WS_MEMKV, 4096, WSP(float, WS_RSTD) + 16384); }
            END_PHASE();
            if (IN()) { MKFRAME(); phase_attn_sb(p, F, L); }
            END_PHASE();
            if (IN()) { MKFRAME(); GEMM_RS(WS_OCAT, WS_WO, MTOK, DM, DM, WS_TMP, DM, (const float*)nullptr); }
            END_PHASE();
            if (IN()) { MKFRAME(); phase_resid(p, F, (L == 0) ? p.x : (const float*)p.out, p.norm_g + (size_t)(L * 5 + 1) * DM); }
            END_PHASE();
            if (IN()) { MKFRAME(); GEMM_RS(WS_XB, WS_WGU, MTOK, NGU, DM, WS_GU, NGU, WSP(float, WS_RSTD)); }
            END_PHASE();
            if (IN()) { MKFRAME(); phase_conv(p, F, L); }
            END_PHASE();
            if (IN()) { MKFRAME(); GEMM_RS(WS_ACT, WS_WD, MTOK, DM, DFF, WS_TMP, DM, (const float*)nullptr); }
            END_PHASE();
            if (IN()) { MKFRAME(); phase_resid(p, F, (const float*)p.out, p.norm_g + (size_t)(L * 5 + 3) * DM); }
            END_PHASE();
        }
        {
            const int L = 2 * lp + 1;
            if (IN()) { MKFRAME(); phase_convert(p, F, L); }
            END_PHASE();
            if (IN()) { MKFRAME(); GEMM_RS(WS_XB, WS_WIN, MTOK, NSA_N, DM, WS_PROJ, NSA_N, WSP(float, WS_RSTD)); }
            END_PHASE();
            if (IN()) { MKFRAME(); phase_nsa_prep(p, F, L); }
            END_PHASE();
            if (IN()) { MKFRAME(); phase_attn_cmp(p, F, L); }
            END_PHASE();
            if (IN()) { MKFRAME(); phase_attn_selwin(p, F); }
            END_PHASE();
            if (IN()) { MKFRAME(); GEMM_RS(WS_OCAT, WS_WO, MTOK, DM, DM, WS_TMP, DM, (const float*)nullptr); }
            END_PHASE();
            if (IN()) { MKFRAME(); phase_resid(p, F, (const float*)p.out, p.norm_g + (size_t)(L * 5 + 1) * DM); }
            END_PHASE();
            if (IN()) { MKFRAME(); GEMM_RS(WS_XB, WS_WGU, MTOK, NGU, DM, WS_GU, NGU, WSP(float, WS_RSTD)); }
            END_PHASE();
            if (IN()) { MKFRAME(); phase_conv(p, F, L); }
            END_PHASE();
            if (IN()) { MKFRAME(); GEMM_RS(WS_ACT, WS_WD, MTOK, DM, DFF, WS_TMP, DM, (const float*)nullptr); }
            END_PHASE();
            if (IN()) { MKFRAME(); phase_resid(p, F, (const float*)p.out, p.norm_g + (size_t)(L * 5 + 3) * DM); }
            END_PHASE();
        }
    }
#undef IN
#undef END_PHASE
#undef GEMM_RS
}

extern "C" void kernel_launch(void* const* d_in, const int* in_sizes, int n_in, void* d_out, int out_size, void* d_ws, size_t ws_size, hipStream_t stream) {
    static int grid = 0;
    if (grid == 0) {
        if (n_in != 16 || out_size != MTOK * DM || ws_size < WS_END) { fprintf(stderr, "kernel_launch: unexpected shapes (n_in %d, out %d, ws %zu < %zu)\n", n_in, out_size, ws_size, (size_t)WS_END); grid = -1; return; }
        int dev = 0, cus = 0, per_cu = 0;
        if (hipGetDevice(&dev) != hipSuccess || hipDeviceGetAttribute(&cus, hipDeviceAttributeMultiprocessorCount, dev) != hipSuccess) { grid = -1; return; }
        if (hipFuncSetAttribute((const void*)mk_fwd, hipFuncAttributeMaxDynamicSharedMemorySize, LDS_BYTES) != hipSuccess) { fprintf(stderr, "kernel_launch: hipFuncSetAttribute failed\n"); grid = -1; return; }
        if (hipOccupancyMaxActiveBlocksPerMultiprocessor(&per_cu, (const void*)mk_fwd, NTHR, LDS_BYTES) != hipSuccess || per_cu < 1) { fprintf(stderr, "kernel_launch: occupancy query says %d\n", per_cu); (void)hipGetLastError(); }
        grid = cus;
    }
    if (grid < 0) return;
    (void)hipMemsetAsync((char*)d_ws + WS_CTL, 0, CTL_ZERO_BYTES, stream);
    Params p{};
    p.x = (const float*)d_in[0]; p.mem = (const float*)d_in[1]; p.positions = (const int*)d_in[2]; p.norm_g = (const float*)d_in[3]; p.w_in_sb = (const float*)d_in[4]; p.w_in_nsa = (const float*)d_in[5];
    p.cmp_pe = (const float*)d_in[6]; p.cmp_w1 = (const float*)d_in[7]; p.cmp_w2 = (const float*)d_in[8]; p.w_mem_kv = (const float*)d_in[9]; p.w_o = (const float*)d_in[10];
    p.w_gate = (const float*)d_in[11]; p.w_up = (const float*)d_in[12]; p.conv_w = (const float*)d_in[13]; p.conv_b = (const float*)d_in[14]; p.w_down = (const float*)d_in[15];
    p.out = (float*)d_out; p.ws = (unsigned char*)d_ws;
#if MK_PER_PHASE
    for (int ph = 0; ph < NPH; ++ph) { p.ph_lo = ph; p.ph_hi = ph + 1; hipLaunchKernelGGL(mk_fwd, dim3(grid), dim3(NTHR), LDS_BYTES, stream, p); }
#else
    p.ph_lo = 0; p.ph_hi = NPH;
    hipLaunchKernelGGL(mk_fwd, dim3(grid), dim3(NTHR), LDS_BYTES, stream, p);
#endif
}
```

```cpp
#include <hip/hip_runtime.h>
#include <cstdio>
#include <cstdint>
namespace pg8 {
#define PG8_LAS __attribute__((address_space(3)))
typedef unsigned short bf16_t;
typedef short bf16x8 __attribute__((ext_vector_type(8)));
typedef float f32x4 __attribute__((ext_vector_type(4)));
typedef unsigned u32x4 __attribute__((ext_vector_type(4)));
constexpr int BM = 256, BK = 64, HALF = 128, HTB = HALF * BK * 2  , STAGE_BYTES = 8 * HTB, NXCD = 8, WGM = 8;

__host__ __device__ __forceinline__ int lds_byte(int r, int c) { const int st = (r >> 4) * 2 + (c >> 5), rr = r & 15, cc = c & 31, ob = rr * 64 + cc * 2; return st * 1024 + (ob ^ (((ob >> 9) & 1) << 5)); }
__host__ __device__ __forceinline__ void stage_rc(int b, int& R, int& C) { const int st = b / 1024, sb = b % 1024, swz = sb ^ (((sb >> 9) & 1) << 5); R = (st >> 1) * 16 + swz / 64; C = (st & 1) * 32 + (swz % 64) / 2; }
__host__ __device__ __forceinline__ int perm32(int rho) { const int n = rho >> 4, i = rho & 15; return 8 * (i >> 2) + 4 * n + (i & 3); }

struct Unit { int pm, pn; };
struct Gemm { const bf16_t* A; const bf16_t* Bt; int M, N, K; };

struct StaticOrder {
    int nM, nN, nwg, G, c;
    __host__ __device__ void init(int M, int N, int G_, int c_) { nM = M / BM; nN = N / BM; nwg = nM * nN; G = G_; c = c_; }
    __host__ __device__ bool next(int i, Unit& u) const {
        const long L = (long)i * G + c; if (L >= nwg) return false;
        int wgid = (int)L; { const int q = nwg / NXCD, r = nwg % NXCD, xcd = wgid % NXCD, off = wgid / NXCD; wgid = (xcd < r ? xcd * (q + 1) : r * (q + 1) + (xcd - r) * q) + off; }
        const int nig = WGM * nN, gid = wgid / nig, fm = gid * WGM, gsz = (nM - fm) < WGM ? (nM - fm) : WGM;
        u.pm = fm + ((wgid % nig) % gsz); u.pn = (wgid % nig) / gsz; return true;
    }
    __device__ __forceinline__ void a_ready(const Unit&) const {}
    __device__ __forceinline__ void done(const Unit&) const {}
};

__device__ __forceinline__ unsigned cvt_pk_bf16(float lo, float hi) { unsigned r; asm volatile("v_cvt_pk_bf16_f32 %0, %1, %2" : "=v"(r) : "v"(lo), "v"(hi)); return r; }
typedef float f32x2 __attribute__((ext_vector_type(2)));
struct EpiRS {
    static constexpr bool PERM = true, AFTER_DRAIN = false;
    bf16_t* O; int ldc; const float* rs;
    __device__ __forceinline__ void operator()(const f32x4 (&acc)[2][2][4][2], const Unit& u, int wr, int wc, int fr, int fq) const {
        const int row0 = u.pm * BM + wr * 64 + fr; const int col0 = u.pn * BM + wc * 32 + 8 * fq;
#pragma unroll
        for (int ai = 0; ai < 2; ++ai)
#pragma unroll
            for (int m = 0; m < 4; ++m) { const int row = row0 + ai * HALF + m * 16; const float sc = rs ? rs[row] : 1.f; bf16_t* rowp = O + (size_t)row * ldc + col0;
#pragma unroll
                for (int bj = 0; bj < 2; ++bj) { const f32x4 v0 = acc[ai][bj][m][0] * sc, v1 = acc[ai][bj][m][1] * sc;
                    u32x4 w; w.x = cvt_pk_bf16(v0[0], v0[1]); w.y = cvt_pk_bf16(v0[2], v0[3]); w.z = cvt_pk_bf16(v1[0], v1[1]); w.w = cvt_pk_bf16(v1[2], v1[3]);
                    *(u32x4*)(rowp + bj * HALF) = w; } }
    }
};
struct EpiConv {
    static constexpr bool PERM = true, AFTER_DRAIN = false;
    bf16_t* ACT; const float* rs; const float* cw; const float* cb; float* HG; float* FP; float* FU; PG8_LAS float* halo; int dff;
    __device__ __forceinline__ void operator()(const f32x4 (&acc)[2][2][4][2], const Unit& u, int wr, int wc, int fr, int fq) const {
        const int fl = wc * 32 + 8 * fq, f0 = u.pn * 128 + fl, lane = (int)(threadIdx.x & 63);
        const int src1 = (lane & 48) | ((fr + 15) & 15), src2 = (lane & 48) | ((fr + 14) & 15);
        f32x4 w0[2], w1[2], w2[2], bb[2];
#pragma unroll
        for (int n = 0; n < 2; ++n) { w0[n] = *(const f32x4*)(cw + f0 + 4 * n); w1[n] = *(const f32x4*)(cw + dff + f0 + 4 * n); w2[n] = *(const f32x4*)(cw + 2 * dff + f0 + 4 * n); bb[n] = *(const f32x4*)(cb + f0 + 4 * n); }
#pragma unroll
        for (int ai = 0; ai < 2; ++ai) { const float sc = rs[u.pm * BM + ai * HALF + wr * 64 + 48 + fr];
            if (fr >= 14) {
#pragma unroll
                for (int n = 0; n < 2; ++n) *(PG8_LAS f32x4*)(halo + ((ai * 2 + wr) * 2 + (fr - 14)) * 128 + fl + 4 * n) = acc[ai][0][3][n] * sc; } }
        asm volatile("s_waitcnt lgkmcnt(0)" ::: "memory"); __builtin_amdgcn_s_barrier(); asm volatile("" ::: "memory");
#pragma unroll
        for (int ai = 0; ai < 2; ++ai) {
            const int s = ai * 2 + wr;
            f32x4 a1p[2], a2p[2];
#pragma unroll
            for (int n = 0; n < 2; ++n) { f32x4 vp = {0.f, 0.f, 0.f, 0.f};
                if (s > 0 && fr >= 14) vp = *(const PG8_LAS f32x4*)(halo + ((s - 1) * 2 + (fr - 14)) * 128 + fl + 4 * n);
#pragma unroll
                for (int e = 0; e < 4; ++e) { a1p[n][e] = __shfl(vp[e], src1); a2p[n][e] = __shfl(vp[e], src2); } }
#pragma unroll
            for (int m = 0; m < 4; ++m) {
                const int row = u.pm * BM + ai * HALF + wr * 64 + m * 16 + fr; const float sc = rs[row];
                u32x4 wv; unsigned pk[4];
#pragma unroll
                for (int n = 0; n < 2; ++n) {
                    const f32x4 v = acc[ai][0][m][n] * sc, uu = acc[ai][1][m][n] * sc; f32x4 a1, a2, gc, ac;
#pragma unroll
                    for (int e = 0; e < 4; ++e) { a1[e] = __shfl(v[e], src1); a2[e] = __shfl(v[e], src2); }
#pragma unroll
                    for (int e = 0; e < 4; ++e) { const float p1 = (fr >= 1) ? a1[e] : a1p[n][e], p2 = (fr >= 2) ? a2[e] : a2p[n][e];
                        gc[e] = bb[n][e] + w0[n][e] * p2 + w1[n][e] * p1 + w2[n][e] * v[e];
                        ac[e] = gc[e] / (1.f + __builtin_amdgcn_exp2f(-gc[e] * 1.4426950408889634f)) * uu[e]; }
                    if (s == 0 && m == 0 && fr < 2) { *(f32x4*)(FP + (size_t)(u.pm * 2 + fr) * dff + f0 + 4 * n) = gc; *(f32x4*)(FU + (size_t)(u.pm * 2 + fr) * dff + f0 + 4 * n) = uu; }
                    if (s == 3 && m == 3 && fr >= 14) *(f32x4*)(HG + (size_t)(u.pm * 2 + fr - 14) * dff + f0 + 4 * n) = v;
                    pk[2 * n] = cvt_pk_bf16(ac[0], ac[1]); pk[2 * n + 1] = cvt_pk_bf16(ac[2], ac[3]);
                    a1p[n] = a1; a2p[n] = a2;
                }
                wv.x = pk[0]; wv.y = pk[1]; wv.z = pk[2]; wv.w = pk[3];
                *(u32x4*)(ACT + (size_t)row * dff + f0) = wv;
            }
        }
    }
};
template <class Epi, class Sched, bool ALIGN_EPI = false, bool SP2 = false>
__device__ __forceinline__ void gemm_phase(PG8_LAS unsigned char* lds, const Gemm g, const Sched& S, const Epi& E) {
    int tid_ = threadIdx.x; asm volatile("" : "+v"(tid_));
    const int tid = tid_, wid = __builtin_amdgcn_readfirstlane(tid >> 6), lane = tid & 63, wr = wid >> 2, wc = wid & 3, fr = lane & 15, fq = lane >> 4;
    const int K = g.K, nt = K / BK;
    unsigned voffA[2], voffB[2];
#pragma unroll
    for (int i = 0; i < 2; ++i) { int R, C; stage_rc(tid * 16 + i * 8192, R, C); const int Rb = Epi::PERM ? ((R & ~31) + perm32(R & 31)) : R;
        voffA[i] = (unsigned)(R * K + C) * 2u; voffB[i] = (unsigned)(Rb * K + C) * 2u; }
    const size_t kstep = (size_t)(BK * 2);
    const size_t hstep = (size_t)HALF * K * 2;
    const size_t tstep = 2 * hstep;
    const unsigned ldsw = (unsigned)wid * 1024u;
    const int aoff = lds_byte(wr * 64 + fr, fq * 8), boff = lds_byte(wc * 32 + fr, fq * 8);
#define PG8_SA(b, h) (((b) * 2 + (h)) * HTB)
#define PG8_SB(b, h) ((4 + (b) * 2 + (h)) * HTB)
#define PG8_STAGE(bufoff, gbase, voff) do { _Pragma("unroll") for (int _i = 0; _i < 2; ++_i) \
        __builtin_amdgcn_global_load_lds((const unsigned*)((const char*)(gbase) + (voff)[_i]), (PG8_LAS unsigned*)(lds + (bufoff) + ldsw + _i * 8192), 16, 0, 0); } while (0)
#define PG8_LDA(dst, b, h) do { _Pragma("unroll") for (int m = 0; m < 4; ++m) _Pragma("unroll") for (int k = 0; k < 2; ++k) dst[m][k] = *(const PG8_LAS bf16x8*)(lds + PG8_SA(b, h) + aoff + m * 2048 + k * 1024); } while (0)
#define PG8_LDB(dst, b, h) do { _Pragma("unroll") for (int n = 0; n < 2; ++n) _Pragma("unroll") for (int k = 0; k < 2; ++k) dst[n][k] = *(const PG8_LAS bf16x8*)(lds + PG8_SB(b, h) + boff + n * 2048 + k * 1024); } while (0)
#define PG8_MMA(ai, bj, At, Bt) do { __builtin_amdgcn_s_setprio(1); _Pragma("unroll") for (int m = 0; m < 4; ++m) _Pragma("unroll") for (int n = 0; n < 2; ++n) _Pragma("unroll") for (int k = 0; k < 2; ++k) \
        acc[ai][bj][m][n] = __builtin_amdgcn_mfma_f32_16x16x32_bf16(Bt[n][k], At[m][k], acc[ai][bj][m][n], 0, 0, 0); __builtin_amdgcn_s_setprio(0); } while (0)
#define PG8_WAIT_V(n) asm volatile("s_waitcnt vmcnt(" #n ")" ::: "memory")
#define PG8_WAIT_L(n) asm volatile("s_waitcnt lgkmcnt(" #n ")" ::: "memory")
#define PG8_BAR __builtin_amdgcn_s_barrier()
#define PG8_SCHED __builtin_amdgcn_sched_barrier(0)
    Unit cur, nxt; int ui = 0;
    if (!S.next(0, cur)) return;
    f32x4 acc[2][2][4][2];
#pragma unroll
    for (int a = 0; a < 2; ++a)
#pragma unroll
        for (int b = 0; b < 2; ++b)
#pragma unroll
            for (int m = 0; m < 4; ++m)
#pragma unroll
                for (int n = 0; n < 2; ++n) acc[a][b][m][n] = (f32x4){0.f, 0.f, 0.f, 0.f};
    bf16x8 At[4][2], B0[2][2], B1[2][2];
    const char* cA = (const char*)g.A + (size_t)cur.pm * tstep; const char* cB = (const char*)g.Bt + (size_t)cur.pn * tstep;
    S.a_ready(cur);
    if constexpr (SP2) {
        PG8_STAGE(PG8_SB(0, 0), cB, voffB); PG8_STAGE(PG8_SB(0, 1), cB + hstep, voffB); PG8_STAGE(PG8_SA(0, 0), cA, voffA); PG8_STAGE(PG8_SA(0, 1), cA + hstep, voffA);
        if (wr == 1) PG8_BAR;
        PG8_WAIT_V(2); PG8_BAR;
        PG8_STAGE(PG8_SB(1, 0), cB + kstep, voffB); PG8_STAGE(PG8_SA(1, 0), cA + kstep, voffA); PG8_STAGE(PG8_SB(1, 1), cB + hstep + kstep, voffB);
        PG8_WAIT_V(6); PG8_BAR;
    } else {
        PG8_STAGE(PG8_SB(0, 0), cB, voffB); PG8_STAGE(PG8_SA(0, 0), cA, voffA); PG8_STAGE(PG8_SB(0, 1), cB + hstep, voffB); PG8_STAGE(PG8_SA(0, 1), cA + hstep, voffA);
        if (wr == 1) PG8_BAR;
        PG8_WAIT_V(4); PG8_BAR;
        PG8_STAGE(PG8_SB(1, 0), cB + kstep, voffB); PG8_STAGE(PG8_SA(1, 0), cA + kstep, voffA); PG8_STAGE(PG8_SB(1, 1), cB + hstep + kstep, voffB);
        PG8_WAIT_V(6); PG8_BAR;
    }
    for (;;) {
        const bool has_next = S.next(ui + 1, nxt);
        const char* nA = has_next ? (const char*)g.A + (size_t)nxt.pm * tstep : cA; const char* nB = has_next ? (const char*)g.Bt + (size_t)nxt.pn * tstep : cB;
        for (int t = 0; t < nt; t += 2) {
            const bool last = (t == nt - 2);
            const char* a1 = cA + (size_t)(t + 1) * kstep;
            const char* a2 = last ? nA : cA + (size_t)(t + 2) * kstep; const char* b2 = last ? nB : cB + (size_t)(t + 2) * kstep;
            const char* a3 = a2 + kstep; const char* b3 = b2 + kstep;
            if (last && has_next) S.a_ready(nxt);
            if constexpr (SP2) {
            PG8_LDB(B0, 0, 0); PG8_LDB(B1, 0, 1); PG8_SCHED; PG8_LDA(At, 0, 0); PG8_STAGE(PG8_SA(1, 1), a1 + hstep, voffA);
            PG8_WAIT_V(8); PG8_WAIT_L(0); PG8_BAR; PG8_MMA(0, 0, At, B0); PG8_MMA(0, 1, At, B1); PG8_BAR; PG8_SCHED;
            PG8_LDA(At, 0, 1); PG8_STAGE(PG8_SB(0, 0), b2, voffB); PG8_STAGE(PG8_SB(0, 1), b2 + hstep, voffB); PG8_STAGE(PG8_SA(0, 0), a2, voffA);
            PG8_WAIT_V(8); PG8_WAIT_L(0); PG8_BAR; PG8_MMA(1, 0, At, B0); PG8_MMA(1, 1, At, B1); PG8_BAR; PG8_SCHED;
            PG8_LDB(B0, 1, 0); PG8_LDB(B1, 1, 1); PG8_SCHED; PG8_LDA(At, 1, 0); PG8_STAGE(PG8_SA(0, 1), a2 + hstep, voffA);
            PG8_WAIT_V(8); PG8_WAIT_L(0); PG8_BAR; PG8_MMA(0, 0, At, B0); PG8_MMA(0, 1, At, B1); PG8_BAR; PG8_SCHED;
            PG8_LDA(At, 1, 1); PG8_STAGE(PG8_SB(1, 0), b3, voffB); PG8_STAGE(PG8_SB(1, 1), b3 + hstep, voffB); PG8_STAGE(PG8_SA(1, 0), a3, voffA);
            PG8_WAIT_V(8); PG8_WAIT_L(0); PG8_BAR; PG8_MMA(1, 0, At, B0); PG8_MMA(1, 1, At, B1); PG8_BAR; PG8_SCHED;
            } else {
            PG8_LDB(B0, 0, 0); PG8_SCHED; PG8_LDA(At, 0, 0); PG8_STAGE(PG8_SA(1, 1), a1 + hstep, voffA);
            PG8_WAIT_L(8); PG8_BAR; PG8_WAIT_L(0); PG8_MMA(0, 0, At, B0); PG8_BAR; PG8_SCHED;
            PG8_LDB(B1, 0, 1); PG8_STAGE(PG8_SB(0, 0), b2, voffB);
            PG8_BAR; PG8_WAIT_L(0); PG8_MMA(0, 1, At, B1); PG8_BAR;
            PG8_LDA(At, 0, 1); PG8_STAGE(PG8_SA(0, 0), a2, voffA);
            PG8_BAR; PG8_WAIT_L(0); PG8_MMA(1, 0, At, B0); PG8_BAR; PG8_SCHED;
            PG8_STAGE(PG8_SB(0, 1), b2 + hstep, voffB);
            PG8_WAIT_V(6); PG8_BAR; PG8_MMA(1, 1, At, B1); PG8_BAR;
            PG8_LDB(B0, 1, 0); PG8_SCHED; PG8_LDA(At, 1, 0); PG8_STAGE(PG8_SA(0, 1), a2 + hstep, voffA);
            PG8_WAIT_L(8); PG8_BAR; PG8_WAIT_L(0); PG8_MMA(0, 0, At, B0); PG8_BAR; PG8_SCHED;
            PG8_LDB(B1, 1, 1); PG8_STAGE(PG8_SB(1, 0), b3, voffB);
            PG8_BAR; PG8_WAIT_L(0); PG8_MMA(0, 1, At, B1); PG8_BAR;
            PG8_LDA(At, 1, 1); PG8_STAGE(PG8_SA(1, 0), a3, voffA);
            PG8_BAR; PG8_WAIT_L(0); PG8_MMA(1, 0, At, B0); PG8_BAR; PG8_SCHED;
            PG8_STAGE(PG8_SB(1, 1), b3 + hstep, voffB);
            PG8_WAIT_V(6); PG8_BAR; PG8_MMA(1, 1, At, B1); PG8_BAR;
            }
        }
        if constexpr (ALIGN_EPI) { if (wr == 0) PG8_BAR; }
        if constexpr (!Epi::AFTER_DRAIN) { E(acc, cur, wr, wc, fr, fq); S.done(cur); }
        if (!has_next) break;
#pragma unroll
        for (int a = 0; a < 2; ++a)
#pragma unroll
            for (int b = 0; b < 2; ++b)
#pragma unroll
                for (int m = 0; m < 4; ++m)
#pragma unroll
                    for (int n = 0; n < 2; ++n) acc[a][b][m][n] = (f32x4){0.f, 0.f, 0.f, 0.f};
        cur = nxt; cA = nA; cB = nB; ++ui;
        if constexpr (ALIGN_EPI) { if (wr == 1) PG8_BAR; }
    }
    PG8_WAIT_V(0);
    if constexpr (!ALIGN_EPI) { if (wr == 0) PG8_BAR; }
    PG8_BAR;
    if constexpr (Epi::AFTER_DRAIN) { E.fused(acc, cur, wr, wc, fr, fq, lds, wid, lane); S.done(cur); }
#undef PG8_SA
#undef PG8_SB
#undef PG8_STAGE
#undef PG8_LDA
#undef PG8_LDB
#undef PG8_MMA
#undef PG8_WAIT_V
#undef PG8_WAIT_L
#undef PG8_BAR
#undef PG8_SCHED
}
}

#ifndef MK_PER_PHASE
#define MK_PER_PHASE 0
#endif
constexpr int NB = 8, SEQ = 2048, DM = 2048, MTOK = NB * SEQ, DEPTH = 4, HD = 128;
constexpr int NMIX = 12, NMEMH = 4, NMEM = 256, DFF = 5632, NGU = 2 * DFF, NGRP = 2, HPG = 6;
constexpr int SB_N = 5120, NSA_N = 3840, NSA_SRC = 3620;
constexpr int SBQ = 0, SBK = 1536, SBV = 3072, SBQM = 4608;
constexpr int NQ = 0, NKC = 1536, NVC = 1792, NKS = 2048, NVS = 2304, NKW = 2560, NVW = 2816, NQM = 3072, NGL = 3584;
constexpr int NCMP = 127, CMPROWS = NB * NGRP * NCMP;
constexpr int WINDOW = 512;
constexpr float NORM_EPS = 1e-6f;
constexpr float SCALE = 0.08838834764831845f;
constexpr float LOG2E = 1.4426950408889634f;
constexpr int NWAVES = 8, NTHR = 512;

constexpr size_t MiB = 1u << 20;
constexpr size_t WS_CTL = 0, CTL_ZERO_BYTES = 1 * MiB;
constexpr size_t WS_WIN = 2 * MiB;
constexpr size_t WS_WO = 22 * MiB;
constexpr size_t WS_WGU = 30 * MiB;
constexpr size_t WS_WD = 74 * MiB;
constexpr size_t WS_WKV = 96 * MiB;
constexpr size_t WS_CW1 = 112 * MiB;
constexpr size_t WS_CW2 = 116 * MiB;
constexpr size_t WS_MEMB = 117 * MiB;
constexpr size_t WS_MEMKV = 125 * MiB;
constexpr size_t WS_COS = 141 * MiB, WS_SIN = 145 * MiB;
constexpr size_t WS_RSTD = 149 * MiB;
constexpr size_t WS_SEL = 150 * MiB;
constexpr size_t WS_KCMP = 151 * MiB;
constexpr size_t WS_XB = 152 * MiB;
constexpr size_t WS_TMP = 216 * MiB;
constexpr size_t WS_ACT = 280 * MiB;
constexpr size_t WS_GU = 456 * MiB;
constexpr size_t WS_PROJ = 456 * MiB;
constexpr size_t WS_OCAT = 616 * MiB;
constexpr size_t WS_HG = 680 * MiB, WS_FP = 684 * MiB, WS_FU = 688 * MiB;
constexpr size_t WS_END = 808 * MiB;
constexpr int CW_BAR = 4096;

constexpr int RING_BYTES = 131072;
constexpr int LDSCTL_OFF = 143360, MISC_OFF = LDSCTL_OFF + 320;
constexpr int LDS_BYTES = 147456;
constexpr int HALO_OFF = RING_BYTES;
constexpr int SHM_T = 16384;
constexpr int A_V = 0, A_K = 2 * SHM_T, A_WS = 4 * SHM_T, A_FLAGS = A_WS + NWAVES * 64 * 4, A_STASH = 67584;

#define GAS __attribute__((address_space(1)))
#define LAS __attribute__((address_space(3)))
typedef unsigned short bf16_t;
typedef unsigned v4u __attribute__((ext_vector_type(4)));
typedef unsigned v2u __attribute__((ext_vector_type(2)));
typedef float f32x4 __attribute__((ext_vector_type(4)));
typedef float f32x16 __attribute__((ext_vector_type(16)));
typedef short bf16x8 __attribute__((ext_vector_type(8)));
typedef short s16x4 __attribute__((ext_vector_type(4)));
typedef GAS unsigned gu32;
#define RLX_AGENT __ATOMIC_RELAXED, __HIP_MEMORY_SCOPE_AGENT
#define LDS_WAIT() asm volatile("s_waitcnt lgkmcnt(0)" ::: "memory")
#define VM_WAIT() asm volatile("s_waitcnt vmcnt(0)" ::: "memory")
#define SBAR() __builtin_amdgcn_sched_barrier(0)
__device__ __forceinline__ unsigned cvtpk(float lo, float hi) { unsigned r; asm volatile("v_cvt_pk_bf16_f32 %0, %1, %2" : "=v"(r) : "v"(lo), "v"(hi)); return r; }
__device__ __forceinline__ float bf2f(unsigned short b) { return __uint_as_float((unsigned)b << 16); }
__device__ __forceinline__ float bflo(unsigned w) { return __uint_as_float(w << 16); }
__device__ __forceinline__ float bfhi(unsigned w) { return __uint_as_float(w & 0xffff0000u); }
__device__ __forceinline__ bf16x8 pack8(f32x4 a, f32x4 b) { v4u w = {cvtpk(a[0], a[1]), cvtpk(a[2], a[3]), cvtpk(b[0], b[1]), cvtpk(b[2], b[3])}; return __builtin_bit_cast(bf16x8, w); }
__device__ __forceinline__ void unpack8(bf16x8 v, f32x4& a, f32x4& b) { const v4u w = __builtin_bit_cast(v4u, v); a = (f32x4){bflo(w.x), bfhi(w.x), bflo(w.y), bfhi(w.y)}; b = (f32x4){bflo(w.z), bfhi(w.z), bflo(w.w), bfhi(w.w)}; }
__device__ __forceinline__ float wave_sum(float v) {
#pragma unroll
    for (int o = 1; o < 64; o <<= 1) v += __shfl_xor(v, o);
    return v;
}
__device__ __forceinline__ float sigmoidf_(float x) { return 1.f / (1.f + __builtin_amdgcn_exp2f(-x * LOG2E)); }

__device__ const float INV_FREQ[64] = {1.000000000e+00f, 8.659643531e-01f, 7.498942018e-01f, 6.493816376e-01f, 5.623413324e-01f, 4.869675338e-01f, 4.216965139e-01f, 3.651741147e-01f, 3.162277639e-01f, 2.738419771e-01f, 2.371373773e-01f, 2.053525001e-01f, 1.778279394e-01f, 1.539926529e-01f, 1.333521456e-01f, 1.154781953e-01f, 1.000000015e-01f, 8.659642935e-02f, 7.498942316e-02f, 6.493816525e-02f, 5.623413250e-02f, 4.869675264e-02f, 4.216964915e-02f, 3.651741147e-02f, 3.162277490e-02f, 2.738419548e-02f, 2.371373773e-02f, 2.053525113e-02f, 1.778279431e-02f, 1.539926510e-02f, 1.333521400e-02f, 1.154781971e-02f, 9.999999776e-03f, 8.659643121e-03f, 7.498942316e-03f, 6.493816152e-03f, 5.623413250e-03f, 4.869675264e-03f, 4.216964822e-03f, 3.651741194e-03f, 3.162277630e-03f, 2.738419687e-03f, 2.371373819e-03f, 2.053525066e-03f, 1.778279431e-03f, 1.539926510e-03f, 1.333521446e-03f, 1.154782018e-03f, 1.000000047e-03f, 8.659643354e-04f, 7.498941850e-04f, 6.493816036e-04f, 5.623413017e-04f, 4.869675322e-04f, 4.216965172e-04f, 3.651741135e-04f, 3.162277571e-04f, 2.738419571e-04f, 2.371373703e-04f, 2.053525095e-04f, 1.778279402e-04f, 1.539926598e-04f, 1.333521504e-04f, 1.154782003e-04f};
#define XB_TMO      128
#define XB_XCNT(j)  (256  + 64 * (j))
#define XB_XSUB(j)  (1280 + 64 * (j))
#define XB_XGEN(j)  (2304 + 64 * (j))
#define XB_TOP      3328
#define XB_TOPGEN   3392
#define XCD_BAR_WORDS 3456
#define XB_SPIN_CAP (1u << 18)

__device__ __forceinline__ unsigned xb_ld(unsigned* p)              { return __hip_atomic_load(p, __ATOMIC_RELAXED, __HIP_MEMORY_SCOPE_AGENT); }
__device__ __forceinline__ unsigned xb_add(unsigned* p, unsigned v) { return __hip_atomic_fetch_add(p, v, __ATOMIC_RELAXED, __HIP_MEMORY_SCOPE_AGENT); }
__device__ __forceinline__ unsigned xb_xcc_id() { return (unsigned)__builtin_amdgcn_s_getreg((3 << 11) | 20) & 0xFu; }
#define XB_SPIN(cond, bar) do { unsigned _sp = 0; while (cond) { __builtin_amdgcn_s_sleep(1); \
    if ((++_sp & 255u) == 0u) { if (xb_ld(&(bar)[XB_TMO])) break; if (_sp > XB_SPIN_CAP) { atomicAdd(&(bar)[XB_TMO], 1u); break; } } } } while (0)

struct XcdBarrier {
    unsigned* bar; unsigned x;
    volatile LAS unsigned* st;
};

__device__ __forceinline__ XcdBarrier xcd_barrier_post(unsigned* bar, volatile LAS unsigned* st) {
    XcdBarrier b; b.bar = bar; b.x = xb_xcc_id(); b.st = st;
    if (threadIdx.x == 0) (void)xb_add(&bar[XB_XCNT(b.x)], 1u);
    return b;
}
__device__ __forceinline__ void xcd_barrier_complete(unsigned* bar, unsigned x, unsigned& nloc, unsigned& nx) {
    const unsigned G = gridDim.x * gridDim.y * gridDim.z;
    unsigned sum, cnt, mine, sp = 0u;
    for (;;) {
        sum = 0u; cnt = 0u; mine = 0u;
#pragma unroll
        for (unsigned j = 0; j < 16; ++j) { const unsigned c = xb_ld(&bar[XB_XCNT(j)]); sum += c; cnt += (c > 0u) ? 1u : 0u; mine = (j == x) ? c : mine; }
        if (sum == G) break;
        __builtin_amdgcn_s_sleep(1);
        if ((++sp & 255u) == 0u) { if (xb_ld(&bar[XB_TMO])) break; if (sp > XB_SPIN_CAP) { atomicAdd(&bar[XB_TMO], 1u); break; } }
    }
    nloc = mine > 0u ? mine : 1u; nx = cnt > 0u ? cnt : 1u;
}

__device__ __forceinline__ void xcd_barrier(const XcdBarrier& b) {
    asm volatile("s_waitcnt vmcnt(0)" ::: "memory");
    __syncthreads();
    if (threadIdx.x == 0) {
        unsigned* bar = b.bar;
        __builtin_amdgcn_s_waitcnt(0);
        unsigned nloc = b.st[0], nx = b.st[1];
        if (nloc == 0u) { xcd_barrier_complete(bar, b.x, nloc, nx); b.st[0] = nloc; b.st[1] = nx; }
        const unsigned old = xb_add(&bar[XB_XSUB(b.x)], 1u);
        const unsigned gen = old / nloc;
        if (old + 1u == (gen + 1u) * nloc) {
            __builtin_amdgcn_fence(__ATOMIC_RELEASE, "agent");
            asm volatile("s_waitcnt vmcnt(0)" ::: "memory");
            const unsigned og = xb_add(&bar[XB_TOP], 1u);
            const unsigned tg = og / nx;
            if (og + 1u == (tg + 1u) * nx) xb_add(&bar[XB_TOPGEN], 1u);
            else XB_SPIN(xb_ld(&bar[XB_TOPGEN]) == tg, bar);
            __builtin_amdgcn_fence(__ATOMIC_ACQUIRE, "agent");
            xb_add(&bar[XB_XGEN(b.x)], 1u);
            asm volatile("s_waitcnt vmcnt(0)" ::: "memory");
        } else {
            XB_SPIN(xb_ld(&bar[XB_XGEN(b.x)]) == gen, bar);
            __builtin_amdgcn_fence(__ATOMIC_ACQUIRE, "agent");
            asm volatile("s_waitcnt vmcnt(0)" ::: "memory");
        }
    }
    __syncthreads();
}

#define KSWZ(row, colB) ((row) * 256 + ((colB) ^ (((row) & 7) << 4)))
__device__ __forceinline__ int v_st(int k, int c) { const int kk = (k & ~0xC) | ((k & 4) << 1) | ((k & 8) >> 1); return ((kk >> 3) * 4 + (c >> 5)) * 512 + ((kk & 7) * 32 + (c & 31)) * 2; }
__device__ __forceinline__ int v_rd_base(int lane) { return ((lane & 3) << 3) | (((lane >> 2) & 3) << 6) | (((lane >> 4) & 1) << 5) | (((lane >> 5) & 1) << 8); }
constexpr int v_rd_off(int d0, int ks, int half) { return d0 * 512 + ks * 4096 + half * 2048; }
__device__ __forceinline__ int crow(int r, int hi) { return (r & 3) + 8 * (r >> 2) + 4 * hi; }

struct ACtx {
    LAS unsigned char* lds;
    int tid, wid, lane, r32, hi, sr, sc, kws, vst0, vst1, vb0;
    LAS float* ws;
};
__device__ __forceinline__ ACtx make_actx(LAS unsigned char* lds) {
    ACtx c; c.lds = lds; { int t_ = threadIdx.x; asm volatile("" : "+v"(t_)); c.tid = t_; } c.wid = __builtin_amdgcn_readfirstlane(c.tid >> 6); c.lane = c.tid & 63; c.r32 = c.lane & 31; c.hi = c.lane >> 5;
    c.sr = c.tid >> 4; c.sc = (c.tid & 15) * 8; c.kws = KSWZ(c.sr, c.sc * 2); c.vst0 = v_st(c.sr, c.sc); c.vst1 = v_st(32 + c.sr, c.sc);
    c.vb0 = (int)(unsigned)(size_t)(lds + A_V) + v_rd_base(c.lane);
    c.ws = (LAS float*)(lds + A_WS) + c.wid * 64;
    return c;
}
struct Stage { bf16x8 k0, k1, v0, v1; };
__device__ __forceinline__ void stage_load(Stage& S, const bf16_t* Kp, const bf16_t* Vp, int pitch, int kb, const ACtx& c) {
    S.v0 = *(const bf16x8*)(Vp + (size_t)(kb + c.sr) * pitch + c.sc); S.v1 = *(const bf16x8*)(Vp + (size_t)(kb + 32 + c.sr) * pitch + c.sc);
    S.k0 = *(const bf16x8*)(Kp + (size_t)(kb + c.sr) * pitch + c.sc); S.k1 = *(const bf16x8*)(Kp + (size_t)(kb + 32 + c.sr) * pitch + c.sc);
}
__device__ __forceinline__ void stage_write(const Stage& S, int buf, const ACtx& c) {
    LAS unsigned char* Kb = c.lds + A_K + buf * SHM_T; LAS unsigned char* Vb = c.lds + A_V + buf * SHM_T;
    *(LAS bf16x8*)(Kb + c.kws) = S.k0; *(LAS bf16x8*)(Kb + c.kws + 32 * 256) = S.k1;
    *(LAS bf16x8*)(Vb + c.vst0) = S.v0; *(LAS bf16x8*)(Vb + c.vst1) = S.v1;
}
__device__ __forceinline__ void qkt(f32x16& p0, f32x16& p1, int buf, const ACtx& c, const bf16x8* qr) {
    p0 = (f32x16){}; p1 = (f32x16){};
    const LAS unsigned char* Kb = c.lds + A_K + buf * SHM_T;
    const LAS unsigned char* kb[4];
#pragma unroll
    for (int dd = 0; dd < 4; ++dd) kb[dd] = Kb + KSWZ(c.r32, (dd * 16 + c.hi * 8) * 2);
#pragma unroll
    for (int d0 = 0; d0 < 8; ++d0) { const LAS unsigned char* a = kb[d0 & 3] + (d0 >> 2) * 128;
        const bf16x8 b0 = *(const LAS bf16x8*)a; const bf16x8 b1 = *(const LAS bf16x8*)(a + 32 * 256);
        p0 = __builtin_amdgcn_mfma_f32_32x32x16_bf16(b0, qr[d0], p0, 0, 0, 0);
        p1 = __builtin_amdgcn_mfma_f32_32x32x16_bf16(b1, qr[d0], p1, 0, 0, 0); }
}
__device__ __forceinline__ void pv_tile(f32x16* o, int buf, const ACtx& c, bf16x8 pa0, bf16x8 pa1, bf16x8 pa2, bf16x8 pa3) {
    const int vb = c.vb0 + buf * SHM_T;
#define TRRD(dst, off) asm volatile("ds_read_b64_tr_b16 %0, %1 offset:%2" : "=&v"(dst) : "v"(vb), "i"(off) : "memory")
#define PV_D0(d0) do { s16x4 l0, l1, l2, l3, h0, h1, h2, h3; constexpr int b_ = v_rd_off(d0, 0, 0); \
        TRRD(l0, b_); TRRD(h0, b_ + 2048); TRRD(l1, b_ + 4096); TRRD(h1, b_ + 6144); TRRD(l2, b_ + 8192); TRRD(h2, b_ + 10240); TRRD(l3, b_ + 12288); TRRD(h3, b_ + 14336); \
        asm volatile("s_waitcnt lgkmcnt(0)" ::: "memory"); SBAR(); \
        o[d0] = __builtin_amdgcn_mfma_f32_32x32x16_bf16(pa0, (bf16x8){l0[0], l0[1], l0[2], l0[3], h0[0], h0[1], h0[2], h0[3]}, o[d0], 0, 0, 0); \
        o[d0] = __builtin_amdgcn_mfma_f32_32x32x16_bf16(pa1, (bf16x8){l1[0], l1[1], l1[2], l1[3], h1[0], h1[1], h1[2], h1[3]}, o[d0], 0, 0, 0); \
        o[d0] = __builtin_amdgcn_mfma_f32_32x32x16_bf16(pa2, (bf16x8){l2[0], l2[1], l2[2], l2[3], h2[0], h2[1], h2[2], h2[3]}, o[d0], 0, 0, 0); \
        o[d0] = __builtin_amdgcn_mfma_f32_32x32x16_bf16(pa3, (bf16x8){l3[0], l3[1], l3[2], l3[3], h3[0], h3[1], h3[2], h3[3]}, o[d0], 0, 0, 0); } while (0)
    PV_D0(0); PV_D0(1); PV_D0(2); PV_D0(3);
#undef PV_D0
#undef TRRD
}
__device__ __forceinline__ float swap_max(float v) { auto rr = __builtin_amdgcn_permlane32_swap(__float_as_uint(v), __float_as_uint(v), false, false); return fmaxf(__uint_as_float(rr[0]), __uint_as_float(rr[1])); }
__device__ __forceinline__ float swap_sum(float v) { auto rr = __builtin_amdgcn_permlane32_swap(__float_as_uint(v), __float_as_uint(v), false, false); return __uint_as_float(rr[0]) + __uint_as_float(rr[1]); }
__device__ __forceinline__ void swap_both(float v, float& lo, float& hi) { auto rr = __builtin_amdgcn_permlane32_swap(__float_as_uint(v), __float_as_uint(v), false, false); lo = __uint_as_float(rr[0]); hi = __uint_as_float(rr[1]); }
__device__ __forceinline__ void pack_p(const f32x16& p0, const f32x16& p1, bf16x8& pa0, bf16x8& pa1, bf16x8& pa2, bf16x8& pa3) {
#define PK4(P, B_, OUT) do { unsigned a0 = cvtpk(P[B_+0], P[B_+1]), a1 = cvtpk(P[B_+2], P[B_+3]); \
        unsigned b0 = cvtpk(P[B_+4], P[B_+5]), b1 = cvtpk(P[B_+6], P[B_+7]); \
        auto r0 = __builtin_amdgcn_permlane32_swap(a0, b0, false, false); auto r1 = __builtin_amdgcn_permlane32_swap(a1, b1, false, false); \
        v4u w = {r0[0], r1[0], r0[1], r1[1]}; OUT = __builtin_bit_cast(bf16x8, w); } while (0)
    PK4(p0, 0, pa0); PK4(p0, 8, pa1); PK4(p1, 0, pa2); PK4(p1, 8, pa3);
#undef PK4
}
__device__ __forceinline__ void mask_tile(f32x16& p0, f32x16& p1, int dq, unsigned W) {
    const float NEG = -__builtin_inff();
#pragma unroll
    for (int r = 0; r < 16; ++r) { const int cc = (r & 3) + 8 * (r >> 2);
        if ((unsigned)(dq - cc) >= W) p0[r] = NEG;
        if ((unsigned)(dq - cc - 32) >= W) p1[r] = NEG; }
}
constexpr float THR = 8.f;
__device__ __forceinline__ void softmax_tile(f32x16& p0, f32x16& p1, float& m_reg, float& l_reg, f32x16* o, const ACtx& c) {
    float pmax = p0[0];
#pragma unroll
    for (int r = 1; r < 16; ++r) pmax = fmaxf(pmax, p0[r]);
#pragma unroll
    for (int r = 0; r < 16; ++r) pmax = fmaxf(pmax, p1[r]);
    pmax = swap_max(pmax);
    constexpr float C2 = LOG2E * SCALE;
    float mn, alpha;
    if (__all((pmax - m_reg) * SCALE <= THR)) { mn = m_reg; alpha = 1.f; }
    else { mn = fmaxf(m_reg, pmax); alpha = __builtin_amdgcn_exp2f((m_reg - mn) * C2); m_reg = mn; }
    const float mnL = -mn * C2;
#pragma unroll
    for (int r = 0; r < 16; ++r) { p0[r] = __builtin_amdgcn_exp2f(fmaf(p0[r], C2, mnL)); p1[r] = __builtin_amdgcn_exp2f(fmaf(p1[r], C2, mnL)); }
    float ps = 0.f;
#pragma unroll
    for (int r = 0; r < 16; ++r) ps += p0[r] + p1[r];
    ps = swap_sum(ps);
    l_reg = l_reg * alpha + ps;
    if (__any(alpha < 1.f)) {
        if (c.hi == 0) c.ws[32 + c.r32] = alpha;
        LDS_WAIT();
#pragma unroll
        for (int r = 0; r < 16; ++r) { const float a = c.ws[32 + crow(r, c.hi)];
#pragma unroll
            for (int d = 0; d < 4; ++d) o[d][r] *= a; }
    }
}
__device__ __forceinline__ void row_factors(float f, float (&fr)[16], const ACtx& c) {
    LDS_WAIT();
    if (c.hi == 0) c.ws[c.r32] = f;
    LDS_WAIT();
#pragma unroll
    for (int r = 0; r < 16; ++r) fr[r] = c.ws[crow(r, c.hi)];
    LDS_WAIT();
}
template <bool ROPE>
__device__ __forceinline__ void load_q(bf16x8 (&qr)[8], const bf16_t* qrow, const float* cosr, const float* sinr, int hi) {
#pragma unroll
    for (int d0 = 0; d0 < 8; ++d0) qr[d0] = *(const bf16x8*)(qrow + d0 * 16 + hi * 8);
    if constexpr (ROPE) {
#pragma unroll
        for (int d0 = 0; d0 < 4; ++d0) {
            const int i0 = d0 * 16 + hi * 8;
            const f32x4 c0 = *(const f32x4*)(cosr + i0), c1 = *(const f32x4*)(cosr + i0 + 4), s0 = *(const f32x4*)(sinr + i0), s1 = *(const f32x4*)(sinr + i0 + 4);
            f32x4 a0, a1, b0, b1; unpack8(qr[d0], a0, a1); unpack8(qr[d0 + 4], b0, b1);
            qr[d0] = pack8(a0 * c0 - b0 * s0, a1 * c1 - b1 * s1);
            qr[d0 + 4] = pack8(b0 * c0 + a0 * s0, b1 * c1 + a1 * s1);
        }
    }
}
__device__ __forceinline__ void store_o_bf16(const f32x16* o, bf16_t* Ow  , int pitch, const ACtx& c) {
#pragma unroll
    for (int r = 0; r < 16; ++r) { const int orow = crow(r, c.hi);
#pragma unroll
        for (int d0 = 0; d0 < 4; ++d0) { const float v = o[d0][r]; const float vn = __shfl_xor(v, 1);
            if ((c.r32 & 1) == 0) *(unsigned*)(Ow + (size_t)orow * pitch + d0 * 32 + c.r32) = cvtpk(v, vn); } }
}

template <int MODE>
__device__ __forceinline__ void softmax_sweep(const ACtx& c, const bf16x8 (&qr)[8], f32x16 (&o)[4], float& l_out, const bf16_t* Kp, const bf16_t* Vp, int pitch,
                                              int j_lo, int j_hi, int qpos, int qlo, unsigned selbits) {
    float m_reg = -1e30f, l_reg = 0.f;
#pragma unroll
    for (int d = 0; d < 4; ++d) o[d] = (f32x16){};
    Stage S; stage_load(S, Kp, Vp, pitch, j_lo * 64, c);
    for (int j = j_lo; j < j_hi; ++j) {
        const int buf = (j - j_lo) & 1;
        stage_write(S, buf, c);
        __syncthreads();
        if (j + 1 < j_hi) stage_load(S, Kp, Vp, pitch, (j + 1) * 64, c);
        const int kb = j * 64;
        bool act = true;
        if (MODE == 1) act = (kb <= qlo + 31) && (kb + 63 >= qlo - (WINDOW - 1));
        if (MODE == 2) act = (kb <= qlo + 31) && __any((int)((selbits >> j) & 1u));
        if (act) {
            f32x16 p0, p1; qkt(p0, p1, buf, c, qr);
            if (MODE == 1) mask_tile(p0, p1, qpos - kb - 4 * c.hi, (unsigned)WINDOW);
            if (MODE == 2) { mask_tile(p0, p1, qpos - kb - 4 * c.hi, 0x7fffffffu);
                if (!((selbits >> j) & 1u)) { const float NEG = -__builtin_inff();
#pragma unroll
                    for (int r = 0; r < 16; ++r) { p0[r] = NEG; p1[r] = NEG; } } }
            softmax_tile(p0, p1, m_reg, l_reg, o, c);
            bf16x8 pa0, pa1, pa2, pa3; pack_p(p0, p1, pa0, pa1, pa2, pa3);
            pv_tile(o, buf, c, pa0, pa1, pa2, pa3);
        }
    }
    __syncthreads();
    l_out = l_reg;
}

struct Params {
    const float* x; const float* mem; const int* positions; const float* norm_g; const float* w_in_sb; const float* w_in_nsa; const float* cmp_pe; const float* cmp_w1; const float* cmp_w2;
    const float* w_mem_kv; const float* w_o; const float* w_gate; const float* w_up; const float* conv_w; const float* conv_b; const float* w_down;
    float* out; unsigned char* ws; int ph_lo, ph_hi;
};
struct Frame {
    LAS unsigned char* lds; int tid, lane, wave, G, bid;
};
#define WSP(T, off) ((T*)(p.ws + (off)))

__device__ __forceinline__ void tr_item(const float* W, int K, int Nsrc, int src_col0, int ncols, const float* gain, bf16_t* WT, int dst_row0, int mode, LAS float* scr, int item, int lane) {
    const int nblk = (ncols + 31) >> 5, kb = item / nblk, nb = item - kb * nblk, k0 = 64 * kb, n0 = 32 * nb;
    const int n = n0 + (lane & 31); const bool ok = (W != nullptr) && (n < ncols);
#pragma unroll 8
    for (int i = 0; i < 32; ++i) { const int kk = 2 * i + (lane >> 5); float v = 0.f;
        if (ok) { v = W[(size_t)(k0 + kk) * Nsrc + src_col0 + n]; if (gain) v *= gain[k0 + kk]; }
        scr[kk * 33 + (lane & 31)] = v; }
    LDS_WAIT(); asm volatile("" ::: "memory");
    const int c = lane & 7;
    const int drow0 = dst_row0 + (mode == 0 ? n0 : 256 * (n0 >> 7) + (n0 & 127));
#pragma unroll
    for (int j = 0; j < 4; ++j) { const int nn = (lane >> 3) + 8 * j; const LAS float* s = scr + (8 * c) * 33 + nn;
        v4u o; o.x = cvtpk(s[0 * 33], s[1 * 33]); o.y = cvtpk(s[2 * 33], s[3 * 33]); o.z = cvtpk(s[4 * 33], s[5 * 33]); o.w = cvtpk(s[6 * 33], s[7 * 33]);
        *(v4u*)(WT + (size_t)(drow0 + nn) * K + k0 + 8 * c) = o; }
    LDS_WAIT(); asm volatile("" ::: "memory");
}
__device__ __forceinline__ void row_to_bf16_rstd(const float* xrow, bf16_t* orow, float* rstd_out, int lane) {
    const f32x4* xr = (const f32x4*)xrow + lane; f32x4 v[8]; float s = 0.f;
#pragma unroll
    for (int j = 0; j < 8; ++j) { v[j] = xr[64 * j]; s += (v[j].x * v[j].x + v[j].y * v[j].y) + (v[j].z * v[j].z + v[j].w * v[j].w); }
    s = wave_sum(s);
    v2u* o8 = (v2u*)orow + lane;
#pragma unroll
    for (int j = 0; j < 8; ++j) { v2u w; w.x = cvtpk(v[j].x, v[j].y); w.y = cvtpk(v[j].z, v[j].w); o8[64 * j] = w; }
    if (lane == 0) *rstd_out = 1.0f / sqrtf(s * (1.0f / DM) + NORM_EPS);
}
template <class PP> __device__ __forceinline__ void phase_convert(const PP& p, const Frame& F, int L) {
    LAS float* scr = (LAS float*)(F.lds + F.wave * 16384);
    const int gw = F.bid * NWAVES + F.wave, NGW = F.G * NWAVES;
    int it0 = gw;
#define TR(W, K, Nsrc, sc0, nc, gain, WT, dr0, mode) do { const int n_ = ((K) / 64) * (((nc) + 31) >> 5); for (; it0 < n_; it0 += NGW) tr_item(W, K, Nsrc, sc0, nc, gain, WT, dr0, mode, scr, it0, F.lane); it0 -= n_; } while (0)
    const float* g = p.norm_g + (size_t)L * 5 * DM;
    const int j = L >> 1;
    bf16_t* WIN = WSP(bf16_t, WS_WIN);
    if ((L & 1) == 0) {
        TR(p.w_in_sb + (size_t)j * DM * SB_N, DM, SB_N, 0, SB_N, g, WIN, 0, 0);
    } else {
        const float* W = p.w_in_nsa + (size_t)j * DM * NSA_SRC;
        TR(W, DM, NSA_SRC, 0, 3072, g, WIN, 0, 0);
        TR(W, DM, NSA_SRC, 3108, 512, g, WIN, NQM, 0);
        TR(W, DM, NSA_SRC, 3072, 36, g, WIN, NGL, 0);
        TR((const float*)nullptr, DM, NSA_SRC, 0, 192, (const float*)nullptr, WIN, NGL + 64, 0);
        for (int wh = 0; wh < 2; ++wh) {
            TR(p.cmp_w1 + (size_t)(j * 2 + wh) * 4096 * 256, 4096, 256, 0, 256, (const float*)nullptr, WSP(bf16_t, WS_CW1) + (size_t)wh * 256 * 4096, 0, 0);
            TR(p.cmp_w2 + (size_t)(j * 2 + wh) * 256 * 128, 256, 128, 0, 128, (const float*)nullptr, WSP(bf16_t, WS_CW2) + (size_t)wh * 128 * 256, 0, 0);
        }
    }
    TR(p.w_o + (size_t)L * DM * DM, DM, DM, 0, DM, (const float*)nullptr, WSP(bf16_t, WS_WO), 0, 0);
    TR(p.w_gate + (size_t)L * DM * DFF, DM, DFF, 0, DFF, g + 2 * DM, WSP(bf16_t, WS_WGU), 0, 1);
    TR(p.w_up + (size_t)L * DM * DFF, DM, DFF, 0, DFF, g + 2 * DM, WSP(bf16_t, WS_WGU), 128, 1);
    TR(p.w_down + (size_t)L * DFF * DM, DFF, DM, 0, DM, (const float*)nullptr, WSP(bf16_t, WS_WD), 0, 0);
    if (L == 0) {
        for (int l = 0; l < DEPTH; ++l)
            TR(p.w_mem_kv + (size_t)l * DM * 1024, DM, 1024, 0, 1024, p.norm_g + (size_t)(l * 5 + 4) * DM, WSP(bf16_t, WS_WKV), l * 1024, 0);
        float* rstd = WSP(float, WS_RSTD);
        for (int m = gw; m < MTOK; m += NGW) row_to_bf16_rstd(p.x + (size_t)m * DM, WSP(bf16_t, WS_XB) + (size_t)m * DM, rstd + m, F.lane);
        for (int m = gw; m < NB * NMEM; m += NGW) row_to_bf16_rstd(p.mem + (size_t)m * DM, WSP(bf16_t, WS_MEMB) + (size_t)m * DM, rstd + 16384 + m, F.lane);
        float* cosT = WSP(float, WS_COS); float* sinT = WSP(float, WS_SIN);
        for (int idx = F.bid * NTHR + F.tid; idx < MTOK * 64; idx += F.G * NTHR) {
            const int row = idx >> 6, i = idx & 63;
            const float ang = (float)p.positions[row] * INV_FREQ[i];
            double t = (double)ang * 0.15915494309189535; t -= __builtin_rint(t);
            const float fr = (float)t;
            cosT[idx] = __builtin_amdgcn_cosf(fr); sinT[idx] = __builtin_amdgcn_sinf(fr);
        }
    }
#undef TR
}

template <class PP> __device__ __forceinline__ void phase_resid(const PP& p, const Frame& F, const float* xin, const float* gpost) {
    const int gw = F.bid * NWAVES + F.wave, NGW = F.G * NWAVES;
    const bf16_t* T = WSP(bf16_t, WS_TMP); bf16_t* XB = WSP(bf16_t, WS_XB); float* rstd = WSP(float, WS_RSTD);
    for (int m = gw; m < MTOK; m += NGW) {
        const bf16x8* ar = (const bf16x8*)(T + (size_t)m * DM) + F.lane;
        f32x4 a[8]; float s = 0.f;
#pragma unroll
        for (int j = 0; j < 4; ++j) { unpack8(ar[64 * j], a[2 * j], a[2 * j + 1]); }
#pragma unroll
        for (int j = 0; j < 8; ++j) s += (a[j].x * a[j].x + a[j].y * a[j].y) + (a[j].z * a[j].z + a[j].w * a[j].w);
        const float ra = 1.0f / sqrtf(wave_sum(s) * (1.0f / DM) + NORM_EPS);
        float s2 = 0.f;
#pragma unroll
        for (int j = 0; j < 4; ++j) {
            const int e0 = (j * 64 + F.lane) * 8;
#pragma unroll
            for (int h = 0; h < 2; ++h) {
                const f32x4 xv = *(const f32x4*)(xin + (size_t)m * DM + e0 + 4 * h), gv = *(const f32x4*)(gpost + e0 + 4 * h);
                const f32x4 y = xv + a[2 * j + h] * ra * gv;
                a[2 * j + h] = y; s2 += (y.x * y.x + y.y * y.y) + (y.z * y.z + y.w * y.w);
                *(f32x4*)(p.out + (size_t)m * DM + e0 + 4 * h) = y;
            }
            *((bf16x8*)(XB + (size_t)m * DM) + 64 * j + F.lane) = pack8(a[2 * j], a[2 * j + 1]);
        }
        s2 = wave_sum(s2);
        if (F.lane == 0) rstd[m] = 1.0f / sqrtf(s2 * (1.0f / DM) + NORM_EPS);
    }
}
template <class PP> __device__ __forceinline__ void phase_convfix(const PP& p, const Frame& F, int L) {
    bf16_t* ACT = WSP(bf16_t, WS_ACT); const float* HG = WSP(float, WS_HG); const float* FP = WSP(float, WS_FP); const float* FU = WSP(float, WS_FU);
    const float* cw = p.conv_w + (size_t)L * 3 * DFF;
    constexpr int NCH = DFF / 4;
    for (int it = F.bid * NTHR + F.tid; it < 64 * 2 * NCH; it += F.G * NTHR) {
        const int pm = it / (2 * NCH), rem = it - pm * 2 * NCH, i = rem / NCH, f0 = (rem - i * NCH) * 4;
        if ((pm & 7) == 0) continue;
        const f32x4 h0 = *(const f32x4*)(HG + (size_t)((pm - 1) * 2 + 0) * DFF + f0), h1 = *(const f32x4*)(HG + (size_t)((pm - 1) * 2 + 1) * DFF + f0);
        const f32x4 w0 = *(const f32x4*)(cw + f0), w1 = *(const f32x4*)(cw + DFF + f0);
        f32x4 gc = *(const f32x4*)(FP + (size_t)(pm * 2 + i) * DFF + f0); const f32x4 uu = *(const f32x4*)(FU + (size_t)(pm * 2 + i) * DFF + f0);
        if (i == 0) gc += w0 * h0 + w1 * h1; else gc += w0 * h1;
        v2u o; o.x = cvtpk(gc[0] * sigmoidf_(gc[0]) * uu[0], gc[1] * sigmoidf_(gc[1]) * uu[1]); o.y = cvtpk(gc[2] * sigmoidf_(gc[2]) * uu[2], gc[3] * sigmoidf_(gc[3]) * uu[3]);
        *(v2u*)(ACT + (size_t)(pm * 256 + i) * DFF + f0) = o;
    }
}

template <class PP> __device__ __forceinline__ void sb_unit(const PP& p, const ACtx& c, int b, int h, int qt) {
    const bf16_t* PR = WSP(bf16_t, WS_PROJ); bf16_t* OC = WSP(bf16_t, WS_OCAT);
    const int P0 = qt * 256, qlo = P0 + c.wid * 32, qpos = qlo + c.r32;
    const size_t rowb = (size_t)b * SEQ;
    bf16x8 qr[8]; load_q<false>(qr, PR + (rowb + qpos) * SB_N + SBQ + h * HD, nullptr, nullptr, c.hi);
    const bf16_t* Kp = PR + rowb * SB_N + SBK + h * HD; const bf16_t* Vp = PR + rowb * SB_N + SBV + h * HD;
    f32x16 o[4];
#pragma unroll
    for (int d = 0; d < 4; ++d) o[d] = (f32x16){};
    float C2 = 0.f;
    const int jt = (P0 >> 6) + 3;
    LAS int* flags = (LAS int*)(c.lds + A_FLAGS);
    int done_w = 0;
    Stage S; stage_load(S, Kp, Vp, SB_N, jt * 64, c);
    constexpr float ZS = SCALE * LOG2E;
    for (int it = 0; it <= jt; ++it) {
        const int j = jt - it, buf = it & 1;
        stage_write(S, buf, c);
        if (c.lane == 0) flags[buf * 8 + c.wid] = done_w;
        __syncthreads();
        int alld = 1;
#pragma unroll
        for (int w = 0; w < 8; ++w) alld &= flags[buf * 8 + w];
        if (alld) break;
        if (j > 0) stage_load(S, Kp, Vp, SB_N, (j - 1) * 64, c);
        const int kb = j * 64;
        if (!done_w && kb <= qlo + 30) {
            f32x16 p0, p1; qkt(p0, p1, buf, c, qr);
            const int dq = qpos - kb - 4 * c.hi;
#pragma unroll
            for (int r = 0; r < 16; ++r) { const int cc = (r & 3) + 8 * (r >> 2);
                { const float z = p0[r] * ZS; const float t = __builtin_amdgcn_exp2f(-fabsf(z)); const float v = -(fmaxf(z, 0.f) + __builtin_amdgcn_logf(1.f + t)); p0[r] = (cc < dq) ? v : 0.f; }
                { const float z = p1[r] * ZS; const float t = __builtin_amdgcn_exp2f(-fabsf(z)); const float v = -(fmaxf(z, 0.f) + __builtin_amdgcn_logf(1.f + t)); p1[r] = (cc + 32 < dq) ? v : 0.f; } }
            float E[8], Od[8];
#pragma unroll
            for (int q = 0; q < 4; ++q) { const float g0 = (p0[4 * q] + p0[4 * q + 1]) + (p0[4 * q + 2] + p0[4 * q + 3]); swap_both(g0, E[q], Od[q]);
                                          const float g1 = (p1[4 * q] + p1[4 * q + 1]) + (p1[4 * q + 2] + p1[4 * q + 3]); swap_both(g1, E[4 + q], Od[4 + q]); }
            float T = 0.f, ex[8];
#pragma unroll
            for (int q = 7; q >= 0; --q) { const float to = T; T += Od[q]; const float te = T; T += E[q]; ex[q] = c.hi ? to : te; }
#pragma unroll
            for (int q = 0; q < 4; ++q) {
                { float R = C2 + ex[q]; float ep = __builtin_amdgcn_exp2f(R);
#pragma unroll
                  for (int i = 3; i >= 0; --i) { R += p0[4 * q + i]; const float e = __builtin_amdgcn_exp2f(R); p0[4 * q + i] = ep - e; ep = e; } }
                { float R = C2 + ex[4 + q]; float ep = __builtin_amdgcn_exp2f(R);
#pragma unroll
                  for (int i = 3; i >= 0; --i) { R += p1[4 * q + i]; const float e = __builtin_amdgcn_exp2f(R); p1[4 * q + i] = ep - e; ep = e; } }
            }
            C2 += T;
            bf16x8 pa0, pa1, pa2, pa3; pack_p(p0, p1, pa0, pa1, pa2, pa3);
            pv_tile(o, buf, c, pa0, pa1, pa2, pa3);
            done_w = __all(C2 < -72.f) ? 1 : 0;
        }
    }
    __syncthreads();
    store_o_bf16(o, OC + (rowb + qlo) * DM + h * HD, DM, c);
}
template <class PP> __device__ __forceinline__ void mem_unit(const PP& p, const ACtx& c, int L, int b, int hm, int qt, int projN, int qmcol) {
    const bf16_t* PR = WSP(bf16_t, WS_PROJ); bf16_t* OC = WSP(bf16_t, WS_OCAT); const bf16_t* MKV = WSP(bf16_t, WS_MEMKV);
    const int P0 = qt * 256, qlo = P0 + c.wid * 32, qpos = qlo + c.r32;
    const size_t rowb = (size_t)b * SEQ;
    bf16x8 qr[8]; load_q<false>(qr, PR + (rowb + qpos) * projN + qmcol + hm * HD, nullptr, nullptr, c.hi);
    const bf16_t* Kp = MKV + (size_t)b * NMEM * 4096 + L * 1024 + hm * HD; const bf16_t* Vp = Kp + 512;
    f32x16 o[4]; float l;
    softmax_sweep<0>(c, qr, o, l, Kp, Vp, 4096, 0, 4, qpos, qlo, 0u);
    float fr[16]; row_factors(1.0f / l, fr, c);
#pragma unroll
    for (int d = 0; d < 4; ++d)
#pragma unroll
        for (int r = 0; r < 16; ++r) o[d][r] *= fr[r];
    store_o_bf16(o, OC + (rowb + qlo) * DM + NMIX * HD + hm * HD, DM, c);
}
template <class PP> __device__ __forceinline__ void phase_attn_sb(const PP& p, const Frame& F, int L) {
    const ACtx c = make_actx(F.lds);
    constexpr int NSBU = NB * NMIX * 8, NMU = NB * NMEMH * 8;
    for (int u = F.bid; u < NSBU + NMU; u += F.G) {
        if (u < NSBU) { const int qt = 7 - (u % 8), bh = u / 8; sb_unit(p, c, bh / NMIX, bh % NMIX, qt); }
        else { const int v = u - NSBU; const int qt = v % 8, bh = v / 8; mem_unit(p, c, L, bh / NMEMH, bh % NMEMH, qt, SB_N, SBQM); }
    }
}

template <class PP> __device__ __forceinline__ void phase_nsa_prep(const PP& p, const Frame& F, int L) {
    bf16_t* PR = WSP(bf16_t, WS_PROJ); const float* cosT = WSP(float, WS_COS); const float* sinT = WSP(float, WS_SIN);
    const int j = L >> 1;
    const int lane = F.lane, r32 = lane & 31, hi = lane >> 5;
    LAS bf16_t* hid = (LAS bf16_t*)F.lds;
    for (int u = F.bid; u < 128; u += F.G) {
        const int wh = u & 1, rt = u >> 1;
        int rho = rt * 32 + r32; if (rho > CMPROWS - 1) rho = CMPROWS - 1;
        const int bg = rho / NCMP, cc = rho - bg * NCMP, b = bg >> 1, g = bg & 1;
        const size_t tok0 = (size_t)b * SEQ + 16 * cc;
        const bf16_t* src = PR + tok0 * NSA_N + (wh ? NVC : NKC) + g * HD;
        const float* pe = p.cmp_pe + (size_t)(j * 2 + wh) * 32 * HD;
        const bf16_t* w1 = WSP(bf16_t, WS_CW1) + (size_t)wh * 256 * 4096 + (size_t)(F.wave * 32 + r32) * 4096;
        f32x16 acc = (f32x16){};
        for (int l = 0; l < 32; ++l) {
            const bf16_t* rp = src + (size_t)l * NSA_N; const float* pel = pe + l * HD;
            if (wh == 0) {
                const float* cr = cosT + (tok0 + l) * 64; const float* sr = sinT + (tok0 + l) * 64;
#pragma unroll
                for (int kk = 0; kk < 4; ++kk) { const int d = kk * 16 + hi * 8;
                    f32x4 a0, a1, b0, b1; unpack8(*(const bf16x8*)(rp + d), a0, a1); unpack8(*(const bf16x8*)(rp + 64 + d), b0, b1);
                    const f32x4 c0 = *(const f32x4*)(cr + d), c1 = *(const f32x4*)(cr + d + 4), s0 = *(const f32x4*)(sr + d), s1 = *(const f32x4*)(sr + d + 4);
                    const bf16x8 x1 = pack8(a0 * c0 - b0 * s0 + *(const f32x4*)(pel + d), a1 * c1 - b1 * s1 + *(const f32x4*)(pel + d + 4));
                    const bf16x8 x2 = pack8(b0 * c0 + a0 * s0 + *(const f32x4*)(pel + 64 + d), b1 * c1 + a1 * s1 + *(const f32x4*)(pel + 64 + d + 4));
                    acc = __builtin_amdgcn_mfma_f32_32x32x16_bf16(x1, *(const bf16x8*)(w1 + l * HD + d), acc, 0, 0, 0);
                    acc = __builtin_amdgcn_mfma_f32_32x32x16_bf16(x2, *(const bf16x8*)(w1 + l * HD + 64 + d), acc, 0, 0, 0); }
            } else {
#pragma unroll
                for (int kk = 0; kk < 8; ++kk) { const int d = kk * 16 + hi * 8;
                    f32x4 a0, a1; unpack8(*(const bf16x8*)(rp + d), a0, a1);
                    const bf16x8 x1 = pack8(a0 + *(const f32x4*)(pel + d), a1 + *(const f32x4*)(pel + d + 4));
                    acc = __builtin_amdgcn_mfma_f32_32x32x16_bf16(x1, *(const bf16x8*)(w1 + l * HD + d), acc, 0, 0, 0); }
            }
        }
#pragma unroll
        for (int r = 0; r < 16; ++r) { const float v = acc[r]; const float sv = v * sigmoidf_(v);
            hid[crow(r, hi) * 264 + F.wave * 32 + r32] = (bf16_t)(cvtpk(sv, sv) & 0xffffu); }
        __syncthreads();
        if (F.wave < 4) {
            const bf16_t* w2 = WSP(bf16_t, WS_CW2) + (size_t)wh * 128 * 256 + (size_t)(F.wave * 32 + r32) * 256;
            f32x16 a2 = (f32x16){};
#pragma unroll
            for (int kk = 0; kk < 16; ++kk) { const int k = kk * 16 + hi * 8;
                a2 = __builtin_amdgcn_mfma_f32_32x32x16_bf16(*(const LAS bf16x8*)(hid + r32 * 264 + k), *(const bf16x8*)(w2 + k), a2, 0, 0, 0); }
            bf16_t* outp = WSP(bf16_t, WS_KCMP) + (size_t)wh * 16 * 128 * 128;
#pragma unroll
            for (int r = 0; r < 16; ++r) { const int ro = rt * 32 + crow(r, hi);
                if (ro < CMPROWS) { const int bg2 = ro / NCMP, c2 = ro - bg2 * NCMP; outp[((size_t)bg2 * 128 + c2) * 128 + F.wave * 32 + r32] = (bf16_t)(cvtpk(a2[r], a2[r]) & 0xffffu); } }
        }
        if (rt == 0) { bf16_t* outp = WSP(bf16_t, WS_KCMP) + (size_t)wh * 16 * 128 * 128;
            for (int e = F.tid; e < 16 * 128; e += NTHR) outp[((size_t)(e >> 7) * 128 + 127) * 128 + (e & 127)] = 0; }
        __syncthreads();
    }
    const int gw = F.bid * NWAVES + F.wave, NGW = F.G * NWAVES;
    for (int m = gw; m < MTOK; m += NGW) {
        const float cv = cosT[(size_t)m * 64 + lane], sv = sinT[(size_t)m * 64 + lane];
#pragma unroll
        for (int q = 0; q < 4; ++q) { bf16_t* bp = PR + (size_t)m * NSA_N + ((q < 2) ? NKS : NKW) + (q & 1) * HD;
            const float x1 = bf2f(bp[lane]), x2 = bf2f(bp[64 + lane]);
            const float y1 = x1 * cv - x2 * sv, y2 = x2 * cv + x1 * sv;
            bp[lane] = (bf16_t)(cvtpk(y1, y1) & 0xffffu); bp[64 + lane] = (bf16_t)(cvtpk(y2, y2) & 0xffffu); }
    }
}

template <class PP> __device__ __forceinline__ void cmp_unit(const PP& p, const ACtx& c, int b, int g, int qt) {
    const bf16_t* PR = WSP(bf16_t, WS_PROJ); bf16_t* OC = WSP(bf16_t, WS_OCAT); const float* cosT = WSP(float, WS_COS); const float* sinT = WSP(float, WS_SIN);
    const int P0 = qt * 256, qlo = P0 + c.wid * 32, qpos = qlo + c.r32, hi = c.hi;
    const size_t rowb = (size_t)b * SEQ, row = rowb + qpos;
    const bf16_t* Kp = WSP(bf16_t, WS_KCMP) + (size_t)(b * 2 + g) * 128 * 128; const bf16_t* Vp = Kp + (size_t)16 * 128 * 128;
    { Stage S; stage_load(S, Kp, Vp, 128, 0, c); stage_write(S, 0, c); stage_load(S, Kp, Vp, 128, 64, c); stage_write(S, 1, c); }
    __syncthreads();
    const int cmax = (qpos >= 31) ? (((qpos - 31) >> 4) < 126 ? ((qpos - 31) >> 4) : 126) : -1;
    LAS float* acc_l = (LAS float*)(c.lds + A_STASH) + c.wid * 2048 + c.lane;
    const float NEG = -__builtin_inff();
    constexpr float C2 = LOG2E * SCALE;
#pragma nounroll
    for (int hh = 0; hh < HPG; ++hh) {
        const int h = g * HPG + hh;
        bf16x8 qr[8]; load_q<true>(qr, PR + row * NSA_N + NQ + h * HD, cosT + row * 64, sinT + row * 64, hi);
        f32x16 pA0, pA1, pB0, pB1; qkt(pA0, pA1, 0, c, qr); qkt(pB0, pB1, 1, c, qr);
        float mx = NEG;
#pragma unroll
        for (int r = 0; r < 16; ++r) { const int ci = crow(r, hi);
            if (ci > cmax) pA0[r] = NEG; if (ci + 32 > cmax) pA1[r] = NEG; if (ci + 64 > cmax) pB0[r] = NEG; if (ci + 96 > cmax) pB1[r] = NEG;
            mx = fmaxf(fmaxf(mx, pA0[r]), fmaxf(pA1[r], fmaxf(pB0[r], pB1[r]))); }
        mx = swap_max(mx); if (mx == NEG) mx = 0.f;
        const float mL = -mx * C2; float ls = 0.f;
#pragma unroll
        for (int r = 0; r < 16; ++r) { pA0[r] = __builtin_amdgcn_exp2f(fmaf(pA0[r], C2, mL)); pA1[r] = __builtin_amdgcn_exp2f(fmaf(pA1[r], C2, mL));
            pB0[r] = __builtin_amdgcn_exp2f(fmaf(pB0[r], C2, mL)); pB1[r] = __builtin_amdgcn_exp2f(fmaf(pB1[r], C2, mL)); ls += (pA0[r] + pA1[r]) + (pB0[r] + pB1[r]); }
        ls = swap_sum(ls);
        const float inv = ls > 0.f ? 1.0f / ls : 0.f;
#pragma unroll
        for (int r = 0; r < 16; ++r) { pA0[r] *= inv; pA1[r] *= inv; pB0[r] *= inv; pB1[r] *= inv; }
#define ACC_AB(P, Q0) do { _Pragma("unroll") for (int q = 0; q < 4; ++q) { \
            const float a_ = 2.f * (P[4 * q] + P[4 * q + 1] + P[4 * q + 2]) + P[4 * q + 3], b_ = P[4 * q + 3]; \
            LAS float* pa_ = acc_l + (2 * (Q0 + q)) * 64; \
            if (hh == 0) { pa_[0] = a_; pa_[64] = b_; } else { pa_[0] += a_; pa_[64] += b_; } } } while (0)
        ACC_AB(pA0, 0); ACC_AB(pA1, 4); ACC_AB(pB0, 8); ACC_AB(pB1, 12);
#undef ACC_AB
        f32x16 o[4];
#pragma unroll
        for (int d = 0; d < 4; ++d) o[d] = (f32x16){};
        { bf16x8 pa0, pa1, pa2, pa3; pack_p(pA0, pA1, pa0, pa1, pa2, pa3); pv_tile(o, 0, c, pa0, pa1, pa2, pa3); }
        { bf16x8 pa0, pa1, pa2, pa3; pack_p(pB0, pB1, pa0, pa1, pa2, pa3); pv_tile(o, 1, c, pa0, pa1, pa2, pa3); }
        const float gc = sigmoidf_(bf2f(PR[row * NSA_N + NGL + h * 3 + 0]));
        float fr[16]; row_factors(gc, fr, c);
#pragma unroll
        for (int d = 0; d < 4; ++d)
#pragma unroll
            for (int r = 0; r < 16; ++r) o[d][r] *= fr[r];
        store_o_bf16(o, OC + (rowb + qlo) * DM + h * HD, DM, c);
    }
    float Ie[16], Io[16];
    {
        float imp[16], Bb[16];
#pragma unroll
        for (int q = 0; q < 16; ++q) { float blo, bhi; swap_both(acc_l[(2 * q + 1) * 64], blo, bhi); Bb[q] = hi ? blo : bhi; }
#pragma unroll
        for (int q = 0; q < 16; ++q) imp[q] = acc_l[(2 * q) * 64] + (hi ? Bb[q] : (q > 0 ? Bb[q - 1] : 0.f));
#pragma unroll
        for (int q = 0; q < 16; ++q) swap_both(imp[q], Ie[q], Io[q]);
    }
    const int cur = qpos >> 6;
    unsigned bits;
    if (cur < 16) bits = (2u << cur) - 1u;
    else {
#pragma unroll
        for (int q = 0; q < 16; ++q) { const int je = 2 * q, jo = 2 * q + 1;
            if (!(je >= 1 && je <= cur - 2)) Ie[q] = -1.f; if (!(jo >= 1 && jo <= cur - 2)) Io[q] = -1.f; }
        bits = 0u;
#pragma unroll
        for (int q = 0; q < 16; ++q) {
            const int jm = 2 * q + hi; const float vj = hi ? Io[q] : Ie[q];
            int rank = 0;
#pragma unroll
            for (int q2 = 0; q2 < 16; ++q2) {
                const bool lt_e = (q2 < q) || (q2 == q && hi);
                const bool lt_o = (q2 < q);
                rank += (Ie[q2] > vj || (Ie[q2] == vj && lt_e)) ? 1 : 0;
                rank += (Io[q2] > vj || (Io[q2] == vj && lt_o)) ? 1 : 0;
            }
            const bool forced = (jm == 0) || (jm == cur) || (jm == cur - 1);
            const bool sel = forced || (vj >= 0.f && rank < 13);
            bits |= sel ? (1u << jm) : 0u;
        }
        { auto rr = __builtin_amdgcn_permlane32_swap(bits, bits, false, false); bits = rr[0] | rr[1]; }
    }
    if (hi == 0) WSP(unsigned, WS_SEL)[(size_t)(b * 2 + g) * SEQ + qpos] = bits;
    __syncthreads();
}
template <class PP> __device__ __forceinline__ void phase_attn_cmp(const PP& p, const Frame& F, int L) {
    const ACtx c = make_actx(F.lds);
    constexpr int NCU = NB * NGRP * 8, NMU = NB * NMEMH * 8;
    for (int u = F.bid; u < NCU + NMU; u += F.G) {
        if (u < NCU) { const int qt = u % 8, bg = u / 8; cmp_unit(p, c, bg >> 1, bg & 1, qt); }
        else { const int v = u - NCU; const int qt = v % 8, bh = v / 8; mem_unit(p, c, L, bh / NMEMH, bh % NMEMH, qt, NSA_N, NQM); }
    }
}
template <class PP> __device__ __forceinline__ void selwin_unit(const PP& p, const ACtx& c, int b, int h, int qt) {
    const bf16_t* PR = WSP(bf16_t, WS_PROJ); bf16_t* OC = WSP(bf16_t, WS_OCAT); const float* cosT = WSP(float, WS_COS); const float* sinT = WSP(float, WS_SIN);
    const int P0 = qt * 256, qlo = P0 + c.wid * 32, qpos = qlo + c.r32, g = h / HPG;
    const size_t rowb = (size_t)b * SEQ, row = rowb + qpos;
    bf16x8 qr[8]; load_q<true>(qr, PR + row * NSA_N + NQ + h * HD, cosT + row * 64, sinT + row * 64, c.hi);
    const unsigned selbits = WSP(unsigned, WS_SEL)[(size_t)(b * 2 + g) * SEQ + qpos];
    const float gs = sigmoidf_(bf2f(PR[row * NSA_N + NGL + h * 3 + 1])), gwn = sigmoidf_(bf2f(PR[row * NSA_N + NGL + h * 3 + 2]));
    f32x16 o[4]; float l;
    LAS unsigned* stash = (LAS unsigned*)(c.lds + A_STASH) + c.wid * 2048;
    softmax_sweep<2>(c, qr, o, l, PR + rowb * NSA_N + NKS + g * HD, PR + rowb * NSA_N + NVS + g * HD, NSA_N, 0, (P0 >> 6) + 4, qpos, qlo, selbits);
    {
        float fr[16]; row_factors(l > 0.f ? gs / l : 0.f, fr, c);
        const bf16_t* Ow = OC + (rowb + qlo) * DM + h * HD;
#pragma unroll
        for (int r = 0; r < 16; ++r) { const int orow = crow(r, c.hi);
#pragma unroll
            for (int d0 = 0; d0 < 4; ++d0) o[d0][r] = o[d0][r] * fr[r] + bf2f(Ow[(size_t)orow * DM + d0 * 32 + c.r32]); }
#pragma unroll
        for (int r = 0; r < 16; ++r)
#pragma unroll
            for (int d0 = 0; d0 < 4; d0 += 2) stash[((r * 2 + (d0 >> 1)) * 2 + c.hi) * 32 + c.r32] = cvtpk(o[d0][r], o[d0 + 1][r]);
    }
    const int jlo = (P0 - (WINDOW - 1)) > 0 ? ((P0 - (WINDOW - 1)) >> 6) : 0;
    softmax_sweep<1>(c, qr, o, l, PR + rowb * NSA_N + NKW + g * HD, PR + rowb * NSA_N + NVW + g * HD, NSA_N, jlo, (P0 >> 6) + 4, qpos, qlo, 0u);
    {
        float fr[16]; row_factors(l > 0.f ? gwn / l : 0.f, fr, c);
#pragma unroll
        for (int r = 0; r < 16; ++r)
#pragma unroll
            for (int d0 = 0; d0 < 4; d0 += 2) { const unsigned w = stash[((r * 2 + (d0 >> 1)) * 2 + c.hi) * 32 + c.r32];
                o[d0][r] = o[d0][r] * fr[r] + bflo(w); o[d0 + 1][r] = o[d0 + 1][r] * fr[r] + bfhi(w); }
    }
    store_o_bf16(o, OC + (rowb + qlo) * DM + h * HD, DM, c);
}
template <class PP> __device__ __forceinline__ void phase_attn_selwin(const PP& p, const Frame& F) {
    const ACtx c = make_actx(F.lds);
    constexpr int NU = NB * NMIX * 8;
    for (int u = F.bid; u < NU; u += F.G) { const int qt = 7 - (u / (NB * NMIX)), bh = u % (NB * NMIX); selwin_unit(p, c, bh / NMIX, bh % NMIX, qt); }
}

#ifndef PROBE_REPEAT
#define PROBE_REPEAT 0
#endif
constexpr int NPH_SB = 9, NPH_NSA = 11, NPH = 2 * (NPH_SB + NPH_NSA);
__global__ void __launch_bounds__(NTHR, 2) mk_fwd(Params p) {
    extern __shared__ __attribute__((aligned(16))) unsigned char lds_raw[];
    LAS unsigned char* const lds0 = (LAS unsigned char*)lds_raw;
typedef const Params __attribute__((address_space(4))) KParams;
#define MKFRAME() KParams* pp_ = (KParams*)__builtin_amdgcn_kernarg_segment_ptr(); asm volatile("" : "+s"(pp_)); KParams& p = *pp_; Frame F; F.lds = lds0; { int t_ = threadIdx.x; asm volatile("" : "+v"(t_)); F.tid = t_; } F.lane = F.tid & 63; F.wave = __builtin_amdgcn_readfirstlane(F.tid >> 6); F.G = gridDim.x; F.bid = blockIdx.x
    for (int u = threadIdx.x; u < (LDS_BYTES - LDSCTL_OFF) / 4; u += NTHR) ((LAS unsigned*)(lds0 + LDSCTL_OFF))[u] = 0u;
    __syncthreads();
    gu32* ctl = (gu32*)(p.ws + WS_CTL);
    XcdBarrier bar; bar.bar = (unsigned*)(ctl + CW_BAR); bar.x = 0; bar.st = nullptr;
#if !MK_PER_PHASE
    bar = xcd_barrier_post((unsigned*)(ctl + CW_BAR), (volatile LAS unsigned*)(lds0 + MISC_OFF) + 8);
#endif
    const int lo = p.ph_lo, hi = p.ph_hi;
    int ph = 0;
#define IN() (lo <= ph && ph < hi)
#if MK_PER_PHASE
#define END_PHASE() do { ++ph; } while (0)
#else
#define END_PHASE() do { if (IN() && ph + 1 < hi) xcd_barrier(bar); ++ph; } while (0)
#endif
#define GEMM_RS(Aoff, Boff, M_, N_, K_, Ooff, ldc_, rs_) do { pg8::Gemm g{WSP(pg8::bf16_t, Aoff), WSP(pg8::bf16_t, Boff), M_, N_, K_}; pg8::StaticOrder S; S.init(M_, N_, F.G, F.bid); \
        pg8::EpiRS E{WSP(pg8::bf16_t, Ooff), ldc_, rs_}; pg8::gemm_phase<pg8::EpiRS, pg8::StaticOrder, true, true>(F.lds, g, S, E); } while (0)

#define GEMM_GU(L_) do { pg8::Gemm g{WSP(pg8::bf16_t, WS_XB), WSP(pg8::bf16_t, WS_WGU), MTOK, NGU, DM}; pg8::StaticOrder S; S.init(MTOK, NGU, F.G, F.bid); \
        pg8::EpiConv E{WSP(pg8::bf16_t, WS_ACT), WSP(float, WS_RSTD), p.conv_w + (size_t)(L_) * 3 * DFF, p.conv_b + (size_t)(L_) * DFF, WSP(float, WS_HG), WSP(float, WS_FP), WSP(float, WS_FU), (LAS float*)(F.lds + HALO_OFF), DFF}; \
        pg8::gemm_phase<pg8::EpiConv, pg8::StaticOrder, true, true>(F.lds, g, S, E); } while (0)

    for (int lp = 0; lp < 2; ++lp) {
        {
            const int L = 2 * lp;
            if (IN()) { MKFRAME(); for (int rep_ = 0; rep_ < ((PROBE_REPEAT & 1) ? 2 : 1); ++rep_) { phase_convert(p, F, L); } }
            END_PHASE();
            if (IN()) { MKFRAME(); for (int rep_ = 0; rep_ < ((PROBE_REPEAT & 2) ? 2 : 1); ++rep_) { GEMM_RS(WS_XB, WS_WIN, MTOK, SB_N, DM, WS_PROJ, SB_N, WSP(float, WS_RSTD));
                        if (L == 0) GEMM_RS(WS_MEMB, WS_WKV, NB * NMEM, 4096, DM, WS_MEMKV, 4096, WSP(float, WS_RSTD) + 16384); } }
            END_PHASE();
            if (IN()) { MKFRAME(); for (int rep_ = 0; rep_ < ((PROBE_REPEAT & 4) ? 2 : 1); ++rep_) { phase_attn_sb(p, F, L); } }
            END_PHASE();
            if (IN()) { MKFRAME(); for (int rep_ = 0; rep_ < ((PROBE_REPEAT & 2) ? 2 : 1); ++rep_) { GEMM_RS(WS_OCAT, WS_WO, MTOK, DM, DM, WS_TMP, DM, (const float*)nullptr); } }
            END_PHASE();
            if (IN()) { MKFRAME(); for (int rep_ = 0; rep_ < ((PROBE_REPEAT & 8) ? 2 : 1); ++rep_) { phase_resid(p, F, (L == 0) ? p.x : (const float*)p.out, p.norm_g + (size_t)(L * 5 + 1) * DM); } }
            END_PHASE();
            if (IN()) { MKFRAME(); for (int rep_ = 0; rep_ < ((PROBE_REPEAT & 2) ? 2 : 1); ++rep_) { GEMM_GU(L); } }
            END_PHASE();
            if (IN()) { MKFRAME(); for (int rep_ = 0; rep_ < ((PROBE_REPEAT & 16) ? 2 : 1); ++rep_) { phase_convfix(p, F, L); } }
            END_PHASE();
            if (IN()) { MKFRAME(); for (int rep_ = 0; rep_ < ((PROBE_REPEAT & 2) ? 2 : 1); ++rep_) { GEMM_RS(WS_ACT, WS_WD, MTOK, DM, DFF, WS_TMP, DM, (const float*)nullptr); } }
            END_PHASE();
            if (IN()) { MKFRAME(); for (int rep_ = 0; rep_ < ((PROBE_REPEAT & 8) ? 2 : 1); ++rep_) { phase_resid(p, F, (const float*)p.out, p.norm_g + (size_t)(L * 5 + 3) * DM); } }
            END_PHASE();
        }
        {
            const int L = 2 * lp + 1;
            if (IN()) { MKFRAME(); for (int rep_ = 0; rep_ < ((PROBE_REPEAT & 1) ? 2 : 1); ++rep_) { phase_convert(p, F, L); } }
            END_PHASE();
            if (IN()) { MKFRAME(); for (int rep_ = 0; rep_ < ((PROBE_REPEAT & 2) ? 2 : 1); ++rep_) { GEMM_RS(WS_XB, WS_WIN, MTOK, NSA_N, DM, WS_PROJ, NSA_N, WSP(float, WS_RSTD)); } }
            END_PHASE();
            if (IN()) { MKFRAME(); for (int rep_ = 0; rep_ < ((PROBE_REPEAT & 32) ? 2 : 1); ++rep_) { phase_nsa_prep(p, F, L); } }
            END_PHASE();
            if (IN()) { MKFRAME(); for (int rep_ = 0; rep_ < ((PROBE_REPEAT & 64) ? 2 : 1); ++rep_) { phase_attn_cmp(p, F, L); } }
            END_PHASE();
            if (IN()) { MKFRAME(); for (int rep_ = 0; rep_ < ((PROBE_REPEAT & 128) ? 2 : 1); ++rep_) { phase_attn_selwin(p, F); } }
            END_PHASE();
            if (IN()) { MKFRAME(); for (int rep_ = 0; rep_ < ((PROBE_REPEAT & 2) ? 2 : 1); ++rep_) { GEMM_RS(WS_OCAT, WS_WO, MTOK, DM, DM, WS_TMP, DM, (const float*)nullptr); } }
            END_PHASE();
            if (IN()) { MKFRAME(); for (int rep_ = 0; rep_ < ((PROBE_REPEAT & 8) ? 2 : 1); ++rep_) { phase_resid(p, F, (const float*)p.out, p.norm_g + (size_t)(L * 5 + 1) * DM); } }
            END_PHASE();
            if (IN()) { MKFRAME(); for (int rep_ = 0; rep_ < ((PROBE_REPEAT & 2) ? 2 : 1); ++rep_) { GEMM_GU(L); } }
            END_PHASE();
            if (IN()) { MKFRAME(); for (int rep_ = 0; rep_ < ((PROBE_REPEAT & 16) ? 2 : 1); ++rep_) { phase_convfix(p, F, L); } }
            END_PHASE();
            if (IN()) { MKFRAME(); for (int rep_ = 0; rep_ < ((PROBE_REPEAT & 2) ? 2 : 1); ++rep_) { GEMM_RS(WS_ACT, WS_WD, MTOK, DM, DFF, WS_TMP, DM, (const float*)nullptr); } }
            END_PHASE();
            if (IN()) { MKFRAME(); for (int rep_ = 0; rep_ < ((PROBE_REPEAT & 8) ? 2 : 1); ++rep_) { phase_resid(p, F, (const float*)p.out, p.norm_g + (size_t)(L * 5 + 3) * DM); } }
            END_PHASE();
        }
    }
#undef IN
#undef END_PHASE
#undef GEMM_RS
#undef GEMM_GU
}

extern "C" void kernel_launch(void* const* d_in, const int* in_sizes, int n_in, void* d_out, int out_size, void* d_ws, size_t ws_size, hipStream_t stream) {
    static int grid = 0;
    if (grid == 0) {
        if (n_in != 16 || out_size != MTOK * DM || ws_size < WS_END) { fprintf(stderr, "kernel_launch: unexpected shapes (n_in %d, out %d, ws %zu < %zu)\n", n_in, out_size, ws_size, (size_t)WS_END); grid = -1; return; }
        int dev = 0, cus = 0, per_cu = 0;
        if (hipGetDevice(&dev) != hipSuccess || hipDeviceGetAttribute(&cus, hipDeviceAttributeMultiprocessorCount, dev) != hipSuccess) { grid = -1; return; }
        if (hipFuncSetAttribute((const void*)mk_fwd, hipFuncAttributeMaxDynamicSharedMemorySize, LDS_BYTES) != hipSuccess) { fprintf(stderr, "kernel_launch: hipFuncSetAttribute failed\n"); grid = -1; return; }
        if (hipOccupancyMaxActiveBlocksPerMultiprocessor(&per_cu, (const void*)mk_fwd, NTHR, LDS_BYTES) != hipSuccess || per_cu < 1) { fprintf(stderr, "kernel_launch: occupancy query says %d\n", per_cu); (void)hipGetLastError(); }
        grid = cus;
    }
    if (grid < 0) return;
    (void)hipMemsetAsync((char*)d_ws + WS_CTL, 0, CTL_ZERO_BYTES, stream);
    Params p{};
    p.x = (const float*)d_in[0]; p.mem = (const float*)d_in[1]; p.positions = (const int*)d_in[2]; p.norm_g = (const float*)d_in[3]; p.w_in_sb = (const float*)d_in[4]; p.w_in_nsa = (const float*)d_in[5];
    p.cmp_pe = (const float*)d_in[6]; p.cmp_w1 = (const float*)d_in[7]; p.cmp_w2 = (const float*)d_in[8]; p.w_mem_kv = (const float*)d_in[9]; p.w_o = (const float*)d_in[10];
    p.w_gate = (const float*)d_in[11]; p.w_up = (const float*)d_in[12]; p.conv_w = (const float*)d_in[13]; p.conv_b = (const float*)d_in[14]; p.w_down = (const float*)d_in[15];
    p.out = (float*)d_out; p.ws = (unsigned char*)d_ws;
#if MK_PER_PHASE
    for (int ph = 0; ph < NPH; ++ph) { p.ph_lo = ph; p.ph_hi = ph + 1; hipLaunchKernelGGL(mk_fwd, dim3(grid), dim3(NTHR), LDS_BYTES, stream, p); }
#else
    p.ph_lo = 0; p.ph_hi = NPH;
    hipLaunchKernelGGL(mk_fwd, dim3(grid), dim3(NTHR), LDS_BYTES, stream, p);
#endif
}
```

```cpp
#include <hip/hip_runtime.h>
#include <cstdio>
#include <cstdint>
namespace pg8 {
#define PG8_LAS __attribute__((address_space(3)))
typedef unsigned short bf16_t;
typedef short bf16x8 __attribute__((ext_vector_type(8)));
typedef float f32x4 __attribute__((ext_vector_type(4)));
typedef unsigned u32x4 __attribute__((ext_vector_type(4)));
constexpr int BM = 256, BK = 64, HALF = 128, HTB = HALF * BK * 2  , STAGE_BYTES = 8 * HTB, NXCD = 8, WGM = 8;

__host__ __device__ __forceinline__ int lds_byte(int r, int c) { const int st = (r >> 4) * 2 + (c >> 5), rr = r & 15, cc = c & 31, ob = rr * 64 + cc * 2; return st * 1024 + (ob ^ (((ob >> 9) & 1) << 5)); }
__host__ __device__ __forceinline__ void stage_rc(int b, int& R, int& C) { const int st = b / 1024, sb = b % 1024, swz = sb ^ (((sb >> 9) & 1) << 5); R = (st >> 1) * 16 + swz / 64; C = (st & 1) * 32 + (swz % 64) / 2; }
__host__ __device__ __forceinline__ int perm32(int rho) { const int n = rho >> 4, i = rho & 15; return 8 * (i >> 2) + 4 * n + (i & 3); }

struct Unit { int pm, pn; };
struct Gemm { const bf16_t* A; const bf16_t* Bt; int M, N, K; };

struct StaticOrder {
    int nM, nN, nwg, G, c;
    __host__ __device__ void init(int M, int N, int G_, int c_) { nM = M / BM; nN = N / BM; nwg = nM * nN; G = G_; c = c_; }
    __host__ __device__ bool next(int i, Unit& u) const {
        const long L = (long)i * G + c; if (L >= nwg) return false;
        int wgid = (int)L; { const int q = nwg / NXCD, r = nwg % NXCD, xcd = wgid % NXCD, off = wgid / NXCD; wgid = (xcd < r ? xcd * (q + 1) : r * (q + 1) + (xcd - r) * q) + off; }
        const int nig = WGM * nN, gid = wgid / nig, fm = gid * WGM, gsz = (nM - fm) < WGM ? (nM - fm) : WGM;
        u.pm = fm + ((wgid % nig) % gsz); u.pn = (wgid % nig) / gsz; return true;
    }
    __device__ __forceinline__ void a_ready(const Unit&) const {}
    __device__ __forceinline__ void done(const Unit&) const {}
};

__device__ __forceinline__ unsigned cvt_pk_bf16(float lo, float hi) { unsigned r; asm volatile("v_cvt_pk_bf16_f32 %0, %1, %2" : "=v"(r) : "v"(lo), "v"(hi)); return r; }
typedef float f32x2 __attribute__((ext_vector_type(2)));
struct EpiRS {
    static constexpr bool PERM = true, AFTER_DRAIN = false;
    bf16_t* O; int ldc; const float* rs;
    __device__ __forceinline__ void operator()(const f32x4 (&acc)[2][2][4][2], const Unit& u, int wr, int wc, int fr, int fq) const {
        const int row0 = u.pm * BM + wr * 64 + fr; const int col0 = u.pn * BM + wc * 32 + 8 * fq;
#pragma unroll
        for (int ai = 0; ai < 2; ++ai)
#pragma unroll
            for (int m = 0; m < 4; ++m) { const int row = row0 + ai * HALF + m * 16; const float sc = rs ? rs[row] : 1.f; bf16_t* rowp = O + (size_t)row * ldc + col0;
#pragma unroll
                for (int bj = 0; bj < 2; ++bj) { const f32x4 v0 = acc[ai][bj][m][0] * sc, v1 = acc[ai][bj][m][1] * sc;
                    u32x4 w; w.x = cvt_pk_bf16(v0[0], v0[1]); w.y = cvt_pk_bf16(v0[2], v0[3]); w.z = cvt_pk_bf16(v1[0], v1[1]); w.w = cvt_pk_bf16(v1[2], v1[3]);
                    *(u32x4*)(rowp + bj * HALF) = w; } }
    }
};
struct EpiConv {
    static constexpr bool PERM = true, AFTER_DRAIN = false;
    bf16_t* ACT; const float* rs; const float* cw; const float* cb; float* HG; float* FP; float* FU; PG8_LAS float* halo; int dff;
    __device__ __forceinline__ void operator()(const f32x4 (&acc)[2][2][4][2], const Unit& u, int wr, int wc, int fr, int fq) const {
        const int fl = wc * 32 + 8 * fq, f0 = u.pn * 128 + fl, lane = (int)(threadIdx.x & 63);
        const int src1 = (lane & 48) | ((fr + 15) & 15), src2 = (lane & 48) | ((fr + 14) & 15);
        f32x4 w0[2], w1[2], w2[2], bb[2];
#pragma unroll
        for (int n = 0; n < 2; ++n) { w0[n] = *(const f32x4*)(cw + f0 + 4 * n); w1[n] = *(const f32x4*)(cw + dff + f0 + 4 * n); w2[n] = *(const f32x4*)(cw + 2 * dff + f0 + 4 * n); bb[n] = *(const f32x4*)(cb + f0 + 4 * n); }
#pragma unroll
        for (int ai = 0; ai < 2; ++ai) { const float sc = rs[u.pm * BM + ai * HALF + wr * 64 + 48 + fr];
            if (fr >= 14) {
#pragma unroll
                for (int n = 0; n < 2; ++n) *(PG8_LAS f32x4*)(halo + ((ai * 2 + wr) * 2 + (fr - 14)) * 128 + fl + 4 * n) = acc[ai][0][3][n] * sc; } }
        asm volatile("s_waitcnt lgkmcnt(0)" ::: "memory"); __builtin_amdgcn_s_barrier(); asm volatile("" ::: "memory");
#pragma unroll
        for (int ai = 0; ai < 2; ++ai) {
            const int s = ai * 2 + wr;
            f32x4 a1p[2], a2p[2];
#pragma unroll
            for (int n = 0; n < 2; ++n) { f32x4 vp = {0.f, 0.f, 0.f, 0.f};
                if (s > 0 && fr >= 14) vp = *(const PG8_LAS f32x4*)(halo + ((s - 1) * 2 + (fr - 14)) * 128 + fl + 4 * n);
#pragma unroll
                for (int e = 0; e < 4; ++e) { a1p[n][e] = __shfl(vp[e], src1); a2p[n][e] = __shfl(vp[e], src2); } }
#pragma unroll
            for (int m = 0; m < 4; ++m) {
                const int row = u.pm * BM + ai * HALF + wr * 64 + m * 16 + fr; const float sc = rs[row];
                u32x4 wv; unsigned pk[4];
#pragma unroll
                for (int n = 0; n < 2; ++n) {
                    const f32x4 v = acc[ai][0][m][n] * sc, uu = acc[ai][1][m][n] * sc; f32x4 a1, a2, gc, ac;
#pragma unroll
                    for (int e = 0; e < 4; ++e) { a1[e] = __shfl(v[e], src1); a2[e] = __shfl(v[e], src2); }
#pragma unroll
                    for (int e = 0; e < 4; ++e) { const float p1 = (fr >= 1) ? a1[e] : a1p[n][e], p2 = (fr >= 2) ? a2[e] : a2p[n][e];
                        gc[e] = bb[n][e] + w0[n][e] * p2 + w1[n][e] * p1 + w2[n][e] * v[e];
                        ac[e] = gc[e] / (1.f + __builtin_amdgcn_exp2f(-gc[e] * 1.4426950408889634f)) * uu[e]; }
                    if (s == 0 && m == 0 && fr < 2) { *(f32x4*)(FP + (size_t)(u.pm * 2 + fr) * dff + f0 + 4 * n) = gc; *(f32x4*)(FU + (size_t)(u.pm * 2 + fr) * dff + f0 + 4 * n) = uu; }
                    if (s == 3 && m == 3 && fr >= 14) *(f32x4*)(HG + (size_t)(u.pm * 2 + fr - 14) * dff + f0 + 4 * n) = v;
                    pk[2 * n] = cvt_pk_bf16(ac[0], ac[1]); pk[2 * n + 1] = cvt_pk_bf16(ac[2], ac[3]);
                    a1p[n] = a1; a2p[n] = a2;
                }
                wv.x = pk[0]; wv.y = pk[1]; wv.z = pk[2]; wv.w = pk[3];
                *(u32x4*)(ACT + (size_t)row * dff + f0) = wv;
            }
        }
    }
};
template <class Epi, class Sched, bool ALIGN_EPI = false, bool SP2 = false>
__device__ __forceinline__ void gemm_phase(PG8_LAS unsigned char* lds, const Gemm g, const Sched& S, const Epi& E) {
    int tid_ = threadIdx.x; asm volatile("" : "+v"(tid_));
    const int tid = tid_, wid = __builtin_amdgcn_readfirstlane(tid >> 6), lane = tid & 63, wr = wid >> 2, wc = wid & 3, fr = lane & 15, fq = lane >> 4;
    const int K = g.K, nt = K / BK;
    unsigned voffA[2], voffB[2];
#pragma unroll
    for (int i = 0; i < 2; ++i) { int R, C; stage_rc(tid * 16 + i * 8192, R, C); const int Rb = Epi::PERM ? ((R & ~31) + perm32(R & 31)) : R;
        voffA[i] = (unsigned)(R * K + C) * 2u; voffB[i] = (unsigned)(Rb * K + C) * 2u; }
    const size_t kstep = (size_t)(BK * 2);
    const size_t hstep = (size_t)HALF * K * 2;
    const size_t tstep = 2 * hstep;
    const unsigned ldsw = (unsigned)wid * 1024u;
    const int aoff = lds_byte(wr * 64 + fr, fq * 8), boff = lds_byte(wc * 32 + fr, fq * 8);
#define PG8_SA(b, h) (((b) * 2 + (h)) * HTB)
#define PG8_SB(b, h) ((4 + (b) * 2 + (h)) * HTB)
#define PG8_STAGE(bufoff, gbase, voff) do { _Pragma("unroll") for (int _i = 0; _i < 2; ++_i) \
        __builtin_amdgcn_global_load_lds((const unsigned*)((const char*)(gbase) + (voff)[_i]), (PG8_LAS unsigned*)(lds + (bufoff) + ldsw + _i * 8192), 16, 0, 0); } while (0)
#define PG8_LDA(dst, b, h) do { _Pragma("unroll") for (int m = 0; m < 4; ++m) _Pragma("unroll") for (int k = 0; k < 2; ++k) dst[m][k] = *(const PG8_LAS bf16x8*)(lds + PG8_SA(b, h) + aoff + m * 2048 + k * 1024); } while (0)
#define PG8_LDB(dst, b, h) do { _Pragma("unroll") for (int n = 0; n < 2; ++n) _Pragma("unroll") for (int k = 0; k < 2; ++k) dst[n][k] = *(const PG8_LAS bf16x8*)(lds + PG8_SB(b, h) + boff + n * 2048 + k * 1024); } while (0)
#define PG8_MMA(ai, bj, At, Bt) do { __builtin_amdgcn_s_setprio(1); _Pragma("unroll") for (int m = 0; m < 4; ++m) _Pragma("unroll") for (int n = 0; n < 2; ++n) _Pragma("unroll") for (int k = 0; k < 2; ++k) \
        acc[ai][bj][m][n] = __builtin_amdgcn_mfma_f32_16x16x32_bf16(Bt[n][k], At[m][k], acc[ai][bj][m][n], 0, 0, 0); __builtin_amdgcn_s_setprio(0); } while (0)
#define PG8_WAIT_V(n) asm volatile("s_waitcnt vmcnt(" #n ")" ::: "memory")
#define PG8_WAIT_L(n) asm volatile("s_waitcnt lgkmcnt(" #n ")" ::: "memory")
#define PG8_BAR __builtin_amdgcn_s_barrier()
#define PG8_SCHED __builtin_amdgcn_sched_barrier(0)
    Unit cur, nxt; int ui = 0;
    if (!S.next(0, cur)) return;
    f32x4 acc[2][2][4][2];
#pragma unroll
    for (int a = 0; a < 2; ++a)
#pragma unroll
        for (int b = 0; b < 2; ++b)
#pragma unroll
            for (int m = 0; m < 4; ++m)
#pragma unroll
                for (int n = 0; n < 2; ++n) acc[a][b][m][n] = (f32x4){0.f, 0.f, 0.f, 0.f};
    bf16x8 At[4][2], B0[2][2], B1[2][2];
    const char* cA = (const char*)g.A + (size_t)cur.pm * tstep; const char* cB = (const char*)g.Bt + (size_t)cur.pn * tstep;
    S.a_ready(cur);
    if constexpr (SP2) {
        PG8_STAGE(PG8_SB(0, 0), cB, voffB); PG8_STAGE(PG8_SB(0, 1), cB + hstep, voffB); PG8_STAGE(PG8_SA(0, 0), cA, voffA); PG8_STAGE(PG8_SA(0, 1), cA + hstep, voffA);
        if (wr == 1) PG8_BAR;
        PG8_WAIT_V(2); PG8_BAR;
        PG8_STAGE(PG8_SB(1, 0), cB + kstep, voffB); PG8_STAGE(PG8_SA(1, 0), cA + kstep, voffA); PG8_STAGE(PG8_SB(1, 1), cB + hstep + kstep, voffB);
        PG8_WAIT_V(6); PG8_BAR;
    } else {
        PG8_STAGE(PG8_SB(0, 0), cB, voffB); PG8_STAGE(PG8_SA(0, 0), cA, voffA); PG8_STAGE(PG8_SB(0, 1), cB + hstep, voffB); PG8_STAGE(PG8_SA(0, 1), cA + hstep, voffA);
        if (wr == 1) PG8_BAR;
        PG8_WAIT_V(4); PG8_BAR;
        PG8_STAGE(PG8_SB(1, 0), cB + kstep, voffB); PG8_STAGE(PG8_SA(1, 0), cA + kstep, voffA); PG8_STAGE(PG8_SB(1, 1), cB + hstep + kstep, voffB);
        PG8_WAIT_V(6); PG8_BAR;
    }
    for (;;) {
        const bool has_next = S.next(ui + 1, nxt);
        const char* nA = has_next ? (const char*)g.A + (size_t)nxt.pm * tstep : cA; const char* nB = has_next ? (const char*)g.Bt + (size_t)nxt.pn * tstep : cB;
        for (int t = 0; t < nt; t += 2) {
            const bool last = (t == nt - 2);
            const char* a1 = cA + (size_t)(t + 1) * kstep;
            const char* a2 = last ? nA : cA + (size_t)(t + 2) * kstep; const char* b2 = last ? nB : cB + (size_t)(t + 2) * kstep;
            const char* a3 = a2 + kstep; const char* b3 = b2 + kstep;
            if (last && has_next) S.a_ready(nxt);
            if constexpr (SP2) {
            PG8_LDB(B0, 0, 0); PG8_LDB(B1, 0, 1); PG8_SCHED; PG8_LDA(At, 0, 0); PG8_STAGE(PG8_SA(1, 1), a1 + hstep, voffA);
            PG8_WAIT_V(8); PG8_WAIT_L(0); PG8_BAR; PG8_MMA(0, 0, At, B0); PG8_MMA(0, 1, At, B1); PG8_BAR; PG8_SCHED;
            PG8_LDA(At, 0, 1); PG8_STAGE(PG8_SB(0, 0), b2, voffB); PG8_STAGE(PG8_SB(0, 1), b2 + hstep, voffB); PG8_STAGE(PG8_SA(0, 0), a2, voffA);
            PG8_WAIT_V(8); PG8_WAIT_L(0); PG8_BAR; PG8_MMA(1, 0, At, B0); PG8_MMA(1, 1, At, B1); PG8_BAR; PG8_SCHED;
            PG8_LDB(B0, 1, 0); PG8_LDB(B1, 1, 1); PG8_SCHED; PG8_LDA(At, 1, 0); PG8_STAGE(PG8_SA(0, 1), a2 + hstep, voffA);
            PG8_WAIT_V(8); PG8_WAIT_L(0); PG8_BAR; PG8_MMA(0, 0, At, B0); PG8_MMA(0, 1, At, B1); PG8_BAR; PG8_SCHED;
            PG8_LDA(At, 1, 1); PG8_STAGE(PG8_SB(1, 0), b3, voffB); PG8_STAGE(PG8_SB(1, 1), b3 + hstep, voffB); PG8_STAGE(PG8_SA(1, 0), a3, voffA);
            PG8_WAIT_V(8); PG8_WAIT_L(0); PG8_BAR; PG8_MMA(1, 0, At, B0); PG8_MMA(1, 1, At, B1); PG8_BAR; PG8_SCHED;
            } else {
            PG8_LDB(B0, 0, 0); PG8_SCHED; PG8_LDA(At, 0, 0); PG8_STAGE(PG8_SA(1, 1), a1 + hstep, voffA);
            PG8_WAIT_L(8); PG8_BAR; PG8_WAIT_L(0); PG8_MMA(0, 0, At, B0); PG8_BAR; PG8_SCHED;
            PG8_LDB(B1, 0, 1); PG8_STAGE(PG8_SB(0, 0), b2, voffB);
            PG8_BAR; PG8_WAIT_L(0); PG8_MMA(0, 1, At, B1); PG8_BAR;
            PG8_LDA(At, 0, 1); PG8_STAGE(PG8_SA(0, 0), a2, voffA);
            PG8_BAR; PG8_WAIT_L(0); PG8_MMA(1, 0, At, B0); PG8_BAR; PG8_SCHED;
            PG8_STAGE(PG8_SB(0, 1), b2 + hstep, voffB);
            PG8_WAIT_V(6); PG8_BAR; PG8_MMA(1, 1, At, B1); PG8_BAR;
            PG8_LDB(B0, 1, 0); PG8_SCHED; PG8_LDA(At, 1, 0); PG8_STAGE(PG8_SA(0, 1), a2 + hstep, voffA);
            PG8_WAIT_L(8); PG8_BAR; PG8_WAIT_L(0); PG8_MMA(0, 0, At, B0); PG8_BAR; PG8_SCHED;
            PG8_LDB(B1, 1, 1); PG8_STAGE(PG8_SB(1, 0), b3, voffB);
            PG8_BAR; PG8_WAIT_L(0); PG8_MMA(0, 1, At, B1); PG8_BAR;
            PG8_LDA(At, 1, 1); PG8_STAGE(PG8_SA(1, 0), a3, voffA);
            PG8_BAR; PG8_WAIT_L(0); PG8_MMA(1, 0, At, B0); PG8_BAR; PG8_SCHED;
            PG8_STAGE(PG8_SB(1, 1), b3 + hstep, voffB);
            PG8_WAIT_V(6); PG8_BAR; PG8_MMA(1, 1, At, B1); PG8_BAR;
            }
        }
        if constexpr (ALIGN_EPI) { if (wr == 0) PG8_BAR; }
        if constexpr (!Epi::AFTER_DRAIN) { E(acc, cur, wr, wc, fr, fq); S.done(cur); }
        if (!has_next) break;
#pragma unroll
        for (int a = 0; a < 2; ++a)
#pragma unroll
            for (int b = 0; b < 2; ++b)
#pragma unroll
                for (int m = 0; m < 4; ++m)
#pragma unroll
                    for (int n = 0; n < 2; ++n) acc[a][b][m][n] = (f32x4){0.f, 0.f, 0.f, 0.f};
        cur = nxt; cA = nA; cB = nB; ++ui;
        if constexpr (ALIGN_EPI) { if (wr == 1) PG8_BAR; }
    }
    PG8_WAIT_V(0);
    if constexpr (!ALIGN_EPI) { if (wr == 0) PG8_BAR; }
    PG8_BAR;
    if constexpr (Epi::AFTER_DRAIN) { E.fused(acc, cur, wr, wc, fr, fq, lds, wid, lane); S.done(cur); }
#undef PG8_SA
#undef PG8_SB
#undef PG8_STAGE
#undef PG8_LDA
#undef PG8_LDB
#undef PG8_MMA
#undef PG8_WAIT_V
#undef PG8_WAIT_L
#undef PG8_BAR
#undef PG8_SCHED
}
}

#ifndef MK_PER_PHASE
#define MK_PER_PHASE 0
#endif
constexpr int NB = 8, SEQ = 2048, DM = 2048, MTOK = NB * SEQ, DEPTH = 4, HD = 128;
constexpr int NMIX = 12, NMEMH = 4, NMEM = 256, DFF = 5632, NGU = 2 * DFF, NGRP = 2, HPG = 6;
constexpr int SB_N = 5120, NSA_N = 3840, NSA_SRC = 3620;
constexpr int SBQ = 0, SBK = 1536, SBV = 3072, SBQM = 4608;
constexpr int NQ = 0, NKC = 1536, NVC = 1792, NKS = 2048, NVS = 2304, NKW = 2560, NVW = 2816, NQM = 3072, NGL = 3584;
constexpr int NCMP = 127, CMPROWS = NB * NGRP * NCMP;
constexpr int WINDOW = 512;
constexpr float NORM_EPS = 1e-6f;
constexpr float SCALE = 0.08838834764831845f;
constexpr float LOG2E = 1.4426950408889634f;
constexpr int NWAVES = 8, NTHR = 512;

constexpr size_t MiB = 1u << 20;
constexpr size_t WS_CTL = 0, CTL_ZERO_BYTES = 1 * MiB;
constexpr size_t WS_WIN = 2 * MiB;
constexpr size_t WS_WO = 22 * MiB;
constexpr size_t WS_WGU = 30 * MiB;
constexpr size_t WS_WD = 74 * MiB;
constexpr size_t WS_WKV = 96 * MiB;
constexpr size_t WS_CW1 = 112 * MiB;
constexpr size_t WS_CW2 = 116 * MiB;
constexpr size_t WS_MEMB = 117 * MiB;
constexpr size_t WS_MEMKV = 125 * MiB;
constexpr size_t WS_COS = 141 * MiB, WS_SIN = 145 * MiB;
constexpr size_t WS_RSTD = 149 * MiB;
constexpr size_t WS_SEL = 150 * MiB;
constexpr size_t WS_KCMP = 151 * MiB;
constexpr size_t WS_XB = 152 * MiB;
constexpr size_t WS_TMP = 216 * MiB;
constexpr size_t WS_ACT = 280 * MiB;
constexpr size_t WS_GU = 456 * MiB;
constexpr size_t WS_PROJ = 456 * MiB;
constexpr size_t WS_OCAT = 616 * MiB;
constexpr size_t WS_HG = 680 * MiB, WS_FP = 684 * MiB, WS_FU = 688 * MiB;
constexpr size_t WS_END = 808 * MiB;
constexpr int CW_BAR = 4096;

constexpr int RING_BYTES = 131072;
constexpr int LDSCTL_OFF = 143360, MISC_OFF = LDSCTL_OFF + 320;
constexpr int LDS_BYTES = 147456;
constexpr int HALO_OFF = RING_BYTES;
constexpr int SHM_T = 16384;
constexpr int A_V = 0, A_K = 2 * SHM_T, A_WS = 4 * SHM_T, A_FLAGS = A_WS + NWAVES * 64 * 4, A_STASH = 67584;

#define GAS __attribute__((address_space(1)))
#define LAS __attribute__((address_space(3)))
typedef unsigned short bf16_t;
typedef unsigned v4u __attribute__((ext_vector_type(4)));
typedef unsigned v2u __attribute__((ext_vector_type(2)));
typedef float f32x4 __attribute__((ext_vector_type(4)));
typedef float f32x16 __attribute__((ext_vector_type(16)));
typedef short bf16x8 __attribute__((ext_vector_type(8)));
typedef short s16x4 __attribute__((ext_vector_type(4)));
typedef GAS unsigned gu32;
#define RLX_AGENT __ATOMIC_RELAXED, __HIP_MEMORY_SCOPE_AGENT
#define LDS_WAIT() asm volatile("s_waitcnt lgkmcnt(0)" ::: "memory")
#define VM_WAIT() asm volatile("s_waitcnt vmcnt(0)" ::: "memory")
#define SBAR() __builtin_amdgcn_sched_barrier(0)
__device__ __forceinline__ unsigned cvtpk(float lo, float hi) { unsigned r; asm volatile("v_cvt_pk_bf16_f32 %0, %1, %2" : "=v"(r) : "v"(lo), "v"(hi)); return r; }
__device__ __forceinline__ float bf2f(unsigned short b) { return __uint_as_float((unsigned)b << 16); }
__device__ __forceinline__ float bflo(unsigned w) { return __uint_as_float(w << 16); }
__device__ __forceinline__ float bfhi(unsigned w) { return __uint_as_float(w & 0xffff0000u); }
__device__ __forceinline__ bf16x8 pack8(f32x4 a, f32x4 b) { v4u w = {cvtpk(a[0], a[1]), cvtpk(a[2], a[3]), cvtpk(b[0], b[1]), cvtpk(b[2], b[3])}; return __builtin_bit_cast(bf16x8, w); }
__device__ __forceinline__ void unpack8(bf16x8 v, f32x4& a, f32x4& b) { const v4u w = __builtin_bit_cast(v4u, v); a = (f32x4){bflo(w.x), bfhi(w.x), bflo(w.y), bfhi(w.y)}; b = (f32x4){bflo(w.z), bfhi(w.z), bflo(w.w), bfhi(w.w)}; }
__device__ __forceinline__ float wave_sum(float v) {
#pragma unroll
    for (int o = 1; o < 64; o <<= 1) v += __shfl_xor(v, o);
    return v;
}
__device__ __forceinline__ float sigmoidf_(float x) { return 1.f / (1.f + __builtin_amdgcn_exp2f(-x * LOG2E)); }

__device__ const float INV_FREQ[64] = {1.000000000e+00f, 8.659643531e-01f, 7.498942018e-01f, 6.493816376e-01f, 5.623413324e-01f, 4.869675338e-01f, 4.216965139e-01f, 3.651741147e-01f, 3.162277639e-01f, 2.738419771e-01f, 2.371373773e-01f, 2.053525001e-01f, 1.778279394e-01f, 1.539926529e-01f, 1.333521456e-01f, 1.154781953e-01f, 1.000000015e-01f, 8.659642935e-02f, 7.498942316e-02f, 6.493816525e-02f, 5.623413250e-02f, 4.869675264e-02f, 4.216964915e-02f, 3.651741147e-02f, 3.162277490e-02f, 2.738419548e-02f, 2.371373773e-02f, 2.053525113e-02f, 1.778279431e-02f, 1.539926510e-02f, 1.333521400e-02f, 1.154781971e-02f, 9.999999776e-03f, 8.659643121e-03f, 7.498942316e-03f, 6.493816152e-03f, 5.623413250e-03f, 4.869675264e-03f, 4.216964822e-03f, 3.651741194e-03f, 3.162277630e-03f, 2.738419687e-03f, 2.371373819e-03f, 2.053525066e-03f, 1.778279431e-03f, 1.539926510e-03f, 1.333521446e-03f, 1.154782018e-03f, 1.000000047e-03f, 8.659643354e-04f, 7.498941850e-04f, 6.493816036e-04f, 5.623413017e-04f, 4.869675322e-04f, 4.216965172e-04f, 3.651741135e-04f, 3.162277571e-04f, 2.738419571e-04f, 2.371373703e-04f, 2.053525095e-04f, 1.778279402e-04f, 1.539926598e-04f, 1.333521504e-04f, 1.154782003e-04f};
#define XB_TMO      128
#define XB_XCNT(j)  (256  + 64 * (j))
#define XB_XSUB(j)  (1280 + 64 * (j))
#define XB_XGEN(j)  (2304 + 64 * (j))
#define XB_TOP      3328
#define XB_TOPGEN   3392
#define XCD_BAR_WORDS 3456
#define XB_SPIN_CAP (1u << 18)

__device__ __forceinline__ unsigned xb_ld(unsigned* p)              { return __hip_atomic_load(p, __ATOMIC_RELAXED, __HIP_MEMORY_SCOPE_AGENT); }
__device__ __forceinline__ unsigned xb_add(unsigned* p, unsigned v) { return __hip_atomic_fetch_add(p, v, __ATOMIC_RELAXED, __HIP_MEMORY_SCOPE_AGENT); }
__device__ __forceinline__ unsigned xb_xcc_id() { return (unsigned)__builtin_amdgcn_s_getreg((3 << 11) | 20) & 0xFu; }
#define XB_SPIN(cond, bar) do { unsigned _sp = 0; while (cond) { __builtin_amdgcn_s_sleep(1); \
    if ((++_sp & 255u) == 0u) { if (xb_ld(&(bar)[XB_TMO])) break; if (_sp > XB_SPIN_CAP) { atomicAdd(&(bar)[XB_TMO], 1u); break; } } } } while (0)

struct XcdBarrier {
    unsigned* bar; unsigned x;
    volatile LAS unsigned* st;
};

__device__ __forceinline__ XcdBarrier xcd_barrier_post(unsigned* bar, volatile LAS unsigned* st) {
    XcdBarrier b; b.bar = bar; b.x = xb_xcc_id(); b.st = st;
    if (threadIdx.x == 0) (void)xb_add(&bar[XB_XCNT(b.x)], 1u);
    return b;
}
__device__ __forceinline__ void xcd_barrier_complete(unsigned* bar, unsigned x, unsigned& nloc, unsigned& nx) {
    const unsigned G = gridDim.x * gridDim.y * gridDim.z;
    unsigned sum, cnt, mine, sp = 0u;
    for (;;) {
        sum = 0u; cnt = 0u; mine = 0u;
#pragma unroll
        for (unsigned j = 0; j < 16; ++j) { const unsigned c = xb_ld(&bar[XB_XCNT(j)]); sum += c; cnt += (c > 0u) ? 1u : 0u; mine = (j == x) ? c : mine; }
        if (sum == G) break;
        __builtin_amdgcn_s_sleep(1);
        if ((++sp & 255u) == 0u) { if (xb_ld(&bar[XB_TMO])) break; if (sp > XB_SPIN_CAP) { atomicAdd(&bar[XB_TMO], 1u); break; } }
    }
    nloc = mine > 0u ? mine : 1u; nx = cnt > 0u ? cnt : 1u;
}

__device__ __forceinline__ void xcd_barrier(const XcdBarrier& b) {
    asm volatile("s_waitcnt vmcnt(0)" ::: "memory");
    __syncthreads();
    if (threadIdx.x == 0) {
        unsigned* bar = b.bar;
        __builtin_amdgcn_s_waitcnt(0);
        unsigned nloc = b.st[0], nx = b.st[1];
        if (nloc == 0u) { xcd_barrier_complete(bar, b.x, nloc, nx); b.st[0] = nloc; b.st[1] = nx; }
        const unsigned old = xb_add(&bar[XB_XSUB(b.x)], 1u);
        const unsigned gen = old / nloc;
        if (old + 1u == (gen + 1u) * nloc) {
            __builtin_amdgcn_fence(__ATOMIC_RELEASE, "agent");
            asm volatile("s_waitcnt vmcnt(0)" ::: "memory");
            const unsigned og = xb_add(&bar[XB_TOP], 1u);
            const unsigned tg = og / nx;
            if (og + 1u == (tg + 1u) * nx) xb_add(&bar[XB_TOPGEN], 1u);
            else XB_SPIN(xb_ld(&bar[XB_TOPGEN]) == tg, bar);
            __builtin_amdgcn_fence(__ATOMIC_ACQUIRE, "agent");
            xb_add(&bar[XB_XGEN(b.x)], 1u);
            asm volatile("s_waitcnt vmcnt(0)" ::: "memory");
        } else {
            XB_SPIN(xb_ld(&bar[XB_XGEN(b.x)]) == gen, bar);
            __builtin_amdgcn_fence(__ATOMIC_ACQUIRE, "agent");
            asm volatile("s_waitcnt vmcnt(0)" ::: "memory");
        }
    }
    __syncthreads();
}

#define KSWZ(row, colB) ((row) * 256 + ((colB) ^ (((row) & 7) << 4)))
__device__ __forceinline__ int v_st(int k, int c) { const int kk = (k & ~0xC) | ((k & 4) << 1) | ((k & 8) >> 1); return ((kk >> 3) * 4 + (c >> 5)) * 512 + ((kk & 7) * 32 + (c & 31)) * 2; }
__device__ __forceinline__ int v_rd_base(int lane) { return ((lane & 3) << 3) | (((lane >> 2) & 3) << 6) | (((lane >> 4) & 1) << 5) | (((lane >> 5) & 1) << 8); }
constexpr int v_rd_off(int d0, int ks, int half) { return d0 * 512 + ks * 4096 + half * 2048; }
__device__ __forceinline__ int crow(int r, int hi) { return (r & 3) + 8 * (r >> 2) + 4 * hi; }

struct ACtx {
    LAS unsigned char* lds;
    int tid, wid, lane, r32, hi, sr, sc, kws, vst0, vst1, vb0;
    LAS float* ws;
};
__device__ __forceinline__ ACtx make_actx(LAS unsigned char* lds) {
    ACtx c; c.lds = lds; { int t_ = threadIdx.x; asm volatile("" : "+v"(t_)); c.tid = t_; } c.wid = __builtin_amdgcn_readfirstlane(c.tid >> 6); c.lane = c.tid & 63; c.r32 = c.lane & 31; c.hi = c.lane >> 5;
    c.sr = c.tid >> 4; c.sc = (c.tid & 15) * 8; c.kws = KSWZ(c.sr, c.sc * 2); c.vst0 = v_st(c.sr, c.sc); c.vst1 = v_st(32 + c.sr, c.sc);
    c.vb0 = (int)(unsigned)(size_t)(lds + A_V) + v_rd_base(c.lane);
    c.ws = (LAS float*)(lds + A_WS) + c.wid * 64;
    return c;
}
struct Stage { bf16x8 k0, k1, v0, v1; };
__device__ __forceinline__ void stage_load(Stage& S, const bf16_t* Kp, const bf16_t* Vp, int pitch, int kb, const ACtx& c) {
    S.v0 = *(const bf16x8*)(Vp + (size_t)(kb + c.sr) * pitch + c.sc); S.v1 = *(const bf16x8*)(Vp + (size_t)(kb + 32 + c.sr) * pitch + c.sc);
    S.k0 = *(const bf16x8*)(Kp + (size_t)(kb + c.sr) * pitch + c.sc); S.k1 = *(const bf16x8*)(Kp + (size_t)(kb + 32 + c.sr) * pitch + c.sc);
}
__device__ __forceinline__ void stage_write(const Stage& S, int buf, const ACtx& c) {
    LAS unsigned char* Kb = c.lds + A_K + buf * SHM_T; LAS unsigned char* Vb = c.lds + A_V + buf * SHM_T;
    *(LAS bf16x8*)(Kb + c.kws) = S.k0; *(LAS bf16x8*)(Kb + c.kws + 32 * 256) = S.k1;
    *(LAS bf16x8*)(Vb + c.vst0) = S.v0; *(LAS bf16x8*)(Vb + c.vst1) = S.v1;
}
__device__ __forceinline__ void qkt(f32x16& p0, f32x16& p1, int buf, const ACtx& c, const bf16x8* qr) {
    p0 = (f32x16){}; p1 = (f32x16){};
    const LAS unsigned char* Kb = c.lds + A_K + buf * SHM_T;
    const LAS unsigned char* kb[4];
#pragma unroll
    for (int dd = 0; dd < 4; ++dd) kb[dd] = Kb + KSWZ(c.r32, (dd * 16 + c.hi * 8) * 2);
#pragma unroll
    for (int d0 = 0; d0 < 8; ++d0) { const LAS unsigned char* a = kb[d0 & 3] + (d0 >> 2) * 128;
        const bf16x8 b0 = *(const LAS bf16x8*)a; const bf16x8 b1 = *(const LAS bf16x8*)(a + 32 * 256);
        p0 = __builtin_amdgcn_mfma_f32_32x32x16_bf16(b0, qr[d0], p0, 0, 0, 0);
        p1 = __builtin_amdgcn_mfma_f32_32x32x16_bf16(b1, qr[d0], p1, 0, 0, 0); }
}
__device__ __forceinline__ void pv_tile(f32x16* o, int buf, const ACtx& c, bf16x8 pa0, bf16x8 pa1, bf16x8 pa2, bf16x8 pa3) {
    const int vb = c.vb0 + buf * SHM_T;
#define TRRD(dst, off) asm volatile("ds_read_b64_tr_b16 %0, %1 offset:%2" : "=&v"(dst) : "v"(vb), "i"(off) : "memory")
#define PV_D0(d0) do { s16x4 l0, l1, l2, l3, h0, h1, h2, h3; constexpr int b_ = v_rd_off(d0, 0, 0); \
        TRRD(l0, b_); TRRD(h0, b_ + 2048); TRRD(l1, b_ + 4096); TRRD(h1, b_ + 6144); TRRD(l2, b_ + 8192); TRRD(h2, b_ + 10240); TRRD(l3, b_ + 12288); TRRD(h3, b_ + 14336); \
        asm volatile("s_waitcnt lgkmcnt(0)" ::: "memory"); SBAR(); \
        o[d0] = __builtin_amdgcn_mfma_f32_32x32x16_bf16(pa0, (bf16x8){l0[0], l0[1], l0[2], l0[3], h0[0], h0[1], h0[2], h0[3]}, o[d0], 0, 0, 0); \
        o[d0] = __builtin_amdgcn_mfma_f32_32x32x16_bf16(pa1, (bf16x8){l1[0], l1[1], l1[2], l1[3], h1[0], h1[1], h1[2], h1[3]}, o[d0], 0, 0, 0); \
        o[d0] = __builtin_amdgcn_mfma_f32_32x32x16_bf16(pa2, (bf16x8){l2[0], l2[1], l2[2], l2[3], h2[0], h2[1], h2[2], h2[3]}, o[d0], 0, 0, 0); \
        o[d0] = __builtin_amdgcn_mfma_f32_32x32x16_bf16(pa3, (bf16x8){l3[0], l3[1], l3[2], l3[3], h3[0], h3[1], h3[2], h3[3]}, o[d0], 0, 0, 0); } while (0)
    PV_D0(0); PV_D0(1); PV_D0(2); PV_D0(3);
#undef PV_D0
#undef TRRD
}
__device__ __forceinline__ float swap_max(float v) { auto rr = __builtin_amdgcn_permlane32_swap(__float_as_uint(v), __float_as_uint(v), false, false); return fmaxf(__uint_as_float(rr[0]), __uint_as_float(rr[1])); }
__device__ __forceinline__ float swap_sum(float v) { auto rr = __builtin_amdgcn_permlane32_swap(__float_as_uint(v), __float_as_uint(v), false, false); return __uint_as_float(rr[0]) + __uint_as_float(rr[1]); }
__device__ __forceinline__ void swap_both(float v, float& lo, float& hi) { auto rr = __builtin_amdgcn_permlane32_swap(__float_as_uint(v), __float_as_uint(v), false, false); lo = __uint_as_float(rr[0]); hi = __uint_as_float(rr[1]); }
__device__ __forceinline__ void pack_p(const f32x16& p0, const f32x16& p1, bf16x8& pa0, bf16x8& pa1, bf16x8& pa2, bf16x8& pa3) {
#define PK4(P, B_, OUT) do { unsigned a0 = cvtpk(P[B_+0], P[B_+1]), a1 = cvtpk(P[B_+2], P[B_+3]); \
        unsigned b0 = cvtpk(P[B_+4], P[B_+5]), b1 = cvtpk(P[B_+6], P[B_+7]); \
        auto r0 = __builtin_amdgcn_permlane32_swap(a0, b0, false, false); auto r1 = __builtin_amdgcn_permlane32_swap(a1, b1, false, false); \
        v4u w = {r0[0], r1[0], r0[1], r1[1]}; OUT = __builtin_bit_cast(bf16x8, w); } while (0)
    PK4(p0, 0, pa0); PK4(p0, 8, pa1); PK4(p1, 0, pa2); PK4(p1, 8, pa3);
#undef PK4
}
__device__ __forceinline__ void mask_tile(f32x16& p0, f32x16& p1, int dq, unsigned W) {
    const float NEG = -__builtin_inff();
#pragma unroll
    for (int r = 0; r < 16; ++r) { const int cc = (r & 3) + 8 * (r >> 2);
        if ((unsigned)(dq - cc) >= W) p0[r] = NEG;
        if ((unsigned)(dq - cc - 32) >= W) p1[r] = NEG; }
}
constexpr float THR = 8.f;
__device__ __forceinline__ void softmax_tile(f32x16& p0, f32x16& p1, float& m_reg, float& l_reg, f32x16* o, const ACtx& c) {
    float pmax = p0[0];
#pragma unroll
    for (int r = 1; r < 16; ++r) pmax = fmaxf(pmax, p0[r]);
#pragma unroll
    for (int r = 0; r < 16; ++r) pmax = fmaxf(pmax, p1[r]);
    pmax = swap_max(pmax);
    constexpr float C2 = LOG2E * SCALE;
    float mn, alpha;
    if (__all((pmax - m_reg) * SCALE <= THR)) { mn = m_reg; alpha = 1.f; }
    else { mn = fmaxf(m_reg, pmax); alpha = __builtin_amdgcn_exp2f((m_reg - mn) * C2); m_reg = mn; }
    const float mnL = -mn * C2;
#pragma unroll
    for (int r = 0; r < 16; ++r) { p0[r] = __builtin_amdgcn_exp2f(fmaf(p0[r], C2, mnL)); p1[r] = __builtin_amdgcn_exp2f(fmaf(p1[r], C2, mnL)); }
    float ps = 0.f;
#pragma unroll
    for (int r = 0; r < 16; ++r) ps += p0[r] + p1[r];
    ps = swap_sum(ps);
    l_reg = l_reg * alpha + ps;
    if (__any(alpha < 1.f)) {
        if (c.hi == 0) c.ws[32 + c.r32] = alpha;
        LDS_WAIT();
#pragma unroll
        for (int r = 0; r < 16; ++r) { const float a = c.ws[32 + crow(r, c.hi)];
#pragma unroll
            for (int d = 0; d < 4; ++d) o[d][r] *= a; }
    }
}
__device__ __forceinline__ void row_factors(float f, float (&fr)[16], const ACtx& c) {
    LDS_WAIT();
    if (c.hi == 0) c.ws[c.r32] = f;
    LDS_WAIT();
#pragma unroll
    for (int r = 0; r < 16; ++r) fr[r] = c.ws[crow(r, c.hi)];
    LDS_WAIT();
}
template <bool ROPE>
__device__ __forceinline__ void load_q(bf16x8 (&qr)[8], const bf16_t* qrow, const float* cosr, const float* sinr, int hi) {
#pragma unroll
    for (int d0 = 0; d0 < 8; ++d0) qr[d0] = *(const bf16x8*)(qrow + d0 * 16 + hi * 8);
    if constexpr (ROPE) {
#pragma unroll
        for (int d0 = 0; d0 < 4; ++d0) {
            const int i0 = d0 * 16 + hi * 8;
            const f32x4 c0 = *(const f32x4*)(cosr + i0), c1 = *(const f32x4*)(cosr + i0 + 4), s0 = *(const f32x4*)(sinr + i0), s1 = *(const f32x4*)(sinr + i0 + 4);
            f32x4 a0, a1, b0, b1; unpack8(qr[d0], a0, a1); unpack8(qr[d0 + 4], b0, b1);
            qr[d0] = pack8(a0 * c0 - b0 * s0, a1 * c1 - b1 * s1);
            qr[d0 + 4] = pack8(b0 * c0 + a0 * s0, b1 * c1 + a1 * s1);
        }
    }
}
__device__ __forceinline__ void store_o_bf16(const f32x16* o, bf16_t* Ow  , int pitch, const ACtx& c) {
#pragma unroll
    for (int r = 0; r < 16; ++r) { const int orow = crow(r, c.hi);
#pragma unroll
        for (int d0 = 0; d0 < 4; ++d0) { const float v = o[d0][r]; const float vn = __shfl_xor(v, 1);
            if ((c.r32 & 1) == 0) *(unsigned*)(Ow + (size_t)orow * pitch + d0 * 32 + c.r32) = cvtpk(v, vn); } }
}

template <int MODE>
__device__ __forceinline__ void softmax_sweep(const ACtx& c, const bf16x8 (&qr)[8], f32x16 (&o)[4], float& l_out, const bf16_t* Kp, const bf16_t* Vp, int pitch,
                                              int j_lo, int j_hi, int qpos, int qlo, unsigned selbits) {
    float m_reg = -1e30f, l_reg = 0.f;
#pragma unroll
    for (int d = 0; d < 4; ++d) o[d] = (f32x16){};
    Stage S; stage_load(S, Kp, Vp, pitch, j_lo * 64, c);
    for (int j = j_lo; j < j_hi; ++j) {
        const int buf = (j - j_lo) & 1;
        stage_write(S, buf, c);
        __syncthreads();
        if (j + 1 < j_hi) stage_load(S, Kp, Vp, pitch, (j + 1) * 64, c);
        const int kb = j * 64;
        bool act = true;
        if (MODE == 1) act = (kb <= qlo + 31) && (kb + 63 >= qlo - (WINDOW - 1));
        if (MODE == 2) act = (kb <= qlo + 31) && __any((int)((selbits >> j) & 1u));
        if (act) {
            f32x16 p0, p1; qkt(p0, p1, buf, c, qr);
            if (MODE == 1) mask_tile(p0, p1, qpos - kb - 4 * c.hi, (unsigned)WINDOW);
            if (MODE == 2) { mask_tile(p0, p1, qpos - kb - 4 * c.hi, 0x7fffffffu);
                if (!((selbits >> j) & 1u)) { const float NEG = -__builtin_inff();
#pragma unroll
                    for (int r = 0; r < 16; ++r) { p0[r] = NEG; p1[r] = NEG; } } }
            softmax_tile(p0, p1, m_reg, l_reg, o, c);
            bf16x8 pa0, pa1, pa2, pa3; pack_p(p0, p1, pa0, pa1, pa2, pa3);
            pv_tile(o, buf, c, pa0, pa1, pa2, pa3);
        }
    }
    __syncthreads();
    l_out = l_reg;
}

struct Params {
    const float* x; const float* mem; const int* positions; const float* norm_g; const float* w_in_sb; const float* w_in_nsa; const float* cmp_pe; const float* cmp_w1; const float* cmp_w2;
    const float* w_mem_kv; const float* w_o; const float* w_gate; const float* w_up; const float* conv_w; const float* conv_b; const float* w_down;
    float* out; unsigned char* ws; int ph_lo, ph_hi;
};
struct Frame {
    LAS unsigned char* lds; int tid, lane, wave, G, bid;
};
#define WSP(T, off) ((T*)(p.ws + (off)))

__device__ __forceinline__ void tr_item(const float* W, int K, int Nsrc, int src_col0, int ncols, const float* gain, bf16_t* WT, int dst_row0, int mode, int item, int lane) {
    const int nblk = (ncols + 255) >> 8, kb = item / nblk, nb = item - kb * nblk, k0 = 16 * kb, n = nb * 256 + 4 * lane;
    if (n >= ncols) return;
    f32x4 v[16];
    if (W != nullptr) {
        const float* src = W + (size_t)k0 * Nsrc + src_col0 + n;
#pragma unroll
        for (int j = 0; j < 16; ++j) v[j] = *(const f32x4*)(src + (size_t)j * Nsrc);
        if (gain) {
#pragma unroll
            for (int j = 0; j < 16; ++j) v[j] = v[j] * gain[k0 + j];
        }
    } else {
#pragma unroll
        for (int j = 0; j < 16; ++j) v[j] = (f32x4){0.f, 0.f, 0.f, 0.f};
    }
#pragma unroll
    for (int e = 0; e < 4; ++e) {
        const int nn = n + e; const int drow = dst_row0 + (mode == 0 ? nn : 256 * (nn >> 7) + (nn & 127));
        v4u o0, o1;
        o0.x = cvtpk(v[0][e], v[1][e]); o0.y = cvtpk(v[2][e], v[3][e]); o0.z = cvtpk(v[4][e], v[5][e]); o0.w = cvtpk(v[6][e], v[7][e]);
        o1.x = cvtpk(v[8][e], v[9][e]); o1.y = cvtpk(v[10][e], v[11][e]); o1.z = cvtpk(v[12][e], v[13][e]); o1.w = cvtpk(v[14][e], v[15][e]);
        v4u* dst = (v4u*)(WT + (size_t)drow * K + k0); dst[0] = o0; dst[1] = o1;
    }
}
__device__ __forceinline__ void row_to_bf16_rstd(const float* xrow, bf16_t* orow, float* rstd_out, int lane) {
    const f32x4* xr = (const f32x4*)xrow + lane; f32x4 v[8]; float s = 0.f;
#pragma unroll
    for (int j = 0; j < 8; ++j) { v[j] = xr[64 * j]; s += (v[j].x * v[j].x + v[j].y * v[j].y) + (v[j].z * v[j].z + v[j].w * v[j].w); }
    s = wave_sum(s);
    v2u* o8 = (v2u*)orow + lane;
#pragma unroll
    for (int j = 0; j < 8; ++j) { v2u w; w.x = cvtpk(v[j].x, v[j].y); w.y = cvtpk(v[j].z, v[j].w); o8[64 * j] = w; }
    if (lane == 0) *rstd_out = 1.0f / sqrtf(s * (1.0f / DM) + NORM_EPS);
}
template <class PP> __device__ __forceinline__ void phase_convert(const PP& p, const Frame& F, int L) {
    const int gw = F.bid * NWAVES + F.wave, NGW = F.G * NWAVES;
    int it0 = gw;
#define TR(W, K, Nsrc, sc0, nc, gain, WT, dr0, mode) do { const int n_ = ((K) / 16) * (((nc) + 255) >> 8); for (; it0 < n_; it0 += NGW) tr_item(W, K, Nsrc, sc0, nc, gain, WT, dr0, mode, it0, F.lane); it0 -= n_; } while (0)
    const float* g = p.norm_g + (size_t)L * 5 * DM;
    const int j = L >> 1;
    bf16_t* WIN = WSP(bf16_t, WS_WIN);
    if ((L & 1) == 0) {
        TR(p.w_in_sb + (size_t)j * DM * SB_N, DM, SB_N, 0, SB_N, g, WIN, 0, 0);
    } else {
        const float* W = p.w_in_nsa + (size_t)j * DM * NSA_SRC;
        TR(W, DM, NSA_SRC, 0, 3072, g, WIN, 0, 0);
        TR(W, DM, NSA_SRC, 3108, 512, g, WIN, NQM, 0);
        TR(W, DM, NSA_SRC, 3072, 36, g, WIN, NGL, 0);
        TR((const float*)nullptr, DM, NSA_SRC, 0, 220, (const float*)nullptr, WIN, NGL + 36, 0);
        for (int wh = 0; wh < 2; ++wh) {
            TR(p.cmp_w1 + (size_t)(j * 2 + wh) * 4096 * 256, 4096, 256, 0, 256, (const float*)nullptr, WSP(bf16_t, WS_CW1) + (size_t)wh * 256 * 4096, 0, 0);
            TR(p.cmp_w2 + (size_t)(j * 2 + wh) * 256 * 128, 256, 128, 0, 128, (const float*)nullptr, WSP(bf16_t, WS_CW2) + (size_t)wh * 128 * 256, 0, 0);
        }
    }
    TR(p.w_o + (size_t)L * DM * DM, DM, DM, 0, DM, (const float*)nullptr, WSP(bf16_t, WS_WO), 0, 0);
    TR(p.w_gate + (size_t)L * DM * DFF, DM, DFF, 0, DFF, g + 2 * DM, WSP(bf16_t, WS_WGU), 0, 1);
    TR(p.w_up + (size_t)L * DM * DFF, DM, DFF, 0, DFF, g + 2 * DM, WSP(bf16_t, WS_WGU), 128, 1);
    TR(p.w_down + (size_t)L * DFF * DM, DFF, DM, 0, DM, (const float*)nullptr, WSP(bf16_t, WS_WD), 0, 0);
    if (L == 0) {
        for (int l = 0; l < DEPTH; ++l)
            TR(p.w_mem_kv + (size_t)l * DM * 1024, DM, 1024, 0, 1024, p.norm_g + (size_t)(l * 5 + 4) * DM, WSP(bf16_t, WS_WKV), l * 1024, 0);
        float* rstd = WSP(float, WS_RSTD);
        for (int m = gw; m < MTOK; m += NGW) row_to_bf16_rstd(p.x + (size_t)m * DM, WSP(bf16_t, WS_XB) + (size_t)m * DM, rstd + m, F.lane);
        for (int m = gw; m < NB * NMEM; m += NGW) row_to_bf16_rstd(p.mem + (size_t)m * DM, WSP(bf16_t, WS_MEMB) + (size_t)m * DM, rstd + 16384 + m, F.lane);
        float* cosT = WSP(float, WS_COS); float* sinT = WSP(float, WS_SIN);
        for (int idx = F.bid * NTHR + F.tid; idx < MTOK * 64; idx += F.G * NTHR) {
            const int row = idx >> 6, i = idx & 63;
            const float ang = (float)p.positions[row] * INV_FREQ[i];
            double t = (double)ang * 0.15915494309189535; t -= __builtin_rint(t);
            const float fr = (float)t;
            cosT[idx] = __builtin_amdgcn_cosf(fr); sinT[idx] = __builtin_amdgcn_sinf(fr);
        }
    }
#undef TR
}

template <class PP> __device__ __forceinline__ void phase_resid(const PP& p, const Frame& F, const float* xin, const float* gpost) {
    const int gw = F.bid * NWAVES + F.wave, NGW = F.G * NWAVES;
    const bf16_t* T = WSP(bf16_t, WS_TMP); bf16_t* XB = WSP(bf16_t, WS_XB); float* rstd = WSP(float, WS_RSTD);
    for (int m = gw; m < MTOK; m += NGW) {
        const bf16x8* ar = (const bf16x8*)(T + (size_t)m * DM) + F.lane;
        f32x4 a[8]; float s = 0.f;
#pragma unroll
        for (int j = 0; j < 4; ++j) { unpack8(ar[64 * j], a[2 * j], a[2 * j + 1]); }
#pragma unroll
        for (int j = 0; j < 8; ++j) s += (a[j].x * a[j].x + a[j].y * a[j].y) + (a[j].z * a[j].z + a[j].w * a[j].w);
        const float ra = 1.0f / sqrtf(wave_sum(s) * (1.0f / DM) + NORM_EPS);
        float s2 = 0.f;
#pragma unroll
        for (int j = 0; j < 4; ++j) {
            const int e0 = (j * 64 + F.lane) * 8;
#pragma unroll
            for (int h = 0; h < 2; ++h) {
                const f32x4 xv = *(const f32x4*)(xin + (size_t)m * DM + e0 + 4 * h), gv = *(const f32x4*)(gpost + e0 + 4 * h);
                const f32x4 y = xv + a[2 * j + h] * ra * gv;
                a[2 * j + h] = y; s2 += (y.x * y.x + y.y * y.y) + (y.z * y.z + y.w * y.w);
                *(f32x4*)(p.out + (size_t)m * DM + e0 + 4 * h) = y;
            }
            *((bf16x8*)(XB + (size_t)m * DM) + 64 * j + F.lane) = pack8(a[2 * j], a[2 * j + 1]);
        }
        s2 = wave_sum(s2);
        if (F.lane == 0) rstd[m] = 1.0f / sqrtf(s2 * (1.0f / DM) + NORM_EPS);
    }
}
template <class PP> __device__ __forceinline__ void phase_convfix(const PP& p, const Frame& F, int L) {
    bf16_t* ACT = WSP(bf16_t, WS_ACT); const float* HG = WSP(float, WS_HG); const float* FP = WSP(float, WS_FP); const float* FU = WSP(float, WS_FU);
    const float* cw = p.conv_w + (size_t)L * 3 * DFF;
    constexpr int NCH = DFF / 4;
    for (int it = F.bid * NTHR + F.tid; it < 64 * 2 * NCH; it += F.G * NTHR) {
        const int pm = it / (2 * NCH), rem = it - pm * 2 * NCH, i = rem / NCH, f0 = (rem - i * NCH) * 4;
        if ((pm & 7) == 0) continue;
        const f32x4 h0 = *(const f32x4*)(HG + (size_t)((pm - 1) * 2 + 0) * DFF + f0), h1 = *(const f32x4*)(HG + (size_t)((pm - 1) * 2 + 1) * DFF + f0);
        const f32x4 w0 = *(const f32x4*)(cw + f0), w1 = *(const f32x4*)(cw + DFF + f0);
        f32x4 gc = *(const f32x4*)(FP + (size_t)(pm * 2 + i) * DFF + f0); const f32x4 uu = *(const f32x4*)(FU + (size_t)(pm * 2 + i) * DFF + f0);
        if (i == 0) gc += w0 * h0 + w1 * h1; else gc += w0 * h1;
        v2u o; o.x = cvtpk(gc[0] * sigmoidf_(gc[0]) * uu[0], gc[1] * sigmoidf_(gc[1]) * uu[1]); o.y = cvtpk(gc[2] * sigmoidf_(gc[2]) * uu[2], gc[3] * sigmoidf_(gc[3]) * uu[3]);
        *(v2u*)(ACT + (size_t)(pm * 256 + i) * DFF + f0) = o;
    }
}

template <class PP> __device__ __forceinline__ void sb_unit(const PP& p, const ACtx& c, int b, int h, int qt) {
    const bf16_t* PR = WSP(bf16_t, WS_PROJ); bf16_t* OC = WSP(bf16_t, WS_OCAT);
    const int P0 = qt * 256, qlo = P0 + c.wid * 32, qpos = qlo + c.r32;
    const size_t rowb = (size_t)b * SEQ;
    bf16x8 qr[8]; load_q<false>(qr, PR + (rowb + qpos) * SB_N + SBQ + h * HD, nullptr, nullptr, c.hi);
    const bf16_t* Kp = PR + rowb * SB_N + SBK + h * HD; const bf16_t* Vp = PR + rowb * SB_N + SBV + h * HD;
    f32x16 o[4];
#pragma unroll
    for (int d = 0; d < 4; ++d) o[d] = (f32x16){};
    float C2 = 0.f;
    const int jt = (P0 >> 6) + 3;
    LAS int* flags = (LAS int*)(c.lds + A_FLAGS);
    int done_w = 0;
    Stage S; stage_load(S, Kp, Vp, SB_N, jt * 64, c);
    constexpr float ZS = SCALE * LOG2E;
    for (int it = 0; it <= jt; ++it) {
        const int j = jt - it, buf = it & 1;
        stage_write(S, buf, c);
        if (c.lane == 0) flags[buf * 8 + c.wid] = done_w;
        __syncthreads();
        int alld = 1;
#pragma unroll
        for (int w = 0; w < 8; ++w) alld &= flags[buf * 8 + w];
        if (alld) break;
        if (j > 0) stage_load(S, Kp, Vp, SB_N, (j - 1) * 64, c);
        const int kb = j * 64;
        if (!done_w && kb <= qlo + 30) {
            f32x16 p0, p1; qkt(p0, p1, buf, c, qr);
            const int dq = qpos - kb - 4 * c.hi;
#pragma unroll
            for (int r = 0; r < 16; ++r) { const int cc = (r & 3) + 8 * (r >> 2);
                { const float z = p0[r] * ZS; const float t = __builtin_amdgcn_exp2f(-fabsf(z)); const float v = -(fmaxf(z, 0.f) + __builtin_amdgcn_logf(1.f + t)); p0[r] = (cc < dq) ? v : 0.f; }
                { const float z = p1[r] * ZS; const float t = __builtin_amdgcn_exp2f(-fabsf(z)); const float v = -(fmaxf(z, 0.f) + __builtin_amdgcn_logf(1.f + t)); p1[r] = (cc + 32 < dq) ? v : 0.f; } }
            float E[8], Od[8];
#pragma unroll
            for (int q = 0; q < 4; ++q) { const float g0 = (p0[4 * q] + p0[4 * q + 1]) + (p0[4 * q + 2] + p0[4 * q + 3]); swap_both(g0, E[q], Od[q]);
                                          const float g1 = (p1[4 * q] + p1[4 * q + 1]) + (p1[4 * q + 2] + p1[4 * q + 3]); swap_both(g1, E[4 + q], Od[4 + q]); }
            float T = 0.f, ex[8];
#pragma unroll
            for (int q = 7; q >= 0; --q) { const float to = T; T += Od[q]; const float te = T; T += E[q]; ex[q] = c.hi ? to : te; }
#pragma unroll
            for (int q = 0; q < 4; ++q) {
                { float R = C2 + ex[q]; float ep = __builtin_amdgcn_exp2f(R);
#pragma unroll
                  for (int i = 3; i >= 0; --i) { R += p0[4 * q + i]; const float e = __builtin_amdgcn_exp2f(R); p0[4 * q + i] = ep - e; ep = e; } }
                { float R = C2 + ex[4 + q]; float ep = __builtin_amdgcn_exp2f(R);
#pragma unroll
                  for (int i = 3; i >= 0; --i) { R += p1[4 * q + i]; const float e = __builtin_amdgcn_exp2f(R); p1[4 * q + i] = ep - e; ep = e; } }
            }
            C2 += T;
            bf16x8 pa0, pa1, pa2, pa3; pack_p(p0, p1, pa0, pa1, pa2, pa3);
            pv_tile(o, buf, c, pa0, pa1, pa2, pa3);
            done_w = __all(C2 < -72.f) ? 1 : 0;
        }
    }
    __syncthreads();
    store_o_bf16(o, OC + (rowb + qlo) * DM + h * HD, DM, c);
}
template <class PP> __device__ __forceinline__ void mem_unit(const PP& p, const ACtx& c, int L, int b, int hm, int qt, int projN, int qmcol) {
    const bf16_t* PR = WSP(bf16_t, WS_PROJ); bf16_t* OC = WSP(bf16_t, WS_OCAT); const bf16_t* MKV = WSP(bf16_t, WS_MEMKV);
    const int P0 = qt * 256, qlo = P0 + c.wid * 32, qpos = qlo + c.r32;
    const size_t rowb = (size_t)b * SEQ;
    bf16x8 qr[8]; load_q<false>(qr, PR + (rowb + qpos) * projN + qmcol + hm * HD, nullptr, nullptr, c.hi);
    const bf16_t* Kp = MKV + (size_t)b * NMEM * 4096 + L * 1024 + hm * HD; const bf16_t* Vp = Kp + 512;
    f32x16 o[4]; float l;
    softmax_sweep<0>(c, qr, o, l, Kp, Vp, 4096, 0, 4, qpos, qlo, 0u);
    float fr[16]; row_factors(1.0f / l, fr, c);
#pragma unroll
    for (int d = 0; d < 4; ++d)
#pragma unroll
        for (int r = 0; r < 16; ++r) o[d][r] *= fr[r];
    store_o_bf16(o, OC + (rowb + qlo) * DM + NMIX * HD + hm * HD, DM, c);
}
template <class PP> __device__ __forceinline__ void phase_attn_sb(const PP& p, const Frame& F, int L) {
    const ACtx c = make_actx(F.lds);
    constexpr int NSBU = NB * NMIX * 8, NMU = NB * NMEMH * 8;
    for (int u = F.bid; u < NSBU + NMU; u += F.G) {
        if (u < NSBU) { const int qt = 7 - (u % 8), bh = u / 8; sb_unit(p, c, bh / NMIX, bh % NMIX, qt); }
        else { const int v = u - NSBU; const int qt = v % 8, bh = v / 8; mem_unit(p, c, L, bh / NMEMH, bh % NMEMH, qt, SB_N, SBQM); }
    }
}

template <class PP> __device__ __forceinline__ void phase_nsa_prep(const PP& p, const Frame& F, int L) {
    bf16_t* PR = WSP(bf16_t, WS_PROJ); const float* cosT = WSP(float, WS_COS); const float* sinT = WSP(float, WS_SIN);
    const int j = L >> 1;
    const int lane = F.lane, r32 = lane & 31, hi = lane >> 5;
    LAS bf16_t* hid = (LAS bf16_t*)F.lds;
    for (int u = F.bid; u < 128; u += F.G) {
        const int wh = u & 1, rt = u >> 1;
        int rho = rt * 32 + r32; if (rho > CMPROWS - 1) rho = CMPROWS - 1;
        const int bg = rho / NCMP, cc = rho - bg * NCMP, b = bg >> 1, g = bg & 1;
        const size_t tok0 = (size_t)b * SEQ + 16 * cc;
        const bf16_t* src = PR + tok0 * NSA_N + (wh ? NVC : NKC) + g * HD;
        const float* pe = p.cmp_pe + (size_t)(j * 2 + wh) * 32 * HD;
        const bf16_t* w1 = WSP(bf16_t, WS_CW1) + (size_t)wh * 256 * 4096 + (size_t)(F.wave * 32 + r32) * 4096;
        f32x16 acc = (f32x16){};
        for (int l = 0; l < 32; ++l) {
            const bf16_t* rp = src + (size_t)l * NSA_N; const float* pel = pe + l * HD;
            if (wh == 0) {
                const float* cr = cosT + (tok0 + l) * 64; const float* sr = sinT + (tok0 + l) * 64;
#pragma unroll
                for (int kk = 0; kk < 4; ++kk) { const int d = kk * 16 + hi * 8;
                    f32x4 a0, a1, b0, b1; unpack8(*(const bf16x8*)(rp + d), a0, a1); unpack8(*(const bf16x8*)(rp + 64 + d), b0, b1);
                    const f32x4 c0 = *(const f32x4*)(cr + d), c1 = *(const f32x4*)(cr + d + 4), s0 = *(const f32x4*)(sr + d), s1 = *(const f32x4*)(sr + d + 4);
                    const bf16x8 x1 = pack8(a0 * c0 - b0 * s0 + *(const f32x4*)(pel + d), a1 * c1 - b1 * s1 + *(const f32x4*)(pel + d + 4));
                    const bf16x8 x2 = pack8(b0 * c0 + a0 * s0 + *(const f32x4*)(pel + 64 + d), b1 * c1 + a1 * s1 + *(const f32x4*)(pel + 64 + d + 4));
                    acc = __builtin_amdgcn_mfma_f32_32x32x16_bf16(x1, *(const bf16x8*)(w1 + l * HD + d), acc, 0, 0, 0);
                    acc = __builtin_amdgcn_mfma_f32_32x32x16_bf16(x2, *(const bf16x8*)(w1 + l * HD + 64 + d), acc, 0, 0, 0); }
            } else {
#pragma unroll
                for (int kk = 0; kk < 8; ++kk) { const int d = kk * 16 + hi * 8;
                    f32x4 a0, a1; unpack8(*(const bf16x8*)(rp + d), a0, a1);
                    const bf16x8 x1 = pack8(a0 + *(const f32x4*)(pel + d), a1 + *(const f32x4*)(pel + d + 4));
                    acc = __builtin_amdgcn_mfma_f32_32x32x16_bf16(x1, *(const bf16x8*)(w1 + l * HD + d), acc, 0, 0, 0); }
            }
        }
#pragma unroll
        for (int r = 0; r < 16; ++r) { const float v = acc[r]; const float sv = v * sigmoidf_(v);
            hid[crow(r, hi) * 264 + F.wave * 32 + r32] = (bf16_t)(cvtpk(sv, sv) & 0xffffu); }
        __syncthreads();
        if (F.wave < 4) {
            const bf16_t* w2 = WSP(bf16_t, WS_CW2) + (size_t)wh * 128 * 256 + (size_t)(F.wave * 32 + r32) * 256;
            f32x16 a2 = (f32x16){};
#pragma unroll
            for (int kk = 0; kk < 16; ++kk) { const int k = kk * 16 + hi * 8;
                a2 = __builtin_amdgcn_mfma_f32_32x32x16_bf16(*(const LAS bf16x8*)(hid + r32 * 264 + k), *(const bf16x8*)(w2 + k), a2, 0, 0, 0); }
            bf16_t* outp = WSP(bf16_t, WS_KCMP) + (size_t)wh * 16 * 128 * 128;
#pragma unroll
            for (int r = 0; r < 16; ++r) { const int ro = rt * 32 + crow(r, hi);
                if (ro < CMPROWS) { const int bg2 = ro / NCMP, c2 = ro - bg2 * NCMP; outp[((size_t)bg2 * 128 + c2) * 128 + F.wave * 32 + r32] = (bf16_t)(cvtpk(a2[r], a2[r]) & 0xffffu); } }
        }
        if (rt == 0) { bf16_t* outp = WSP(bf16_t, WS_KCMP) + (size_t)wh * 16 * 128 * 128;
            for (int e = F.tid; e < 16 * 128; e += NTHR) outp[((size_t)(e >> 7) * 128 + 127) * 128 + (e & 127)] = 0; }
        __syncthreads();
    }
    const int gw = F.bid * NWAVES + F.wave, NGW = F.G * NWAVES;
    for (int m = gw; m < MTOK; m += NGW) {
        const float cv = cosT[(size_t)m * 64 + lane], sv = sinT[(size_t)m * 64 + lane];
#pragma unroll
        for (int q = 0; q < 4; ++q) { bf16_t* bp = PR + (size_t)m * NSA_N + ((q < 2) ? NKS : NKW) + (q & 1) * HD;
            const float x1 = bf2f(bp[lane]), x2 = bf2f(bp[64 + lane]);
            const float y1 = x1 * cv - x2 * sv, y2 = x2 * cv + x1 * sv;
            bp[lane] = (bf16_t)(cvtpk(y1, y1) & 0xffffu); bp[64 + lane] = (bf16_t)(cvtpk(y2, y2) & 0xffffu); }
    }
}

template <class PP> __device__ __forceinline__ void cmp_unit(const PP& p, const ACtx& c, int b, int g, int qt) {
    const bf16_t* PR = WSP(bf16_t, WS_PROJ); bf16_t* OC = WSP(bf16_t, WS_OCAT); const float* cosT = WSP(float, WS_COS); const float* sinT = WSP(float, WS_SIN);
    const int P0 = qt * 256, qlo = P0 + c.wid * 32, qpos = qlo + c.r32, hi = c.hi;
    const size_t rowb = (size_t)b * SEQ, row = rowb + qpos;
    const bf16_t* Kp = WSP(bf16_t, WS_KCMP) + (size_t)(b * 2 + g) * 128 * 128; const bf16_t* Vp = Kp + (size_t)16 * 128 * 128;
    { Stage S; stage_load(S, Kp, Vp, 128, 0, c); stage_write(S, 0, c); stage_load(S, Kp, Vp, 128, 64, c); stage_write(S, 1, c); }
    __syncthreads();
    const int cmax = (qpos >= 31) ? (((qpos - 31) >> 4) < 126 ? ((qpos - 31) >> 4) : 126) : -1;
    LAS float* acc_l = (LAS float*)(c.lds + A_STASH) + c.wid * 2048 + c.lane;
    const float NEG = -__builtin_inff();
    constexpr float C2 = LOG2E * SCALE;
#pragma nounroll
    for (int hh = 0; hh < HPG; ++hh) {
        const int h = g * HPG + hh;
        bf16x8 qr[8]; load_q<true>(qr, PR + row * NSA_N + NQ + h * HD, cosT + row * 64, sinT + row * 64, hi);
        f32x16 pA0, pA1, pB0, pB1; qkt(pA0, pA1, 0, c, qr); qkt(pB0, pB1, 1, c, qr);
        float mx = NEG;
#pragma unroll
        for (int r = 0; r < 16; ++r) { const int ci = crow(r, hi);
            if (ci > cmax) pA0[r] = NEG; if (ci + 32 > cmax) pA1[r] = NEG; if (ci + 64 > cmax) pB0[r] = NEG; if (ci + 96 > cmax) pB1[r] = NEG;
            mx = fmaxf(fmaxf(mx, pA0[r]), fmaxf(pA1[r], fmaxf(pB0[r], pB1[r]))); }
        mx = swap_max(mx); if (mx == NEG) mx = 0.f;
        const float mL = -mx * C2; float ls = 0.f;
#pragma unroll
        for (int r = 0; r < 16; ++r) { pA0[r] = __builtin_amdgcn_exp2f(fmaf(pA0[r], C2, mL)); pA1[r] = __builtin_amdgcn_exp2f(fmaf(pA1[r], C2, mL));
            pB0[r] = __builtin_amdgcn_exp2f(fmaf(pB0[r], C2, mL)); pB1[r] = __builtin_amdgcn_exp2f(fmaf(pB1[r], C2, mL)); ls += (pA0[r] + pA1[r]) + (pB0[r] + pB1[r]); }
        ls = swap_sum(ls);
        const float inv = ls > 0.f ? 1.0f / ls : 0.f;
#pragma unroll
        for (int r = 0; r < 16; ++r) { pA0[r] *= inv; pA1[r] *= inv; pB0[r] *= inv; pB1[r] *= inv; }
#define ACC_AB(P, Q0) do { _Pragma("unroll") for (int q = 0; q < 4; ++q) { \
            const float a_ = 2.f * (P[4 * q] + P[4 * q + 1] + P[4 * q + 2]) + P[4 * q + 3], b_ = P[4 * q + 3]; \
            LAS float* pa_ = acc_l + (2 * (Q0 + q)) * 64; \
            if (hh == 0) { pa_[0] = a_; pa_[64] = b_; } else { pa_[0] += a_; pa_[64] += b_; } } } while (0)
        ACC_AB(pA0, 0); ACC_AB(pA1, 4); ACC_AB(pB0, 8); ACC_AB(pB1, 12);
#undef ACC_AB
        f32x16 o[4];
#pragma unroll
        for (int d = 0; d < 4; ++d) o[d] = (f32x16){};
        { bf16x8 pa0, pa1, pa2, pa3; pack_p(pA0, pA1, pa0, pa1, pa2, pa3); pv_tile(o, 0, c, pa0, pa1, pa2, pa3); }
        { bf16x8 pa0, pa1, pa2, pa3; pack_p(pB0, pB1, pa0, pa1, pa2, pa3); pv_tile(o, 1, c, pa0, pa1, pa2, pa3); }
        const float gc = sigmoidf_(bf2f(PR[row * NSA_N + NGL + h * 3 + 0]));
        float fr[16]; row_factors(gc, fr, c);
#pragma unroll
        for (int d = 0; d < 4; ++d)
#pragma unroll
            for (int r = 0; r < 16; ++r) o[d][r] *= fr[r];
        store_o_bf16(o, OC + (rowb + qlo) * DM + h * HD, DM, c);
    }
    float Ie[16], Io[16];
    {
        float imp[16], Bb[16];
#pragma unroll
        for (int q = 0; q < 16; ++q) { float blo, bhi; swap_both(acc_l[(2 * q + 1) * 64], blo, bhi); Bb[q] = hi ? blo : bhi; }
#pragma unroll
        for (int q = 0; q < 16; ++q) imp[q] = acc_l[(2 * q) * 64] + (hi ? Bb[q] : (q > 0 ? Bb[q - 1] : 0.f));
#pragma unroll
        for (int q = 0; q < 16; ++q) swap_both(imp[q], Ie[q], Io[q]);
    }
    const int cur = qpos >> 6;
    unsigned bits;
    if (cur < 16) bits = (2u << cur) - 1u;
    else {
#pragma unroll
        for (int q = 0; q < 16; ++q) { const int je = 2 * q, jo = 2 * q + 1;
            if (!(je >= 1 && je <= cur - 2)) Ie[q] = -1.f; if (!(jo >= 1 && jo <= cur - 2)) Io[q] = -1.f; }
        bits = 0u;
#pragma unroll
        for (int q = 0; q < 16; ++q) {
            const int jm = 2 * q + hi; const float vj = hi ? Io[q] : Ie[q];
            int rank = 0;
#pragma unroll
            for (int q2 = 0; q2 < 16; ++q2) {
                const bool lt_e = (q2 < q) || (q2 == q && hi);
                const bool lt_o = (q2 < q);
                rank += (Ie[q2] > vj || (Ie[q2] == vj && lt_e)) ? 1 : 0;
                rank += (Io[q2] > vj || (Io[q2] == vj && lt_o)) ? 1 : 0;
            }
            const bool forced = (jm == 0) || (jm == cur) || (jm == cur - 1);
            const bool sel = forced || (vj >= 0.f && rank < 13);
            bits |= sel ? (1u << jm) : 0u;
        }
        { auto rr = __builtin_amdgcn_permlane32_swap(bits, bits, false, false); bits = rr[0] | rr[1]; }
    }
    if (hi == 0) WSP(unsigned, WS_SEL)[(size_t)(b * 2 + g) * SEQ + qpos] = bits;
    __syncthreads();
}
template <class PP> __device__ __forceinline__ void phase_attn_cmp(const PP& p, const Frame& F, int L) {
    const ACtx c = make_actx(F.lds);
    constexpr int NCU = NB * NGRP * 8, NMU = NB * NMEMH * 8;
    for (int u = F.bid; u < NCU + NMU; u += F.G) {
        if (u < NCU) { const int qt = u % 8, bg = u / 8; cmp_unit(p, c, bg >> 1, bg & 1, qt); }
        else { const int v = u - NCU; const int qt = v % 8, bh = v / 8; mem_unit(p, c, L, bh / NMEMH, bh % NMEMH, qt, NSA_N, NQM); }
    }
}
template <class PP> __device__ __forceinline__ void selwin_unit(const PP& p, const ACtx& c, int b, int h, int qt) {
    const bf16_t* PR = WSP(bf16_t, WS_PROJ); bf16_t* OC = WSP(bf16_t, WS_OCAT); const float* cosT = WSP(float, WS_COS); const float* sinT = WSP(float, WS_SIN);
    const int P0 = qt * 256, qlo = P0 + c.wid * 32, qpos = qlo + c.r32, g = h / HPG;
    const size_t rowb = (size_t)b * SEQ, row = rowb + qpos;
    bf16x8 qr[8]; load_q<true>(qr, PR + row * NSA_N + NQ + h * HD, cosT + row * 64, sinT + row * 64, c.hi);
    const unsigned selbits = WSP(unsigned, WS_SEL)[(size_t)(b * 2 + g) * SEQ + qpos];
    const float gs = sigmoidf_(bf2f(PR[row * NSA_N + NGL + h * 3 + 1])), gwn = sigmoidf_(bf2f(PR[row * NSA_N + NGL + h * 3 + 2]));
    f32x16 o[4]; float l;
    LAS unsigned* stash = (LAS unsigned*)(c.lds + A_STASH) + c.wid * 2048;
    softmax_sweep<2>(c, qr, o, l, PR + rowb * NSA_N + NKS + g * HD, PR + rowb * NSA_N + NVS + g * HD, NSA_N, 0, (P0 >> 6) + 4, qpos, qlo, selbits);
    {
        float fr[16]; row_factors(l > 0.f ? gs / l : 0.f, fr, c);
        const bf16_t* Ow = OC + (rowb + qlo) * DM + h * HD;
#pragma unroll
        for (int r = 0; r < 16; ++r) { const int orow = crow(r, c.hi);
#pragma unroll
            for (int d0 = 0; d0 < 4; ++d0) o[d0][r] = o[d0][r] * fr[r] + bf2f(Ow[(size_t)orow * DM + d0 * 32 + c.r32]); }
#pragma unroll
        for (int r = 0; r < 16; ++r)
#pragma unroll
            for (int d0 = 0; d0 < 4; d0 += 2) stash[((r * 2 + (d0 >> 1)) * 2 + c.hi) * 32 + c.r32] = cvtpk(o[d0][r], o[d0 + 1][r]);
    }
    const int jlo = (P0 - (WINDOW - 1)) > 0 ? ((P0 - (WINDOW - 1)) >> 6) : 0;
    softmax_sweep<1>(c, qr, o, l, PR + rowb * NSA_N + NKW + g * HD, PR + rowb * NSA_N + NVW + g * HD, NSA_N, jlo, (P0 >> 6) + 4, qpos, qlo, 0u);
    {
        float fr[16]; row_factors(l > 0.f ? gwn / l : 0.f, fr, c);
#pragma unroll
        for (int r = 0; r < 16; ++r)
#pragma unroll
            for (int d0 = 0; d0 < 4; d0 += 2) { const unsigned w = stash[((r * 2 + (d0 >> 1)) * 2 + c.hi) * 32 + c.r32];
                o[d0][r] = o[d0][r] * fr[r] + bflo(w); o[d0 + 1][r] = o[d0 + 1][r] * fr[r] + bfhi(w); }
    }
    store_o_bf16(o, OC + (rowb + qlo) * DM + h * HD, DM, c);
}
template <class PP> __device__ __forceinline__ void phase_attn_selwin(const PP& p, const Frame& F) {
    const ACtx c = make_actx(F.lds);
    constexpr int NU = NB * NMIX * 8;
    for (int u = F.bid; u < NU; u += F.G) { const int qt = 7 - (u / (NB * NMIX)), bh = u % (NB * NMIX); selwin_unit(p, c, bh / NMIX, bh % NMIX, qt); }
}

#ifndef PROBE_REPEAT
#define PROBE_REPEAT 0
#endif
constexpr int NPH_SB = 9, NPH_NSA = 11, NPH = 2 * (NPH_SB + NPH_NSA);
__global__ void __launch_bounds__(NTHR, 2) mk_fwd(Params p) {
    extern __shared__ __attribute__((aligned(16))) unsigned char lds_raw[];
    LAS unsigned char* const lds0 = (LAS unsigned char*)lds_raw;
typedef const Params __attribute__((address_space(4))) KParams;
#define MKFRAME() KParams* pp_ = (KParams*)__builtin_amdgcn_kernarg_segment_ptr(); asm volatile("" : "+s"(pp_)); KParams& p = *pp_; Frame F; F.lds = lds0; { int t_ = threadIdx.x; asm volatile("" : "+v"(t_)); F.tid = t_; } F.lane = F.tid & 63; F.wave = __builtin_amdgcn_readfirstlane(F.tid >> 6); F.G = gridDim.x; F.bid = blockIdx.x
    for (int u = threadIdx.x; u < (LDS_BYTES - LDSCTL_OFF) / 4; u += NTHR) ((LAS unsigned*)(lds0 + LDSCTL_OFF))[u] = 0u;
    __syncthreads();
    gu32* ctl = (gu32*)(p.ws + WS_CTL);
    XcdBarrier bar; bar.bar = (unsigned*)(ctl + CW_BAR); bar.x = 0; bar.st = nullptr;
#if !MK_PER_PHASE
    bar = xcd_barrier_post((unsigned*)(ctl + CW_BAR), (volatile LAS unsigned*)(lds0 + MISC_OFF) + 8);
#endif
    const int lo = p.ph_lo, hi = p.ph_hi;
    int ph = 0;
#define IN() (lo <= ph && ph < hi)
#if MK_PER_PHASE
#define END_PHASE() do { ++ph; } while (0)
#else
#define END_PHASE() do { if (IN() && ph + 1 < hi) xcd_barrier(bar); ++ph; } while (0)
#endif
#define GEMM_RS(Aoff, Boff, M_, N_, K_, Ooff, ldc_, rs_) do { pg8::Gemm g{WSP(pg8::bf16_t, Aoff), WSP(pg8::bf16_t, Boff), M_, N_, K_}; pg8::StaticOrder S; S.init(M_, N_, F.G, F.bid); \
        pg8::EpiRS E{WSP(pg8::bf16_t, Ooff), ldc_, rs_}; pg8::gemm_phase<pg8::EpiRS, pg8::StaticOrder, true, true>(F.lds, g, S, E); } while (0)

#define GEMM_GU(L_) do { pg8::Gemm g{WSP(pg8::bf16_t, WS_XB), WSP(pg8::bf16_t, WS_WGU), MTOK, NGU, DM}; pg8::StaticOrder S; S.init(MTOK, NGU, F.G, F.bid); \
        pg8::EpiConv E{WSP(pg8::bf16_t, WS_ACT), WSP(float, WS_RSTD), p.conv_w + (size_t)(L_) * 3 * DFF, p.conv_b + (size_t)(L_) * DFF, WSP(float, WS_HG), WSP(float, WS_FP), WSP(float, WS_FU), (LAS float*)(F.lds + HALO_OFF), DFF}; \
        pg8::gemm_phase<pg8::EpiConv, pg8::StaticOrder, true, true>(F.lds, g, S, E); } while (0)

    for (int lp = 0; lp < 2; ++lp) {
        {
            const int L = 2 * lp;
            if (IN()) { MKFRAME(); for (int rep_ = 0; rep_ < ((PROBE_REPEAT & 1) ? 2 : 1); ++rep_) { phase_convert(p, F, L); } }
            END_PHASE();
            if (IN()) { MKFRAME(); for (int rep_ = 0; rep_ < ((PROBE_REPEAT & 2) ? 2 : 1); ++rep_) { GEMM_RS(WS_XB, WS_WIN, MTOK, SB_N, DM, WS_PROJ, SB_N, WSP(float, WS_RSTD));
                        if (L == 0) GEMM_RS(WS_MEMB, WS_WKV, NB * NMEM, 4096, DM, WS_MEMKV, 4096, WSP(float, WS_RSTD) + 16384); } }
            END_PHASE();
            if (IN()) { MKFRAME(); for (int rep_ = 0; rep_ < ((PROBE_REPEAT & 4) ? 2 : 1); ++rep_) { phase_attn_sb(p, F, L); } }
            END_PHASE();
            if (IN()) { MKFRAME(); for (int rep_ = 0; rep_ < ((PROBE_REPEAT & 2) ? 2 : 1); ++rep_) { GEMM_RS(WS_OCAT, WS_WO, MTOK, DM, DM, WS_TMP, DM, (const float*)nullptr); } }
            END_PHASE();
            if (IN()) { MKFRAME(); for (int rep_ = 0; rep_ < ((PROBE_REPEAT & 8) ? 2 : 1); ++rep_) { phase_resid(p, F, (L == 0) ? p.x : (const float*)p.out, p.norm_g + (size_t)(L * 5 + 1) * DM); } }
            END_PHASE();
            if (IN()) { MKFRAME(); for (int rep_ = 0; rep_ < ((PROBE_REPEAT & 2) ? 2 : 1); ++rep_) { GEMM_GU(L); } }
            END_PHASE();
            if (IN()) { MKFRAME(); for (int rep_ = 0; rep_ < ((PROBE_REPEAT & 16) ? 2 : 1); ++rep_) { phase_convfix(p, F, L); } }
            END_PHASE();
            if (IN()) { MKFRAME(); for (int rep_ = 0; rep_ < ((PROBE_REPEAT & 2) ? 2 : 1); ++rep_) { GEMM_RS(WS_ACT, WS_WD, MTOK, DM, DFF, WS_TMP, DM, (const float*)nullptr); } }
            END_PHASE();
            if (IN()) { MKFRAME(); for (int rep_ = 0; rep_ < ((PROBE_REPEAT & 8) ? 2 : 1); ++rep_) { phase_resid(p, F, (const float*)p.out, p.norm_g + (size_t)(L * 5 + 3) * DM); } }
            END_PHASE();
        }
        {
            const int L = 2 * lp + 1;
            if (IN()) { MKFRAME(); for (int rep_ = 0; rep_ < ((PROBE_REPEAT & 1) ? 2 : 1); ++rep_) { phase_convert(p, F, L); } }
            END_PHASE();
            if (IN()) { MKFRAME(); for (int rep_ = 0; rep_ < ((PROBE_REPEAT & 2) ? 2 : 1); ++rep_) { GEMM_RS(WS_XB, WS_WIN, MTOK, NSA_N, DM, WS_PROJ, NSA_N, WSP(float, WS_RSTD)); } }
            END_PHASE();
            if (IN()) { MKFRAME(); for (int rep_ = 0; rep_ < ((PROBE_REPEAT & 32) ? 2 : 1); ++rep_) { phase_nsa_prep(p, F, L); } }
            END_PHASE();
            if (IN()) { MKFRAME(); for (int rep_ = 0; rep_ < ((PROBE_REPEAT & 64) ? 2 : 1); ++rep_) { phase_attn_cmp(p, F, L); } }
            END_PHASE();
            if (IN()) { MKFRAME(); for (int rep_ = 0; rep_ < ((PROBE_REPEAT & 128) ? 2 : 1); ++rep_) { phase_attn_selwin(p, F); } }
            END_PHASE();
            if (IN()) { MKFRAME(); for (int rep_ = 0; rep_ < ((PROBE_REPEAT & 2) ? 2 : 1); ++rep_) { GEMM_RS(WS_OCAT, WS_WO, MTOK, DM, DM, WS_TMP, DM, (const float*)nullptr); } }
            END_PHASE();
            if (IN()) { MKFRAME(); for (int rep_ = 0; rep_ < ((PROBE_REPEAT & 8) ? 2 : 1); ++rep_) { phase_resid(p, F, (const float*)p.out, p.norm_g + (size_t)(L * 5 + 1) * DM); } }
            END_PHASE();
            if (IN()) { MKFRAME(); for (int rep_ = 0; rep_ < ((PROBE_REPEAT & 2) ? 2 : 1); ++rep_) { GEMM_GU(L); } }
            END_PHASE();
            if (IN()) { MKFRAME(); for (int rep_ = 0; rep_ < ((PROBE_REPEAT & 16) ? 2 : 1); ++rep_) { phase_convfix(p, F, L); } }
            END_PHASE();
            if (IN()) { MKFRAME(); for (int rep_ = 0; rep_ < ((PROBE_REPEAT & 2) ? 2 : 1); ++rep_) { GEMM_RS(WS_ACT, WS_WD, MTOK, DM, DFF, WS_TMP, DM, (const float*)nullptr); } }
            END_PHASE();
            if (IN()) { MKFRAME(); for (int rep_ = 0; rep_ < ((PROBE_REPEAT & 8) ? 2 : 1); ++rep_) { phase_resid(p, F, (const float*)p.out, p.norm_g + (size_t)(L * 5 + 3) * DM); } }
            END_PHASE();
        }
    }
#undef IN
#undef END_PHASE
#undef GEMM_RS
#undef GEMM_GU
}

extern "C" void kernel_launch(void* const* d_in, const int* in_sizes, int n_in, void* d_out, int out_size, void* d_ws, size_t ws_size, hipStream_t stream) {
    static int grid = 0;
    if (grid == 0) {
        if (n_in != 16 || out_size != MTOK * DM || ws_size < WS_END) { fprintf(stderr, "kernel_launch: unexpected shapes (n_in %d, out %d, ws %zu < %zu)\n", n_in, out_size, ws_size, (size_t)WS_END); grid = -1; return; }
        int dev = 0, cus = 0, per_cu = 0;
        if (hipGetDevice(&dev) != hipSuccess || hipDeviceGetAttribute(&cus, hipDeviceAttributeMultiprocessorCount, dev) != hipSuccess) { grid = -1; return; }
        if (hipFuncSetAttribute((const void*)mk_fwd, hipFuncAttributeMaxDynamicSharedMemorySize, LDS_BYTES) != hipSuccess) { fprintf(stderr, "kernel_launch: hipFuncSetAttribute failed\n"); grid = -1; return; }
        if (hipOccupancyMaxActiveBlocksPerMultiprocessor(&per_cu, (const void*)mk_fwd, NTHR, LDS_BYTES) != hipSuccess || per_cu < 1) { fprintf(stderr, "kernel_launch: occupancy query says %d\n", per_cu); (void)hipGetLastError(); }
        grid = cus;
    }
    if (grid < 0) return;
    (void)hipMemsetAsync((char*)d_ws + WS_CTL, 0, CTL_ZERO_BYTES, stream);
    Params p{};
    p.x = (const float*)d_in[0]; p.mem = (const float*)d_in[1]; p.positions = (const int*)d_in[2]; p.norm_g = (const float*)d_in[3]; p.w_in_sb = (const float*)d_in[4]; p.w_in_nsa = (const float*)d_in[5];
    p.cmp_pe = (const float*)d_in[6]; p.cmp_w1 = (const float*)d_in[7]; p.cmp_w2 = (const float*)d_in[8]; p.w_mem_kv = (const float*)d_in[9]; p.w_o = (const float*)d_in[10];
    p.w_gate = (const float*)d_in[11]; p.w_up = (const float*)d_in[12]; p.conv_w = (const float*)d_in[13]; p.conv_b = (const float*)d_in[14]; p.w_down = (const float*)d_in[15];
    p.out = (float*)d_out; p.ws = (unsigned char*)d_ws;
#if MK_PER_PHASE
    for (int ph = 0; ph < NPH; ++ph) { p.ph_lo = ph; p.ph_hi = ph + 1; hipLaunchKernelGGL(mk_fwd, dim3(grid), dim3(NTHR), LDS_BYTES, stream, p); }
#else
    p.ph_lo = 0; p.ph_hi = NPH;
    hipLaunchKernelGGL(mk_fwd, dim3(grid), dim3(NTHR), LDS_BYTES, stream, p);
#endif
}
```

```cpp
#include <hip/hip_runtime.h>
#include <cstdio>
#include <cstdint>
namespace pg8 {
#define PG8_LAS __attribute__((address_space(3)))
typedef unsigned short bf16_t;
typedef short bf16x8 __attribute__((ext_vector_type(8)));
typedef float f32x4 __attribute__((ext_vector_type(4)));
typedef unsigned u32x4 __attribute__((ext_vector_type(4)));
constexpr int BM = 256, BK = 64, HALF = 128, HTB = HALF * BK * 2  , STAGE_BYTES = 8 * HTB, NXCD = 8, WGM = 8;

__host__ __device__ __forceinline__ int lds_byte(int r, int c) { const int st = (r >> 4) * 2 + (c >> 5), rr = r & 15, cc = c & 31, ob = rr * 64 + cc * 2; return st * 1024 + (ob ^ (((ob >> 9) & 1) << 5)); }
__host__ __device__ __forceinline__ void stage_rc(int b, int& R, int& C) { const int st = b / 1024, sb = b % 1024, swz = sb ^ (((sb >> 9) & 1) << 5); R = (st >> 1) * 16 + swz / 64; C = (st & 1) * 32 + (swz % 64) / 2; }
__host__ __device__ __forceinline__ int perm32(int rho) { const int n = rho >> 4, i = rho & 15; return 8 * (i >> 2) + 4 * n + (i & 3); }

struct Unit { int pm, pn; };
struct Gemm { const bf16_t* A; const bf16_t* Bt; int M, N, K; int lda; unsigned hstepA, kpairA; size_t tstepA; };

struct StaticOrder {
    int nM, nN, nwg, G, c;
    __host__ __device__ void init(int M, int N, int G_, int c_) { nM = M / BM; nN = N / BM; nwg = nM * nN; G = G_; c = c_; }
    __host__ __device__ bool next(int i, Unit& u) const {
        const long L = (long)i * G + c; if (L >= nwg) return false;
        int wgid = (int)L; { const int q = nwg / NXCD, r = nwg % NXCD, xcd = wgid % NXCD, off = wgid / NXCD; wgid = (xcd < r ? xcd * (q + 1) : r * (q + 1) + (xcd - r) * q) + off; }
        const int nig = WGM * nN, gid = wgid / nig, fm = gid * WGM, gsz = (nM - fm) < WGM ? (nM - fm) : WGM;
        u.pm = fm + ((wgid % nig) % gsz); u.pn = (wgid % nig) / gsz; return true;
    }
    __device__ __forceinline__ void a_ready(const Unit&) const {}
    __device__ __forceinline__ void done(const Unit&) const {}
};

__device__ __forceinline__ unsigned cvt_pk_bf16(float lo, float hi) { unsigned r; asm volatile("v_cvt_pk_bf16_f32 %0, %1, %2" : "=v"(r) : "v"(lo), "v"(hi)); return r; }
typedef float f32x2 __attribute__((ext_vector_type(2)));
struct EpiRS {
    static constexpr bool PERM = true, AFTER_DRAIN = false;
    bf16_t* O; int ldc; const float* rs;
    __device__ __forceinline__ void operator()(const f32x4 (&acc)[2][2][4][2], const Unit& u, int wr, int wc, int fr, int fq) const {
        const int row0 = u.pm * BM + wr * 64 + fr; const int col0 = u.pn * BM + wc * 32 + 8 * fq;
#pragma unroll
        for (int ai = 0; ai < 2; ++ai)
#pragma unroll
            for (int m = 0; m < 4; ++m) { const int row = row0 + ai * HALF + m * 16; const float sc = rs ? rs[row] : 1.f; bf16_t* rowp = O + (size_t)row * ldc + col0;
#pragma unroll
                for (int bj = 0; bj < 2; ++bj) { const f32x4 v0 = acc[ai][bj][m][0] * sc, v1 = acc[ai][bj][m][1] * sc;
                    u32x4 w; w.x = cvt_pk_bf16(v0[0], v0[1]); w.y = cvt_pk_bf16(v0[2], v0[3]); w.z = cvt_pk_bf16(v1[0], v1[1]); w.w = cvt_pk_bf16(v1[2], v1[3]);
                    *(u32x4*)(rowp + bj * HALF) = w; } }
    }
};
struct EpiConv {
    static constexpr bool PERM = true, AFTER_DRAIN = false;
    bf16_t* ACT; const float* rs; const float* cw; const float* cb; float* HG; float* FP; float* FU; PG8_LAS float* halo; int dff;
    __device__ __forceinline__ void operator()(const f32x4 (&acc)[2][2][4][2], const Unit& u, int wr, int wc, int fr, int fq) const {
        const int fl = wc * 32 + 8 * fq, f0 = u.pn * 128 + fl, lane = (int)(threadIdx.x & 63);
        const int src1 = (lane & 48) | ((fr + 15) & 15), src2 = (lane & 48) | ((fr + 14) & 15);
        f32x4 w0[2], w1[2], w2[2], bb[2];
#pragma unroll
        for (int n = 0; n < 2; ++n) { w0[n] = *(const f32x4*)(cw + f0 + 4 * n); w1[n] = *(const f32x4*)(cw + dff + f0 + 4 * n); w2[n] = *(const f32x4*)(cw + 2 * dff + f0 + 4 * n); bb[n] = *(const f32x4*)(cb + f0 + 4 * n); }
#pragma unroll
        for (int ai = 0; ai < 2; ++ai) { const float sc = rs[u.pm * BM + ai * HALF + wr * 64 + 48 + fr];
            if (fr >= 14) {
#pragma unroll
                for (int n = 0; n < 2; ++n) *(PG8_LAS f32x4*)(halo + ((ai * 2 + wr) * 2 + (fr - 14)) * 128 + fl + 4 * n) = acc[ai][0][3][n] * sc; } }
        asm volatile("s_waitcnt lgkmcnt(0)" ::: "memory"); __builtin_amdgcn_s_barrier(); asm volatile("" ::: "memory");
#pragma unroll
        for (int ai = 0; ai < 2; ++ai) {
            const int s = ai * 2 + wr;
            f32x4 a1p[2], a2p[2];
#pragma unroll
            for (int n = 0; n < 2; ++n) { f32x4 vp = {0.f, 0.f, 0.f, 0.f};
                if (s > 0 && fr >= 14) vp = *(const PG8_LAS f32x4*)(halo + ((s - 1) * 2 + (fr - 14)) * 128 + fl + 4 * n);
#pragma unroll
                for (int e = 0; e < 4; ++e) { a1p[n][e] = __shfl(vp[e], src1); a2p[n][e] = __shfl(vp[e], src2); } }
#pragma unroll
            for (int m = 0; m < 4; ++m) {
                const int row = u.pm * BM + ai * HALF + wr * 64 + m * 16 + fr; const float sc = rs[row];
                u32x4 wv; unsigned pk[4];
#pragma unroll
                for (int n = 0; n < 2; ++n) {
                    const f32x4 v = acc[ai][0][m][n] * sc, uu = acc[ai][1][m][n] * sc; f32x4 a1, a2, gc, ac;
#pragma unroll
                    for (int e = 0; e < 4; ++e) { a1[e] = __shfl(v[e], src1); a2[e] = __shfl(v[e], src2); }
#pragma unroll
                    for (int e = 0; e < 4; ++e) { const float p1 = (fr >= 1) ? a1[e] : a1p[n][e], p2 = (fr >= 2) ? a2[e] : a2p[n][e];
                        gc[e] = bb[n][e] + w0[n][e] * p2 + w1[n][e] * p1 + w2[n][e] * v[e];
                        ac[e] = gc[e] / (1.f + __builtin_amdgcn_exp2f(-gc[e] * 1.4426950408889634f)) * uu[e]; }
                    if (s == 0 && m == 0 && fr < 2) { *(f32x4*)(FP + (size_t)(u.pm * 2 + fr) * dff + f0 + 4 * n) = gc; *(f32x4*)(FU + (size_t)(u.pm * 2 + fr) * dff + f0 + 4 * n) = uu; }
                    if (s == 3 && m == 3 && fr >= 14) *(f32x4*)(HG + (size_t)(u.pm * 2 + fr - 14) * dff + f0 + 4 * n) = v;
                    pk[2 * n] = cvt_pk_bf16(ac[0], ac[1]); pk[2 * n + 1] = cvt_pk_bf16(ac[2], ac[3]);
                    a1p[n] = a1; a2p[n] = a2;
                }
                wv.x = pk[0]; wv.y = pk[1]; wv.z = pk[2]; wv.w = pk[3];
                *(u32x4*)(ACT + (size_t)row * dff + f0) = wv;
            }
        }
    }
};
struct EpiSiluBias {
    static constexpr bool PERM = true, AFTER_DRAIN = false;
    bf16_t* O; int ldc; const float* bias;
    __device__ __forceinline__ void operator()(const f32x4 (&acc)[2][2][4][2], const Unit& u, int wr, int wc, int fr, int fq) const {
        const int row0 = u.pm * BM + wr * 64 + fr; const int col0 = u.pn * BM + wc * 32 + 8 * fq;
        f32x4 bv[2][2];
#pragma unroll
        for (int bj = 0; bj < 2; ++bj)
#pragma unroll
            for (int n = 0; n < 2; ++n) bv[bj][n] = *(const f32x4*)(bias + col0 + bj * HALF + 4 * n);
#pragma unroll
        for (int ai = 0; ai < 2; ++ai)
#pragma unroll
            for (int m = 0; m < 4; ++m) { bf16_t* rowp = O + (size_t)(row0 + ai * HALF + m * 16) * ldc + col0;
#pragma unroll
                for (int bj = 0; bj < 2; ++bj) { f32x4 v0 = acc[ai][bj][m][0] + bv[bj][0], v1 = acc[ai][bj][m][1] + bv[bj][1];
#pragma unroll
                    for (int e = 0; e < 4; ++e) { v0[e] = v0[e] / (1.f + __builtin_amdgcn_exp2f(-v0[e] * 1.4426950408889634f)); v1[e] = v1[e] / (1.f + __builtin_amdgcn_exp2f(-v1[e] * 1.4426950408889634f)); }
                    u32x4 w; w.x = cvt_pk_bf16(v0[0], v0[1]); w.y = cvt_pk_bf16(v0[2], v0[3]); w.z = cvt_pk_bf16(v1[0], v1[1]); w.w = cvt_pk_bf16(v1[2], v1[3]);
                    *(u32x4*)(rowp + bj * HALF) = w; } }
    }
};
template <class Epi, class Sched, bool ALIGN_EPI = false, bool SP2 = false, bool AGEN = false>
__device__ __forceinline__ void gemm_phase(PG8_LAS unsigned char* lds, const Gemm g, const Sched& S, const Epi& E) {
    int tid_ = threadIdx.x; asm volatile("" : "+v"(tid_));
    const int tid = tid_, wid = __builtin_amdgcn_readfirstlane(tid >> 6), lane = tid & 63, wr = wid >> 2, wc = wid & 3, fr = lane & 15, fq = lane >> 4;
    const int K = g.K, nt = K / BK;
    unsigned voffA[2], voffB[2];
#pragma unroll
    for (int i = 0; i < 2; ++i) { int R, C; stage_rc(tid * 16 + i * 8192, R, C); const int Rb = Epi::PERM ? ((R & ~31) + perm32(R & 31)) : R;
        voffA[i] = (unsigned)(R * (AGEN ? g.lda : K) + C) * 2u; voffB[i] = (unsigned)(Rb * K + C) * 2u; }
    const size_t kstep = (size_t)(BK * 2);
    const size_t hstep = (size_t)HALF * K * 2;
    const size_t tstep = 2 * hstep;
    const size_t hstepA = AGEN ? (size_t)g.hstepA : hstep, tstepA = AGEN ? g.tstepA : tstep, kpairA = AGEN ? (size_t)g.kpairA : 2 * kstep;
    const unsigned ldsw = (unsigned)wid * 1024u;
    const int aoff = lds_byte(wr * 64 + fr, fq * 8), boff = lds_byte(wc * 32 + fr, fq * 8);
#define PG8_SA(b, h) (((b) * 2 + (h)) * HTB)
#define PG8_SB(b, h) ((4 + (b) * 2 + (h)) * HTB)
#define PG8_STAGE(bufoff, gbase, voff) do { _Pragma("unroll") for (int _i = 0; _i < 2; ++_i) \
        __builtin_amdgcn_global_load_lds((const unsigned*)((const char*)(gbase) + (voff)[_i]), (PG8_LAS unsigned*)(lds + (bufoff) + ldsw + _i * 8192), 16, 0, 0); } while (0)
#define PG8_LDA(dst, b, h) do { _Pragma("unroll") for (int m = 0; m < 4; ++m) _Pragma("unroll") for (int k = 0; k < 2; ++k) dst[m][k] = *(const PG8_LAS bf16x8*)(lds + PG8_SA(b, h) + aoff + m * 2048 + k * 1024); } while (0)
#define PG8_LDB(dst, b, h) do { _Pragma("unroll") for (int n = 0; n < 2; ++n) _Pragma("unroll") for (int k = 0; k < 2; ++k) dst[n][k] = *(const PG8_LAS bf16x8*)(lds + PG8_SB(b, h) + boff + n * 2048 + k * 1024); } while (0)
#define PG8_MMA(ai, bj, At, Bt) do { __builtin_amdgcn_s_setprio(1); _Pragma("unroll") for (int m = 0; m < 4; ++m) _Pragma("unroll") for (int n = 0; n < 2; ++n) _Pragma("unroll") for (int k = 0; k < 2; ++k) \
        acc[ai][bj][m][n] = __builtin_amdgcn_mfma_f32_16x16x32_bf16(Bt[n][k], At[m][k], acc[ai][bj][m][n], 0, 0, 0); __builtin_amdgcn_s_setprio(0); } while (0)
#define PG8_WAIT_V(n) asm volatile("s_waitcnt vmcnt(" #n ")" ::: "memory")
#define PG8_WAIT_L(n) asm volatile("s_waitcnt lgkmcnt(" #n ")" ::: "memory")
#define PG8_BAR __builtin_amdgcn_s_barrier()
#define PG8_SCHED __builtin_amdgcn_sched_barrier(0)
    Unit cur, nxt; int ui = 0;
    if (!S.next(0, cur)) return;
    f32x4 acc[2][2][4][2];
#pragma unroll
    for (int a = 0; a < 2; ++a)
#pragma unroll
        for (int b = 0; b < 2; ++b)
#pragma unroll
            for (int m = 0; m < 4; ++m)
#pragma unroll
                for (int n = 0; n < 2; ++n) acc[a][b][m][n] = (f32x4){0.f, 0.f, 0.f, 0.f};
    bf16x8 At[4][2], B0[2][2], B1[2][2];
    const char* cA = (const char*)g.A + (size_t)cur.pm * tstepA; const char* cB = (const char*)g.Bt + (size_t)cur.pn * tstep;
    S.a_ready(cur);
    if constexpr (SP2) {
        PG8_STAGE(PG8_SB(0, 0), cB, voffB); PG8_STAGE(PG8_SB(0, 1), cB + hstep, voffB); PG8_STAGE(PG8_SA(0, 0), cA, voffA); PG8_STAGE(PG8_SA(0, 1), cA + hstepA, voffA);
        if (wr == 1) PG8_BAR;
        PG8_WAIT_V(2); PG8_BAR;
        PG8_STAGE(PG8_SB(1, 0), cB + kstep, voffB); PG8_STAGE(PG8_SA(1, 0), cA + kstep, voffA); PG8_STAGE(PG8_SB(1, 1), cB + hstep + kstep, voffB);
        PG8_WAIT_V(6); PG8_BAR;
    } else {
        PG8_STAGE(PG8_SB(0, 0), cB, voffB); PG8_STAGE(PG8_SA(0, 0), cA, voffA); PG8_STAGE(PG8_SB(0, 1), cB + hstep, voffB); PG8_STAGE(PG8_SA(0, 1), cA + hstepA, voffA);
        if (wr == 1) PG8_BAR;
        PG8_WAIT_V(4); PG8_BAR;
        PG8_STAGE(PG8_SB(1, 0), cB + kstep, voffB); PG8_STAGE(PG8_SA(1, 0), cA + kstep, voffA); PG8_STAGE(PG8_SB(1, 1), cB + hstep + kstep, voffB);
        PG8_WAIT_V(6); PG8_BAR;
    }
    for (;;) {
        const bool has_next = S.next(ui + 1, nxt);
        const char* nA = has_next ? (const char*)g.A + (size_t)nxt.pm * tstepA : cA; const char* nB = has_next ? (const char*)g.Bt + (size_t)nxt.pn * tstep : cB;
        for (int t = 0; t < nt; t += 2) {
            const bool last = (t == nt - 2);
            const char* a1 = cA + (size_t)(t >> 1) * kpairA + kstep;
            const char* a2 = last ? nA : cA + (size_t)((t >> 1) + 1) * kpairA; const char* b2 = last ? nB : cB + (size_t)(t + 2) * kstep;
            const char* a3 = a2 + kstep; const char* b3 = b2 + kstep;
            if (last && has_next) S.a_ready(nxt);
            if constexpr (SP2) {
            PG8_LDB(B0, 0, 0); PG8_LDB(B1, 0, 1); PG8_SCHED; PG8_LDA(At, 0, 0); PG8_STAGE(PG8_SA(1, 1), a1 + hstepA, voffA);
            PG8_WAIT_V(8); PG8_WAIT_L(0); PG8_BAR; PG8_MMA(0, 0, At, B0); PG8_MMA(0, 1, At, B1); PG8_BAR; PG8_SCHED;
            PG8_LDA(At, 0, 1); PG8_STAGE(PG8_SB(0, 0), b2, voffB); PG8_STAGE(PG8_SB(0, 1), b2 + hstep, voffB); PG8_STAGE(PG8_SA(0, 0), a2, voffA);
            PG8_WAIT_V(8); PG8_WAIT_L(0); PG8_BAR; PG8_MMA(1, 0, At, B0); PG8_MMA(1, 1, At, B1); PG8_BAR; PG8_SCHED;
            PG8_LDB(B0, 1, 0); PG8_LDB(B1, 1, 1); PG8_SCHED; PG8_LDA(At, 1, 0); PG8_STAGE(PG8_SA(0, 1), a2 + hstepA, voffA);
            PG8_WAIT_V(8); PG8_WAIT_L(0); PG8_BAR; PG8_MMA(0, 0, At, B0); PG8_MMA(0, 1, At, B1); PG8_BAR; PG8_SCHED;
            PG8_LDA(At, 1, 1); PG8_STAGE(PG8_SB(1, 0), b3, voffB); PG8_STAGE(PG8_SB(1, 1), b3 + hstep, voffB); PG8_STAGE(PG8_SA(1, 0), a3, voffA);
            PG8_WAIT_V(8); PG8_WAIT_L(0); PG8_BAR; PG8_MMA(1, 0, At, B0); PG8_MMA(1, 1, At, B1); PG8_BAR; PG8_SCHED;
            } else {
            PG8_LDB(B0, 0, 0); PG8_SCHED; PG8_LDA(At, 0, 0); PG8_STAGE(PG8_SA(1, 1), a1 + hstepA, voffA);
            PG8_WAIT_L(8); PG8_BAR; PG8_WAIT_L(0); PG8_MMA(0, 0, At, B0); PG8_BAR; PG8_SCHED;
            PG8_LDB(B1, 0, 1); PG8_STAGE(PG8_SB(0, 0), b2, voffB);
            PG8_BAR; PG8_WAIT_L(0); PG8_MMA(0, 1, At, B1); PG8_BAR;
            PG8_LDA(At, 0, 1); PG8_STAGE(PG8_SA(0, 0), a2, voffA);
            PG8_BAR; PG8_WAIT_L(0); PG8_MMA(1, 0, At, B0); PG8_BAR; PG8_SCHED;
            PG8_STAGE(PG8_SB(0, 1), b2 + hstep, voffB);
            PG8_WAIT_V(6); PG8_BAR; PG8_MMA(1, 1, At, B1); PG8_BAR;
            PG8_LDB(B0, 1, 0); PG8_SCHED; PG8_LDA(At, 1, 0); PG8_STAGE(PG8_SA(0, 1), a2 + hstepA, voffA);
            PG8_WAIT_L(8); PG8_BAR; PG8_WAIT_L(0); PG8_MMA(0, 0, At, B0); PG8_BAR; PG8_SCHED;
            PG8_LDB(B1, 1, 1); PG8_STAGE(PG8_SB(1, 0), b3, voffB);
            PG8_BAR; PG8_WAIT_L(0); PG8_MMA(0, 1, At, B1); PG8_BAR;
            PG8_LDA(At, 1, 1); PG8_STAGE(PG8_SA(1, 0), a3, voffA);
            PG8_BAR; PG8_WAIT_L(0); PG8_MMA(1, 0, At, B0); PG8_BAR; PG8_SCHED;
            PG8_STAGE(PG8_SB(1, 1), b3 + hstep, voffB);
            PG8_WAIT_V(6); PG8_BAR; PG8_MMA(1, 1, At, B1); PG8_BAR;
            }
        }
        if constexpr (ALIGN_EPI) { if (wr == 0) PG8_BAR; }
        if constexpr (!Epi::AFTER_DRAIN) { E(acc, cur, wr, wc, fr, fq); S.done(cur); }
        if (!has_next) break;
#pragma unroll
        for (int a = 0; a < 2; ++a)
#pragma unroll
            for (int b = 0; b < 2; ++b)
#pragma unroll
                for (int m = 0; m < 4; ++m)
#pragma unroll
                    for (int n = 0; n < 2; ++n) acc[a][b][m][n] = (f32x4){0.f, 0.f, 0.f, 0.f};
        cur = nxt; cA = nA; cB = nB; ++ui;
        if constexpr (ALIGN_EPI) { if (wr == 1) PG8_BAR; }
    }
    PG8_WAIT_V(0);
    if constexpr (!ALIGN_EPI) { if (wr == 0) PG8_BAR; }
    PG8_BAR;
    if constexpr (Epi::AFTER_DRAIN) { E.fused(acc, cur, wr, wc, fr, fq, lds, wid, lane); S.done(cur); }
#undef PG8_SA
#undef PG8_SB
#undef PG8_STAGE
#undef PG8_LDA
#undef PG8_LDB
#undef PG8_MMA
#undef PG8_WAIT_V
#undef PG8_WAIT_L
#undef PG8_BAR
#undef PG8_SCHED
}
}

#ifndef MK_PER_PHASE
#define MK_PER_PHASE 0
#endif
constexpr int NB = 8, SEQ = 2048, DM = 2048, MTOK = NB * SEQ, DEPTH = 4, HD = 128;
constexpr int NMIX = 12, NMEMH = 4, NMEM = 256, DFF = 5632, NGU = 2 * DFF, NGRP = 2, HPG = 6;
constexpr int SB_N = 5120, NSA_N = 3840, NSA_SRC = 3620;
constexpr int SBQ = 0, SBK = 1536, SBV = 3072, SBQM = 4608;
constexpr int NQ = 0, NKC = 1536, NVC = 1792, NKS = 2048, NVS = 2304, NKW = 2560, NVW = 2816, NQM = 3072, NGL = 3584;
constexpr int NCMP = 127, CMPROWS = NB * NGRP * NCMP;
constexpr int WINDOW = 512;
constexpr float NORM_EPS = 1e-6f;
constexpr float SCALE = 0.08838834764831845f;
constexpr float LOG2E = 1.4426950408889634f;
constexpr int NWAVES = 8, NTHR = 512;

constexpr size_t MiB = 1u << 20;
constexpr size_t WS_CTL = 0, CTL_ZERO_BYTES = 1 * MiB;
constexpr size_t WS_WIN = 2 * MiB;
constexpr size_t WS_WO = 22 * MiB;
constexpr size_t WS_WGU = 30 * MiB;
constexpr size_t WS_WD = 74 * MiB;
constexpr size_t WS_WKV = 96 * MiB;
constexpr size_t WS_CW1 = 112 * MiB;
constexpr size_t WS_CW2 = 116 * MiB;
constexpr size_t WS_MEMB = 117 * MiB;
constexpr size_t WS_MEMKV = 125 * MiB;
constexpr size_t WS_COS = 141 * MiB, WS_SIN = 145 * MiB;
constexpr size_t WS_RSTD = 149 * MiB;
constexpr size_t WS_SEL = 150 * MiB;
constexpr size_t WS_KCMP = 151 * MiB;
constexpr size_t WS_XB = 152 * MiB;
constexpr size_t WS_TMP = 216 * MiB;
constexpr size_t WS_ACT = 280 * MiB;
constexpr size_t WS_GU = 456 * MiB;
constexpr size_t WS_PROJ = 456 * MiB;
constexpr size_t WS_OCAT = 616 * MiB;
constexpr size_t WS_HG = 680 * MiB, WS_FP = 684 * MiB, WS_FU = 688 * MiB;
constexpr size_t WS_HID = 692 * MiB;
constexpr size_t WS_BIAS1 = 694 * MiB;
constexpr size_t WS_END = 808 * MiB;
constexpr int CW_BAR = 4096;

constexpr int RING_BYTES = 131072;
constexpr int LDSCTL_OFF = 143360, MISC_OFF = LDSCTL_OFF + 320;
constexpr int LDS_BYTES = 147456;
constexpr int HALO_OFF = RING_BYTES;
constexpr int SHM_T = 16384;
constexpr int A_V = 0, A_K = 2 * SHM_T, A_WS = 4 * SHM_T, A_FLAGS = A_WS + NWAVES * 64 * 4, A_STASH = 67584;

#define GAS __attribute__((address_space(1)))
#define LAS __attribute__((address_space(3)))
typedef unsigned short bf16_t;
typedef unsigned v4u __attribute__((ext_vector_type(4)));
typedef unsigned v2u __attribute__((ext_vector_type(2)));
typedef float f32x4 __attribute__((ext_vector_type(4)));
typedef float f32x16 __attribute__((ext_vector_type(16)));
typedef short bf16x8 __attribute__((ext_vector_type(8)));
typedef short s16x4 __attribute__((ext_vector_type(4)));
typedef GAS unsigned gu32;
#define RLX_AGENT __ATOMIC_RELAXED, __HIP_MEMORY_SCOPE_AGENT
#define LDS_WAIT() asm volatile("s_waitcnt lgkmcnt(0)" ::: "memory")
#define VM_WAIT() asm volatile("s_waitcnt vmcnt(0)" ::: "memory")
#define SBAR() __builtin_amdgcn_sched_barrier(0)
__device__ __forceinline__ unsigned cvtpk(float lo, float hi) { unsigned r; asm volatile("v_cvt_pk_bf16_f32 %0, %1, %2" : "=v"(r) : "v"(lo), "v"(hi)); return r; }
__device__ __forceinline__ float bf2f(unsigned short b) { return __uint_as_float((unsigned)b << 16); }
__device__ __forceinline__ float bflo(unsigned w) { return __uint_as_float(w << 16); }
__device__ __forceinline__ float bfhi(unsigned w) { return __uint_as_float(w & 0xffff0000u); }
__device__ __forceinline__ bf16x8 pack8(f32x4 a, f32x4 b) { v4u w = {cvtpk(a[0], a[1]), cvtpk(a[2], a[3]), cvtpk(b[0], b[1]), cvtpk(b[2], b[3])}; return __builtin_bit_cast(bf16x8, w); }
__device__ __forceinline__ void unpack8(bf16x8 v, f32x4& a, f32x4& b) { const v4u w = __builtin_bit_cast(v4u, v); a = (f32x4){bflo(w.x), bfhi(w.x), bflo(w.y), bfhi(w.y)}; b = (f32x4){bflo(w.z), bfhi(w.z), bflo(w.w), bfhi(w.w)}; }
__device__ __forceinline__ float wave_sum(float v) {
#pragma unroll
    for (int o = 1; o < 64; o <<= 1) v += __shfl_xor(v, o);
    return v;
}
__device__ __forceinline__ float sigmoidf_(float x) { return 1.f / (1.f + __builtin_amdgcn_exp2f(-x * LOG2E)); }

__device__ const float INV_FREQ[64] = {1.000000000e+00f, 8.659643531e-01f, 7.498942018e-01f, 6.493816376e-01f, 5.623413324e-01f, 4.869675338e-01f, 4.216965139e-01f, 3.651741147e-01f, 3.162277639e-01f, 2.738419771e-01f, 2.371373773e-01f, 2.053525001e-01f, 1.778279394e-01f, 1.539926529e-01f, 1.333521456e-01f, 1.154781953e-01f, 1.000000015e-01f, 8.659642935e-02f, 7.498942316e-02f, 6.493816525e-02f, 5.623413250e-02f, 4.869675264e-02f, 4.216964915e-02f, 3.651741147e-02f, 3.162277490e-02f, 2.738419548e-02f, 2.371373773e-02f, 2.053525113e-02f, 1.778279431e-02f, 1.539926510e-02f, 1.333521400e-02f, 1.154781971e-02f, 9.999999776e-03f, 8.659643121e-03f, 7.498942316e-03f, 6.493816152e-03f, 5.623413250e-03f, 4.869675264e-03f, 4.216964822e-03f, 3.651741194e-03f, 3.162277630e-03f, 2.738419687e-03f, 2.371373819e-03f, 2.053525066e-03f, 1.778279431e-03f, 1.539926510e-03f, 1.333521446e-03f, 1.154782018e-03f, 1.000000047e-03f, 8.659643354e-04f, 7.498941850e-04f, 6.493816036e-04f, 5.623413017e-04f, 4.869675322e-04f, 4.216965172e-04f, 3.651741135e-04f, 3.162277571e-04f, 2.738419571e-04f, 2.371373703e-04f, 2.053525095e-04f, 1.778279402e-04f, 1.539926598e-04f, 1.333521504e-04f, 1.154782003e-04f};
#define XB_TMO      128
#define XB_XCNT(j)  (256  + 64 * (j))
#define XB_XSUB(j)  (1280 + 64 * (j))
#define XB_XGEN(j)  (2304 + 64 * (j))
#define XB_TOP      3328
#define XB_TOPGEN   3392
#define XCD_BAR_WORDS 3456
#define XB_SPIN_CAP (1u << 18)

__device__ __forceinline__ unsigned xb_ld(unsigned* p)              { return __hip_atomic_load(p, __ATOMIC_RELAXED, __HIP_MEMORY_SCOPE_AGENT); }
__device__ __forceinline__ unsigned xb_add(unsigned* p, unsigned v) { return __hip_atomic_fetch_add(p, v, __ATOMIC_RELAXED, __HIP_MEMORY_SCOPE_AGENT); }
__device__ __forceinline__ unsigned xb_xcc_id() { return (unsigned)__builtin_amdgcn_s_getreg((3 << 11) | 20) & 0xFu; }
#define XB_SPIN(cond, bar) do { unsigned _sp = 0; while (cond) { __builtin_amdgcn_s_sleep(1); \
    if ((++_sp & 255u) == 0u) { if (xb_ld(&(bar)[XB_TMO])) break; if (_sp > XB_SPIN_CAP) { atomicAdd(&(bar)[XB_TMO], 1u); break; } } } } while (0)

struct XcdBarrier {
    unsigned* bar; unsigned x;
    volatile LAS unsigned* st;
};

__device__ __forceinline__ XcdBarrier xcd_barrier_post(unsigned* bar, volatile LAS unsigned* st) {
    XcdBarrier b; b.bar = bar; b.x = xb_xcc_id(); b.st = st;
    if (threadIdx.x == 0) (void)xb_add(&bar[XB_XCNT(b.x)], 1u);
    return b;
}
__device__ __forceinline__ void xcd_barrier_complete(unsigned* bar, unsigned x, unsigned& nloc, unsigned& nx) {
    const unsigned G = gridDim.x * gridDim.y * gridDim.z;
    unsigned sum, cnt, mine, sp = 0u;
    for (;;) {
        sum = 0u; cnt = 0u; mine = 0u;
#pragma unroll
        for (unsigned j = 0; j < 16; ++j) { const unsigned c = xb_ld(&bar[XB_XCNT(j)]); sum += c; cnt += (c > 0u) ? 1u : 0u; mine = (j == x) ? c : mine; }
        if (sum == G) break;
        __builtin_amdgcn_s_sleep(1);
        if ((++sp & 255u) == 0u) { if (xb_ld(&bar[XB_TMO])) break; if (sp > XB_SPIN_CAP) { atomicAdd(&bar[XB_TMO], 1u); break; } }
    }
    nloc = mine > 0u ? mine : 1u; nx = cnt > 0u ? cnt : 1u;
}

__device__ __forceinline__ void xcd_barrier(const XcdBarrier& b) {
    asm volatile("s_waitcnt vmcnt(0)" ::: "memory");
    __syncthreads();
    if (threadIdx.x == 0) {
        unsigned* bar = b.bar;
        __builtin_amdgcn_s_waitcnt(0);
        unsigned nloc = b.st[0], nx = b.st[1];
        if (nloc == 0u) { xcd_barrier_complete(bar, b.x, nloc, nx); b.st[0] = nloc; b.st[1] = nx; }
        const unsigned old = xb_add(&bar[XB_XSUB(b.x)], 1u);
        const unsigned gen = old / nloc;
        if (old + 1u == (gen + 1u) * nloc) {
            __builtin_amdgcn_fence(__ATOMIC_RELEASE, "agent");
            asm volatile("s_waitcnt vmcnt(0)" ::: "memory");
            const unsigned og = xb_add(&bar[XB_TOP], 1u);
            const unsigned tg = og / nx;
            if (og + 1u == (tg + 1u) * nx) xb_add(&bar[XB_TOPGEN], 1u);
            else XB_SPIN(xb_ld(&bar[XB_TOPGEN]) == tg, bar);
            __builtin_amdgcn_fence(__ATOMIC_ACQUIRE, "agent");
            xb_add(&bar[XB_XGEN(b.x)], 1u);
            asm volatile("s_waitcnt vmcnt(0)" ::: "memory");
        } else {
            XB_SPIN(xb_ld(&bar[XB_XGEN(b.x)]) == gen, bar);
            __builtin_amdgcn_fence(__ATOMIC_ACQUIRE, "agent");
            asm volatile("s_waitcnt vmcnt(0)" ::: "memory");
        }
    }
    __syncthreads();
}

#define KSWZ(row, colB) ((row) * 256 + ((colB) ^ (((row) & 7) << 4)))
__device__ __forceinline__ int v_st(int k, int c) { const int kk = (k & ~0xC) | ((k & 4) << 1) | ((k & 8) >> 1); return ((kk >> 3) * 4 + (c >> 5)) * 512 + ((kk & 7) * 32 + (c & 31)) * 2; }
__device__ __forceinline__ int v_rd_base(int lane) { return ((lane & 3) << 3) | (((lane >> 2) & 3) << 6) | (((lane >> 4) & 1) << 5) | (((lane >> 5) & 1) << 8); }
constexpr int v_rd_off(int d0, int ks, int half) { return d0 * 512 + ks * 4096 + half * 2048; }
__device__ __forceinline__ int crow(int r, int hi) { return (r & 3) + 8 * (r >> 2) + 4 * hi; }

struct ACtx {
    LAS unsigned char* lds;
    int tid, wid, lane, r32, hi, sr, sc, kws, vst0, vst1, vb0;
    LAS float* ws;
};
__device__ __forceinline__ ACtx make_actx(LAS unsigned char* lds) {
    ACtx c; c.lds = lds; { int t_ = threadIdx.x; asm volatile("" : "+v"(t_)); c.tid = t_; } c.wid = __builtin_amdgcn_readfirstlane(c.tid >> 6); c.lane = c.tid & 63; c.r32 = c.lane & 31; c.hi = c.lane >> 5;
    c.sr = c.tid >> 4; c.sc = (c.tid & 15) * 8; c.kws = KSWZ(c.sr, c.sc * 2); c.vst0 = v_st(c.sr, c.sc); c.vst1 = v_st(32 + c.sr, c.sc);
    c.vb0 = (int)(unsigned)(size_t)(lds + A_V) + v_rd_base(c.lane);
    c.ws = (LAS float*)(lds + A_WS) + c.wid * 64;
    return c;
}
struct Stage { bf16x8 k0, k1, v0, v1; };
__device__ __forceinline__ void stage_load(Stage& S, const bf16_t* Kp, const bf16_t* Vp, int pitch, int kb, const ACtx& c) {
    S.v0 = *(const bf16x8*)(Vp + (size_t)(kb + c.sr) * pitch + c.sc); S.v1 = *(const bf16x8*)(Vp + (size_t)(kb + 32 + c.sr) * pitch + c.sc);
    S.k0 = *(const bf16x8*)(Kp + (size_t)(kb + c.sr) * pitch + c.sc); S.k1 = *(const bf16x8*)(Kp + (size_t)(kb + 32 + c.sr) * pitch + c.sc);
}
__device__ __forceinline__ void stage_write(const Stage& S, int buf, const ACtx& c) {
    LAS unsigned char* Kb = c.lds + A_K + buf * SHM_T; LAS unsigned char* Vb = c.lds + A_V + buf * SHM_T;
    *(LAS bf16x8*)(Kb + c.kws) = S.k0; *(LAS bf16x8*)(Kb + c.kws + 32 * 256) = S.k1;
    *(LAS bf16x8*)(Vb + c.vst0) = S.v0; *(LAS bf16x8*)(Vb + c.vst1) = S.v1;
}
__device__ __forceinline__ void qkt(f32x16& p0, f32x16& p1, int buf, const ACtx& c, const bf16x8* qr) {
    p0 = (f32x16){}; p1 = (f32x16){};
    const LAS unsigned char* Kb = c.lds + A_K + buf * SHM_T;
    const LAS unsigned char* kb[4];
#pragma unroll
    for (int dd = 0; dd < 4; ++dd) kb[dd] = Kb + KSWZ(c.r32, (dd * 16 + c.hi * 8) * 2);
#pragma unroll
    for (int d0 = 0; d0 < 8; ++d0) { const LAS unsigned char* a = kb[d0 & 3] + (d0 >> 2) * 128;
        const bf16x8 b0 = *(const LAS bf16x8*)a; const bf16x8 b1 = *(const LAS bf16x8*)(a + 32 * 256);
        p0 = __builtin_amdgcn_mfma_f32_32x32x16_bf16(b0, qr[d0], p0, 0, 0, 0);
        p1 = __builtin_amdgcn_mfma_f32_32x32x16_bf16(b1, qr[d0], p1, 0, 0, 0); }
}
__device__ __forceinline__ void pv_tile(f32x16* o, int buf, const ACtx& c, bf16x8 pa0, bf16x8 pa1, bf16x8 pa2, bf16x8 pa3) {
    const int vb = c.vb0 + buf * SHM_T;
#define TRRD(dst, off) asm volatile("ds_read_b64_tr_b16 %0, %1 offset:%2" : "=&v"(dst) : "v"(vb), "i"(off) : "memory")
#define PV_D0(d0) do { s16x4 l0, l1, l2, l3, h0, h1, h2, h3; constexpr int b_ = v_rd_off(d0, 0, 0); \
        TRRD(l0, b_); TRRD(h0, b_ + 2048); TRRD(l1, b_ + 4096); TRRD(h1, b_ + 6144); TRRD(l2, b_ + 8192); TRRD(h2, b_ + 10240); TRRD(l3, b_ + 12288); TRRD(h3, b_ + 14336); \
        asm volatile("s_waitcnt lgkmcnt(0)" ::: "memory"); SBAR(); \
        o[d0] = __builtin_amdgcn_mfma_f32_32x32x16_bf16(pa0, (bf16x8){l0[0], l0[1], l0[2], l0[3], h0[0], h0[1], h0[2], h0[3]}, o[d0], 0, 0, 0); \
        o[d0] = __builtin_amdgcn_mfma_f32_32x32x16_bf16(pa1, (bf16x8){l1[0], l1[1], l1[2], l1[3], h1[0], h1[1], h1[2], h1[3]}, o[d0], 0, 0, 0); \
        o[d0] = __builtin_amdgcn_mfma_f32_32x32x16_bf16(pa2, (bf16x8){l2[0], l2[1], l2[2], l2[3], h2[0], h2[1], h2[2], h2[3]}, o[d0], 0, 0, 0); \
        o[d0] = __builtin_amdgcn_mfma_f32_32x32x16_bf16(pa3, (bf16x8){l3[0], l3[1], l3[2], l3[3], h3[0], h3[1], h3[2], h3[3]}, o[d0], 0, 0, 0); } while (0)
    PV_D0(0); PV_D0(1); PV_D0(2); PV_D0(3);
#undef PV_D0
#undef TRRD
}
__device__ __forceinline__ float swap_max(float v) { auto rr = __builtin_amdgcn_permlane32_swap(__float_as_uint(v), __float_as_uint(v), false, false); return fmaxf(__uint_as_float(rr[0]), __uint_as_float(rr[1])); }
__device__ __forceinline__ float swap_sum(float v) { auto rr = __builtin_amdgcn_permlane32_swap(__float_as_uint(v), __float_as_uint(v), false, false); return __uint_as_float(rr[0]) + __uint_as_float(rr[1]); }
__device__ __forceinline__ void swap_both(float v, float& lo, float& hi) { auto rr = __builtin_amdgcn_permlane32_swap(__float_as_uint(v), __float_as_uint(v), false, false); lo = __uint_as_float(rr[0]); hi = __uint_as_float(rr[1]); }
__device__ __forceinline__ void pack_p(const f32x16& p0, const f32x16& p1, bf16x8& pa0, bf16x8& pa1, bf16x8& pa2, bf16x8& pa3) {
#define PK4(P, B_, OUT) do { unsigned a0 = cvtpk(P[B_+0], P[B_+1]), a1 = cvtpk(P[B_+2], P[B_+3]); \
        unsigned b0 = cvtpk(P[B_+4], P[B_+5]), b1 = cvtpk(P[B_+6], P[B_+7]); \
        auto r0 = __builtin_amdgcn_permlane32_swap(a0, b0, false, false); auto r1 = __builtin_amdgcn_permlane32_swap(a1, b1, false, false); \
        v4u w = {r0[0], r1[0], r0[1], r1[1]}; OUT = __builtin_bit_cast(bf16x8, w); } while (0)
    PK4(p0, 0, pa0); PK4(p0, 8, pa1); PK4(p1, 0, pa2); PK4(p1, 8, pa3);
#undef PK4
}
__device__ __forceinline__ void mask_tile(f32x16& p0, f32x16& p1, int dq, unsigned W) {
    const float NEG = -__builtin_inff();
#pragma unroll
    for (int r = 0; r < 16; ++r) { const int cc = (r & 3) + 8 * (r >> 2);
        if ((unsigned)(dq - cc) >= W) p0[r] = NEG;
        if ((unsigned)(dq - cc - 32) >= W) p1[r] = NEG; }
}
constexpr float THR = 8.f;
__device__ __forceinline__ void softmax_tile(f32x16& p0, f32x16& p1, float& m_reg, float& l_reg, f32x16* o, const ACtx& c) {
    float pmax = p0[0];
#pragma unroll
    for (int r = 1; r < 16; ++r) pmax = fmaxf(pmax, p0[r]);
#pragma unroll
    for (int r = 0; r < 16; ++r) pmax = fmaxf(pmax, p1[r]);
    pmax = swap_max(pmax);
    constexpr float C2 = LOG2E * SCALE;
    float mn, alpha;
    if (__all((pmax - m_reg) * SCALE <= THR)) { mn = m_reg; alpha = 1.f; }
    else { mn = fmaxf(m_reg, pmax); alpha = __builtin_amdgcn_exp2f((m_reg - mn) * C2); m_reg = mn; }
    const float mnL = -mn * C2;
#pragma unroll
    for (int r = 0; r < 16; ++r) { p0[r] = __builtin_amdgcn_exp2f(fmaf(p0[r], C2, mnL)); p1[r] = __builtin_amdgcn_exp2f(fmaf(p1[r], C2, mnL)); }
    float ps = 0.f;
#pragma unroll
    for (int r = 0; r < 16; ++r) ps += p0[r] + p1[r];
    ps = swap_sum(ps);
    l_reg = l_reg * alpha + ps;
    if (__any(alpha < 1.f)) {
        if (c.hi == 0) c.ws[32 + c.r32] = alpha;
        LDS_WAIT();
#pragma unroll
        for (int r = 0; r < 16; ++r) { const float a = c.ws[32 + crow(r, c.hi)];
#pragma unroll
            for (int d = 0; d < 4; ++d) o[d][r] *= a; }
    }
}
__device__ __forceinline__ void row_factors(float f, float (&fr)[16], const ACtx& c) {
    LDS_WAIT();
    if (c.hi == 0) c.ws[c.r32] = f;
    LDS_WAIT();
#pragma unroll
    for (int r = 0; r < 16; ++r) fr[r] = c.ws[crow(r, c.hi)];
    LDS_WAIT();
}
template <bool ROPE>
__device__ __forceinline__ void load_q(bf16x8 (&qr)[8], const bf16_t* qrow, const float* cosr, const float* sinr, int hi) {
#pragma unroll
    for (int d0 = 0; d0 < 8; ++d0) qr[d0] = *(const bf16x8*)(qrow + d0 * 16 + hi * 8);
    if constexpr (ROPE) {
#pragma unroll
        for (int d0 = 0; d0 < 4; ++d0) {
            const int i0 = d0 * 16 + hi * 8;
            const f32x4 c0 = *(const f32x4*)(cosr + i0), c1 = *(const f32x4*)(cosr + i0 + 4), s0 = *(const f32x4*)(sinr + i0), s1 = *(const f32x4*)(sinr + i0 + 4);
            f32x4 a0, a1, b0, b1; unpack8(qr[d0], a0, a1); unpack8(qr[d0 + 4], b0, b1);
            qr[d0] = pack8(a0 * c0 - b0 * s0, a1 * c1 - b1 * s1);
            qr[d0 + 4] = pack8(b0 * c0 + a0 * s0, b1 * c1 + a1 * s1);
        }
    }
}
__device__ __forceinline__ void store_o_bf16(const f32x16* o, bf16_t* Ow  , int pitch, const ACtx& c) {
#pragma unroll
    for (int r = 0; r < 16; ++r) { const int orow = crow(r, c.hi);
#pragma unroll
        for (int d0 = 0; d0 < 4; ++d0) { const float v = o[d0][r]; const float vn = __shfl_xor(v, 1);
            if ((c.r32 & 1) == 0) *(unsigned*)(Ow + (size_t)orow * pitch + d0 * 32 + c.r32) = cvtpk(v, vn); } }
}

template <int MODE>
__device__ __forceinline__ void softmax_sweep(const ACtx& c, const bf16x8 (&qr)[8], f32x16 (&o)[4], float& l_out, const bf16_t* Kp, const bf16_t* Vp, int pitch,
                                              int j_lo, int j_hi, int qpos, int qlo, unsigned selbits) {
    float m_reg = -1e30f, l_reg = 0.f;
#pragma unroll
    for (int d = 0; d < 4; ++d) o[d] = (f32x16){};
    Stage S; stage_load(S, Kp, Vp, pitch, j_lo * 64, c);
    for (int j = j_lo; j < j_hi; ++j) {
        const int buf = (j - j_lo) & 1;
        stage_write(S, buf, c);
        __syncthreads();
        if (j + 1 < j_hi) stage_load(S, Kp, Vp, pitch, (j + 1) * 64, c);
        const int kb = j * 64;
        bool act = true;
        if (MODE == 1) act = (kb <= qlo + 31) && (kb + 63 >= qlo - (WINDOW - 1));
        if (MODE == 2) act = (kb <= qlo + 31) && __any((int)((selbits >> j) & 1u));
        if (act) {
            f32x16 p0, p1; qkt(p0, p1, buf, c, qr);
            if (MODE == 1) mask_tile(p0, p1, qpos - kb - 4 * c.hi, (unsigned)WINDOW);
            if (MODE == 2) { mask_tile(p0, p1, qpos - kb - 4 * c.hi, 0x7fffffffu);
                if (!((selbits >> j) & 1u)) { const float NEG = -__builtin_inff();
#pragma unroll
                    for (int r = 0; r < 16; ++r) { p0[r] = NEG; p1[r] = NEG; } } }
            softmax_tile(p0, p1, m_reg, l_reg, o, c);
            bf16x8 pa0, pa1, pa2, pa3; pack_p(p0, p1, pa0, pa1, pa2, pa3);
            pv_tile(o, buf, c, pa0, pa1, pa2, pa3);
        }
    }
    __syncthreads();
    l_out = l_reg;
}

struct Params {
    const float* x; const float* mem; const int* positions; const float* norm_g; const float* w_in_sb; const float* w_in_nsa; const float* cmp_pe; const float* cmp_w1; const float* cmp_w2;
    const float* w_mem_kv; const float* w_o; const float* w_gate; const float* w_up; const float* conv_w; const float* conv_b; const float* w_down;
    float* out; unsigned char* ws; int ph_lo, ph_hi;
};
struct Frame {
    LAS unsigned char* lds; int tid, lane, wave, G, bid;
};
#define WSP(T, off) ((T*)(p.ws + (off)))

__device__ __forceinline__ void tr_item(const float* W, int K, int Nsrc, int src_col0, int ncols, const float* gain, bf16_t* WT, int dst_row0, int mode, int item, int lane) {
    const int nblk = (ncols + 255) >> 8, kb = item / nblk, nb = item - kb * nblk, k0 = 16 * kb, n = nb * 256 + 4 * lane;
    if (n >= ncols) return;
    f32x4 v[16];
    if (W != nullptr) {
        const float* src = W + (size_t)k0 * Nsrc + src_col0 + n;
#pragma unroll
        for (int j = 0; j < 16; ++j) v[j] = *(const f32x4*)(src + (size_t)j * Nsrc);
        if (gain) {
#pragma unroll
            for (int j = 0; j < 16; ++j) v[j] = v[j] * gain[k0 + j];
        }
    } else {
#pragma unroll
        for (int j = 0; j < 16; ++j) v[j] = (f32x4){0.f, 0.f, 0.f, 0.f};
    }
#pragma unroll
    for (int e = 0; e < 4; ++e) {
        const int nn = n + e; const int drow = dst_row0 + (mode == 0 ? nn : 256 * (nn >> 7) + (nn & 127));
        v4u o0, o1;
        o0.x = cvtpk(v[0][e], v[1][e]); o0.y = cvtpk(v[2][e], v[3][e]); o0.z = cvtpk(v[4][e], v[5][e]); o0.w = cvtpk(v[6][e], v[7][e]);
        o1.x = cvtpk(v[8][e], v[9][e]); o1.y = cvtpk(v[10][e], v[11][e]); o1.z = cvtpk(v[12][e], v[13][e]); o1.w = cvtpk(v[14][e], v[15][e]);
        v4u* dst = (v4u*)(WT + (size_t)drow * K + k0); dst[0] = o0; dst[1] = o1;
    }
}
__device__ __forceinline__ void row_to_bf16_rstd(const float* xrow, bf16_t* orow, float* rstd_out, int lane) {
    const f32x4* xr = (const f32x4*)xrow + lane; f32x4 v[8]; float s = 0.f;
#pragma unroll
    for (int j = 0; j < 8; ++j) { v[j] = xr[64 * j]; s += (v[j].x * v[j].x + v[j].y * v[j].y) + (v[j].z * v[j].z + v[j].w * v[j].w); }
    s = wave_sum(s);
    v2u* o8 = (v2u*)orow + lane;
#pragma unroll
    for (int j = 0; j < 8; ++j) { v2u w; w.x = cvtpk(v[j].x, v[j].y); w.y = cvtpk(v[j].z, v[j].w); o8[64 * j] = w; }
    if (lane == 0) *rstd_out = 1.0f / sqrtf(s * (1.0f / DM) + NORM_EPS);
}
template <class PP> __device__ __forceinline__ void phase_convert(const PP& p, const Frame& F, int L) {
    const int gw = F.bid * NWAVES + F.wave, NGW = F.G * NWAVES;
    int it0 = gw;
#define TR(W, K, Nsrc, sc0, nc, gain, WT, dr0, mode) do { const int n_ = ((K) / 16) * (((nc) + 255) >> 8); for (; it0 < n_; it0 += NGW) tr_item(W, K, Nsrc, sc0, nc, gain, WT, dr0, mode, it0, F.lane); it0 -= n_; } while (0)
    const float* g = p.norm_g + (size_t)L * 5 * DM;
    const int j = L >> 1;
    bf16_t* WIN = WSP(bf16_t, WS_WIN);
    if ((L & 1) == 0) {
        TR(p.w_in_sb + (size_t)j * DM * SB_N, DM, SB_N, 0, SB_N, g, WIN, 0, 0);
    } else {
        const float* W = p.w_in_nsa + (size_t)j * DM * NSA_SRC;
        TR(W, DM, NSA_SRC, 0, 3072, g, WIN, 0, 0);
        TR(W, DM, NSA_SRC, 3108, 512, g, WIN, NQM, 0);
        TR(W, DM, NSA_SRC, 3072, 36, g, WIN, NGL, 0);
        TR((const float*)nullptr, DM, NSA_SRC, 0, 220, (const float*)nullptr, WIN, NGL + 36, 0);
        for (int wh = 0; wh < 2; ++wh) {
            TR(p.cmp_w1 + (size_t)(j * 2 + wh) * 4096 * 256, 4096, 256, 0, 256, (const float*)nullptr, WSP(bf16_t, WS_CW1) + (size_t)wh * 256 * 4096, 0, 0);
            TR(p.cmp_w2 + (size_t)(j * 2 + wh) * 256 * 128, 256, 128, 0, 128, (const float*)nullptr, WSP(bf16_t, WS_CW2) + (size_t)wh * 128 * 256, 0, 0);
        }
    }
    if ((L & 1) && F.bid < 16) {
        const int wh = F.bid >> 3, n = 32 * (F.bid & 7) + (F.tid & 31), kg = F.tid >> 5;
        const float* pe = p.cmp_pe + (size_t)(j * 2 + wh) * 4096; const float* w1 = p.cmp_w1 + (size_t)(j * 2 + wh) * 4096 * 256;
        float s = 0.f;
        for (int k = kg * 256; k < kg * 256 + 256; ++k) s += pe[k] * w1[(size_t)k * 256 + n];
        LAS float* red = (LAS float*)F.lds;
        red[kg * 32 + (F.tid & 31)] = s;
        __syncthreads();
        if (F.tid < 32) { float t = 0.f;
#pragma unroll
            for (int q = 0; q < 16; ++q) t += red[q * 32 + F.tid];
            WSP(float, WS_BIAS1)[wh * 256 + n] = t; }
        __syncthreads();
    }
    TR(p.w_o + (size_t)L * DM * DM, DM, DM, 0, DM, (const float*)nullptr, WSP(bf16_t, WS_WO), 0, 0);
    TR(p.w_gate + (size_t)L * DM * DFF, DM, DFF, 0, DFF, g + 2 * DM, WSP(bf16_t, WS_WGU), 0, 1);
    TR(p.w_up + (size_t)L * DM * DFF, DM, DFF, 0, DFF, g + 2 * DM, WSP(bf16_t, WS_WGU), 128, 1);
    TR(p.w_down + (size_t)L * DFF * DM, DFF, DM, 0, DM, (const float*)nullptr, WSP(bf16_t, WS_WD), 0, 0);
    if (L == 0) {
        for (int l = 0; l < DEPTH; ++l)
            TR(p.w_mem_kv + (size_t)l * DM * 1024, DM, 1024, 0, 1024, p.norm_g + (size_t)(l * 5 + 4) * DM, WSP(bf16_t, WS_WKV), l * 1024, 0);
        float* rstd = WSP(float, WS_RSTD);
        for (int m = gw; m < MTOK; m += NGW) row_to_bf16_rstd(p.x + (size_t)m * DM, WSP(bf16_t, WS_XB) + (size_t)m * DM, rstd + m, F.lane);
        for (int m = gw; m < NB * NMEM; m += NGW) row_to_bf16_rstd(p.mem + (size_t)m * DM, WSP(bf16_t, WS_MEMB) + (size_t)m * DM, rstd + 16384 + m, F.lane);
        float* cosT = WSP(float, WS_COS); float* sinT = WSP(float, WS_SIN);
        for (int idx = F.bid * NTHR + F.tid; idx < MTOK * 64; idx += F.G * NTHR) {
            const int row = idx >> 6, i = idx & 63;
            const float ang = (float)p.positions[row] * INV_FREQ[i];
            double t = (double)ang * 0.15915494309189535; t -= __builtin_rint(t);
            const float fr = (float)t;
            cosT[idx] = __builtin_amdgcn_cosf(fr); sinT[idx] = __builtin_amdgcn_sinf(fr);
        }
    }
#undef TR
}

template <class PP> __device__ __forceinline__ void phase_resid(const PP& p, const Frame& F, const float* xin, const float* gpost, float* xout, bf16_t* XB, float* rstd) {
    const int gw = F.bid * NWAVES + F.wave, NGW = F.G * NWAVES;
    const bf16_t* T = WSP(bf16_t, WS_TMP);
    for (int m = gw; m < MTOK; m += NGW) {
        const bf16x8* ar = (const bf16x8*)(T + (size_t)m * DM) + F.lane;
        f32x4 a[8]; float s = 0.f;
#pragma unroll
        for (int j = 0; j < 4; ++j) { unpack8(ar[64 * j], a[2 * j], a[2 * j + 1]); }
#pragma unroll
        for (int j = 0; j < 8; ++j) s += (a[j].x * a[j].x + a[j].y * a[j].y) + (a[j].z * a[j].z + a[j].w * a[j].w);
        const float ra = 1.0f / sqrtf(wave_sum(s) * (1.0f / DM) + NORM_EPS);
        float s2 = 0.f;
#pragma unroll
        for (int j = 0; j < 4; ++j) {
            const int e0 = (j * 64 + F.lane) * 8;
#pragma unroll
            for (int h = 0; h < 2; ++h) {
                const f32x4 xv = *(const f32x4*)(xin + (size_t)m * DM + e0 + 4 * h), gv = *(const f32x4*)(gpost + e0 + 4 * h);
                const f32x4 y = xv + a[2 * j + h] * ra * gv;
                a[2 * j + h] = y; s2 += (y.x * y.x + y.y * y.y) + (y.z * y.z + y.w * y.w);
                *(f32x4*)(xout + (size_t)m * DM + e0 + 4 * h) = y;
            }
            *((bf16x8*)(XB + (size_t)m * DM) + 64 * j + F.lane) = pack8(a[2 * j], a[2 * j + 1]);
        }
        s2 = wave_sum(s2);
        if (F.lane == 0) rstd[m] = 1.0f / sqrtf(s2 * (1.0f / DM) + NORM_EPS);
    }
}
template <class PP> __device__ __forceinline__ void phase_convfix(const PP& p, const Frame& F, int L) {
    bf16_t* ACT = WSP(bf16_t, WS_ACT); const float* HG = WSP(float, WS_HG); const float* FP = WSP(float, WS_FP); const float* FU = WSP(float, WS_FU);
    const float* cw = p.conv_w + (size_t)L * 3 * DFF;
    constexpr int NCH = DFF / 4;
    for (int it = F.bid * NTHR + F.tid; it < 64 * 2 * NCH; it += F.G * NTHR) {
        const int pm = it / (2 * NCH), rem = it - pm * 2 * NCH, i = rem / NCH, f0 = (rem - i * NCH) * 4;
        if ((pm & 7) == 0) continue;
        const f32x4 h0 = *(const f32x4*)(HG + (size_t)((pm - 1) * 2 + 0) * DFF + f0), h1 = *(const f32x4*)(HG + (size_t)((pm - 1) * 2 + 1) * DFF + f0);
        const f32x4 w0 = *(const f32x4*)(cw + f0), w1 = *(const f32x4*)(cw + DFF + f0);
        f32x4 gc = *(const f32x4*)(FP + (size_t)(pm * 2 + i) * DFF + f0); const f32x4 uu = *(const f32x4*)(FU + (size_t)(pm * 2 + i) * DFF + f0);
        if (i == 0) gc += w0 * h0 + w1 * h1; else gc += w0 * h1;
        v2u o; o.x = cvtpk(gc[0] * sigmoidf_(gc[0]) * uu[0], gc[1] * sigmoidf_(gc[1]) * uu[1]); o.y = cvtpk(gc[2] * sigmoidf_(gc[2]) * uu[2], gc[3] * sigmoidf_(gc[3]) * uu[3]);
        *(v2u*)(ACT + (size_t)(pm * 256 + i) * DFF + f0) = o;
    }
}

template <class PP> __device__ __forceinline__ void sb_unit(const PP& p, const ACtx& c, int b, int h, int qt) {
    const bf16_t* PR = WSP(bf16_t, WS_PROJ); bf16_t* OC = WSP(bf16_t, WS_OCAT);
    const int P0 = qt * 256, qlo = P0 + c.wid * 32, qpos = qlo + c.r32;
    const size_t rowb = (size_t)b * SEQ;
    bf16x8 qr[8]; load_q<false>(qr, PR + (rowb + qpos) * SB_N + SBQ + h * HD, nullptr, nullptr, c.hi);
    const bf16_t* Kp = PR + rowb * SB_N + SBK + h * HD; const bf16_t* Vp = PR + rowb * SB_N + SBV + h * HD;
    f32x16 o[4];
#pragma unroll
    for (int d = 0; d < 4; ++d) o[d] = (f32x16){};
    float C2 = 0.f;
    const int jt = (P0 >> 6) + 3;
    LAS int* flags = (LAS int*)(c.lds + A_FLAGS);
    int done_w = 0;
    Stage S; stage_load(S, Kp, Vp, SB_N, jt * 64, c);
    constexpr float ZS = SCALE * LOG2E;
    for (int it = 0; it <= jt; ++it) {
        const int j = jt - it, buf = it & 1;
        stage_write(S, buf, c);
        if (c.lane == 0) flags[buf * 8 + c.wid] = done_w;
        __syncthreads();
        int alld = 1;
#pragma unroll
        for (int w = 0; w < 8; ++w) alld &= flags[buf * 8 + w];
        if (alld) break;
        if (j > 0) stage_load(S, Kp, Vp, SB_N, (j - 1) * 64, c);
        const int kb = j * 64;
        if (!done_w && kb <= qlo + 30) {
            f32x16 p0, p1; qkt(p0, p1, buf, c, qr);
            const int dq = qpos - kb - 4 * c.hi;
#pragma unroll
            for (int r = 0; r < 16; ++r) { const int cc = (r & 3) + 8 * (r >> 2);
                { const float z = p0[r] * ZS; const float t = __builtin_amdgcn_exp2f(-fabsf(z)); const float v = -(fmaxf(z, 0.f) + __builtin_amdgcn_logf(1.f + t)); p0[r] = (cc < dq) ? v : 0.f; }
                { const float z = p1[r] * ZS; const float t = __builtin_amdgcn_exp2f(-fabsf(z)); const float v = -(fmaxf(z, 0.f) + __builtin_amdgcn_logf(1.f + t)); p1[r] = (cc + 32 < dq) ? v : 0.f; } }
            float E[8], Od[8];
#pragma unroll
            for (int q = 0; q < 4; ++q) { const float g0 = (p0[4 * q] + p0[4 * q + 1]) + (p0[4 * q + 2] + p0[4 * q + 3]); swap_both(g0, E[q], Od[q]);
                                          const float g1 = (p1[4 * q] + p1[4 * q + 1]) + (p1[4 * q + 2] + p1[4 * q + 3]); swap_both(g1, E[4 + q], Od[4 + q]); }
            float T = 0.f, ex[8];
#pragma unroll
            for (int q = 7; q >= 0; --q) { const float to = T; T += Od[q]; const float te = T; T += E[q]; ex[q] = c.hi ? to : te; }
#pragma unroll
            for (int q = 0; q < 4; ++q) {
                { float R = C2 + ex[q]; float ep = __builtin_amdgcn_exp2f(R);
#pragma unroll
                  for (int i = 3; i >= 0; --i) { R += p0[4 * q + i]; const float e = __builtin_amdgcn_exp2f(R); p0[4 * q + i] = ep - e; ep = e; } }
                { float R = C2 + ex[4 + q]; float ep = __builtin_amdgcn_exp2f(R);
#pragma unroll
                  for (int i = 3; i >= 0; --i) { R += p1[4 * q + i]; const float e = __builtin_amdgcn_exp2f(R); p1[4 * q + i] = ep - e; ep = e; } }
            }
            C2 += T;
            bf16x8 pa0, pa1, pa2, pa3; pack_p(p0, p1, pa0, pa1, pa2, pa3);
            pv_tile(o, buf, c, pa0, pa1, pa2, pa3);
            done_w = __all(C2 < -72.f) ? 1 : 0;
        }
    }
    __syncthreads();
    store_o_bf16(o, OC + (rowb + qlo) * DM + h * HD, DM, c);
}
template <class PP> __device__ __forceinline__ void mem_unit(const PP& p, const ACtx& c, int L, int b, int hm, int qt, int projN, int qmcol) {
    const bf16_t* PR = WSP(bf16_t, WS_PROJ); bf16_t* OC = WSP(bf16_t, WS_OCAT); const bf16_t* MKV = WSP(bf16_t, WS_MEMKV);
    const int P0 = qt * 256, qlo = P0 + c.wid * 32, qpos = qlo + c.r32;
    const size_t rowb = (size_t)b * SEQ;
    bf16x8 qr[8]; load_q<false>(qr, PR + (rowb + qpos) * projN + qmcol + hm * HD, nullptr, nullptr, c.hi);
    const bf16_t* Kp = MKV + (size_t)b * NMEM * 4096 + L * 1024 + hm * HD; const bf16_t* Vp = Kp + 512;
    f32x16 o[4]; float l;
    softmax_sweep<0>(c, qr, o, l, Kp, Vp, 4096, 0, 4, qpos, qlo, 0u);
    float fr[16]; row_factors(1.0f / l, fr, c);
#pragma unroll
    for (int d = 0; d < 4; ++d)
#pragma unroll
        for (int r = 0; r < 16; ++r) o[d][r] *= fr[r];
    store_o_bf16(o, OC + (rowb + qlo) * DM + NMIX * HD + hm * HD, DM, c);
}
template <class PP> __device__ __forceinline__ void phase_attn_sb(const PP& p, const Frame& F, int L) {
    const ACtx c = make_actx(F.lds);
    constexpr int NSBU = NB * NMIX * 8, NMU = NB * NMEMH * 8;
    for (int u = F.bid; u < NSBU + NMU; u += F.G) {
        if (u < NSBU) { const int qt = 7 - (u % 8), bh = u / 8; sb_unit(p, c, bh / NMIX, bh % NMIX, qt); }
        else { const int v = u - NSBU; const int qt = v % 8, bh = v / 8; mem_unit(p, c, L, bh / NMEMH, bh % NMEMH, qt, SB_N, SBQM); }
    }
}

template <class PP> __device__ __forceinline__ void phase_rope(const PP& p, const Frame& F) {
    bf16_t* PR = WSP(bf16_t, WS_PROJ); const float* cosT = WSP(float, WS_COS); const float* sinT = WSP(float, WS_SIN);
    const int lane = F.lane, gw = F.bid * NWAVES + F.wave, NGW = F.G * NWAVES;
    for (int m = gw; m < MTOK; m += NGW) {
        const float cv = cosT[(size_t)m * 64 + lane], sv = sinT[(size_t)m * 64 + lane];
        bf16_t* rowp = PR + (size_t)m * NSA_N;
        float x1[6], x2[6];
#pragma unroll
        for (int q = 0; q < 6; ++q) { const int base = ((q < 2) ? NKC : (q < 4) ? NKS : NKW) + (q & 1) * HD; x1[q] = bf2f(rowp[base + lane]); x2[q] = bf2f(rowp[base + 64 + lane]); }
#pragma unroll
        for (int q = 0; q < 6; ++q) { const int base = ((q < 2) ? NKC : (q < 4) ? NKS : NKW) + (q & 1) * HD;
            const float y1 = x1[q] * cv - x2[q] * sv, y2 = x2[q] * cv + x1[q] * sv;
            rowp[base + lane] = (bf16_t)(cvtpk(y1, y1) & 0xffffu); rowp[base + 64 + lane] = (bf16_t)(cvtpk(y2, y2) & 0xffffu); }
    }
}
template <class PP> __device__ __forceinline__ void phase_cmp_stage2(const PP& p, const Frame& F) {
    const int lane = F.lane, r32 = lane & 31, hi = lane >> 5;
    for (int u = F.bid; u < 128; u += F.G) {
        const int wh = u & 1, rt = u >> 1;
        if (F.wave < 4) {
            const bf16_t* hid = WSP(bf16_t, WS_HID) + (size_t)wh * 2048 * 256 + (size_t)(rt * 32 + r32) * 256;
            const bf16_t* w2 = WSP(bf16_t, WS_CW2) + (size_t)wh * 128 * 256 + (size_t)(F.wave * 32 + r32) * 256;
            f32x16 a2 = (f32x16){};
#pragma unroll
            for (int kk = 0; kk < 16; ++kk) { const int k = kk * 16 + hi * 8;
                a2 = __builtin_amdgcn_mfma_f32_32x32x16_bf16(*(const bf16x8*)(hid + k), *(const bf16x8*)(w2 + k), a2, 0, 0, 0); }
            bf16_t* outp = WSP(bf16_t, WS_KCMP) + (size_t)wh * 16 * 128 * 128;
#pragma unroll
            for (int r = 0; r < 16; ++r) { const int ro = rt * 32 + crow(r, hi);
                outp[(size_t)ro * 128 + F.wave * 32 + r32] = ((ro & 127) == 127) ? (bf16_t)0 : (bf16_t)(cvtpk(a2[r], a2[r]) & 0xffffu); }
        }
    }
}

template <class PP> __device__ __forceinline__ void cmp_unit(const PP& p, const ACtx& c, int b, int g, int qt) {
    const bf16_t* PR = WSP(bf16_t, WS_PROJ); bf16_t* OC = WSP(bf16_t, WS_OCAT); const float* cosT = WSP(float, WS_COS); const float* sinT = WSP(float, WS_SIN);
    const int P0 = qt * 256, qlo = P0 + c.wid * 32, qpos = qlo + c.r32, hi = c.hi;
    const size_t rowb = (size_t)b * SEQ, row = rowb + qpos;
    const bf16_t* Kp = WSP(bf16_t, WS_KCMP) + (size_t)(b * 2 + g) * 128 * 128; const bf16_t* Vp = Kp + (size_t)16 * 128 * 128;
    { Stage S; stage_load(S, Kp, Vp, 128, 0, c); stage_write(S, 0, c); stage_load(S, Kp, Vp, 128, 64, c); stage_write(S, 1, c); }
    __syncthreads();
    const int cmax = (qpos >= 31) ? (((qpos - 31) >> 4) < 126 ? ((qpos - 31) >> 4) : 126) : -1;
    LAS float* acc_l = (LAS float*)(c.lds + A_STASH) + c.wid * 2048 + c.lane;
    const float NEG = -__builtin_inff();
    constexpr float C2 = LOG2E * SCALE;
#pragma nounroll
    for (int hh = 0; hh < HPG; ++hh) {
        const int h = g * HPG + hh;
        bf16x8 qr[8]; load_q<true>(qr, PR + row * NSA_N + NQ + h * HD, cosT + row * 64, sinT + row * 64, hi);
        f32x16 pA0, pA1, pB0, pB1; qkt(pA0, pA1, 0, c, qr); qkt(pB0, pB1, 1, c, qr);
        float mx = NEG;
#pragma unroll
        for (int r = 0; r < 16; ++r) { const int ci = crow(r, hi);
            if (ci > cmax) pA0[r] = NEG; if (ci + 32 > cmax) pA1[r] = NEG; if (ci + 64 > cmax) pB0[r] = NEG; if (ci + 96 > cmax) pB1[r] = NEG;
            mx = fmaxf(fmaxf(mx, pA0[r]), fmaxf(pA1[r], fmaxf(pB0[r], pB1[r]))); }
        mx = swap_max(mx); if (mx == NEG) mx = 0.f;
        const float mL = -mx * C2; float ls = 0.f;
#pragma unroll
        for (int r = 0; r < 16; ++r) { pA0[r] = __builtin_amdgcn_exp2f(fmaf(pA0[r], C2, mL)); pA1[r] = __builtin_amdgcn_exp2f(fmaf(pA1[r], C2, mL));
            pB0[r] = __builtin_amdgcn_exp2f(fmaf(pB0[r], C2, mL)); pB1[r] = __builtin_amdgcn_exp2f(fmaf(pB1[r], C2, mL)); ls += (pA0[r] + pA1[r]) + (pB0[r] + pB1[r]); }
        ls = swap_sum(ls);
        const float inv = ls > 0.f ? 1.0f / ls : 0.f;
#pragma unroll
        for (int r = 0; r < 16; ++r) { pA0[r] *= inv; pA1[r] *= inv; pB0[r] *= inv; pB1[r] *= inv; }
#define ACC_AB(P, Q0) do { _Pragma("unroll") for (int q = 0; q < 4; ++q) { \
            const float a_ = 2.f * (P[4 * q] + P[4 * q + 1] + P[4 * q + 2]) + P[4 * q + 3], b_ = P[4 * q + 3]; \
            LAS float* pa_ = acc_l + (2 * (Q0 + q)) * 64; \
            if (hh == 0) { pa_[0] = a_; pa_[64] = b_; } else { pa_[0] += a_; pa_[64] += b_; } } } while (0)
        ACC_AB(pA0, 0); ACC_AB(pA1, 4); ACC_AB(pB0, 8); ACC_AB(pB1, 12);
#undef ACC_AB
        f32x16 o[4];
#pragma unroll
        for (int d = 0; d < 4; ++d) o[d] = (f32x16){};
        { bf16x8 pa0, pa1, pa2, pa3; pack_p(pA0, pA1, pa0, pa1, pa2, pa3); pv_tile(o, 0, c, pa0, pa1, pa2, pa3); }
        { bf16x8 pa0, pa1, pa2, pa3; pack_p(pB0, pB1, pa0, pa1, pa2, pa3); pv_tile(o, 1, c, pa0, pa1, pa2, pa3); }
        const float gc = sigmoidf_(bf2f(PR[row * NSA_N + NGL + h * 3 + 0]));
        float fr[16]; row_factors(gc, fr, c);
#pragma unroll
        for (int d = 0; d < 4; ++d)
#pragma unroll
            for (int r = 0; r < 16; ++r) o[d][r] *= fr[r];
        store_o_bf16(o, OC + (rowb + qlo) * DM + h * HD, DM, c);
    }
    float Ie[16], Io[16];
    {
        float imp[16], Bb[16];
#pragma unroll
        for (int q = 0; q < 16; ++q) { float blo, bhi; swap_both(acc_l[(2 * q + 1) * 64], blo, bhi); Bb[q] = hi ? blo : bhi; }
#pragma unroll
        for (int q = 0; q < 16; ++q) imp[q] = acc_l[(2 * q) * 64] + (hi ? Bb[q] : (q > 0 ? Bb[q - 1] : 0.f));
#pragma unroll
        for (int q = 0; q < 16; ++q) swap_both(imp[q], Ie[q], Io[q]);
    }
    const int cur = qpos >> 6;
    unsigned bits;
    if (cur < 16) bits = (2u << cur) - 1u;
    else {
#pragma unroll
        for (int q = 0; q < 16; ++q) { const int je = 2 * q, jo = 2 * q + 1;
            if (!(je >= 1 && je <= cur - 2)) Ie[q] = -1.f; if (!(jo >= 1 && jo <= cur - 2)) Io[q] = -1.f; }
        bits = 0u;
#pragma unroll
        for (int q = 0; q < 16; ++q) {
            const int jm = 2 * q + hi; const float vj = hi ? Io[q] : Ie[q];
            int rank = 0;
#pragma unroll
            for (int q2 = 0; q2 < 16; ++q2) {
                const bool lt_e = (q2 < q) || (q2 == q && hi);
                const bool lt_o = (q2 < q);
                rank += (Ie[q2] > vj || (Ie[q2] == vj && lt_e)) ? 1 : 0;
                rank += (Io[q2] > vj || (Io[q2] == vj && lt_o)) ? 1 : 0;
            }
            const bool forced = (jm == 0) || (jm == cur) || (jm == cur - 1);
            const bool sel = forced || (vj >= 0.f && rank < 13);
            bits |= sel ? (1u << jm) : 0u;
        }
        { auto rr = __builtin_amdgcn_permlane32_swap(bits, bits, false, false); bits = rr[0] | rr[1]; }
    }
    if (hi == 0) WSP(unsigned, WS_SEL)[(size_t)(b * 2 + g) * SEQ + qpos] = bits;
    __syncthreads();
}
template <class PP> __device__ __forceinline__ void phase_attn_cmp(const PP& p, const Frame& F) {
    const ACtx c = make_actx(F.lds);
    constexpr int NCU = NB * NGRP * 8;
    for (int u = F.bid; u < NCU; u += F.G) { const int qt = 7 - (u % 8), bg = u / 8; cmp_unit(p, c, bg >> 1, bg & 1, qt); }
}
template <class PP> __device__ __forceinline__ void nsa_mem_units(const PP& p, const Frame& F, int L, int first) {
    const ACtx c = make_actx(F.lds);
    constexpr int NMU = NB * NMEMH * 8;
    for (int v = F.bid - first; v < NMU; v += F.G - first) { const int qt = v % 8, bh = v / 8; mem_unit(p, c, L, bh / NMEMH, bh % NMEMH, qt, NSA_N, NQM); }
}
template <class PP> __device__ __forceinline__ void selwin_unit(const PP& p, const ACtx& c, int b, int h, int qt, bf16_t* OUT) {
    const bf16_t* PR = WSP(bf16_t, WS_PROJ); const bf16_t* OC = WSP(bf16_t, WS_OCAT); const float* cosT = WSP(float, WS_COS); const float* sinT = WSP(float, WS_SIN);
    const int P0 = qt * 256, qlo = P0 + c.wid * 32, qpos = qlo + c.r32, g = h / HPG;
    const size_t rowb = (size_t)b * SEQ, row = rowb + qpos;
    bf16x8 qr[8]; load_q<true>(qr, PR + row * NSA_N + NQ + h * HD, cosT + row * 64, sinT + row * 64, c.hi);
    const unsigned selbits = WSP(unsigned, WS_SEL)[(size_t)(b * 2 + g) * SEQ + qpos];
    const float gs = sigmoidf_(bf2f(PR[row * NSA_N + NGL + h * 3 + 1])), gwn = sigmoidf_(bf2f(PR[row * NSA_N + NGL + h * 3 + 2]));
    f32x16 o[4]; float l;
    LAS unsigned* stash = (LAS unsigned*)(c.lds + A_STASH) + c.wid * 2048;
    softmax_sweep<2>(c, qr, o, l, PR + rowb * NSA_N + NKS + g * HD, PR + rowb * NSA_N + NVS + g * HD, NSA_N, 0, (P0 >> 6) + 4, qpos, qlo, selbits);
    {
        float fr[16]; row_factors(l > 0.f ? gs / l : 0.f, fr, c);
        const bf16_t* Ow = OC + (rowb + qlo) * DM + h * HD;
#pragma unroll
        for (int r = 0; r < 16; ++r) { const int orow = crow(r, c.hi);
#pragma unroll
            for (int d0 = 0; d0 < 4; ++d0) o[d0][r] = o[d0][r] * fr[r] + bf2f(Ow[(size_t)orow * DM + d0 * 32 + c.r32]); }
#pragma unroll
        for (int r = 0; r < 16; ++r)
#pragma unroll
            for (int d0 = 0; d0 < 4; d0 += 2) stash[((r * 2 + (d0 >> 1)) * 2 + c.hi) * 32 + c.r32] = cvtpk(o[d0][r], o[d0 + 1][r]);
    }
    const int jlo = (P0 - (WINDOW - 1)) > 0 ? ((P0 - (WINDOW - 1)) >> 6) : 0;
    softmax_sweep<1>(c, qr, o, l, PR + rowb * NSA_N + NKW + g * HD, PR + rowb * NSA_N + NVW + g * HD, NSA_N, jlo, (P0 >> 6) + 4, qpos, qlo, 0u);
    {
        float fr[16]; row_factors(l > 0.f ? gwn / l : 0.f, fr, c);
#pragma unroll
        for (int r = 0; r < 16; ++r)
#pragma unroll
            for (int d0 = 0; d0 < 4; d0 += 2) { const unsigned w = stash[((r * 2 + (d0 >> 1)) * 2 + c.hi) * 32 + c.r32];
                o[d0][r] = o[d0][r] * fr[r] + bflo(w); o[d0 + 1][r] = o[d0 + 1][r] * fr[r] + bfhi(w); }
    }
    store_o_bf16(o, OUT + (rowb + qlo) * DM + h * HD, DM, c);
}
template <class PP> __device__ __forceinline__ void phase_attn_selwin(const PP& p, const Frame& F, bf16_t* OUT) {
    const ACtx c = make_actx(F.lds);
    constexpr int NU = NB * NMIX * 8;
    for (int u = F.bid; u < NU; u += F.G) { const int qt = 7 - (u / (NB * NMIX)), bh = u % (NB * NMIX); selwin_unit(p, c, bh / NMIX, bh % NMIX, qt, OUT); }
}

#define LAST_() (rep_ == nrep_ - 1)
#ifndef PROBE_REPEAT
#define PROBE_REPEAT 0
#endif
constexpr int NPH_SB = 9, NPH_NSA = 13, NPH = 2 * (NPH_SB + NPH_NSA);
__global__ void __launch_bounds__(NTHR, 2) mk_fwd(Params p) {
    extern __shared__ __attribute__((aligned(16))) unsigned char lds_raw[];
    LAS unsigned char* const lds0 = (LAS unsigned char*)lds_raw;
typedef const Params __attribute__((address_space(4))) KParams;
#define MKFRAME() KParams* pp_ = (KParams*)__builtin_amdgcn_kernarg_segment_ptr(); asm volatile("" : "+s"(pp_)); KParams& p = *pp_; Frame F; F.lds = lds0; { int t_ = threadIdx.x; asm volatile("" : "+v"(t_)); F.tid = t_; } F.lane = F.tid & 63; F.wave = __builtin_amdgcn_readfirstlane(F.tid >> 6); F.G = gridDim.x; F.bid = blockIdx.x
    for (int u = threadIdx.x; u < (LDS_BYTES - LDSCTL_OFF) / 4; u += NTHR) ((LAS unsigned*)(lds0 + LDSCTL_OFF))[u] = 0u;
    __syncthreads();
    gu32* ctl = (gu32*)(p.ws + WS_CTL);
    XcdBarrier bar; bar.bar = (unsigned*)(ctl + CW_BAR); bar.x = 0; bar.st = nullptr;
#if !MK_PER_PHASE
    bar = xcd_barrier_post((unsigned*)(ctl + CW_BAR), (volatile LAS unsigned*)(lds0 + MISC_OFF) + 8);
#endif
    const int lo = p.ph_lo, hi = p.ph_hi;
    int ph = 0;
#define IN() (lo <= ph && ph < hi)
#if MK_PER_PHASE
#define END_PHASE() do { ++ph; } while (0)
#else
#define END_PHASE() do { if (IN() && ph + 1 < hi) { xcd_barrier(bar); if (PROBE_REPEAT & 256) xcd_barrier(bar); } ++ph; } while (0)
#endif
#define GEMM_RS(Aoff, Boff, M_, N_, K_, Ooff, ldc_, rs_) do { pg8::Gemm g{WSP(pg8::bf16_t, Aoff), WSP(pg8::bf16_t, Boff), M_, N_, K_}; pg8::StaticOrder S; S.init(M_, N_, F.G, F.bid); \
        pg8::EpiRS E{WSP(pg8::bf16_t, Ooff), ldc_, rs_}; pg8::gemm_phase<pg8::EpiRS, pg8::StaticOrder, true, true>(F.lds, g, S, E); } while (0)

#define GEMM_GU(L_) do { pg8::Gemm g{WSP(pg8::bf16_t, WS_XB), WSP(pg8::bf16_t, WS_WGU), MTOK, NGU, DM}; pg8::StaticOrder S; S.init(MTOK, NGU, F.G, F.bid); \
        pg8::EpiConv E{WSP(pg8::bf16_t, WS_ACT), WSP(float, WS_RSTD), p.conv_w + (size_t)(L_) * 3 * DFF, p.conv_b + (size_t)(L_) * DFF, WSP(float, WS_HG), WSP(float, WS_FP), WSP(float, WS_FU), (LAS float*)(F.lds + HALO_OFF), DFF}; \
        pg8::gemm_phase<pg8::EpiConv, pg8::StaticOrder, true, true>(F.lds, g, S, E); } while (0)

    for (int lp = 0; lp < 2; ++lp) {
        {
            const int L = 2 * lp;
            if (IN()) { MKFRAME(); for (int rep_ = 0, nrep_ = ((PROBE_REPEAT & 1) ? 2 : 1); rep_ < nrep_; ++rep_) { phase_convert(p, F, L); } }
            END_PHASE();
            if (IN()) { MKFRAME(); for (int rep_ = 0, nrep_ = ((PROBE_REPEAT & 2) ? 2 : 1); rep_ < nrep_; ++rep_) { GEMM_RS(WS_XB, WS_WIN, MTOK, SB_N, DM, WS_PROJ, SB_N, WSP(float, WS_RSTD));
                        if (L == 0) GEMM_RS(WS_MEMB, WS_WKV, NB * NMEM, 4096, DM, WS_MEMKV, 4096, WSP(float, WS_RSTD) + 16384); } }
            END_PHASE();
            if (IN()) { MKFRAME(); for (int rep_ = 0, nrep_ = ((PROBE_REPEAT & 4) ? 2 : 1); rep_ < nrep_; ++rep_) { phase_attn_sb(p, F, L); } }
            END_PHASE();
            if (IN()) { MKFRAME(); for (int rep_ = 0, nrep_ = ((PROBE_REPEAT & 2) ? 2 : 1); rep_ < nrep_; ++rep_) { GEMM_RS(WS_OCAT, WS_WO, MTOK, DM, DM, WS_TMP, DM, (const float*)nullptr); } }
            END_PHASE();
            if (IN()) { MKFRAME(); for (int rep_ = 0, nrep_ = ((PROBE_REPEAT & 8) ? 2 : 1); rep_ < nrep_; ++rep_) { phase_resid(p, F, (L == 0) ? p.x : (const float*)p.out, p.norm_g + (size_t)(L * 5 + 1) * DM, LAST_() ? p.out : WSP(float, WS_ACT), LAST_() ? WSP(bf16_t, WS_XB) : WSP(bf16_t, WS_PROJ), LAST_() ? WSP(float, WS_RSTD) : WSP(float, WS_FP)); } }
            END_PHASE();
            if (IN()) { MKFRAME(); for (int rep_ = 0, nrep_ = ((PROBE_REPEAT & 2) ? 2 : 1); rep_ < nrep_; ++rep_) { GEMM_GU(L); } }
            END_PHASE();
            if (IN()) { MKFRAME(); for (int rep_ = 0, nrep_ = ((PROBE_REPEAT & 16) ? 2 : 1); rep_ < nrep_; ++rep_) { phase_convfix(p, F, L); } }
            END_PHASE();
            if (IN()) { MKFRAME(); for (int rep_ = 0, nrep_ = ((PROBE_REPEAT & 2) ? 2 : 1); rep_ < nrep_; ++rep_) { GEMM_RS(WS_ACT, WS_WD, MTOK, DM, DFF, WS_TMP, DM, (const float*)nullptr); } }
            END_PHASE();
            if (IN()) { MKFRAME(); for (int rep_ = 0, nrep_ = ((PROBE_REPEAT & 8) ? 2 : 1); rep_ < nrep_; ++rep_) { phase_resid(p, F, (const float*)p.out, p.norm_g + (size_t)(L * 5 + 3) * DM, LAST_() ? p.out : WSP(float, WS_ACT), LAST_() ? WSP(bf16_t, WS_XB) : WSP(bf16_t, WS_PROJ), LAST_() ? WSP(float, WS_RSTD) : WSP(float, WS_FP)); } }
            END_PHASE();
        }
        {
            const int L = 2 * lp + 1;
            if (IN()) { MKFRAME(); for (int rep_ = 0, nrep_ = ((PROBE_REPEAT & 1) ? 2 : 1); rep_ < nrep_; ++rep_) { phase_convert(p, F, L); } }
            END_PHASE();
            if (IN()) { MKFRAME(); for (int rep_ = 0, nrep_ = ((PROBE_REPEAT & 2) ? 2 : 1); rep_ < nrep_; ++rep_) { GEMM_RS(WS_XB, WS_WIN, MTOK, NSA_N, DM, WS_PROJ, NSA_N, WSP(float, WS_RSTD)); } }
            END_PHASE();
            if (IN()) { MKFRAME(); phase_rope(p, F); }
            END_PHASE();
            if (IN()) { MKFRAME(); for (int rep_ = 0, nrep_ = ((PROBE_REPEAT & 32) ? 2 : 1); rep_ < nrep_; ++rep_) {
                if (F.bid < 16) { const int wh = F.bid >> 3;
                    pg8::Gemm g{WSP(pg8::bf16_t, WS_PROJ) + (wh ? NVC : NKC), WSP(pg8::bf16_t, WS_CW1) + (size_t)wh * 256 * 4096, 2048, 256, 4096, 16 * NSA_N, 256u, (unsigned)(NSA_N * 2), (size_t)SEQ * NSA_N * 2};
                    pg8::StaticOrder S; S.init(2048, 256, F.G, F.bid & 7);
                    pg8::EpiSiluBias E{WSP(pg8::bf16_t, WS_HID) + (size_t)wh * 2048 * 256, 256, WSP(float, WS_BIAS1) + wh * 256};
                    pg8::gemm_phase<pg8::EpiSiluBias, pg8::StaticOrder, true, true, true>(F.lds, g, S, E);
                } else nsa_mem_units(p, F, L, 16); } }
            END_PHASE();
            if (IN()) { MKFRAME(); phase_cmp_stage2(p, F); }
            END_PHASE();
            if (IN()) { MKFRAME(); for (int rep_ = 0, nrep_ = ((PROBE_REPEAT & 64) ? 2 : 1); rep_ < nrep_; ++rep_) { phase_attn_cmp(p, F); } }
            END_PHASE();
            if (IN()) { MKFRAME(); for (int rep_ = 0, nrep_ = ((PROBE_REPEAT & 128) ? 2 : 1); rep_ < nrep_; ++rep_) { phase_attn_selwin(p, F, LAST_() ? WSP(bf16_t, WS_OCAT) : WSP(bf16_t, WS_TMP)); } }
            END_PHASE();
            if (IN()) { MKFRAME(); for (int rep_ = 0, nrep_ = ((PROBE_REPEAT & 2) ? 2 : 1); rep_ < nrep_; ++rep_) { GEMM_RS(WS_OCAT, WS_WO, MTOK, DM, DM, WS_TMP, DM, (const float*)nullptr); } }
            END_PHASE();
            if (IN()) { MKFRAME(); for (int rep_ = 0, nrep_ = ((PROBE_REPEAT & 8) ? 2 : 1); rep_ < nrep_; ++rep_) { phase_resid(p, F, (const float*)p.out, p.norm_g + (size_t)(L * 5 + 1) * DM, LAST_() ? p.out : WSP(float, WS_ACT), LAST_() ? WSP(bf16_t, WS_XB) : WSP(bf16_t, WS_PROJ), LAST_() ? WSP(float, WS_RSTD) : WSP(float, WS_FP)); } }
            END_PHASE();
            if (IN()) { MKFRAME(); for (int rep_ = 0, nrep_ = ((PROBE_REPEAT & 2) ? 2 : 1); rep_ < nrep_; ++rep_) { GEMM_GU(L); } }
            END_PHASE();
            if (IN()) { MKFRAME(); for (int rep_ = 0, nrep_ = ((PROBE_REPEAT & 16) ? 2 : 1); rep_ < nrep_; ++rep_) { phase_convfix(p, F, L); } }
            END_PHASE();
            if (IN()) { MKFRAME(); for (int rep_ = 0, nrep_ = ((PROBE_REPEAT & 2) ? 2 : 1); rep_ < nrep_; ++rep_) { GEMM_RS(WS_ACT, WS_WD, MTOK, DM, DFF, WS_TMP, DM, (const float*)nullptr); } }
            END_PHASE();
            if (IN()) { MKFRAME(); for (int rep_ = 0, nrep_ = ((PROBE_REPEAT & 8) ? 2 : 1); rep_ < nrep_; ++rep_) { phase_resid(p, F, (const float*)p.out, p.norm_g + (size_t)(L * 5 + 3) * DM, LAST_() ? p.out : WSP(float, WS_ACT), LAST_() ? WSP(bf16_t, WS_XB) : WSP(bf16_t, WS_PROJ), LAST_() ? WSP(float, WS_RSTD) : WSP(float, WS_FP)); } }
            END_PHASE();
        }
    }
#undef IN
#undef END_PHASE
#undef GEMM_RS
#undef GEMM_GU
}

extern "C" void kernel_launch(void* const* d_in, const int* in_sizes, int n_in, void* d_out, int out_size, void* d_ws, size_t ws_size, hipStream_t stream) {
    static int grid = 0;
    if (grid == 0) {
        if (n_in != 16 || out_size != MTOK * DM || ws_size < WS_END) { fprintf(stderr, "kernel_launch: unexpected shapes (n_in %d, out %d, ws %zu < %zu)\n", n_in, out_size, ws_size, (size_t)WS_END); grid = -1; return; }
        int dev = 0, cus = 0, per_cu = 0;
        if (hipGetDevice(&dev) != hipSuccess || hipDeviceGetAttribute(&cus, hipDeviceAttributeMultiprocessorCount, dev) != hipSuccess) { grid = -1; return; }
        if (hipFuncSetAttribute((const void*)mk_fwd, hipFuncAttributeMaxDynamicSharedMemorySize, LDS_BYTES) != hipSuccess) { fprintf(stderr, "kernel_launch: hipFuncSetAttribute failed\n"); grid = -1; return; }
        if (hipOccupancyMaxActiveBlocksPerMultiprocessor(&per_cu, (const void*)mk_fwd, NTHR, LDS_BYTES) != hipSuccess || per_cu < 1) { fprintf(stderr, "kernel_launch: occupancy query says %d\n", per_cu); (void)hipGetLastError(); }
        grid = cus;
    }
    if (grid < 0) return;
    (void)hipMemsetAsync((char*)d_ws + WS_CTL, 0, CTL_ZERO_BYTES, stream);
    Params p{};
    p.x = (const float*)d_in[0]; p.mem = (const float*)d_in[1]; p.positions = (const int*)d_in[2]; p.norm_g = (const float*)d_in[3]; p.w_in_sb = (const float*)d_in[4]; p.w_in_nsa = (const float*)d_in[5];
    p.cmp_pe = (const float*)d_in[6]; p.cmp_w1 = (const float*)d_in[7]; p.cmp_w2 = (const float*)d_in[8]; p.w_mem_kv = (const float*)d_in[9]; p.w_o = (const float*)d_in[10];
    p.w_gate = (const float*)d_in[11]; p.w_up = (const float*)d_in[12]; p.conv_w = (const float*)d_in[13]; p.conv_b = (const float*)d_in[14]; p.w_down = (const float*)d_in[15];
    p.out = (float*)d_out; p.ws = (unsigned char*)d_ws;
#if MK_PER_PHASE
    for (int ph = 0; ph < NPH; ++ph) { p.ph_lo = ph; p.ph_hi = ph + 1; hipLaunchKernelGGL(mk_fwd, dim3(grid), dim3(NTHR), LDS_BYTES, stream, p); }
#else
    p.ph_lo = 0; p.ph_hi = NPH;
    hipLaunchKernelGGL(mk_fwd, dim3(grid), dim3(NTHR), LDS_BYTES, stream, p);
#endif
}
```

```cpp
#include <hip/hip_runtime.h>
#include <cstdio>
#include <cstdint>
namespace pg8 {
#define PG8_LAS __attribute__((address_space(3)))
typedef unsigned short bf16_t;
typedef short bf16x8 __attribute__((ext_vector_type(8)));
typedef float f32x4 __attribute__((ext_vector_type(4)));
typedef unsigned u32x4 __attribute__((ext_vector_type(4)));
constexpr int BM = 256, BK = 64, HALF = 128, HTB = HALF * BK * 2  , STAGE_BYTES = 8 * HTB, NXCD = 8, WGM = 8;

__host__ __device__ __forceinline__ int lds_byte(int r, int c) { const int st = (r >> 4) * 2 + (c >> 5), rr = r & 15, cc = c & 31, ob = rr * 64 + cc * 2; return st * 1024 + (ob ^ (((ob >> 9) & 1) << 5)); }
__host__ __device__ __forceinline__ void stage_rc(int b, int& R, int& C) { const int st = b / 1024, sb = b % 1024, swz = sb ^ (((sb >> 9) & 1) << 5); R = (st >> 1) * 16 + swz / 64; C = (st & 1) * 32 + (swz % 64) / 2; }
__host__ __device__ __forceinline__ int perm32(int rho) { const int n = rho >> 4, i = rho & 15; return 8 * (i >> 2) + 4 * n + (i & 3); }

struct Unit { int pm, pn; };
struct Gemm { const bf16_t* A; const bf16_t* Bt; int M, N, K; int lda; unsigned hstepA, kpairA; size_t tstepA; };

struct StaticOrder {
    int nM, nN, nwg, G, c;
    __host__ __device__ void init(int M, int N, int G_, int c_) { nM = M / BM; nN = N / BM; nwg = nM * nN; G = G_; c = c_; }
    __host__ __device__ bool next(int i, Unit& u) const {
        const long L = (long)i * G + c; if (L >= nwg) return false;
        int wgid = (int)L; { const int q = nwg / NXCD, r = nwg % NXCD, xcd = wgid % NXCD, off = wgid / NXCD; wgid = (xcd < r ? xcd * (q + 1) : r * (q + 1) + (xcd - r) * q) + off; }
        const int nig = WGM * nN, gid = wgid / nig, fm = gid * WGM, gsz = (nM - fm) < WGM ? (nM - fm) : WGM;
        u.pm = fm + ((wgid % nig) % gsz); u.pn = (wgid % nig) / gsz; return true;
    }
    __device__ __forceinline__ void a_ready(const Unit&) const {}
    __device__ __forceinline__ void done(const Unit&) const {}
};

__device__ __forceinline__ unsigned cvt_pk_bf16(float lo, float hi) { unsigned r; asm volatile("v_cvt_pk_bf16_f32 %0, %1, %2" : "=v"(r) : "v"(lo), "v"(hi)); return r; }
typedef float f32x2 __attribute__((ext_vector_type(2)));
struct EpiRS {
    static constexpr bool PERM = true, AFTER_DRAIN = false;
    bf16_t* O; int ldc; const float* rs;
    __device__ __forceinline__ void operator()(const f32x4 (&acc)[2][2][4][2], const Unit& u, int wr, int wc, int fr, int fq) const {
        const int row0 = u.pm * BM + wr * 64 + fr; const int col0 = u.pn * BM + wc * 32 + 8 * fq;
#pragma unroll
        for (int ai = 0; ai < 2; ++ai)
#pragma unroll
            for (int m = 0; m < 4; ++m) { const int row = row0 + ai * HALF + m * 16; const float sc = rs ? rs[row] : 1.f; bf16_t* rowp = O + (size_t)row * ldc + col0;
#pragma unroll
                for (int bj = 0; bj < 2; ++bj) { const f32x4 v0 = acc[ai][bj][m][0] * sc, v1 = acc[ai][bj][m][1] * sc;
                    u32x4 w; w.x = cvt_pk_bf16(v0[0], v0[1]); w.y = cvt_pk_bf16(v0[2], v0[3]); w.z = cvt_pk_bf16(v1[0], v1[1]); w.w = cvt_pk_bf16(v1[2], v1[3]);
                    *(u32x4*)(rowp + bj * HALF) = w; } }
    }
};
struct EpiConv {
    static constexpr bool PERM = true, AFTER_DRAIN = false;
    bf16_t* ACT; const float* rs; const float* cw; const float* cb; float* HG; float* FP; float* FU; PG8_LAS float* halo; int dff;
    __device__ __forceinline__ void operator()(const f32x4 (&acc)[2][2][4][2], const Unit& u, int wr, int wc, int fr, int fq) const {
        const int fl = wc * 32 + 8 * fq, f0 = u.pn * 128 + fl, lane = (int)(threadIdx.x & 63);
        const int src1 = (lane & 48) | ((fr + 15) & 15), src2 = (lane & 48) | ((fr + 14) & 15);
        f32x4 w0[2], w1[2], w2[2], bb[2];
#pragma unroll
        for (int n = 0; n < 2; ++n) { w0[n] = *(const f32x4*)(cw + f0 + 4 * n); w1[n] = *(const f32x4*)(cw + dff + f0 + 4 * n); w2[n] = *(const f32x4*)(cw + 2 * dff + f0 + 4 * n); bb[n] = *(const f32x4*)(cb + f0 + 4 * n); }
#pragma unroll
        for (int ai = 0; ai < 2; ++ai) { const float sc = rs[u.pm * BM + ai * HALF + wr * 64 + 48 + fr];
            if (fr >= 14) {
#pragma unroll
                for (int n = 0; n < 2; ++n) *(PG8_LAS f32x4*)(halo + ((ai * 2 + wr) * 2 + (fr - 14)) * 128 + fl + 4 * n) = acc[ai][0][3][n] * sc; } }
        asm volatile("s_waitcnt lgkmcnt(0)" ::: "memory"); __builtin_amdgcn_s_barrier(); asm volatile("" ::: "memory");
#pragma unroll
        for (int ai = 0; ai < 2; ++ai) {
            const int s = ai * 2 + wr;
            f32x4 a1p[2], a2p[2];
#pragma unroll
            for (int n = 0; n < 2; ++n) { f32x4 vp = {0.f, 0.f, 0.f, 0.f};
                if (s > 0 && fr >= 14) vp = *(const PG8_LAS f32x4*)(halo + ((s - 1) * 2 + (fr - 14)) * 128 + fl + 4 * n);
#pragma unroll
                for (int e = 0; e < 4; ++e) { a1p[n][e] = __shfl(vp[e], src1); a2p[n][e] = __shfl(vp[e], src2); } }
#pragma unroll
            for (int m = 0; m < 4; ++m) {
                const int row = u.pm * BM + ai * HALF + wr * 64 + m * 16 + fr; const float sc = rs[row];
                u32x4 wv; unsigned pk[4];
#pragma unroll
                for (int n = 0; n < 2; ++n) {
                    const f32x4 v = acc[ai][0][m][n] * sc, uu = acc[ai][1][m][n] * sc; f32x4 a1, a2, gc, ac;
#pragma unroll
                    for (int e = 0; e < 4; ++e) { a1[e] = __shfl(v[e], src1); a2[e] = __shfl(v[e], src2); }
#pragma unroll
                    for (int e = 0; e < 4; ++e) { const float p1 = (fr >= 1) ? a1[e] : a1p[n][e], p2 = (fr >= 2) ? a2[e] : a2p[n][e];
                        gc[e] = bb[n][e] + w0[n][e] * p2 + w1[n][e] * p1 + w2[n][e] * v[e];
                        ac[e] = gc[e] / (1.f + __builtin_amdgcn_exp2f(-gc[e] * 1.4426950408889634f)) * uu[e]; }
                    if (s == 0 && m == 0 && fr < 2) { *(f32x4*)(FP + (size_t)(u.pm * 2 + fr) * dff + f0 + 4 * n) = gc; *(f32x4*)(FU + (size_t)(u.pm * 2 + fr) * dff + f0 + 4 * n) = uu; }
                    if (s == 3 && m == 3 && fr >= 14) *(f32x4*)(HG + (size_t)(u.pm * 2 + fr - 14) * dff + f0 + 4 * n) = v;
                    pk[2 * n] = cvt_pk_bf16(ac[0], ac[1]); pk[2 * n + 1] = cvt_pk_bf16(ac[2], ac[3]);
                    a1p[n] = a1; a2p[n] = a2;
                }
                wv.x = pk[0]; wv.y = pk[1]; wv.z = pk[2]; wv.w = pk[3];
                *(u32x4*)(ACT + (size_t)row * dff + f0) = wv;
            }
        }
    }
};
struct EpiSiluBias {
    static constexpr bool PERM = true, AFTER_DRAIN = false;
    bf16_t* O; int ldc; const float* bias;
    __device__ __forceinline__ void operator()(const f32x4 (&acc)[2][2][4][2], const Unit& u, int wr, int wc, int fr, int fq) const {
        const int row0 = u.pm * BM + wr * 64 + fr; const int col0 = u.pn * BM + wc * 32 + 8 * fq;
        f32x4 bv[2][2];
#pragma unroll
        for (int bj = 0; bj < 2; ++bj)
#pragma unroll
            for (int n = 0; n < 2; ++n) bv[bj][n] = *(const f32x4*)(bias + col0 + bj * HALF + 4 * n);
#pragma unroll
        for (int ai = 0; ai < 2; ++ai)
#pragma unroll
            for (int m = 0; m < 4; ++m) { bf16_t* rowp = O + (size_t)(row0 + ai * HALF + m * 16) * ldc + col0;
#pragma unroll
                for (int bj = 0; bj < 2; ++bj) { f32x4 v0 = acc[ai][bj][m][0] + bv[bj][0], v1 = acc[ai][bj][m][1] + bv[bj][1];
#pragma unroll
                    for (int e = 0; e < 4; ++e) { v0[e] = v0[e] / (1.f + __builtin_amdgcn_exp2f(-v0[e] * 1.4426950408889634f)); v1[e] = v1[e] / (1.f + __builtin_amdgcn_exp2f(-v1[e] * 1.4426950408889634f)); }
                    u32x4 w; w.x = cvt_pk_bf16(v0[0], v0[1]); w.y = cvt_pk_bf16(v0[2], v0[3]); w.z = cvt_pk_bf16(v1[0], v1[1]); w.w = cvt_pk_bf16(v1[2], v1[3]);
                    *(u32x4*)(rowp + bj * HALF) = w; } }
    }
};
template <class Epi, class Sched, bool ALIGN_EPI = false, bool SP2 = false, bool AGEN = false>
__device__ __forceinline__ void gemm_phase(PG8_LAS unsigned char* lds, const Gemm g, const Sched& S, const Epi& E) {
    int tid_ = threadIdx.x; asm volatile("" : "+v"(tid_));
    const int tid = tid_, wid = __builtin_amdgcn_readfirstlane(tid >> 6), lane = tid & 63, wr = wid >> 2, wc = wid & 3, fr = lane & 15, fq = lane >> 4;
    const int K = g.K, nt = K / BK;
    unsigned voffA[2], voffB[2];
#pragma unroll
    for (int i = 0; i < 2; ++i) { int R, C; stage_rc(tid * 16 + i * 8192, R, C); const int Rb = Epi::PERM ? ((R & ~31) + perm32(R & 31)) : R;
        voffA[i] = (unsigned)(R * (AGEN ? g.lda : K) + C) * 2u; voffB[i] = (unsigned)(Rb * K + C) * 2u; }
    const size_t kstep = (size_t)(BK * 2);
    const size_t hstep = (size_t)HALF * K * 2;
    const size_t tstep = 2 * hstep;
    const size_t hstepA = AGEN ? (size_t)g.hstepA : hstep, tstepA = AGEN ? g.tstepA : tstep, kpairA = AGEN ? (size_t)g.kpairA : 2 * kstep;
    const unsigned ldsw = (unsigned)wid * 1024u;
    const int aoff = lds_byte(wr * 64 + fr, fq * 8), boff = lds_byte(wc * 32 + fr, fq * 8);
#define PG8_SA(b, h) (((b) * 2 + (h)) * HTB)
#define PG8_SB(b, h) ((4 + (b) * 2 + (h)) * HTB)
#define PG8_STAGE(bufoff, gbase, voff) do { _Pragma("unroll") for (int _i = 0; _i < 2; ++_i) \
        __builtin_amdgcn_global_load_lds((const unsigned*)((const char*)(gbase) + (voff)[_i]), (PG8_LAS unsigned*)(lds + (bufoff) + ldsw + _i * 8192), 16, 0, 0); } while (0)
#define PG8_LDA(dst, b, h) do { _Pragma("unroll") for (int m = 0; m < 4; ++m) _Pragma("unroll") for (int k = 0; k < 2; ++k) dst[m][k] = *(const PG8_LAS bf16x8*)(lds + PG8_SA(b, h) + aoff + m * 2048 + k * 1024); } while (0)
#define PG8_LDB(dst, b, h) do { _Pragma("unroll") for (int n = 0; n < 2; ++n) _Pragma("unroll") for (int k = 0; k < 2; ++k) dst[n][k] = *(const PG8_LAS bf16x8*)(lds + PG8_SB(b, h) + boff + n * 2048 + k * 1024); } while (0)
#define PG8_MMA(ai, bj, At, Bt) do { __builtin_amdgcn_s_setprio(1); _Pragma("unroll") for (int m = 0; m < 4; ++m) _Pragma("unroll") for (int n = 0; n < 2; ++n) _Pragma("unroll") for (int k = 0; k < 2; ++k) \
        acc[ai][bj][m][n] = __builtin_amdgcn_mfma_f32_16x16x32_bf16(Bt[n][k], At[m][k], acc[ai][bj][m][n], 0, 0, 0); __builtin_amdgcn_s_setprio(0); } while (0)
#define PG8_WAIT_V(n) asm volatile("s_waitcnt vmcnt(" #n ")" ::: "memory")
#define PG8_WAIT_L(n) asm volatile("s_waitcnt lgkmcnt(" #n ")" ::: "memory")
#define PG8_BAR __builtin_amdgcn_s_barrier()
#define PG8_SCHED __builtin_amdgcn_sched_barrier(0)
    Unit cur, nxt; int ui = 0;
    if (!S.next(0, cur)) return;
    f32x4 acc[2][2][4][2];
#pragma unroll
    for (int a = 0; a < 2; ++a)
#pragma unroll
        for (int b = 0; b < 2; ++b)
#pragma unroll
            for (int m = 0; m < 4; ++m)
#pragma unroll
                for (int n = 0; n < 2; ++n) acc[a][b][m][n] = (f32x4){0.f, 0.f, 0.f, 0.f};
    bf16x8 At[4][2], B0[2][2], B1[2][2];
    const char* cA = (const char*)g.A + (size_t)cur.pm * tstepA; const char* cB = (const char*)g.Bt + (size_t)cur.pn * tstep;
    S.a_ready(cur);
    if constexpr (SP2) {
        PG8_STAGE(PG8_SB(0, 0), cB, voffB); PG8_STAGE(PG8_SB(0, 1), cB + hstep, voffB); PG8_STAGE(PG8_SA(0, 0), cA, voffA); PG8_STAGE(PG8_SA(0, 1), cA + hstepA, voffA);
        if (wr == 1) PG8_BAR;
        PG8_WAIT_V(2); PG8_BAR;
        PG8_STAGE(PG8_SB(1, 0), cB + kstep, voffB); PG8_STAGE(PG8_SA(1, 0), cA + kstep, voffA); PG8_STAGE(PG8_SB(1, 1), cB + hstep + kstep, voffB);
        PG8_WAIT_V(6); PG8_BAR;
    } else {
        PG8_STAGE(PG8_SB(0, 0), cB, voffB); PG8_STAGE(PG8_SA(0, 0), cA, voffA); PG8_STAGE(PG8_SB(0, 1), cB + hstep, voffB); PG8_STAGE(PG8_SA(0, 1), cA + hstepA, voffA);
        if (wr == 1) PG8_BAR;
        PG8_WAIT_V(4); PG8_BAR;
        PG8_STAGE(PG8_SB(1, 0), cB + kstep, voffB); PG8_STAGE(PG8_SA(1, 0), cA + kstep, voffA); PG8_STAGE(PG8_SB(1, 1), cB + hstep + kstep, voffB);
        PG8_WAIT_V(6); PG8_BAR;
    }
    for (;;) {
        const bool has_next = S.next(ui + 1, nxt);
        const char* nA = has_next ? (const char*)g.A + (size_t)nxt.pm * tstepA : cA; const char* nB = has_next ? (const char*)g.Bt + (size_t)nxt.pn * tstep : cB;
        for (int t = 0; t < nt; t += 2) {
            const bool last = (t == nt - 2);
            const char* a1 = cA + (size_t)(t >> 1) * kpairA + kstep;
            const char* a2 = last ? nA : cA + (size_t)((t >> 1) + 1) * kpairA; const char* b2 = last ? nB : cB + (size_t)(t + 2) * kstep;
            const char* a3 = a2 + kstep; const char* b3 = b2 + kstep;
            if (last && has_next) S.a_ready(nxt);
            if constexpr (SP2) {
            PG8_LDB(B0, 0, 0); PG8_LDB(B1, 0, 1); PG8_SCHED; PG8_LDA(At, 0, 0); PG8_STAGE(PG8_SA(1, 1), a1 + hstepA, voffA);
            PG8_WAIT_V(8); PG8_WAIT_L(0); PG8_BAR; PG8_MMA(0, 0, At, B0); PG8_MMA(0, 1, At, B1); PG8_BAR; PG8_SCHED;
            PG8_LDA(At, 0, 1); PG8_STAGE(PG8_SB(0, 0), b2, voffB); PG8_STAGE(PG8_SB(0, 1), b2 + hstep, voffB); PG8_STAGE(PG8_SA(0, 0), a2, voffA);
            PG8_WAIT_V(8); PG8_WAIT_L(0); PG8_BAR; PG8_MMA(1, 0, At, B0); PG8_MMA(1, 1, At, B1); PG8_BAR; PG8_SCHED;
            PG8_LDB(B0, 1, 0); PG8_LDB(B1, 1, 1); PG8_SCHED; PG8_LDA(At, 1, 0); PG8_STAGE(PG8_SA(0, 1), a2 + hstepA, voffA);
            PG8_WAIT_V(8); PG8_WAIT_L(0); PG8_BAR; PG8_MMA(0, 0, At, B0); PG8_MMA(0, 1, At, B1); PG8_BAR; PG8_SCHED;
            PG8_LDA(At, 1, 1); PG8_STAGE(PG8_SB(1, 0), b3, voffB); PG8_STAGE(PG8_SB(1, 1), b3 + hstep, voffB); PG8_STAGE(PG8_SA(1, 0), a3, voffA);
            PG8_WAIT_V(8); PG8_WAIT_L(0); PG8_BAR; PG8_MMA(1, 0, At, B0); PG8_MMA(1, 1, At, B1); PG8_BAR; PG8_SCHED;
            } else {
            PG8_LDB(B0, 0, 0); PG8_SCHED; PG8_LDA(At, 0, 0); PG8_STAGE(PG8_SA(1, 1), a1 + hstepA, voffA);
            PG8_WAIT_L(8); PG8_BAR; PG8_WAIT_L(0); PG8_MMA(0, 0, At, B0); PG8_BAR; PG8_SCHED;
            PG8_LDB(B1, 0, 1); PG8_STAGE(PG8_SB(0, 0), b2, voffB);
            PG8_BAR; PG8_WAIT_L(0); PG8_MMA(0, 1, At, B1); PG8_BAR;
            PG8_LDA(At, 0, 1); PG8_STAGE(PG8_SA(0, 0), a2, voffA);
            PG8_BAR; PG8_WAIT_L(0); PG8_MMA(1, 0, At, B0); PG8_BAR; PG8_SCHED;
            PG8_STAGE(PG8_SB(0, 1), b2 + hstep, voffB);
            PG8_WAIT_V(6); PG8_BAR; PG8_MMA(1, 1, At, B1); PG8_BAR;
            PG8_LDB(B0, 1, 0); PG8_SCHED; PG8_LDA(At, 1, 0); PG8_STAGE(PG8_SA(0, 1), a2 + hstepA, voffA);
            PG8_WAIT_L(8); PG8_BAR; PG8_WAIT_L(0); PG8_MMA(0, 0, At, B0); PG8_BAR; PG8_SCHED;
            PG8_LDB(B1, 1, 1); PG8_STAGE(PG8_SB(1, 0), b3, voffB);
            PG8_BAR; PG8_WAIT_L(0); PG8_MMA(0, 1, At, B1); PG8_BAR;
            PG8_LDA(At, 1, 1); PG8_STAGE(PG8_SA(1, 0), a3, voffA);
            PG8_BAR; PG8_WAIT_L(0); PG8_MMA(1, 0, At, B0); PG8_BAR; PG8_SCHED;
            PG8_STAGE(PG8_SB(1, 1), b3 + hstep, voffB);
            PG8_WAIT_V(6); PG8_BAR; PG8_MMA(1, 1, At, B1); PG8_BAR;
            }
        }
        if constexpr (ALIGN_EPI) { if (wr == 0) PG8_BAR; }
        if constexpr (!Epi::AFTER_DRAIN) { E(acc, cur, wr, wc, fr, fq); S.done(cur); }
        if (!has_next) break;
#pragma unroll
        for (int a = 0; a < 2; ++a)
#pragma unroll
            for (int b = 0; b < 2; ++b)
#pragma unroll
                for (int m = 0; m < 4; ++m)
#pragma unroll
                    for (int n = 0; n < 2; ++n) acc[a][b][m][n] = (f32x4){0.f, 0.f, 0.f, 0.f};
        cur = nxt; cA = nA; cB = nB; ++ui;
        if constexpr (ALIGN_EPI) { if (wr == 1) PG8_BAR; }
    }
    PG8_WAIT_V(0);
    if constexpr (!ALIGN_EPI) { if (wr == 0) PG8_BAR; }
    PG8_BAR;
    if constexpr (Epi::AFTER_DRAIN) { E.fused(acc, cur, wr, wc, fr, fq, lds, wid, lane); S.done(cur); }
#undef PG8_SA
#undef PG8_SB
#undef PG8_STAGE
#undef PG8_LDA
#undef PG8_LDB
#undef PG8_MMA
#undef PG8_WAIT_V
#undef PG8_WAIT_L
#undef PG8_BAR
#undef PG8_SCHED
}
}

#ifndef MK_PER_PHASE
#define MK_PER_PHASE 0
#endif
constexpr int NB = 8, SEQ = 2048, DM = 2048, MTOK = NB * SEQ, DEPTH = 4, HD = 128;
constexpr int NMIX = 12, NMEMH = 4, NMEM = 256, DFF = 5632, NGU = 2 * DFF, NGRP = 2, HPG = 6;
constexpr int SB_N = 5120, NSA_N = 3840, NSA_SRC = 3620;
constexpr int SBQ = 0, SBK = 1536, SBV = 3072, SBQM = 4608;
constexpr int NQ = 0, NKC = 1536, NVC = 1792, NKS = 2048, NVS = 2304, NKW = 2560, NVW = 2816, NQM = 3072, NGL = 3584;
constexpr int NCMP = 127, CMPROWS = NB * NGRP * NCMP;
constexpr int WINDOW = 512;
constexpr float NORM_EPS = 1e-6f;
constexpr float SCALE = 0.08838834764831845f;
constexpr float LOG2E = 1.4426950408889634f;
constexpr int NWAVES = 8, NTHR = 512;

constexpr size_t MiB = 1u << 20;
constexpr size_t WS_CTL = 0, CTL_ZERO_BYTES = 1 * MiB;
constexpr size_t WS_WIN = 2 * MiB;
constexpr size_t WS_WO = 22 * MiB;
constexpr size_t WS_WGU = 30 * MiB;
constexpr size_t WS_WD = 74 * MiB;
constexpr size_t WS_WKV = 96 * MiB;
constexpr size_t WS_CW1 = 112 * MiB;
constexpr size_t WS_CW2 = 116 * MiB;
constexpr size_t WS_MEMB = 117 * MiB;
constexpr size_t WS_MEMKV = 125 * MiB;
constexpr size_t WS_COS = 141 * MiB, WS_SIN = 145 * MiB;
constexpr size_t WS_RSTD = 149 * MiB;
constexpr size_t WS_SEL = 150 * MiB;
constexpr size_t WS_KCMP = 151 * MiB;
constexpr size_t WS_XB = 152 * MiB;
constexpr size_t WS_TMP = 216 * MiB;
constexpr size_t WS_ACT = 280 * MiB;
constexpr size_t WS_GU = 456 * MiB;
constexpr size_t WS_PROJ = 456 * MiB;
constexpr size_t WS_OCAT = 616 * MiB;
constexpr size_t WS_HG = 680 * MiB, WS_FP = 684 * MiB, WS_FU = 688 * MiB;
constexpr size_t WS_HID = 692 * MiB;
constexpr size_t WS_BIAS1 = 694 * MiB;
constexpr size_t WS_END = 808 * MiB;
constexpr int CW_BAR = 4096;

constexpr int RING_BYTES = 131072;
constexpr int LDSCTL_OFF = 143360, MISC_OFF = LDSCTL_OFF + 320;
constexpr int LDS_BYTES = 147456;
constexpr int HALO_OFF = RING_BYTES;
constexpr int SHM_T = 16384;
constexpr int A_V = 0, A_K = 2 * SHM_T, A_WS = 4 * SHM_T, A_FLAGS = A_WS + NWAVES * 64 * 4, A_STASH = 67584;

#define GAS __attribute__((address_space(1)))
#define LAS __attribute__((address_space(3)))
typedef unsigned short bf16_t;
typedef unsigned v4u __attribute__((ext_vector_type(4)));
typedef unsigned v2u __attribute__((ext_vector_type(2)));
typedef float f32x4 __attribute__((ext_vector_type(4)));
typedef float f32x16 __attribute__((ext_vector_type(16)));
typedef short bf16x8 __attribute__((ext_vector_type(8)));
typedef short s16x4 __attribute__((ext_vector_type(4)));
typedef GAS unsigned gu32;
#define RLX_AGENT __ATOMIC_RELAXED, __HIP_MEMORY_SCOPE_AGENT
#define LDS_WAIT() asm volatile("s_waitcnt lgkmcnt(0)" ::: "memory")
#define VM_WAIT() asm volatile("s_waitcnt vmcnt(0)" ::: "memory")
#define SBAR() __builtin_amdgcn_sched_barrier(0)
__device__ __forceinline__ unsigned cvtpk(float lo, float hi) { unsigned r; asm volatile("v_cvt_pk_bf16_f32 %0, %1, %2" : "=v"(r) : "v"(lo), "v"(hi)); return r; }
__device__ __forceinline__ float bf2f(unsigned short b) { return __uint_as_float((unsigned)b << 16); }
__device__ __forceinline__ float bflo(unsigned w) { return __uint_as_float(w << 16); }
__device__ __forceinline__ float bfhi(unsigned w) { return __uint_as_float(w & 0xffff0000u); }
__device__ __forceinline__ bf16x8 pack8(f32x4 a, f32x4 b) { v4u w = {cvtpk(a[0], a[1]), cvtpk(a[2], a[3]), cvtpk(b[0], b[1]), cvtpk(b[2], b[3])}; return __builtin_bit_cast(bf16x8, w); }
__device__ __forceinline__ void unpack8(bf16x8 v, f32x4& a, f32x4& b) { const v4u w = __builtin_bit_cast(v4u, v); a = (f32x4){bflo(w.x), bfhi(w.x), bflo(w.y), bfhi(w.y)}; b = (f32x4){bflo(w.z), bfhi(w.z), bflo(w.w), bfhi(w.w)}; }
__device__ __forceinline__ float wave_sum(float v) {
#pragma unroll
    for (int o = 1; o < 64; o <<= 1) v += __shfl_xor(v, o);
    return v;
}
__device__ __forceinline__ float sigmoidf_(float x) { return 1.f / (1.f + __builtin_amdgcn_exp2f(-x * LOG2E)); }

__device__ const float INV_FREQ[64] = {1.000000000e+00f, 8.659643531e-01f, 7.498942018e-01f, 6.493816376e-01f, 5.623413324e-01f, 4.869675338e-01f, 4.216965139e-01f, 3.651741147e-01f, 3.162277639e-01f, 2.738419771e-01f, 2.371373773e-01f, 2.053525001e-01f, 1.778279394e-01f, 1.539926529e-01f, 1.333521456e-01f, 1.154781953e-01f, 1.000000015e-01f, 8.659642935e-02f, 7.498942316e-02f, 6.493816525e-02f, 5.623413250e-02f, 4.869675264e-02f, 4.216964915e-02f, 3.651741147e-02f, 3.162277490e-02f, 2.738419548e-02f, 2.371373773e-02f, 2.053525113e-02f, 1.778279431e-02f, 1.539926510e-02f, 1.333521400e-02f, 1.154781971e-02f, 9.999999776e-03f, 8.659643121e-03f, 7.498942316e-03f, 6.493816152e-03f, 5.623413250e-03f, 4.869675264e-03f, 4.216964822e-03f, 3.651741194e-03f, 3.162277630e-03f, 2.738419687e-03f, 2.371373819e-03f, 2.053525066e-03f, 1.778279431e-03f, 1.539926510e-03f, 1.333521446e-03f, 1.154782018e-03f, 1.000000047e-03f, 8.659643354e-04f, 7.498941850e-04f, 6.493816036e-04f, 5.623413017e-04f, 4.869675322e-04f, 4.216965172e-04f, 3.651741135e-04f, 3.162277571e-04f, 2.738419571e-04f, 2.371373703e-04f, 2.053525095e-04f, 1.778279402e-04f, 1.539926598e-04f, 1.333521504e-04f, 1.154782003e-04f};
#define XB_TMO      128
#define XB_XCNT(j)  (256  + 64 * (j))
#define XB_XSUB(j)  (1280 + 64 * (j))
#define XB_XGEN(j)  (2304 + 64 * (j))
#define XB_TOP      3328
#define XB_TOPGEN   3392
#define XCD_BAR_WORDS 3456
#define XB_SPIN_CAP (1u << 18)

__device__ __forceinline__ unsigned xb_ld(unsigned* p)              { return __hip_atomic_load(p, __ATOMIC_RELAXED, __HIP_MEMORY_SCOPE_AGENT); }
__device__ __forceinline__ unsigned xb_add(unsigned* p, unsigned v) { return __hip_atomic_fetch_add(p, v, __ATOMIC_RELAXED, __HIP_MEMORY_SCOPE_AGENT); }
__device__ __forceinline__ unsigned xb_xcc_id() { return (unsigned)__builtin_amdgcn_s_getreg((3 << 11) | 20) & 0xFu; }
#define XB_SPIN(cond, bar) do { unsigned _sp = 0; while (cond) { __builtin_amdgcn_s_sleep(1); \
    if ((++_sp & 255u) == 0u) { if (xb_ld(&(bar)[XB_TMO])) break; if (_sp > XB_SPIN_CAP) { atomicAdd(&(bar)[XB_TMO], 1u); break; } } } } while (0)

struct XcdBarrier {
    unsigned* bar; unsigned x;
    volatile LAS unsigned* st;
};

__device__ __forceinline__ XcdBarrier xcd_barrier_post(unsigned* bar, volatile LAS unsigned* st) {
    XcdBarrier b; b.bar = bar; b.x = xb_xcc_id(); b.st = st;
    if (threadIdx.x == 0) (void)xb_add(&bar[XB_XCNT(b.x)], 1u);
    return b;
}
__device__ __forceinline__ void xcd_barrier_complete(unsigned* bar, unsigned x, unsigned& nloc, unsigned& nx) {
    const unsigned G = gridDim.x * gridDim.y * gridDim.z;
    unsigned sum, cnt, mine, sp = 0u;
    for (;;) {
        sum = 0u; cnt = 0u; mine = 0u;
#pragma unroll
        for (unsigned j = 0; j < 16; ++j) { const unsigned c = xb_ld(&bar[XB_XCNT(j)]); sum += c; cnt += (c > 0u) ? 1u : 0u; mine = (j == x) ? c : mine; }
        if (sum == G) break;
        __builtin_amdgcn_s_sleep(1);
        if ((++sp & 255u) == 0u) { if (xb_ld(&bar[XB_TMO])) break; if (sp > XB_SPIN_CAP) { atomicAdd(&bar[XB_TMO], 1u); break; } }
    }
    nloc = mine > 0u ? mine : 1u; nx = cnt > 0u ? cnt : 1u;
}

__device__ __forceinline__ void xcd_barrier(const XcdBarrier& b) {
    asm volatile("s_waitcnt vmcnt(0)" ::: "memory");
    __syncthreads();
    if (threadIdx.x == 0) {
        unsigned* bar = b.bar;
        __builtin_amdgcn_s_waitcnt(0);
        unsigned nloc = b.st[0], nx = b.st[1];
        if (nloc == 0u) { xcd_barrier_complete(bar, b.x, nloc, nx); b.st[0] = nloc; b.st[1] = nx; }
        const unsigned old = xb_add(&bar[XB_XSUB(b.x)], 1u);
        const unsigned gen = old / nloc;
        if (old + 1u == (gen + 1u) * nloc) {
            __builtin_amdgcn_fence(__ATOMIC_RELEASE, "agent");
            asm volatile("s_waitcnt vmcnt(0)" ::: "memory");
            const unsigned og = xb_add(&bar[XB_TOP], 1u);
            const unsigned tg = og / nx;
            if (og + 1u == (tg + 1u) * nx) xb_add(&bar[XB_TOPGEN], 1u);
            else XB_SPIN(xb_ld(&bar[XB_TOPGEN]) == tg, bar);
            __builtin_amdgcn_fence(__ATOMIC_ACQUIRE, "agent");
            xb_add(&bar[XB_XGEN(b.x)], 1u);
            asm volatile("s_waitcnt vmcnt(0)" ::: "memory");
        } else {
            XB_SPIN(xb_ld(&bar[XB_XGEN(b.x)]) == gen, bar);
            __builtin_amdgcn_fence(__ATOMIC_ACQUIRE, "agent");
            asm volatile("s_waitcnt vmcnt(0)" ::: "memory");
        }
    }
    __syncthreads();
}

#define KSWZ(row, colB) ((row) * 256 + ((colB) ^ (((row) & 7) << 4)))
__device__ __forceinline__ int v_st(int k, int c) { const int kk = (k & ~0xC) | ((k & 4) << 1) | ((k & 8) >> 1); return ((kk >> 3) * 4 + (c >> 5)) * 512 + ((kk & 7) * 32 + (c & 31)) * 2; }
__device__ __forceinline__ int v_rd_base(int lane) { return ((lane & 3) << 3) | (((lane >> 2) & 3) << 6) | (((lane >> 4) & 1) << 5) | (((lane >> 5) & 1) << 8); }
constexpr int v_rd_off(int d0, int ks, int half) { return d0 * 512 + ks * 4096 + half * 2048; }
__device__ __forceinline__ int crow(int r, int hi) { return (r & 3) + 8 * (r >> 2) + 4 * hi; }

struct ACtx {
    LAS unsigned char* lds;
    int tid, wid, lane, r32, hi, sr, sc, kws, vst0, vst1, vb0;
    LAS float* ws;
};
__device__ __forceinline__ ACtx make_actx(LAS unsigned char* lds) {
    ACtx c; c.lds = lds; { int t_ = threadIdx.x; asm volatile("" : "+v"(t_)); c.tid = t_; } c.wid = __builtin_amdgcn_readfirstlane(c.tid >> 6); c.lane = c.tid & 63; c.r32 = c.lane & 31; c.hi = c.lane >> 5;
    c.sr = c.tid >> 4; c.sc = (c.tid & 15) * 8; c.kws = KSWZ(c.sr, c.sc * 2); c.vst0 = v_st(c.sr, c.sc); c.vst1 = v_st(32 + c.sr, c.sc);
    c.vb0 = (int)(unsigned)(size_t)(lds + A_V) + v_rd_base(c.lane);
    c.ws = (LAS float*)(lds + A_WS) + c.wid * 64;
    return c;
}
struct Stage { bf16x8 k0, k1, v0, v1; };
__device__ __forceinline__ void stage_load(Stage& S, const bf16_t* Kp, const bf16_t* Vp, int pitch, int kb, const ACtx& c) {
    S.v0 = *(const bf16x8*)(Vp + (size_t)(kb + c.sr) * pitch + c.sc); S.v1 = *(const bf16x8*)(Vp + (size_t)(kb + 32 + c.sr) * pitch + c.sc);
    S.k0 = *(const bf16x8*)(Kp + (size_t)(kb + c.sr) * pitch + c.sc); S.k1 = *(const bf16x8*)(Kp + (size_t)(kb + 32 + c.sr) * pitch + c.sc);
}
__device__ __forceinline__ void stage_write(const Stage& S, int buf, const ACtx& c) {
    LAS unsigned char* Kb = c.lds + A_K + buf * SHM_T; LAS unsigned char* Vb = c.lds + A_V + buf * SHM_T;
    *(LAS bf16x8*)(Kb + c.kws) = S.k0; *(LAS bf16x8*)(Kb + c.kws + 32 * 256) = S.k1;
    *(LAS bf16x8*)(Vb + c.vst0) = S.v0; *(LAS bf16x8*)(Vb + c.vst1) = S.v1;
}
__device__ __forceinline__ void qkt(f32x16& p0, f32x16& p1, int buf, const ACtx& c, const bf16x8* qr) {
    p0 = (f32x16){}; p1 = (f32x16){};
    const LAS unsigned char* Kb = c.lds + A_K + buf * SHM_T;
    const LAS unsigned char* kb[4];
#pragma unroll
    for (int dd = 0; dd < 4; ++dd) kb[dd] = Kb + KSWZ(c.r32, (dd * 16 + c.hi * 8) * 2);
#pragma unroll
    for (int d0 = 0; d0 < 8; ++d0) { const LAS unsigned char* a = kb[d0 & 3] + (d0 >> 2) * 128;
        const bf16x8 b0 = *(const LAS bf16x8*)a; const bf16x8 b1 = *(const LAS bf16x8*)(a + 32 * 256);
        p0 = __builtin_amdgcn_mfma_f32_32x32x16_bf16(b0, qr[d0], p0, 0, 0, 0);
        p1 = __builtin_amdgcn_mfma_f32_32x32x16_bf16(b1, qr[d0], p1, 0, 0, 0); }
}
__device__ __forceinline__ void pv_tile(f32x16* o, int buf, const ACtx& c, bf16x8 pa0, bf16x8 pa1, bf16x8 pa2, bf16x8 pa3) {
    const int vb = c.vb0 + buf * SHM_T;
#define TRRD(dst, off) asm volatile("ds_read_b64_tr_b16 %0, %1 offset:%2" : "=&v"(dst) : "v"(vb), "i"(off) : "memory")
#define PV_D0(d0) do { s16x4 l0, l1, l2, l3, h0, h1, h2, h3; constexpr int b_ = v_rd_off(d0, 0, 0); \
        TRRD(l0, b_); TRRD(h0, b_ + 2048); TRRD(l1, b_ + 4096); TRRD(h1, b_ + 6144); TRRD(l2, b_ + 8192); TRRD(h2, b_ + 10240); TRRD(l3, b_ + 12288); TRRD(h3, b_ + 14336); \
        asm volatile("s_waitcnt lgkmcnt(0)" ::: "memory"); SBAR(); \
        o[d0] = __builtin_amdgcn_mfma_f32_32x32x16_bf16(pa0, (bf16x8){l0[0], l0[1], l0[2], l0[3], h0[0], h0[1], h0[2], h0[3]}, o[d0], 0, 0, 0); \
        o[d0] = __builtin_amdgcn_mfma_f32_32x32x16_bf16(pa1, (bf16x8){l1[0], l1[1], l1[2], l1[3], h1[0], h1[1], h1[2], h1[3]}, o[d0], 0, 0, 0); \
        o[d0] = __builtin_amdgcn_mfma_f32_32x32x16_bf16(pa2, (bf16x8){l2[0], l2[1], l2[2], l2[3], h2[0], h2[1], h2[2], h2[3]}, o[d0], 0, 0, 0); \
        o[d0] = __builtin_amdgcn_mfma_f32_32x32x16_bf16(pa3, (bf16x8){l3[0], l3[1], l3[2], l3[3], h3[0], h3[1], h3[2], h3[3]}, o[d0], 0, 0, 0); } while (0)
    PV_D0(0); PV_D0(1); PV_D0(2); PV_D0(3);
#undef PV_D0
#undef TRRD
}
__device__ __forceinline__ float swap_max(float v) { auto rr = __builtin_amdgcn_permlane32_swap(__float_as_uint(v), __float_as_uint(v), false, false); return fmaxf(__uint_as_float(rr[0]), __uint_as_float(rr[1])); }
__device__ __forceinline__ float swap_sum(float v) { auto rr = __builtin_amdgcn_permlane32_swap(__float_as_uint(v), __float_as_uint(v), false, false); return __uint_as_float(rr[0]) + __uint_as_float(rr[1]); }
__device__ __forceinline__ void swap_both(float v, float& lo, float& hi) { auto rr = __builtin_amdgcn_permlane32_swap(__float_as_uint(v), __float_as_uint(v), false, false); lo = __uint_as_float(rr[0]); hi = __uint_as_float(rr[1]); }
__device__ __forceinline__ void pack_p(const f32x16& p0, const f32x16& p1, bf16x8& pa0, bf16x8& pa1, bf16x8& pa2, bf16x8& pa3) {
#define PK4(P, B_, OUT) do { unsigned a0 = cvtpk(P[B_+0], P[B_+1]), a1 = cvtpk(P[B_+2], P[B_+3]); \
        unsigned b0 = cvtpk(P[B_+4], P[B_+5]), b1 = cvtpk(P[B_+6], P[B_+7]); \
        auto r0 = __builtin_amdgcn_permlane32_swap(a0, b0, false, false); auto r1 = __builtin_amdgcn_permlane32_swap(a1, b1, false, false); \
        v4u w = {r0[0], r1[0], r0[1], r1[1]}; OUT = __builtin_bit_cast(bf16x8, w); } while (0)
    PK4(p0, 0, pa0); PK4(p0, 8, pa1); PK4(p1, 0, pa2); PK4(p1, 8, pa3);
#undef PK4
}
__device__ __forceinline__ void mask_tile(f32x16& p0, f32x16& p1, int dq, unsigned W) {
    const float NEG = -__builtin_inff();
#pragma unroll
    for (int r = 0; r < 16; ++r) { const int cc = (r & 3) + 8 * (r >> 2);
        if ((unsigned)(dq - cc) >= W) p0[r] = NEG;
        if ((unsigned)(dq - cc - 32) >= W) p1[r] = NEG; }
}
constexpr float THR = 8.f;
__device__ __forceinline__ void softmax_tile(f32x16& p0, f32x16& p1, float& m_reg, float& l_reg, f32x16* o, const ACtx& c) {
    float pmax = p0[0];
#pragma unroll
    for (int r = 1; r < 16; ++r) pmax = fmaxf(pmax, p0[r]);
#pragma unroll
    for (int r = 0; r < 16; ++r) pmax = fmaxf(pmax, p1[r]);
    pmax = swap_max(pmax);
    constexpr float C2 = LOG2E * SCALE;
    float mn, alpha;
    if (__all((pmax - m_reg) * SCALE <= THR)) { mn = m_reg; alpha = 1.f; }
    else { mn = fmaxf(m_reg, pmax); alpha = __builtin_amdgcn_exp2f((m_reg - mn) * C2); m_reg = mn; }
    const float mnL = -mn * C2;
#pragma unroll
    for (int r = 0; r < 16; ++r) { p0[r] = __builtin_amdgcn_exp2f(fmaf(p0[r], C2, mnL)); p1[r] = __builtin_amdgcn_exp2f(fmaf(p1[r], C2, mnL)); }
    float ps = 0.f;
#pragma unroll
    for (int r = 0; r < 16; ++r) ps += p0[r] + p1[r];
    ps = swap_sum(ps);
    l_reg = l_reg * alpha + ps;
    if (__any(alpha < 1.f)) {
        if (c.hi == 0) c.ws[32 + c.r32] = alpha;
        LDS_WAIT();
#pragma unroll
        for (int r = 0; r < 16; ++r) { const float a = c.ws[32 + crow(r, c.hi)];
#pragma unroll
            for (int d = 0; d < 4; ++d) o[d][r] *= a; }
    }
}
__device__ __forceinline__ void row_factors(float f, float (&fr)[16], const ACtx& c) {
    LDS_WAIT();
    if (c.hi == 0) c.ws[c.r32] = f;
    LDS_WAIT();
#pragma unroll
    for (int r = 0; r < 16; ++r) fr[r] = c.ws[crow(r, c.hi)];
    LDS_WAIT();
}
template <bool ROPE>
__device__ __forceinline__ void load_q(bf16x8 (&qr)[8], const bf16_t* qrow, const float* cosr, const float* sinr, int hi) {
#pragma unroll
    for (int d0 = 0; d0 < 8; ++d0) qr[d0] = *(const bf16x8*)(qrow + d0 * 16 + hi * 8);
    if constexpr (ROPE) {
#pragma unroll
        for (int d0 = 0; d0 < 4; ++d0) {
            const int i0 = d0 * 16 + hi * 8;
            const f32x4 c0 = *(const f32x4*)(cosr + i0), c1 = *(const f32x4*)(cosr + i0 + 4), s0 = *(const f32x4*)(sinr + i0), s1 = *(const f32x4*)(sinr + i0 + 4);
            f32x4 a0, a1, b0, b1; unpack8(qr[d0], a0, a1); unpack8(qr[d0 + 4], b0, b1);
            qr[d0] = pack8(a0 * c0 - b0 * s0, a1 * c1 - b1 * s1);
            qr[d0 + 4] = pack8(b0 * c0 + a0 * s0, b1 * c1 + a1 * s1);
        }
    }
}
__device__ __forceinline__ void store_o_bf16(const f32x16* o, bf16_t* Ow  , int pitch, const ACtx& c) {
#pragma unroll
    for (int r = 0; r < 16; ++r) { const int orow = crow(r, c.hi);
#pragma unroll
        for (int d0 = 0; d0 < 4; ++d0) { const float v = o[d0][r]; const float vn = __shfl_xor(v, 1);
            if ((c.r32 & 1) == 0) *(unsigned*)(Ow + (size_t)orow * pitch + d0 * 32 + c.r32) = cvtpk(v, vn); } }
}

__device__ __forceinline__ void add_o_bf16(f32x16* o, const bf16_t* Ow, int pitch, const ACtx& c) {
#pragma unroll
    for (int r = 0; r < 16; ++r) { const int orow = crow(r, c.hi);
#pragma unroll
        for (int d0 = 0; d0 < 4; ++d0) o[d0][r] += bf2f(Ow[(size_t)orow * pitch + d0 * 32 + c.r32]); }
}
__device__ __forceinline__ int wq_next(gu32* ctr, LAS int* slot, int tid) {
    __syncthreads();
    if (tid == 0) *slot = (int)__hip_atomic_fetch_add(ctr, 1u, RLX_AGENT);
    __syncthreads();
    return *slot;
}
template <int MODE>
__device__ __forceinline__ void softmax_sweep(const ACtx& c, const bf16x8 (&qr)[8], f32x16 (&o)[4], float& l_out, const bf16_t* Kp, const bf16_t* Vp, int pitch,
                                              int j_lo, int j_hi, int qpos, int qlo, unsigned selbits) {
    float m_reg = -1e30f, l_reg = 0.f;
#pragma unroll
    for (int d = 0; d < 4; ++d) o[d] = (f32x16){};
    Stage S; stage_load(S, Kp, Vp, pitch, j_lo * 64, c);
    for (int j = j_lo; j < j_hi; ++j) {
        const int buf = (j - j_lo) & 1;
        stage_write(S, buf, c);
        __syncthreads();
        if (j + 1 < j_hi) stage_load(S, Kp, Vp, pitch, (j + 1) * 64, c);
        const int kb = j * 64;
        bool act = true;
        if (MODE == 1) act = (kb <= qlo + 31) && (kb + 63 >= qlo - (WINDOW - 1));
        if (MODE == 2) act = (kb <= qlo + 31) && __any((int)((selbits >> j) & 1u));
        if (act) {
            f32x16 p0, p1; qkt(p0, p1, buf, c, qr);
            if (MODE == 1) { if (kb + 63 > qlo || kb < qlo + 31 - (WINDOW - 1)) mask_tile(p0, p1, qpos - kb - 4 * c.hi, (unsigned)WINDOW); }
            if (MODE == 2) { if (kb + 63 > qlo) mask_tile(p0, p1, qpos - kb - 4 * c.hi, 0x7fffffffu);
                if (!__all((int)((selbits >> j) & 1u))) { if (!((selbits >> j) & 1u)) { const float NEG = -__builtin_inff();
#pragma unroll
                    for (int r = 0; r < 16; ++r) { p0[r] = NEG; p1[r] = NEG; } } } }
            softmax_tile(p0, p1, m_reg, l_reg, o, c);
            bf16x8 pa0, pa1, pa2, pa3; pack_p(p0, p1, pa0, pa1, pa2, pa3);
            pv_tile(o, buf, c, pa0, pa1, pa2, pa3);
        }
    }
    __syncthreads();
    l_out = l_reg;
}

struct Params {
    const float* x; const float* mem; const int* positions; const float* norm_g; const float* w_in_sb; const float* w_in_nsa; const float* cmp_pe; const float* cmp_w1; const float* cmp_w2;
    const float* w_mem_kv; const float* w_o; const float* w_gate; const float* w_up; const float* conv_w; const float* conv_b; const float* w_down;
    float* out; unsigned char* ws; int ph_lo, ph_hi;
};
struct Frame {
    LAS unsigned char* lds; int tid, lane, wave, G, bid;
};
#define WSP(T, off) ((T*)(p.ws + (off)))

__device__ __forceinline__ void tr_item(const float* W, int K, int Nsrc, int src_col0, int ncols, const float* gain, bf16_t* WT, int dst_row0, int mode, int item, int lane) {
    const int nblk = (ncols + 255) >> 8, kb = item / nblk, nb = item - kb * nblk, k0 = 16 * kb, n = nb * 256 + 4 * lane;
    if (n >= ncols) return;
    f32x4 v[16];
    if (W != nullptr) {
        const float* src = W + (size_t)k0 * Nsrc + src_col0 + n;
#pragma unroll
        for (int j = 0; j < 16; ++j) v[j] = *(const f32x4*)(src + (size_t)j * Nsrc);
        if (gain) {
#pragma unroll
            for (int j = 0; j < 16; ++j) v[j] = v[j] * gain[k0 + j];
        }
    } else {
#pragma unroll
        for (int j = 0; j < 16; ++j) v[j] = (f32x4){0.f, 0.f, 0.f, 0.f};
    }
#pragma unroll
    for (int e = 0; e < 4; ++e) {
        const int nn = n + e; const int drow = dst_row0 + (mode == 0 ? nn : 256 * (nn >> 7) + (nn & 127));
        v4u o0, o1;
        o0.x = cvtpk(v[0][e], v[1][e]); o0.y = cvtpk(v[2][e], v[3][e]); o0.z = cvtpk(v[4][e], v[5][e]); o0.w = cvtpk(v[6][e], v[7][e]);
        o1.x = cvtpk(v[8][e], v[9][e]); o1.y = cvtpk(v[10][e], v[11][e]); o1.z = cvtpk(v[12][e], v[13][e]); o1.w = cvtpk(v[14][e], v[15][e]);
        v4u* dst = (v4u*)(WT + (size_t)drow * K + k0); dst[0] = o0; dst[1] = o1;
    }
}
__device__ __forceinline__ void row_to_bf16_rstd(const float* xrow, bf16_t* orow, float* rstd_out, int lane) {
    const f32x4* xr = (const f32x4*)xrow + lane; f32x4 v[8]; float s = 0.f;
#pragma unroll
    for (int j = 0; j < 8; ++j) { v[j] = xr[64 * j]; s += (v[j].x * v[j].x + v[j].y * v[j].y) + (v[j].z * v[j].z + v[j].w * v[j].w); }
    s = wave_sum(s);
    v2u* o8 = (v2u*)orow + lane;
#pragma unroll
    for (int j = 0; j < 8; ++j) { v2u w; w.x = cvtpk(v[j].x, v[j].y); w.y = cvtpk(v[j].z, v[j].w); o8[64 * j] = w; }
    if (lane == 0) *rstd_out = 1.0f / sqrtf(s * (1.0f / DM) + NORM_EPS);
}
template <class PP> __device__ __forceinline__ void phase_convert(const PP& p, const Frame& F, int L) {
    const int gw = F.bid * NWAVES + F.wave, NGW = F.G * NWAVES;
    int it0 = gw;
#define TR(W, K, Nsrc, sc0, nc, gain, WT, dr0, mode) do { const int n_ = ((K) / 16) * (((nc) + 255) >> 8); for (; it0 < n_; it0 += NGW) tr_item(W, K, Nsrc, sc0, nc, gain, WT, dr0, mode, it0, F.lane); it0 -= n_; } while (0)
    const float* g = p.norm_g + (size_t)L * 5 * DM;
    const int j = L >> 1;
    bf16_t* WIN = WSP(bf16_t, WS_WIN);
    if ((L & 1) == 0) {
        TR(p.w_in_sb + (size_t)j * DM * SB_N, DM, SB_N, 0, SB_N, g, WIN, 0, 0);
    } else {
        const float* W = p.w_in_nsa + (size_t)j * DM * NSA_SRC;
        TR(W, DM, NSA_SRC, 0, 3072, g, WIN, 0, 0);
        TR(W, DM, NSA_SRC, 3108, 512, g, WIN, NQM, 0);
        TR(W, DM, NSA_SRC, 3072, 36, g, WIN, NGL, 0);
        TR((const float*)nullptr, DM, NSA_SRC, 0, 220, (const float*)nullptr, WIN, NGL + 36, 0);
        for (int wh = 0; wh < 2; ++wh) {
            TR(p.cmp_w1 + (size_t)(j * 2 + wh) * 4096 * 256, 4096, 256, 0, 256, (const float*)nullptr, WSP(bf16_t, WS_CW1) + (size_t)wh * 256 * 4096, 0, 0);
            TR(p.cmp_w2 + (size_t)(j * 2 + wh) * 256 * 128, 256, 128, 0, 128, (const float*)nullptr, WSP(bf16_t, WS_CW2) + (size_t)wh * 128 * 256, 0, 0);
        }
    }
    if ((L & 1) && F.bid < 16) {
        const int wh = F.bid >> 3, n = 32 * (F.bid & 7) + (F.tid & 31), kg = F.tid >> 5;
        const float* pe = p.cmp_pe + (size_t)(j * 2 + wh) * 4096; const float* w1 = p.cmp_w1 + (size_t)(j * 2 + wh) * 4096 * 256;
        float s = 0.f;
        for (int k = kg * 256; k < kg * 256 + 256; ++k) s += pe[k] * w1[(size_t)k * 256 + n];
        LAS float* red = (LAS float*)F.lds;
        red[kg * 32 + (F.tid & 31)] = s;
        __syncthreads();
        if (F.tid < 32) { float t = 0.f;
#pragma unroll
            for (int q = 0; q < 16; ++q) t += red[q * 32 + F.tid];
            WSP(float, WS_BIAS1)[wh * 256 + n] = t; }
        __syncthreads();
    }
    TR(p.w_o + (size_t)L * DM * DM, DM, DM, 0, DM, (const float*)nullptr, WSP(bf16_t, WS_WO), 0, 0);
    TR(p.w_gate + (size_t)L * DM * DFF, DM, DFF, 0, DFF, g + 2 * DM, WSP(bf16_t, WS_WGU), 0, 1);
    TR(p.w_up + (size_t)L * DM * DFF, DM, DFF, 0, DFF, g + 2 * DM, WSP(bf16_t, WS_WGU), 128, 1);
    TR(p.w_down + (size_t)L * DFF * DM, DFF, DM, 0, DM, (const float*)nullptr, WSP(bf16_t, WS_WD), 0, 0);
    if (L == 0) {
        for (int l = 0; l < DEPTH; ++l)
            TR(p.w_mem_kv + (size_t)l * DM * 1024, DM, 1024, 0, 1024, p.norm_g + (size_t)(l * 5 + 4) * DM, WSP(bf16_t, WS_WKV), l * 1024, 0);
        float* rstd = WSP(float, WS_RSTD);
        for (int m = gw; m < MTOK; m += NGW) row_to_bf16_rstd(p.x + (size_t)m * DM, WSP(bf16_t, WS_XB) + (size_t)m * DM, rstd + m, F.lane);
        for (int m = gw; m < NB * NMEM; m += NGW) row_to_bf16_rstd(p.mem + (size_t)m * DM, WSP(bf16_t, WS_MEMB) + (size_t)m * DM, rstd + 16384 + m, F.lane);
        float* cosT = WSP(float, WS_COS); float* sinT = WSP(float, WS_SIN);
        for (int idx = F.bid * NTHR + F.tid; idx < MTOK * 64; idx += F.G * NTHR) {
            const int row = idx >> 6, i = idx & 63;
            const float ang = (float)p.positions[row] * INV_FREQ[i];
            double t = (double)ang * 0.15915494309189535; t -= __builtin_rint(t);
            const float fr = (float)t;
            cosT[idx] = __builtin_amdgcn_cosf(fr); sinT[idx] = __builtin_amdgcn_sinf(fr);
        }
    }
#undef TR
}

template <class PP> __device__ __forceinline__ void phase_resid(const PP& p, const Frame& F, const float* xin, const float* gpost, float* xout, bf16_t* XB, float* rstd) {
    const int gw = F.bid * NWAVES + F.wave, NGW = F.G * NWAVES;
    const bf16_t* T = WSP(bf16_t, WS_TMP);
    for (int m = gw; m < MTOK; m += NGW) {
        const bf16x8* ar = (const bf16x8*)(T + (size_t)m * DM) + F.lane;
        f32x4 a[8]; float s = 0.f;
#pragma unroll
        for (int j = 0; j < 4; ++j) { unpack8(ar[64 * j], a[2 * j], a[2 * j + 1]); }
#pragma unroll
        for (int j = 0; j < 8; ++j) s += (a[j].x * a[j].x + a[j].y * a[j].y) + (a[j].z * a[j].z + a[j].w * a[j].w);
        const float ra = 1.0f / sqrtf(wave_sum(s) * (1.0f / DM) + NORM_EPS);
        float s2 = 0.f;
#pragma unroll
        for (int j = 0; j < 4; ++j) {
            const int e0 = (j * 64 + F.lane) * 8;
#pragma unroll
            for (int h = 0; h < 2; ++h) {
                const f32x4 xv = *(const f32x4*)(xin + (size_t)m * DM + e0 + 4 * h), gv = *(const f32x4*)(gpost + e0 + 4 * h);
                const f32x4 y = xv + a[2 * j + h] * ra * gv;
                a[2 * j + h] = y; s2 += (y.x * y.x + y.y * y.y) + (y.z * y.z + y.w * y.w);
                *(f32x4*)(xout + (size_t)m * DM + e0 + 4 * h) = y;
            }
            *((bf16x8*)(XB + (size_t)m * DM) + 64 * j + F.lane) = pack8(a[2 * j], a[2 * j + 1]);
        }
        s2 = wave_sum(s2);
        if (F.lane == 0) rstd[m] = 1.0f / sqrtf(s2 * (1.0f / DM) + NORM_EPS);
    }
}
template <class PP> __device__ __forceinline__ void phase_convfix(const PP& p, const Frame& F, int L) {
    bf16_t* ACT = WSP(bf16_t, WS_ACT); const float* HG = WSP(float, WS_HG); const float* FP = WSP(float, WS_FP); const float* FU = WSP(float, WS_FU);
    const float* cw = p.conv_w + (size_t)L * 3 * DFF;
    constexpr int NCH = DFF / 4;
    for (int it = F.bid * NTHR + F.tid; it < 64 * 2 * NCH; it += F.G * NTHR) {
        const int pm = it / (2 * NCH), rem = it - pm * 2 * NCH, i = rem / NCH, f0 = (rem - i * NCH) * 4;
        if ((pm & 7) == 0) continue;
        const f32x4 h0 = *(const f32x4*)(HG + (size_t)((pm - 1) * 2 + 0) * DFF + f0), h1 = *(const f32x4*)(HG + (size_t)((pm - 1) * 2 + 1) * DFF + f0);
        const f32x4 w0 = *(const f32x4*)(cw + f0), w1 = *(const f32x4*)(cw + DFF + f0);
        f32x4 gc = *(const f32x4*)(FP + (size_t)(pm * 2 + i) * DFF + f0); const f32x4 uu = *(const f32x4*)(FU + (size_t)(pm * 2 + i) * DFF + f0);
        if (i == 0) gc += w0 * h0 + w1 * h1; else gc += w0 * h1;
        v2u o; o.x = cvtpk(gc[0] * sigmoidf_(gc[0]) * uu[0], gc[1] * sigmoidf_(gc[1]) * uu[1]); o.y = cvtpk(gc[2] * sigmoidf_(gc[2]) * uu[2], gc[3] * sigmoidf_(gc[3]) * uu[3]);
        *(v2u*)(ACT + (size_t)(pm * 256 + i) * DFF + f0) = o;
    }
}

template <class PP> __device__ __forceinline__ void sb_unit(const PP& p, const ACtx& c, int b, int h, int qt) {
    const bf16_t* PR = WSP(bf16_t, WS_PROJ); bf16_t* OC = WSP(bf16_t, WS_OCAT);
    const int P0 = qt * 256, qlo = P0 + c.wid * 32, qpos = qlo + c.r32;
    const size_t rowb = (size_t)b * SEQ;
    bf16x8 qr[8]; load_q<false>(qr, PR + (rowb + qpos) * SB_N + SBQ + h * HD, nullptr, nullptr, c.hi);
    const bf16_t* Kp = PR + rowb * SB_N + SBK + h * HD; const bf16_t* Vp = PR + rowb * SB_N + SBV + h * HD;
    f32x16 o[4];
#pragma unroll
    for (int d = 0; d < 4; ++d) o[d] = (f32x16){};
    float C2 = 0.f;
    const int jt = (P0 >> 6) + 3;
    LAS int* flags = (LAS int*)(c.lds + A_FLAGS);
    int done_w = 0;
    Stage S; stage_load(S, Kp, Vp, SB_N, jt * 64, c);
    constexpr float ZS = SCALE * LOG2E;
    for (int it = 0; it <= jt; ++it) {
        const int j = jt - it, buf = it & 1;
        stage_write(S, buf, c);
        if (c.lane == 0) flags[buf * 8 + c.wid] = done_w;
        __syncthreads();
        int alld = 1;
#pragma unroll
        for (int w = 0; w < 8; ++w) alld &= flags[buf * 8 + w];
        if (alld) break;
        if (j > 0) stage_load(S, Kp, Vp, SB_N, (j - 1) * 64, c);
        const int kb = j * 64;
        if (!done_w && kb <= qlo + 30) {
            f32x16 p0, p1; qkt(p0, p1, buf, c, qr);
            const int dq = qpos - kb - 4 * c.hi;
#pragma unroll
            for (int r = 0; r < 16; ++r) { const int cc = (r & 3) + 8 * (r >> 2);
                { const float z = p0[r] * ZS; const float t = __builtin_amdgcn_exp2f(-fabsf(z)); const float v = -(fmaxf(z, 0.f) + __builtin_amdgcn_logf(1.f + t)); p0[r] = (cc < dq) ? v : 0.f; }
                { const float z = p1[r] * ZS; const float t = __builtin_amdgcn_exp2f(-fabsf(z)); const float v = -(fmaxf(z, 0.f) + __builtin_amdgcn_logf(1.f + t)); p1[r] = (cc + 32 < dq) ? v : 0.f; } }
            float E[8], Od[8];
#pragma unroll
            for (int q = 0; q < 4; ++q) { const float g0 = (p0[4 * q] + p0[4 * q + 1]) + (p0[4 * q + 2] + p0[4 * q + 3]); swap_both(g0, E[q], Od[q]);
                                          const float g1 = (p1[4 * q] + p1[4 * q + 1]) + (p1[4 * q + 2] + p1[4 * q + 3]); swap_both(g1, E[4 + q], Od[4 + q]); }
            float T = 0.f, ex[8];
#pragma unroll
            for (int q = 7; q >= 0; --q) { const float to = T; T += Od[q]; const float te = T; T += E[q]; ex[q] = c.hi ? to : te; }
#pragma unroll
            for (int q = 0; q < 4; ++q) {
                { float R = C2 + ex[q]; float ep = __builtin_amdgcn_exp2f(R);
#pragma unroll
                  for (int i = 3; i >= 0; --i) { R += p0[4 * q + i]; const float e = __builtin_amdgcn_exp2f(R); p0[4 * q + i] = ep - e; ep = e; } }
                { float R = C2 + ex[4 + q]; float ep = __builtin_amdgcn_exp2f(R);
#pragma unroll
                  for (int i = 3; i >= 0; --i) { R += p1[4 * q + i]; const float e = __builtin_amdgcn_exp2f(R); p1[4 * q + i] = ep - e; ep = e; } }
            }
            C2 += T;
            bf16x8 pa0, pa1, pa2, pa3; pack_p(p0, p1, pa0, pa1, pa2, pa3);
            pv_tile(o, buf, c, pa0, pa1, pa2, pa3);
            done_w = __all(C2 < -72.f) ? 1 : 0;
        }
    }
    __syncthreads();
    store_o_bf16(o, OC + (rowb + qlo) * DM + h * HD, DM, c);
}
template <class PP> __device__ __forceinline__ void mem_unit(const PP& p, const ACtx& c, int L, int b, int hm, int qt, int projN, int qmcol) {
    const bf16_t* PR = WSP(bf16_t, WS_PROJ); bf16_t* OC = WSP(bf16_t, WS_OCAT); const bf16_t* MKV = WSP(bf16_t, WS_MEMKV);
    const int P0 = qt * 256, qlo = P0 + c.wid * 32, qpos = qlo + c.r32;
    const size_t rowb = (size_t)b * SEQ;
    bf16x8 qr[8]; load_q<false>(qr, PR + (rowb + qpos) * projN + qmcol + hm * HD, nullptr, nullptr, c.hi);
    const bf16_t* Kp = MKV + (size_t)b * NMEM * 4096 + L * 1024 + hm * HD; const bf16_t* Vp = Kp + 512;
    f32x16 o[4]; float l;
    softmax_sweep<0>(c, qr, o, l, Kp, Vp, 4096, 0, 4, qpos, qlo, 0u);
    float fr[16]; row_factors(1.0f / l, fr, c);
#pragma unroll
    for (int d = 0; d < 4; ++d)
#pragma unroll
        for (int r = 0; r < 16; ++r) o[d][r] *= fr[r];
    store_o_bf16(o, OC + (rowb + qlo) * DM + NMIX * HD + hm * HD, DM, c);
}
template <class PP> __device__ __forceinline__ void phase_attn_sb(const PP& p, const Frame& F, int L, gu32* ctr) {
    const ACtx c = make_actx(F.lds);
    LAS int* slot = (LAS int*)(F.lds + MISC_OFF) + 16;
    constexpr int NSBU = NB * NMIX * 8, NMU = NB * NMEMH * 8;
    for (;;) { const int u = wq_next(ctr, slot, c.tid); if (u >= NSBU + NMU) break;
        if (u < NSBU) { const int qt = 7 - (u / (NB * NMIX)), bh = u % (NB * NMIX); sb_unit(p, c, bh / NMIX, bh % NMIX, qt); }
        else { const int v = u - NSBU; const int qt = v % 8, bh = v / 8; mem_unit(p, c, L, bh / NMEMH, bh % NMEMH, qt, SB_N, SBQM); }
    }
}

template <class PP> __device__ __forceinline__ void phase_rope(const PP& p, const Frame& F) {
    bf16_t* PR = WSP(bf16_t, WS_PROJ); const float* cosT = WSP(float, WS_COS); const float* sinT = WSP(float, WS_SIN);
    const int lane = F.lane, gw = F.bid * NWAVES + F.wave, NGW = F.G * NWAVES;
    for (int m = gw; m < MTOK; m += NGW) {
        const float cv = cosT[(size_t)m * 64 + lane], sv = sinT[(size_t)m * 64 + lane];
        bf16_t* rowp = PR + (size_t)m * NSA_N;
        float x1[6], x2[6];
#pragma unroll
        for (int q = 0; q < 6; ++q) { const int base = ((q < 2) ? NKC : (q < 4) ? NKS : NKW) + (q & 1) * HD; x1[q] = bf2f(rowp[base + lane]); x2[q] = bf2f(rowp[base + 64 + lane]); }
#pragma unroll
        for (int q = 0; q < 6; ++q) { const int base = ((q < 2) ? NKC : (q < 4) ? NKS : NKW) + (q & 1) * HD;
            const float y1 = x1[q] * cv - x2[q] * sv, y2 = x2[q] * cv + x1[q] * sv;
            rowp[base + lane] = (bf16_t)(cvtpk(y1, y1) & 0xffffu); rowp[base + 64 + lane] = (bf16_t)(cvtpk(y2, y2) & 0xffffu); }
    }
}
template <class PP> __device__ __forceinline__ void phase_cmp_stage2(const PP& p, const Frame& F) {
    const int lane = F.lane, r32 = lane & 31, hi = lane >> 5;
    for (int u = F.bid; u < 128; u += F.G) {
        const int wh = u & 1, rt = u >> 1;
        if (F.wave < 4) {
            const bf16_t* hid = WSP(bf16_t, WS_HID) + (size_t)wh * 2048 * 256 + (size_t)(rt * 32 + r32) * 256;
            const bf16_t* w2 = WSP(bf16_t, WS_CW2) + (size_t)wh * 128 * 256 + (size_t)(F.wave * 32 + r32) * 256;
            f32x16 a2 = (f32x16){};
#pragma unroll
            for (int kk = 0; kk < 16; ++kk) { const int k = kk * 16 + hi * 8;
                a2 = __builtin_amdgcn_mfma_f32_32x32x16_bf16(*(const bf16x8*)(hid + k), *(const bf16x8*)(w2 + k), a2, 0, 0, 0); }
            bf16_t* outp = WSP(bf16_t, WS_KCMP) + (size_t)wh * 16 * 128 * 128;
#pragma unroll
            for (int r = 0; r < 16; ++r) { const int ro = rt * 32 + crow(r, hi);
                outp[(size_t)ro * 128 + F.wave * 32 + r32] = ((ro & 127) == 127) ? (bf16_t)0 : (bf16_t)(cvtpk(a2[r], a2[r]) & 0xffffu); }
        }
    }
}

template <class PP> __device__ __forceinline__ void cmp_unit(const PP& p, const ACtx& c, int b, int g, int qt) {
    const bf16_t* PR = WSP(bf16_t, WS_PROJ); bf16_t* OC = WSP(bf16_t, WS_OCAT); const float* cosT = WSP(float, WS_COS); const float* sinT = WSP(float, WS_SIN);
    const int P0 = qt * 256, qlo = P0 + c.wid * 32, qpos = qlo + c.r32, hi = c.hi;
    const size_t rowb = (size_t)b * SEQ, row = rowb + qpos;
    const bf16_t* Kp = WSP(bf16_t, WS_KCMP) + (size_t)(b * 2 + g) * 128 * 128; const bf16_t* Vp = Kp + (size_t)16 * 128 * 128;
    { Stage S; stage_load(S, Kp, Vp, 128, 0, c); stage_write(S, 0, c); stage_load(S, Kp, Vp, 128, 64, c); stage_write(S, 1, c); }
    __syncthreads();
    const int cmax = (qpos >= 31) ? (((qpos - 31) >> 4) < 126 ? ((qpos - 31) >> 4) : 126) : -1;
    LAS float* acc_l = (LAS float*)(c.lds + A_STASH) + c.wid * 2048 + c.lane;
    const float NEG = -__builtin_inff();
    constexpr float C2 = LOG2E * SCALE;
#pragma nounroll
    for (int hh = 0; hh < HPG; ++hh) {
        const int h = g * HPG + hh;
        bf16x8 qr[8]; load_q<true>(qr, PR + row * NSA_N + NQ + h * HD, cosT + row * 64, sinT + row * 64, hi);
        f32x16 pA0, pA1, pB0, pB1; qkt(pA0, pA1, 0, c, qr); qkt(pB0, pB1, 1, c, qr);
        float mx = NEG;
#pragma unroll
        for (int r = 0; r < 16; ++r) { const int ci = crow(r, hi);
            if (ci > cmax) pA0[r] = NEG; if (ci + 32 > cmax) pA1[r] = NEG; if (ci + 64 > cmax) pB0[r] = NEG; if (ci + 96 > cmax) pB1[r] = NEG;
            mx = fmaxf(fmaxf(mx, pA0[r]), fmaxf(pA1[r], fmaxf(pB0[r], pB1[r]))); }
        mx = swap_max(mx); if (mx == NEG) mx = 0.f;
        const float mL = -mx * C2; float ls = 0.f;
#pragma unroll
        for (int r = 0; r < 16; ++r) { pA0[r] = __builtin_amdgcn_exp2f(fmaf(pA0[r], C2, mL)); pA1[r] = __builtin_amdgcn_exp2f(fmaf(pA1[r], C2, mL));
            pB0[r] = __builtin_amdgcn_exp2f(fmaf(pB0[r], C2, mL)); pB1[r] = __builtin_amdgcn_exp2f(fmaf(pB1[r], C2, mL)); ls += (pA0[r] + pA1[r]) + (pB0[r] + pB1[r]); }
        ls = swap_sum(ls);
        const float inv = ls > 0.f ? 1.0f / ls : 0.f;
#pragma unroll
        for (int r = 0; r < 16; ++r) { pA0[r] *= inv; pA1[r] *= inv; pB0[r] *= inv; pB1[r] *= inv; }
#define ACC_AB(P, Q0) do { _Pragma("unroll") for (int q = 0; q < 4; ++q) { \
            const float a_ = 2.f * (P[4 * q] + P[4 * q + 1] + P[4 * q + 2]) + P[4 * q + 3], b_ = P[4 * q + 3]; \
            LAS float* pa_ = acc_l + (2 * (Q0 + q)) * 64; \
            if (hh == 0) { pa_[0] = a_; pa_[64] = b_; } else { pa_[0] += a_; pa_[64] += b_; } } } while (0)
        ACC_AB(pA0, 0); ACC_AB(pA1, 4); ACC_AB(pB0, 8); ACC_AB(pB1, 12);
#undef ACC_AB
        f32x16 o[4];
#pragma unroll
        for (int d = 0; d < 4; ++d) o[d] = (f32x16){};
        { bf16x8 pa0, pa1, pa2, pa3; pack_p(pA0, pA1, pa0, pa1, pa2, pa3); pv_tile(o, 0, c, pa0, pa1, pa2, pa3); }
        { bf16x8 pa0, pa1, pa2, pa3; pack_p(pB0, pB1, pa0, pa1, pa2, pa3); pv_tile(o, 1, c, pa0, pa1, pa2, pa3); }
        const float gc = sigmoidf_(bf2f(PR[row * NSA_N + NGL + h * 3 + 0]));
        float fr[16]; row_factors(gc, fr, c);
#pragma unroll
        for (int d = 0; d < 4; ++d)
#pragma unroll
            for (int r = 0; r < 16; ++r) o[d][r] *= fr[r];
        add_o_bf16(o, OC + (rowb + qlo) * DM + h * HD, DM, c);
        store_o_bf16(o, OC + (rowb + qlo) * DM + h * HD, DM, c);
    }
    float Ie[16], Io[16];
    {
        float imp[16], Bb[16];
#pragma unroll
        for (int q = 0; q < 16; ++q) { float blo, bhi; swap_both(acc_l[(2 * q + 1) * 64], blo, bhi); Bb[q] = hi ? blo : bhi; }
#pragma unroll
        for (int q = 0; q < 16; ++q) imp[q] = acc_l[(2 * q) * 64] + (hi ? Bb[q] : (q > 0 ? Bb[q - 1] : 0.f));
#pragma unroll
        for (int q = 0; q < 16; ++q) swap_both(imp[q], Ie[q], Io[q]);
    }
    const int cur = qpos >> 6;
    unsigned bits;
    if (cur < 16) bits = (2u << cur) - 1u;
    else {
#pragma unroll
        for (int q = 0; q < 16; ++q) { const int je = 2 * q, jo = 2 * q + 1;
            if (!(je >= 1 && je <= cur - 2)) Ie[q] = -1.f; if (!(jo >= 1 && jo <= cur - 2)) Io[q] = -1.f; }
        bits = 0u;
#pragma unroll
        for (int q = 0; q < 16; ++q) {
            const int jm = 2 * q + hi; const float vj = hi ? Io[q] : Ie[q];
            int rank = 0;
#pragma unroll
            for (int q2 = 0; q2 < 16; ++q2) {
                const bool lt_e = (q2 < q) || (q2 == q && hi);
                const bool lt_o = (q2 < q);
                rank += (Ie[q2] > vj || (Ie[q2] == vj && lt_e)) ? 1 : 0;
                rank += (Io[q2] > vj || (Io[q2] == vj && lt_o)) ? 1 : 0;
            }
            const bool forced = (jm == 0) || (jm == cur) || (jm == cur - 1);
            const bool sel = forced || (vj >= 0.f && rank < 13);
            bits |= sel ? (1u << jm) : 0u;
        }
        { auto rr = __builtin_amdgcn_permlane32_swap(bits, bits, false, false); bits = rr[0] | rr[1]; }
    }
    if (hi == 0) WSP(unsigned, WS_SEL)[(size_t)(b * 2 + g) * SEQ + qpos] = bits;
    __syncthreads();
}
template <class PP> __device__ __forceinline__ void phase_attn_cmp(const PP& p, const Frame& F) {
    const ACtx c = make_actx(F.lds);
    constexpr int NCU = NB * NGRP * 8;
    for (int u = F.bid; u < NCU; u += F.G) { const int qt = 7 - (u % 8), bg = u / 8; cmp_unit(p, c, bg >> 1, bg & 1, qt); }
}
template <class PP> __device__ __forceinline__ void win_unit(const PP& p, const ACtx& c, int b, int h, int qt) {
    const bf16_t* PR = WSP(bf16_t, WS_PROJ); bf16_t* OC = WSP(bf16_t, WS_OCAT); const float* cosT = WSP(float, WS_COS); const float* sinT = WSP(float, WS_SIN);
    const int P0 = qt * 256, qlo = P0 + c.wid * 32, qpos = qlo + c.r32, g = h / HPG;
    const size_t rowb = (size_t)b * SEQ, row = rowb + qpos;
    bf16x8 qr[8]; load_q<true>(qr, PR + row * NSA_N + NQ + h * HD, cosT + row * 64, sinT + row * 64, c.hi);
    const float gwn = sigmoidf_(bf2f(PR[row * NSA_N + NGL + h * 3 + 2]));
    f32x16 o[4]; float l;
    const int jlo = (P0 - (WINDOW - 1)) > 0 ? ((P0 - (WINDOW - 1)) >> 6) : 0;
    softmax_sweep<1>(c, qr, o, l, PR + rowb * NSA_N + NKW + g * HD, PR + rowb * NSA_N + NVW + g * HD, NSA_N, jlo, (P0 >> 6) + 4, qpos, qlo, 0u);
    float fr[16]; row_factors(l > 0.f ? gwn / l : 0.f, fr, c);
#pragma unroll
    for (int d = 0; d < 4; ++d)
#pragma unroll
        for (int r = 0; r < 16; ++r) o[d][r] *= fr[r];
    store_o_bf16(o, OC + (rowb + qlo) * DM + h * HD, DM, c);
}
template <class PP> __device__ __forceinline__ void nsa_win_mem_units(const PP& p, const Frame& F, int L, gu32* ctr) {
    const ACtx c = make_actx(F.lds);
    LAS int* slot = (LAS int*)(F.lds + MISC_OFF) + 16;
    constexpr int NWU = NB * NMIX * 8, NMU = NB * NMEMH * 8;
    for (;;) { const int u = wq_next(ctr, slot, c.tid); if (u >= NWU + NMU) break;
        if (u < NWU) { const int qt = 7 - (u / (NB * NMIX)), bh = u % (NB * NMIX); win_unit(p, c, bh / NMIX, bh % NMIX, qt); }
        else { const int v = u - NWU; const int qt = v % 8, bh = v / 8; mem_unit(p, c, L, bh / NMEMH, bh % NMEMH, qt, NSA_N, NQM); }
    }
}
template <class PP> __device__ __forceinline__ void sel_unit(const PP& p, const ACtx& c, int b, int h, int qt, bf16_t* OUT) {
    const bf16_t* PR = WSP(bf16_t, WS_PROJ); const bf16_t* OC = WSP(bf16_t, WS_OCAT); const float* cosT = WSP(float, WS_COS); const float* sinT = WSP(float, WS_SIN);
    const int P0 = qt * 256, qlo = P0 + c.wid * 32, qpos = qlo + c.r32, g = h / HPG;
    const size_t rowb = (size_t)b * SEQ, row = rowb + qpos;
    bf16x8 qr[8]; load_q<true>(qr, PR + row * NSA_N + NQ + h * HD, cosT + row * 64, sinT + row * 64, c.hi);
    const unsigned selbits = WSP(unsigned, WS_SEL)[(size_t)(b * 2 + g) * SEQ + qpos];
    const float gs = sigmoidf_(bf2f(PR[row * NSA_N + NGL + h * 3 + 1]));
    f32x16 o[4]; float l;
    softmax_sweep<2>(c, qr, o, l, PR + rowb * NSA_N + NKS + g * HD, PR + rowb * NSA_N + NVS + g * HD, NSA_N, 0, (P0 >> 6) + 4, qpos, qlo, selbits);
    float fr[16]; row_factors(l > 0.f ? gs / l : 0.f, fr, c);
#pragma unroll
    for (int d = 0; d < 4; ++d)
#pragma unroll
        for (int r = 0; r < 16; ++r) o[d][r] *= fr[r];
    add_o_bf16(o, OC + (rowb + qlo) * DM + h * HD, DM, c);
    store_o_bf16(o, OUT + (rowb + qlo) * DM + h * HD, DM, c);
}
template <class PP> __device__ __forceinline__ void phase_attn_sel(const PP& p, const Frame& F, bf16_t* OUT, gu32* ctr) {
    const ACtx c = make_actx(F.lds);
    LAS int* slot = (LAS int*)(F.lds + MISC_OFF) + 16;
    constexpr int NU = NB * NMIX * 8;
    for (;;) { const int u = wq_next(ctr, slot, c.tid); if (u >= NU) break;
        const int qt = 7 - (u / (NB * NMIX)), bh = u % (NB * NMIX); sel_unit(p, c, bh / NMIX, bh % NMIX, qt, OUT); }
}

#define LAST_() (rep_ == nrep_ - 1)
#define WQ_(k) ((gu32*)(p.ws + WS_CTL) + 64 * (8 + ((lp * 3 + (k)) * 2 + rep_)))
#ifndef PROBE_REPEAT
#define PROBE_REPEAT 0
#endif
constexpr int NPH_SB = 9, NPH_NSA = 13, NPH = 2 * (NPH_SB + NPH_NSA);
__global__ void __launch_bounds__(NTHR, 2) mk_fwd(Params p) {
    extern __shared__ __attribute__((aligned(16))) unsigned char lds_raw[];
    LAS unsigned char* const lds0 = (LAS unsigned char*)lds_raw;
typedef const Params __attribute__((address_space(4))) KParams;
#define MKFRAME() KParams* pp_ = (KParams*)__builtin_amdgcn_kernarg_segment_ptr(); asm volatile("" : "+s"(pp_)); KParams& p = *pp_; Frame F; F.lds = lds0; { int t_ = threadIdx.x; asm volatile("" : "+v"(t_)); F.tid = t_; } F.lane = F.tid & 63; F.wave = __builtin_amdgcn_readfirstlane(F.tid >> 6); F.G = gridDim.x; F.bid = blockIdx.x
    for (int u = threadIdx.x; u < (LDS_BYTES - LDSCTL_OFF) / 4; u += NTHR) ((LAS unsigned*)(lds0 + LDSCTL_OFF))[u] = 0u;
    __syncthreads();
    gu32* ctl = (gu32*)(p.ws + WS_CTL);
    XcdBarrier bar; bar.bar = (unsigned*)(ctl + CW_BAR); bar.x = 0; bar.st = nullptr;
#if !MK_PER_PHASE
    bar = xcd_barrier_post((unsigned*)(ctl + CW_BAR), (volatile LAS unsigned*)(lds0 + MISC_OFF) + 8);
#endif
    const int lo = p.ph_lo, hi = p.ph_hi;
    int ph = 0;
#define IN() (lo <= ph && ph < hi)
#if MK_PER_PHASE
#define END_PHASE() do { ++ph; } while (0)
#else
#define END_PHASE() do { if (IN() && ph + 1 < hi) { xcd_barrier(bar); if (PROBE_REPEAT & 256) xcd_barrier(bar); } ++ph; } while (0)
#endif
#define GEMM_RS(Aoff, Boff, M_, N_, K_, Ooff, ldc_, rs_) do { pg8::Gemm g{WSP(pg8::bf16_t, Aoff), WSP(pg8::bf16_t, Boff), M_, N_, K_}; pg8::StaticOrder S; S.init(M_, N_, F.G, F.bid); \
        pg8::EpiRS E{WSP(pg8::bf16_t, Ooff), ldc_, rs_}; pg8::gemm_phase<pg8::EpiRS, pg8::StaticOrder, true, true>(F.lds, g, S, E); } while (0)

#define GEMM_GU(L_) do { pg8::Gemm g{WSP(pg8::bf16_t, WS_XB), WSP(pg8::bf16_t, WS_WGU), MTOK, NGU, DM}; pg8::StaticOrder S; S.init(MTOK, NGU, F.G, F.bid); \
        pg8::EpiConv E{WSP(pg8::bf16_t, WS_ACT), WSP(float, WS_RSTD), p.conv_w + (size_t)(L_) * 3 * DFF, p.conv_b + (size_t)(L_) * DFF, WSP(float, WS_HG), WSP(float, WS_FP), WSP(float, WS_FU), (LAS float*)(F.lds + HALO_OFF), DFF}; \
        pg8::gemm_phase<pg8::EpiConv, pg8::StaticOrder, true, true>(F.lds, g, S, E); } while (0)

    for (int lp = 0; lp < 2; ++lp) {
        {
            const int L = 2 * lp;
            if (IN()) { MKFRAME(); for (int rep_ = 0, nrep_ = ((PROBE_REPEAT & 1) ? 2 : 1); rep_ < nrep_; ++rep_) { phase_convert(p, F, L); } }
            END_PHASE();
            if (IN()) { MKFRAME(); for (int rep_ = 0, nrep_ = ((PROBE_REPEAT & 2) ? 2 : 1); rep_ < nrep_; ++rep_) { GEMM_RS(WS_XB, WS_WIN, MTOK, SB_N, DM, WS_PROJ, SB_N, WSP(float, WS_RSTD));
                        if (L == 0) GEMM_RS(WS_MEMB, WS_WKV, NB * NMEM, 4096, DM, WS_MEMKV, 4096, WSP(float, WS_RSTD) + 16384); } }
            END_PHASE();
            if (IN()) { MKFRAME(); for (int rep_ = 0, nrep_ = ((PROBE_REPEAT & 4) ? 2 : 1); rep_ < nrep_; ++rep_) { phase_attn_sb(p, F, L, WQ_(0)); } }
            END_PHASE();
            if (IN()) { MKFRAME(); for (int rep_ = 0, nrep_ = ((PROBE_REPEAT & 2) ? 2 : 1); rep_ < nrep_; ++rep_) { GEMM_RS(WS_OCAT, WS_WO, MTOK, DM, DM, WS_TMP, DM, (const float*)nullptr); } }
            END_PHASE();
            if (IN()) { MKFRAME(); for (int rep_ = 0, nrep_ = ((PROBE_REPEAT & 8) ? 2 : 1); rep_ < nrep_; ++rep_) { phase_resid(p, F, (L == 0) ? p.x : (const float*)p.out, p.norm_g + (size_t)(L * 5 + 1) * DM, LAST_() ? p.out : WSP(float, WS_ACT), LAST_() ? WSP(bf16_t, WS_XB) : WSP(bf16_t, WS_PROJ), LAST_() ? WSP(float, WS_RSTD) : WSP(float, WS_FP)); } }
            END_PHASE();
            if (IN()) { MKFRAME(); for (int rep_ = 0, nrep_ = ((PROBE_REPEAT & 2) ? 2 : 1); rep_ < nrep_; ++rep_) { GEMM_GU(L); } }
            END_PHASE();
            if (IN()) { MKFRAME(); for (int rep_ = 0, nrep_ = ((PROBE_REPEAT & 16) ? 2 : 1); rep_ < nrep_; ++rep_) { phase_convfix(p, F, L); } }
            END_PHASE();
            if (IN()) { MKFRAME(); for (int rep_ = 0, nrep_ = ((PROBE_REPEAT & 2) ? 2 : 1); rep_ < nrep_; ++rep_) { GEMM_RS(WS_ACT, WS_WD, MTOK, DM, DFF, WS_TMP, DM, (const float*)nullptr); } }
            END_PHASE();
            if (IN()) { MKFRAME(); for (int rep_ = 0, nrep_ = ((PROBE_REPEAT & 8) ? 2 : 1); rep_ < nrep_; ++rep_) { phase_resid(p, F, (const float*)p.out, p.norm_g + (size_t)(L * 5 + 3) * DM, LAST_() ? p.out : WSP(float, WS_ACT), LAST_() ? WSP(bf16_t, WS_XB) : WSP(bf16_t, WS_PROJ), LAST_() ? WSP(float, WS_RSTD) : WSP(float, WS_FP)); } }
            END_PHASE();
        }
        {
            const int L = 2 * lp + 1;
            if (IN()) { MKFRAME(); for (int rep_ = 0, nrep_ = ((PROBE_REPEAT & 1) ? 2 : 1); rep_ < nrep_; ++rep_) { phase_convert(p, F, L); } }
            END_PHASE();
            if (IN()) { MKFRAME(); for (int rep_ = 0, nrep_ = ((PROBE_REPEAT & 2) ? 2 : 1); rep_ < nrep_; ++rep_) { GEMM_RS(WS_XB, WS_WIN, MTOK, NSA_N, DM, WS_PROJ, NSA_N, WSP(float, WS_RSTD)); } }
            END_PHASE();
            if (IN()) { MKFRAME(); phase_rope(p, F); }
            END_PHASE();
            if (IN()) { MKFRAME(); for (int rep_ = 0, nrep_ = ((PROBE_REPEAT & 32) ? 2 : 1); rep_ < nrep_; ++rep_) {
                if (F.bid < 16) { const int wh = F.bid >> 3;
                    pg8::Gemm g{WSP(pg8::bf16_t, WS_PROJ) + (wh ? NVC : NKC), WSP(pg8::bf16_t, WS_CW1) + (size_t)wh * 256 * 4096, 2048, 256, 4096, 16 * NSA_N, 256u, (unsigned)(NSA_N * 2), (size_t)SEQ * NSA_N * 2};
                    pg8::StaticOrder S; S.init(2048, 256, F.G, F.bid & 7);
                    pg8::EpiSiluBias E{WSP(pg8::bf16_t, WS_HID) + (size_t)wh * 2048 * 256, 256, WSP(float, WS_BIAS1) + wh * 256};
                    pg8::gemm_phase<pg8::EpiSiluBias, pg8::StaticOrder, true, true, true>(F.lds, g, S, E);
                }
                nsa_win_mem_units(p, F, L, WQ_(1)); } }
            END_PHASE();
            if (IN()) { MKFRAME(); phase_cmp_stage2(p, F); }
            END_PHASE();
            if (IN()) { MKFRAME(); for (int rep_ = 0, nrep_ = ((PROBE_REPEAT & 64) ? 2 : 1); rep_ < nrep_; ++rep_) { phase_attn_cmp(p, F); } }
            END_PHASE();
            if (IN()) { MKFRAME(); for (int rep_ = 0, nrep_ = ((PROBE_REPEAT & 128) ? 2 : 1); rep_ < nrep_; ++rep_) { phase_attn_sel(p, F, LAST_() ? WSP(bf16_t, WS_OCAT) : WSP(bf16_t, WS_TMP), WQ_(2)); } }
            END_PHASE();
            if (IN()) { MKFRAME(); for (int rep_ = 0, nrep_ = ((PROBE_REPEAT & 2) ? 2 : 1); rep_ < nrep_; ++rep_) { GEMM_RS(WS_OCAT, WS_WO, MTOK, DM, DM, WS_TMP, DM, (const float*)nullptr); } }
            END_PHASE();
            if (IN()) { MKFRAME(); for (int rep_ = 0, nrep_ = ((PROBE_REPEAT & 8) ? 2 : 1); rep_ < nrep_; ++rep_) { phase_resid(p, F, (const float*)p.out, p.norm_g + (size_t)(L * 5 + 1) * DM, LAST_() ? p.out : WSP(float, WS_ACT), LAST_() ? WSP(bf16_t, WS_XB) : WSP(bf16_t, WS_PROJ), LAST_() ? WSP(float, WS_RSTD) : WSP(float, WS_FP)); } }
            END_PHASE();
            if (IN()) { MKFRAME(); for (int rep_ = 0, nrep_ = ((PROBE_REPEAT & 2) ? 2 : 1); rep_ < nrep_; ++rep_) { GEMM_GU(L); } }
            END_PHASE();
            if (IN()) { MKFRAME(); for (int rep_ = 0, nrep_ = ((PROBE_REPEAT & 16) ? 2 : 1); rep_ < nrep_; ++rep_) { phase_convfix(p, F, L); } }
            END_PHASE();
            if (IN()) { MKFRAME(); for (int rep_ = 0, nrep_ = ((PROBE_REPEAT & 2) ? 2 : 1); rep_ < nrep_; ++rep_) { GEMM_RS(WS_ACT, WS_WD, MTOK, DM, DFF, WS_TMP, DM, (const float*)nullptr); } }
            END_PHASE();
            if (IN()) { MKFRAME(); for (int rep_ = 0, nrep_ = ((PROBE_REPEAT & 8) ? 2 : 1); rep_ < nrep_; ++rep_) { phase_resid(p, F, (const float*)p.out, p.norm_g + (size_t)(L * 5 + 3) * DM, LAST_() ? p.out : WSP(float, WS_ACT), LAST_() ? WSP(bf16_t, WS_XB) : WSP(bf16_t, WS_PROJ), LAST_() ? WSP(float, WS_RSTD) : WSP(float, WS_FP)); } }
            END_PHASE();
        }
    }
#undef IN
#undef END_PHASE
#undef GEMM_RS
#undef GEMM_GU
}

extern "C" void kernel_launch(void* const* d_in, const int* in_sizes, int n_in, void* d_out, int out_size, void* d_ws, size_t ws_size, hipStream_t stream) {
    static int grid = 0;
    if (grid == 0) {
        if (n_in != 16 || out_size != MTOK * DM || ws_size < WS_END) { fprintf(stderr, "kernel_launch: unexpected shapes (n_in %d, out %d, ws %zu < %zu)\n", n_in, out_size, ws_size, (size_t)WS_END); grid = -1; return; }
        int dev = 0, cus = 0, per_cu = 0;
        if (hipGetDevice(&dev) != hipSuccess || hipDeviceGetAttribute(&cus, hipDeviceAttributeMultiprocessorCount, dev) != hipSuccess) { grid = -1; return; }
        if (hipFuncSetAttribute((const void*)mk_fwd, hipFuncAttributeMaxDynamicSharedMemorySize, LDS_BYTES) != hipSuccess) { fprintf(stderr, "kernel_launch: hipFuncSetAttribute failed\n"); grid = -1; return; }
        if (hipOccupancyMaxActiveBlocksPerMultiprocessor(&per_cu, (const void*)mk_fwd, NTHR, LDS_BYTES) != hipSuccess || per_cu < 1) { fprintf(stderr, "kernel_launch: occupancy query says %d\n", per_cu); (void)hipGetLastError(); }
        grid = cus;
    }
    if (grid < 0) return;
    (void)hipMemsetAsync((char*)d_ws + WS_CTL, 0, CTL_ZERO_BYTES, stream);
    Params p{};
    p.x = (const float*)d_in[0]; p.mem = (const float*)d_in[1]; p.positions = (const int*)d_in[2]; p.norm_g = (const float*)d_in[3]; p.w_in_sb = (const float*)d_in[4]; p.w_in_nsa = (const float*)d_in[5];
    p.cmp_pe = (const float*)d_in[6]; p.cmp_w1 = (const float*)d_in[7]; p.cmp_w2 = (const float*)d_in[8]; p.w_mem_kv = (const float*)d_in[9]; p.w_o = (const float*)d_in[10];
    p.w_gate = (const float*)d_in[11]; p.w_up = (const float*)d_in[12]; p.conv_w = (const float*)d_in[13]; p.conv_b = (const float*)d_in[14]; p.w_down = (const float*)d_in[15];
    p.out = (float*)d_out; p.ws = (unsigned char*)d_ws;
#if MK_PER_PHASE
    for (int ph = 0; ph < NPH; ++ph) { p.ph_lo = ph; p.ph_hi = ph + 1; hipLaunchKernelGGL(mk_fwd, dim3(grid), dim3(NTHR), LDS_BYTES, stream, p); }
#else
    p.ph_lo = 0; p.ph_hi = NPH;
    hipLaunchKernelGGL(mk_fwd, dim3(grid), dim3(NTHR), LDS_BYTES, stream, p);
#endif
}
```

```cpp
#include <hip/hip_runtime.h>
#include <cstdio>
#include <cstdint>
namespace pg8 {
#define PG8_LAS __attribute__((address_space(3)))
typedef unsigned short bf16_t;
typedef short bf16x8 __attribute__((ext_vector_type(8)));
typedef float f32x4 __attribute__((ext_vector_type(4)));
typedef unsigned u32x4 __attribute__((ext_vector_type(4)));
constexpr int BM = 256, BK = 64, HALF = 128, HTB = HALF * BK * 2  , STAGE_BYTES = 8 * HTB, NXCD = 8, WGM = 8;

__host__ __device__ __forceinline__ int lds_byte(int r, int c) { const int st = (r >> 4) * 2 + (c >> 5), rr = r & 15, cc = c & 31, ob = rr * 64 + cc * 2; return st * 1024 + (ob ^ (((ob >> 9) & 1) << 5)); }
__host__ __device__ __forceinline__ void stage_rc(int b, int& R, int& C) { const int st = b / 1024, sb = b % 1024, swz = sb ^ (((sb >> 9) & 1) << 5); R = (st >> 1) * 16 + swz / 64; C = (st & 1) * 32 + (swz % 64) / 2; }
__host__ __device__ __forceinline__ int perm32(int rho) { const int n = rho >> 4, i = rho & 15; return 8 * (i >> 2) + 4 * n + (i & 3); }

struct Unit { int pm, pn; };
struct Gemm { const bf16_t* A; const bf16_t* Bt; int M, N, K; int lda; unsigned hstepA, kpairA; size_t tstepA; };

struct StaticOrder {
    int nM, nN, nwg, G, c;
    __host__ __device__ void init(int M, int N, int G_, int c_) { nM = M / BM; nN = N / BM; nwg = nM * nN; G = G_; c = c_; }
    __host__ __device__ bool next(int i, Unit& u) const {
        const long L = (long)i * G + c; if (L >= nwg) return false;
        int wgid = (int)L; { const int q = nwg / NXCD, r = nwg % NXCD, xcd = wgid % NXCD, off = wgid / NXCD; wgid = (xcd < r ? xcd * (q + 1) : r * (q + 1) + (xcd - r) * q) + off; }
        const int nig = WGM * nN, gid = wgid / nig, fm = gid * WGM, gsz = (nM - fm) < WGM ? (nM - fm) : WGM;
        u.pm = fm + ((wgid % nig) % gsz); u.pn = (wgid % nig) / gsz; return true;
    }
    __device__ __forceinline__ void a_ready(const Unit&) const {}
    __device__ __forceinline__ void done(const Unit&) const {}
};

__device__ __forceinline__ unsigned cvt_pk_bf16(float lo, float hi) { unsigned r; asm volatile("v_cvt_pk_bf16_f32 %0, %1, %2" : "=v"(r) : "v"(lo), "v"(hi)); return r; }
typedef float f32x2 __attribute__((ext_vector_type(2)));
struct EpiRS {
    static constexpr bool PERM = true, AFTER_DRAIN = false;
    bf16_t* O; int ldc; const float* rs;
    __device__ __forceinline__ void operator()(const f32x4 (&acc)[2][2][4][2], const Unit& u, int wr, int wc, int fr, int fq) const {
        const int row0 = u.pm * BM + wr * 64 + fr; const int col0 = u.pn * BM + wc * 32 + 8 * fq;
#pragma unroll
        for (int ai = 0; ai < 2; ++ai)
#pragma unroll
            for (int m = 0; m < 4; ++m) { const int row = row0 + ai * HALF + m * 16; const float sc = rs ? rs[row] : 1.f; bf16_t* rowp = O + (size_t)row * ldc + col0;
#pragma unroll
                for (int bj = 0; bj < 2; ++bj) { const f32x4 v0 = acc[ai][bj][m][0] * sc, v1 = acc[ai][bj][m][1] * sc;
                    u32x4 w; w.x = cvt_pk_bf16(v0[0], v0[1]); w.y = cvt_pk_bf16(v0[2], v0[3]); w.z = cvt_pk_bf16(v1[0], v1[1]); w.w = cvt_pk_bf16(v1[2], v1[3]);
                    *(u32x4*)(rowp + bj * HALF) = w; } }
    }
};
__device__ __forceinline__ float dpp_ror1(float v) { return __builtin_bit_cast(float, __builtin_amdgcn_update_dpp(0, __builtin_bit_cast(int, v), 0x121, 0xf, 0xf, false)); }
__device__ __forceinline__ float dpp_ror2(float v) { return __builtin_bit_cast(float, __builtin_amdgcn_update_dpp(0, __builtin_bit_cast(int, v), 0x122, 0xf, 0xf, false)); }
__device__ __forceinline__ float silu_fast(float x) { return x * __builtin_amdgcn_rcpf(1.f + __builtin_amdgcn_exp2f(-x * 1.4426950408889634f)); }
struct EpiConv {
    static constexpr bool PERM = true, AFTER_DRAIN = false;
    bf16_t* ACT; const float* rs; const float* cw; const float* cb; float* HG; float* FP; float* FU; PG8_LAS float* halo; int dff;
    __device__ __forceinline__ void operator()(const f32x4 (&acc)[2][2][4][2], const Unit& u, int wr, int wc, int fr, int fq) const {
        const int fl = wc * 32 + 8 * fq, f0 = u.pn * 128 + fl;
        f32x4 w0[2], w1[2], w2[2], bb[2];
#pragma unroll
        for (int n = 0; n < 2; ++n) { w0[n] = *(const f32x4*)(cw + f0 + 4 * n); w1[n] = *(const f32x4*)(cw + dff + f0 + 4 * n); w2[n] = *(const f32x4*)(cw + 2 * dff + f0 + 4 * n); bb[n] = *(const f32x4*)(cb + f0 + 4 * n); }
#pragma unroll
        for (int ai = 0; ai < 2; ++ai) { const float sc = rs[u.pm * BM + ai * HALF + wr * 64 + 48 + fr];
            if (fr >= 14) {
#pragma unroll
                for (int n = 0; n < 2; ++n) *(PG8_LAS f32x4*)(halo + ((ai * 2 + wr) * 2 + (fr - 14)) * 128 + fl + 4 * n) = acc[ai][0][3][n] * sc; } }
        asm volatile("s_waitcnt lgkmcnt(0)" ::: "memory"); __builtin_amdgcn_s_barrier(); asm volatile("" ::: "memory");
#pragma unroll
        for (int ai = 0; ai < 2; ++ai) {
            const int s = ai * 2 + wr;
            f32x4 a1p[2], a2p[2];
#pragma unroll
            for (int n = 0; n < 2; ++n) { f32x4 vp = {0.f, 0.f, 0.f, 0.f};
                if (s > 0 && fr >= 14) vp = *(const PG8_LAS f32x4*)(halo + ((s - 1) * 2 + (fr - 14)) * 128 + fl + 4 * n);
#pragma unroll
                for (int e = 0; e < 4; ++e) { a1p[n][e] = dpp_ror1(vp[e]); a2p[n][e] = dpp_ror2(vp[e]); } }
#pragma unroll
            for (int m = 0; m < 4; ++m) {
                const int row = u.pm * BM + ai * HALF + wr * 64 + m * 16 + fr; const float sc = rs[row];
                u32x4 wv; unsigned pk[4];
#pragma unroll
                for (int n = 0; n < 2; ++n) {
                    const f32x4 v = acc[ai][0][m][n] * sc, uu = acc[ai][1][m][n] * sc; f32x4 a1, a2, gc, ac;
#pragma unroll
                    for (int e = 0; e < 4; ++e) { a1[e] = dpp_ror1(v[e]); a2[e] = dpp_ror2(v[e]); }
#pragma unroll
                    for (int e = 0; e < 4; ++e) { const float p1 = (fr >= 1) ? a1[e] : a1p[n][e], p2 = (fr >= 2) ? a2[e] : a2p[n][e];
                        gc[e] = bb[n][e] + w0[n][e] * p2 + w1[n][e] * p1 + w2[n][e] * v[e];
                        ac[e] = silu_fast(gc[e]) * uu[e]; }
                    if (s == 0 && m == 0 && fr < 2) { *(f32x4*)(FP + (size_t)(u.pm * 2 + fr) * dff + f0 + 4 * n) = gc; *(f32x4*)(FU + (size_t)(u.pm * 2 + fr) * dff + f0 + 4 * n) = uu; }
                    if (s == 3 && m == 3 && fr >= 14) *(f32x4*)(HG + (size_t)(u.pm * 2 + fr - 14) * dff + f0 + 4 * n) = v;
                    pk[2 * n] = cvt_pk_bf16(ac[0], ac[1]); pk[2 * n + 1] = cvt_pk_bf16(ac[2], ac[3]);
                    a1p[n] = a1; a2p[n] = a2;
                }
                wv.x = pk[0]; wv.y = pk[1]; wv.z = pk[2]; wv.w = pk[3];
                *(u32x4*)(ACT + (size_t)row * dff + f0) = wv;
            }
        }
    }
};
struct EpiSiluBias {
    static constexpr bool PERM = true, AFTER_DRAIN = false;
    bf16_t* O; int ldc; const float* bias;
    __device__ __forceinline__ void operator()(const f32x4 (&acc)[2][2][4][2], const Unit& u, int wr, int wc, int fr, int fq) const {
        const int row0 = u.pm * BM + wr * 64 + fr; const int col0 = u.pn * BM + wc * 32 + 8 * fq;
        f32x4 bv[2][2];
#pragma unroll
        for (int bj = 0; bj < 2; ++bj)
#pragma unroll
            for (int n = 0; n < 2; ++n) bv[bj][n] = *(const f32x4*)(bias + col0 + bj * HALF + 4 * n);
#pragma unroll
        for (int ai = 0; ai < 2; ++ai)
#pragma unroll
            for (int m = 0; m < 4; ++m) { bf16_t* rowp = O + (size_t)(row0 + ai * HALF + m * 16) * ldc + col0;
#pragma unroll
                for (int bj = 0; bj < 2; ++bj) { f32x4 v0 = acc[ai][bj][m][0] + bv[bj][0], v1 = acc[ai][bj][m][1] + bv[bj][1];
#pragma unroll
                    for (int e = 0; e < 4; ++e) { v0[e] = v0[e] * __builtin_amdgcn_rcpf(1.f + __builtin_amdgcn_exp2f(-v0[e] * 1.4426950408889634f)); v1[e] = v1[e] * __builtin_amdgcn_rcpf(1.f + __builtin_amdgcn_exp2f(-v1[e] * 1.4426950408889634f)); }
                    u32x4 w; w.x = cvt_pk_bf16(v0[0], v0[1]); w.y = cvt_pk_bf16(v0[2], v0[3]); w.z = cvt_pk_bf16(v1[0], v1[1]); w.w = cvt_pk_bf16(v1[2], v1[3]);
                    *(u32x4*)(rowp + bj * HALF) = w; } }
    }
};
template <class Epi, class Sched, bool ALIGN_EPI = false, bool SP2 = false, bool AGEN = false>
__device__ __forceinline__ void gemm_phase(PG8_LAS unsigned char* lds, const Gemm g, const Sched& S, const Epi& E) {
    int tid_ = threadIdx.x; asm volatile("" : "+v"(tid_));
    const int tid = tid_, wid = __builtin_amdgcn_readfirstlane(tid >> 6), lane = tid & 63, wr = wid >> 2, wc = wid & 3, fr = lane & 15, fq = lane >> 4;
    const int K = g.K, nt = K / BK;
    unsigned voffA[2], voffB[2];
#pragma unroll
    for (int i = 0; i < 2; ++i) { int R, C; stage_rc(tid * 16 + i * 8192, R, C); const int Rb = Epi::PERM ? ((R & ~31) + perm32(R & 31)) : R;
        voffA[i] = (unsigned)(R * (AGEN ? g.lda : K) + C) * 2u; voffB[i] = (unsigned)(Rb * K + C) * 2u; }
    const size_t kstep = (size_t)(BK * 2);
    const size_t hstep = (size_t)HALF * K * 2;
    const size_t tstep = 2 * hstep;
    const size_t hstepA = AGEN ? (size_t)g.hstepA : hstep, tstepA = AGEN ? g.tstepA : tstep, kpairA = AGEN ? (size_t)g.kpairA : 2 * kstep;
    const unsigned ldsw = (unsigned)wid * 1024u;
    const int aoff = lds_byte(wr * 64 + fr, fq * 8), boff = lds_byte(wc * 32 + fr, fq * 8);
#define PG8_SA(b, h) (((b) * 2 + (h)) * HTB)
#define PG8_SB(b, h) ((4 + (b) * 2 + (h)) * HTB)
#define PG8_STAGE(bufoff, gbase, voff) do { _Pragma("unroll") for (int _i = 0; _i < 2; ++_i) \
        __builtin_amdgcn_global_load_lds((const unsigned*)((const char*)(gbase) + (voff)[_i]), (PG8_LAS unsigned*)(lds + (bufoff) + ldsw + _i * 8192), 16, 0, 0); } while (0)
#define PG8_LDA(dst, b, h) do { _Pragma("unroll") for (int m = 0; m < 4; ++m) _Pragma("unroll") for (int k = 0; k < 2; ++k) dst[m][k] = *(const PG8_LAS bf16x8*)(lds + PG8_SA(b, h) + aoff + m * 2048 + k * 1024); } while (0)
#define PG8_LDB(dst, b, h) do { _Pragma("unroll") for (int n = 0; n < 2; ++n) _Pragma("unroll") for (int k = 0; k < 2; ++k) dst[n][k] = *(const PG8_LAS bf16x8*)(lds + PG8_SB(b, h) + boff + n * 2048 + k * 1024); } while (0)
#define PG8_MMA(ai, bj, At, Bt) do { __builtin_amdgcn_s_setprio(1); _Pragma("unroll") for (int m = 0; m < 4; ++m) _Pragma("unroll") for (int n = 0; n < 2; ++n) _Pragma("unroll") for (int k = 0; k < 2; ++k) \
        acc[ai][bj][m][n] = __builtin_amdgcn_mfma_f32_16x16x32_bf16(Bt[n][k], At[m][k], acc[ai][bj][m][n], 0, 0, 0); __builtin_amdgcn_s_setprio(0); } while (0)
#define PG8_WAIT_V(n) asm volatile("s_waitcnt vmcnt(" #n ")" ::: "memory")
#define PG8_WAIT_L(n) asm volatile("s_waitcnt lgkmcnt(" #n ")" ::: "memory")
#define PG8_BAR __builtin_amdgcn_s_barrier()
#define PG8_SCHED __builtin_amdgcn_sched_barrier(0)
    Unit cur, nxt; int ui = 0;
    if (!S.next(0, cur)) return;
    f32x4 acc[2][2][4][2];
#pragma unroll
    for (int a = 0; a < 2; ++a)
#pragma unroll
        for (int b = 0; b < 2; ++b)
#pragma unroll
            for (int m = 0; m < 4; ++m)
#pragma unroll
                for (int n = 0; n < 2; ++n) acc[a][b][m][n] = (f32x4){0.f, 0.f, 0.f, 0.f};
    bf16x8 At[4][2], B0[2][2], B1[2][2];
    const char* cA = (const char*)g.A + (size_t)cur.pm * tstepA; const char* cB = (const char*)g.Bt + (size_t)cur.pn * tstep;
    S.a_ready(cur);
    if constexpr (SP2) {
        PG8_STAGE(PG8_SB(0, 0), cB, voffB); PG8_STAGE(PG8_SB(0, 1), cB + hstep, voffB); PG8_STAGE(PG8_SA(0, 0), cA, voffA); PG8_STAGE(PG8_SA(0, 1), cA + hstepA, voffA);
        if (wr == 1) PG8_BAR;
        PG8_WAIT_V(2); PG8_BAR;
        PG8_STAGE(PG8_SB(1, 0), cB + kstep, voffB); PG8_STAGE(PG8_SA(1, 0), cA + kstep, voffA); PG8_STAGE(PG8_SB(1, 1), cB + hstep + kstep, voffB);
        PG8_WAIT_V(6); PG8_BAR;
    } else {
        PG8_STAGE(PG8_SB(0, 0), cB, voffB); PG8_STAGE(PG8_SA(0, 0), cA, voffA); PG8_STAGE(PG8_SB(0, 1), cB + hstep, voffB); PG8_STAGE(PG8_SA(0, 1), cA + hstepA, voffA);
        if (wr == 1) PG8_BAR;
        PG8_WAIT_V(4); PG8_BAR;
        PG8_STAGE(PG8_SB(1, 0), cB + kstep, voffB); PG8_STAGE(PG8_SA(1, 0), cA + kstep, voffA); PG8_STAGE(PG8_SB(1, 1), cB + hstep + kstep, voffB);
        PG8_WAIT_V(6); PG8_BAR;
    }
    for (;;) {
        const bool has_next = S.next(ui + 1, nxt);
        const char* nA = has_next ? (const char*)g.A + (size_t)nxt.pm * tstepA : cA; const char* nB = has_next ? (const char*)g.Bt + (size_t)nxt.pn * tstep : cB;
        for (int t = 0; t < nt; t += 2) {
            const bool last = (t == nt - 2);
            const char* a1 = cA + (size_t)(t >> 1) * kpairA + kstep;
            const char* a2 = last ? nA : cA + (size_t)((t >> 1) + 1) * kpairA; const char* b2 = last ? nB : cB + (size_t)(t + 2) * kstep;
            const char* a3 = a2 + kstep; const char* b3 = b2 + kstep;
            if (last && has_next) S.a_ready(nxt);
            if constexpr (SP2) {
            PG8_LDB(B0, 0, 0); PG8_LDB(B1, 0, 1); PG8_SCHED; PG8_LDA(At, 0, 0); PG8_STAGE(PG8_SA(1, 1), a1 + hstepA, voffA);
            PG8_WAIT_V(8); PG8_WAIT_L(0); PG8_BAR; PG8_MMA(0, 0, At, B0); PG8_MMA(0, 1, At, B1); PG8_BAR; PG8_SCHED;
            PG8_LDA(At, 0, 1); PG8_STAGE(PG8_SB(0, 0), b2, voffB); PG8_STAGE(PG8_SB(0, 1), b2 + hstep, voffB); PG8_STAGE(PG8_SA(0, 0), a2, voffA);
            PG8_WAIT_V(8); PG8_WAIT_L(0); PG8_BAR; PG8_MMA(1, 0, At, B0); PG8_MMA(1, 1, At, B1); PG8_BAR; PG8_SCHED;
            PG8_LDB(B0, 1, 0); PG8_LDB(B1, 1, 1); PG8_SCHED; PG8_LDA(At, 1, 0); PG8_STAGE(PG8_SA(0, 1), a2 + hstepA, voffA);
            PG8_WAIT_V(8); PG8_WAIT_L(0); PG8_BAR; PG8_MMA(0, 0, At, B0); PG8_MMA(0, 1, At, B1); PG8_BAR; PG8_SCHED;
            PG8_LDA(At, 1, 1); PG8_STAGE(PG8_SB(1, 0), b3, voffB); PG8_STAGE(PG8_SB(1, 1), b3 + hstep, voffB); PG8_STAGE(PG8_SA(1, 0), a3, voffA);
            PG8_WAIT_V(8); PG8_WAIT_L(0); PG8_BAR; PG8_MMA(1, 0, At, B0); PG8_MMA(1, 1, At, B1); PG8_BAR; PG8_SCHED;
            } else {
            PG8_LDB(B0, 0, 0); PG8_SCHED; PG8_LDA(At, 0, 0); PG8_STAGE(PG8_SA(1, 1), a1 + hstepA, voffA);
            PG8_WAIT_L(8); PG8_BAR; PG8_WAIT_L(0); PG8_MMA(0, 0, At, B0); PG8_BAR; PG8_SCHED;
            PG8_LDB(B1, 0, 1); PG8_STAGE(PG8_SB(0, 0), b2, voffB);
            PG8_BAR; PG8_WAIT_L(0); PG8_MMA(0, 1, At, B1); PG8_BAR;
            PG8_LDA(At, 0, 1); PG8_STAGE(PG8_SA(0, 0), a2, voffA);
            PG8_BAR; PG8_WAIT_L(0); PG8_MMA(1, 0, At, B0); PG8_BAR; PG8_SCHED;
            PG8_STAGE(PG8_SB(0, 1), b2 + hstep, voffB);
            PG8_WAIT_V(6); PG8_BAR; PG8_MMA(1, 1, At, B1); PG8_BAR;
            PG8_LDB(B0, 1, 0); PG8_SCHED; PG8_LDA(At, 1, 0); PG8_STAGE(PG8_SA(0, 1), a2 + hstepA, voffA);
            PG8_WAIT_L(8); PG8_BAR; PG8_WAIT_L(0); PG8_MMA(0, 0, At, B0); PG8_BAR; PG8_SCHED;
            PG8_LDB(B1, 1, 1); PG8_STAGE(PG8_SB(1, 0), b3, voffB);
            PG8_BAR; PG8_WAIT_L(0); PG8_MMA(0, 1, At, B1); PG8_BAR;
            PG8_LDA(At, 1, 1); PG8_STAGE(PG8_SA(1, 0), a3, voffA);
            PG8_BAR; PG8_WAIT_L(0); PG8_MMA(1, 0, At, B0); PG8_BAR; PG8_SCHED;
            PG8_STAGE(PG8_SB(1, 1), b3 + hstep, voffB);
            PG8_WAIT_V(6); PG8_BAR; PG8_MMA(1, 1, At, B1); PG8_BAR;
            }
        }
        if constexpr (ALIGN_EPI) { if (wr == 0) PG8_BAR; }
        if constexpr (!Epi::AFTER_DRAIN) { E(acc, cur, wr, wc, fr, fq); S.done(cur); }
        if (!has_next) break;
#pragma unroll
        for (int a = 0; a < 2; ++a)
#pragma unroll
            for (int b = 0; b < 2; ++b)
#pragma unroll
                for (int m = 0; m < 4; ++m)
#pragma unroll
                    for (int n = 0; n < 2; ++n) acc[a][b][m][n] = (f32x4){0.f, 0.f, 0.f, 0.f};
        cur = nxt; cA = nA; cB = nB; ++ui;
        if constexpr (ALIGN_EPI) { if (wr == 1) PG8_BAR; }
    }
    PG8_WAIT_V(0);
    if constexpr (!ALIGN_EPI) { if (wr == 0) PG8_BAR; }
    PG8_BAR;
    if constexpr (Epi::AFTER_DRAIN) { E.fused(acc, cur, wr, wc, fr, fq, lds, wid, lane); S.done(cur); }
#undef PG8_SA
#undef PG8_SB
#undef PG8_STAGE
#undef PG8_LDA
#undef PG8_LDB
#undef PG8_MMA
#undef PG8_WAIT_V
#undef PG8_WAIT_L
#undef PG8_BAR
#undef PG8_SCHED
}
}

#ifndef MK_PER_PHASE
#define MK_PER_PHASE 0
#endif
constexpr int NB = 8, SEQ = 2048, DM = 2048, MTOK = NB * SEQ, DEPTH = 4, HD = 128;
constexpr int NMIX = 12, NMEMH = 4, NMEM = 256, DFF = 5632, NGU = 2 * DFF, NGRP = 2, HPG = 6;
constexpr int SB_N = 5120, NSA_N = 3840, NSA_SRC = 3620;
constexpr int SBQ = 0, SBK = 1536, SBV = 3072, SBQM = 4608;
constexpr int NQ = 0, NKC = 1536, NVC = 1792, NKS = 2048, NVS = 2304, NKW = 2560, NVW = 2816, NQM = 3072, NGL = 3584;
constexpr int NCMP = 127, CMPROWS = NB * NGRP * NCMP;
constexpr int WINDOW = 512;
constexpr float NORM_EPS = 1e-6f;
constexpr float SCALE = 0.08838834764831845f;
constexpr float LOG2E = 1.4426950408889634f;
constexpr int NWAVES = 8, NTHR = 512;

constexpr size_t MiB = 1u << 20;
constexpr size_t WS_CTL = 0, CTL_ZERO_BYTES = 1 * MiB;
constexpr size_t WS_WIN = 2 * MiB;
constexpr size_t WS_WO = 22 * MiB;
constexpr size_t WS_WGU = 30 * MiB;
constexpr size_t WS_WD = 74 * MiB;
constexpr size_t WS_WKV = 96 * MiB;
constexpr size_t WS_CW1 = 112 * MiB;
constexpr size_t WS_CW2 = 116 * MiB;
constexpr size_t WS_MEMB = 117 * MiB;
constexpr size_t WS_MEMKV = 125 * MiB;
constexpr size_t WS_COS = 141 * MiB, WS_SIN = 145 * MiB;
constexpr size_t WS_RSTD = 149 * MiB;
constexpr size_t WS_SEL = 150 * MiB;
constexpr size_t WS_KCMP = 151 * MiB;
constexpr size_t WS_XB = 152 * MiB;
constexpr size_t WS_TMP = 216 * MiB;
constexpr size_t WS_ACT = 280 * MiB;
constexpr size_t WS_GU = 456 * MiB;
constexpr size_t WS_PROJ = 456 * MiB;
constexpr size_t WS_OCAT = 616 * MiB;
constexpr size_t WS_HG = 680 * MiB, WS_FP = 684 * MiB, WS_FU = 688 * MiB;
constexpr size_t WS_HID = 692 * MiB;
constexpr size_t WS_BIAS1 = 694 * MiB;
constexpr size_t WS_END = 808 * MiB;
constexpr int CW_BAR = 4096;

constexpr int RING_BYTES = 131072;
constexpr int LDSCTL_OFF = 143360, MISC_OFF = LDSCTL_OFF + 320;
constexpr int LDS_BYTES = 147456;
constexpr int HALO_OFF = RING_BYTES;
constexpr int SHM_T = 16384;
constexpr int A_V = 0, A_K = 2 * SHM_T, A_WS = 4 * SHM_T, A_FLAGS = A_WS + NWAVES * 64 * 4, A_STASH = 67584;

#define GAS __attribute__((address_space(1)))
#define LAS __attribute__((address_space(3)))
typedef unsigned short bf16_t;
typedef unsigned v4u __attribute__((ext_vector_type(4)));
typedef unsigned v2u __attribute__((ext_vector_type(2)));
typedef float f32x4 __attribute__((ext_vector_type(4)));
typedef float f32x16 __attribute__((ext_vector_type(16)));
typedef short bf16x8 __attribute__((ext_vector_type(8)));
typedef short s16x4 __attribute__((ext_vector_type(4)));
typedef GAS unsigned gu32;
#define RLX_AGENT __ATOMIC_RELAXED, __HIP_MEMORY_SCOPE_AGENT
#define LDS_WAIT() asm volatile("s_waitcnt lgkmcnt(0)" ::: "memory")
#define VM_WAIT() asm volatile("s_waitcnt vmcnt(0)" ::: "memory")
#define SBAR() __builtin_amdgcn_sched_barrier(0)
__device__ __forceinline__ unsigned cvtpk(float lo, float hi) { unsigned r; asm volatile("v_cvt_pk_bf16_f32 %0, %1, %2" : "=v"(r) : "v"(lo), "v"(hi)); return r; }
__device__ __forceinline__ float bf2f(unsigned short b) { return __uint_as_float((unsigned)b << 16); }
__device__ __forceinline__ float bflo(unsigned w) { return __uint_as_float(w << 16); }
__device__ __forceinline__ float bfhi(unsigned w) { return __uint_as_float(w & 0xffff0000u); }
__device__ __forceinline__ bf16x8 pack8(f32x4 a, f32x4 b) { v4u w = {cvtpk(a[0], a[1]), cvtpk(a[2], a[3]), cvtpk(b[0], b[1]), cvtpk(b[2], b[3])}; return __builtin_bit_cast(bf16x8, w); }
__device__ __forceinline__ void unpack8(bf16x8 v, f32x4& a, f32x4& b) { const v4u w = __builtin_bit_cast(v4u, v); a = (f32x4){bflo(w.x), bfhi(w.x), bflo(w.y), bfhi(w.y)}; b = (f32x4){bflo(w.z), bfhi(w.z), bflo(w.w), bfhi(w.w)}; }
__device__ __forceinline__ float wave_sum(float v) {
#pragma unroll
    for (int o = 1; o < 64; o <<= 1) v += __shfl_xor(v, o);
    return v;
}
__device__ __forceinline__ float sigmoidf_(float x) { return __builtin_amdgcn_rcpf(1.f + __builtin_amdgcn_exp2f(-x * LOG2E)); }

__device__ const float INV_FREQ[64] = {1.000000000e+00f, 8.659643531e-01f, 7.498942018e-01f, 6.493816376e-01f, 5.623413324e-01f, 4.869675338e-01f, 4.216965139e-01f, 3.651741147e-01f, 3.162277639e-01f, 2.738419771e-01f, 2.371373773e-01f, 2.053525001e-01f, 1.778279394e-01f, 1.539926529e-01f, 1.333521456e-01f, 1.154781953e-01f, 1.000000015e-01f, 8.659642935e-02f, 7.498942316e-02f, 6.493816525e-02f, 5.623413250e-02f, 4.869675264e-02f, 4.216964915e-02f, 3.651741147e-02f, 3.162277490e-02f, 2.738419548e-02f, 2.371373773e-02f, 2.053525113e-02f, 1.778279431e-02f, 1.539926510e-02f, 1.333521400e-02f, 1.154781971e-02f, 9.999999776e-03f, 8.659643121e-03f, 7.498942316e-03f, 6.493816152e-03f, 5.623413250e-03f, 4.869675264e-03f, 4.216964822e-03f, 3.651741194e-03f, 3.162277630e-03f, 2.738419687e-03f, 2.371373819e-03f, 2.053525066e-03f, 1.778279431e-03f, 1.539926510e-03f, 1.333521446e-03f, 1.154782018e-03f, 1.000000047e-03f, 8.659643354e-04f, 7.498941850e-04f, 6.493816036e-04f, 5.623413017e-04f, 4.869675322e-04f, 4.216965172e-04f, 3.651741135e-04f, 3.162277571e-04f, 2.738419571e-04f, 2.371373703e-04f, 2.053525095e-04f, 1.778279402e-04f, 1.539926598e-04f, 1.333521504e-04f, 1.154782003e-04f};
#define XB_TMO      128
#define XB_XCNT(j)  (256  + 64 * (j))
#define XB_XSUB(j)  (1280 + 64 * (j))
#define XB_XGEN(j)  (2304 + 64 * (j))
#define XB_TOP      3328
#define XB_TOPGEN   3392
#define XCD_BAR_WORDS 3456
#define XB_SPIN_CAP (1u << 18)

__device__ __forceinline__ unsigned xb_ld(unsigned* p)              { return __hip_atomic_load(p, __ATOMIC_RELAXED, __HIP_MEMORY_SCOPE_AGENT); }
__device__ __forceinline__ unsigned xb_add(unsigned* p, unsigned v) { return __hip_atomic_fetch_add(p, v, __ATOMIC_RELAXED, __HIP_MEMORY_SCOPE_AGENT); }
__device__ __forceinline__ unsigned xb_xcc_id() { return (unsigned)__builtin_amdgcn_s_getreg((3 << 11) | 20) & 0xFu; }
#define XB_SPIN(cond, bar) do { unsigned _sp = 0; while (cond) { __builtin_amdgcn_s_sleep(1); \
    if ((++_sp & 255u) == 0u) { if (xb_ld(&(bar)[XB_TMO])) break; if (_sp > XB_SPIN_CAP) { atomicAdd(&(bar)[XB_TMO], 1u); break; } } } } while (0)

struct XcdBarrier {
    unsigned* bar; unsigned x;
    volatile LAS unsigned* st;
};

__device__ __forceinline__ XcdBarrier xcd_barrier_post(unsigned* bar, volatile LAS unsigned* st) {
    XcdBarrier b; b.bar = bar; b.x = xb_xcc_id(); b.st = st;
    if (threadIdx.x == 0) (void)xb_add(&bar[XB_XCNT(b.x)], 1u);
    return b;
}
__device__ __forceinline__ void xcd_barrier_complete(unsigned* bar, unsigned x, unsigned& nloc, unsigned& nx) {
    const unsigned G = gridDim.x * gridDim.y * gridDim.z;
    unsigned sum, cnt, mine, sp = 0u;
    for (;;) {
        sum = 0u; cnt = 0u; mine = 0u;
#pragma unroll
        for (unsigned j = 0; j < 16; ++j) { const unsigned c = xb_ld(&bar[XB_XCNT(j)]); sum += c; cnt += (c > 0u) ? 1u : 0u; mine = (j == x) ? c : mine; }
        if (sum == G) break;
        __builtin_amdgcn_s_sleep(1);
        if ((++sp & 255u) == 0u) { if (xb_ld(&bar[XB_TMO])) break; if (sp > XB_SPIN_CAP) { atomicAdd(&bar[XB_TMO], 1u); break; } }
    }
    nloc = mine > 0u ? mine : 1u; nx = cnt > 0u ? cnt : 1u;
}

__device__ __forceinline__ void xcd_barrier(const XcdBarrier& b) {
    asm volatile("s_waitcnt vmcnt(0)" ::: "memory");
    __syncthreads();
    if (threadIdx.x == 0) {
        unsigned* bar = b.bar;
        __builtin_amdgcn_s_waitcnt(0);
        unsigned nloc = b.st[0], nx = b.st[1];
        if (nloc == 0u) { xcd_barrier_complete(bar, b.x, nloc, nx); b.st[0] = nloc; b.st[1] = nx; }
        const unsigned old = xb_add(&bar[XB_XSUB(b.x)], 1u);
        const unsigned gen = old / nloc;
        if (old + 1u == (gen + 1u) * nloc) {
            __builtin_amdgcn_fence(__ATOMIC_RELEASE, "agent");
            asm volatile("s_waitcnt vmcnt(0)" ::: "memory");
            const unsigned og = xb_add(&bar[XB_TOP], 1u);
            const unsigned tg = og / nx;
            if (og + 1u == (tg + 1u) * nx) xb_add(&bar[XB_TOPGEN], 1u);
            else XB_SPIN(xb_ld(&bar[XB_TOPGEN]) == tg, bar);
            __builtin_amdgcn_fence(__ATOMIC_ACQUIRE, "agent");
            xb_add(&bar[XB_XGEN(b.x)], 1u);
            asm volatile("s_waitcnt vmcnt(0)" ::: "memory");
        } else {
            XB_SPIN(xb_ld(&bar[XB_XGEN(b.x)]) == gen, bar);
            __builtin_amdgcn_fence(__ATOMIC_ACQUIRE, "agent");
            asm volatile("s_waitcnt vmcnt(0)" ::: "memory");
        }
    }
    __syncthreads();
}

#define KSWZ(row, colB) ((row) * 256 + ((colB) ^ (((row) & 7) << 4)))
__device__ __forceinline__ int v_st(int k, int c) { const int kk = (k & ~0xC) | ((k & 4) << 1) | ((k & 8) >> 1); return ((kk >> 3) * 4 + (c >> 5)) * 512 + ((kk & 7) * 32 + (c & 31)) * 2; }
__device__ __forceinline__ int v_rd_base(int lane) { return ((lane & 3) << 3) | (((lane >> 2) & 3) << 6) | (((lane >> 4) & 1) << 5) | (((lane >> 5) & 1) << 8); }
constexpr int v_rd_off(int d0, int ks, int half) { return d0 * 512 + ks * 4096 + half * 2048; }
__device__ __forceinline__ int crow(int r, int hi) { return (r & 3) + 8 * (r >> 2) + 4 * hi; }

struct ACtx {
    LAS unsigned char* lds;
    int tid, wid, lane, r32, hi, sr, sc, kws, vst0, vst1, vb0;
    LAS float* ws;
};
__device__ __forceinline__ ACtx make_actx(LAS unsigned char* lds) {
    ACtx c; c.lds = lds; { int t_ = threadIdx.x; asm volatile("" : "+v"(t_)); c.tid = t_; } c.wid = __builtin_amdgcn_readfirstlane(c.tid >> 6); c.lane = c.tid & 63; c.r32 = c.lane & 31; c.hi = c.lane >> 5;
    c.sr = c.tid >> 4; c.sc = (c.tid & 15) * 8; c.kws = KSWZ(c.sr, c.sc * 2); c.vst0 = v_st(c.sr, c.sc); c.vst1 = v_st(32 + c.sr, c.sc);
    c.vb0 = (int)(unsigned)(size_t)(lds + A_V) + v_rd_base(c.lane);
    c.ws = (LAS float*)(lds + A_WS) + c.wid * 64;
    return c;
}
struct Stage { bf16x8 k0, k1, v0, v1; };
__device__ __forceinline__ void stage_load(Stage& S, const bf16_t* Kp, const bf16_t* Vp, int pitch, int kb, const ACtx& c) {
    S.v0 = *(const bf16x8*)(Vp + (size_t)(kb + c.sr) * pitch + c.sc); S.v1 = *(const bf16x8*)(Vp + (size_t)(kb + 32 + c.sr) * pitch + c.sc);
    S.k0 = *(const bf16x8*)(Kp + (size_t)(kb + c.sr) * pitch + c.sc); S.k1 = *(const bf16x8*)(Kp + (size_t)(kb + 32 + c.sr) * pitch + c.sc);
}
__device__ __forceinline__ void stage_write(const Stage& S, int buf, const ACtx& c) {
    LAS unsigned char* Kb = c.lds + A_K + buf * SHM_T; LAS unsigned char* Vb = c.lds + A_V + buf * SHM_T;
    *(LAS bf16x8*)(Kb + c.kws) = S.k0; *(LAS bf16x8*)(Kb + c.kws + 32 * 256) = S.k1;
    *(LAS bf16x8*)(Vb + c.vst0) = S.v0; *(LAS bf16x8*)(Vb + c.vst1) = S.v1;
}
__device__ __forceinline__ void qkt(f32x16& p0, f32x16& p1, int buf, const ACtx& c, const bf16x8* qr) {
    p0 = (f32x16){}; p1 = (f32x16){};
    const LAS unsigned char* Kb = c.lds + A_K + buf * SHM_T;
    const LAS unsigned char* kb[4];
#pragma unroll
    for (int dd = 0; dd < 4; ++dd) kb[dd] = Kb + KSWZ(c.r32, (dd * 16 + c.hi * 8) * 2);
#pragma unroll
    for (int d0 = 0; d0 < 8; ++d0) { const LAS unsigned char* a = kb[d0 & 3] + (d0 >> 2) * 128;
        const bf16x8 b0 = *(const LAS bf16x8*)a; const bf16x8 b1 = *(const LAS bf16x8*)(a + 32 * 256);
        p0 = __builtin_amdgcn_mfma_f32_32x32x16_bf16(b0, qr[d0], p0, 0, 0, 0);
        p1 = __builtin_amdgcn_mfma_f32_32x32x16_bf16(b1, qr[d0], p1, 0, 0, 0); }
}
__device__ __forceinline__ void pv_tile(f32x16* o, int buf, const ACtx& c, bf16x8 pa0, bf16x8 pa1, bf16x8 pa2, bf16x8 pa3) {
    const int vb = c.vb0 + buf * SHM_T;
#define TRRD(dst, off) asm volatile("ds_read_b64_tr_b16 %0, %1 offset:%2" : "=&v"(dst) : "v"(vb), "i"(off) : "memory")
#define PV_D0(d0) do { s16x4 l0, l1, l2, l3, h0, h1, h2, h3; constexpr int b_ = v_rd_off(d0, 0, 0); \
        TRRD(l0, b_); TRRD(h0, b_ + 2048); TRRD(l1, b_ + 4096); TRRD(h1, b_ + 6144); TRRD(l2, b_ + 8192); TRRD(h2, b_ + 10240); TRRD(l3, b_ + 12288); TRRD(h3, b_ + 14336); \
        asm volatile("s_waitcnt lgkmcnt(0)" ::: "memory"); SBAR(); \
        o[d0] = __builtin_amdgcn_mfma_f32_32x32x16_bf16(pa0, (bf16x8){l0[0], l0[1], l0[2], l0[3], h0[0], h0[1], h0[2], h0[3]}, o[d0], 0, 0, 0); \
        o[d0] = __builtin_amdgcn_mfma_f32_32x32x16_bf16(pa1, (bf16x8){l1[0], l1[1], l1[2], l1[3], h1[0], h1[1], h1[2], h1[3]}, o[d0], 0, 0, 0); \
        o[d0] = __builtin_amdgcn_mfma_f32_32x32x16_bf16(pa2, (bf16x8){l2[0], l2[1], l2[2], l2[3], h2[0], h2[1], h2[2], h2[3]}, o[d0], 0, 0, 0); \
        o[d0] = __builtin_amdgcn_mfma_f32_32x32x16_bf16(pa3, (bf16x8){l3[0], l3[1], l3[2], l3[3], h3[0], h3[1], h3[2], h3[3]}, o[d0], 0, 0, 0); } while (0)
    PV_D0(0); PV_D0(1); PV_D0(2); PV_D0(3);
#undef PV_D0
#undef TRRD
}
__device__ __forceinline__ float swap_max(float v) { auto rr = __builtin_amdgcn_permlane32_swap(__float_as_uint(v), __float_as_uint(v), false, false); return fmaxf(__uint_as_float(rr[0]), __uint_as_float(rr[1])); }
__device__ __forceinline__ float swap_sum(float v) { auto rr = __builtin_amdgcn_permlane32_swap(__float_as_uint(v), __float_as_uint(v), false, false); return __uint_as_float(rr[0]) + __uint_as_float(rr[1]); }
__device__ __forceinline__ void swap_both(float v, float& lo, float& hi) { auto rr = __builtin_amdgcn_permlane32_swap(__float_as_uint(v), __float_as_uint(v), false, false); lo = __uint_as_float(rr[0]); hi = __uint_as_float(rr[1]); }
__device__ __forceinline__ void pack_p(const f32x16& p0, const f32x16& p1, bf16x8& pa0, bf16x8& pa1, bf16x8& pa2, bf16x8& pa3) {
#define PK4(P, B_, OUT) do { unsigned a0 = cvtpk(P[B_+0], P[B_+1]), a1 = cvtpk(P[B_+2], P[B_+3]); \
        unsigned b0 = cvtpk(P[B_+4], P[B_+5]), b1 = cvtpk(P[B_+6], P[B_+7]); \
        auto r0 = __builtin_amdgcn_permlane32_swap(a0, b0, false, false); auto r1 = __builtin_amdgcn_permlane32_swap(a1, b1, false, false); \
        v4u w = {r0[0], r1[0], r0[1], r1[1]}; OUT = __builtin_bit_cast(bf16x8, w); } while (0)
    PK4(p0, 0, pa0); PK4(p0, 8, pa1); PK4(p1, 0, pa2); PK4(p1, 8, pa3);
#undef PK4
}
__device__ __forceinline__ void mask_tile(f32x16& p0, f32x16& p1, int dq, unsigned W) {
    const float NEG = -__builtin_inff();
#pragma unroll
    for (int r = 0; r < 16; ++r) { const int cc = (r & 3) + 8 * (r >> 2);
        if ((unsigned)(dq - cc) >= W) p0[r] = NEG;
        if ((unsigned)(dq - cc - 32) >= W) p1[r] = NEG; }
}
constexpr float THR = 8.f;
__device__ __forceinline__ void softmax_tile(f32x16& p0, f32x16& p1, float& m_reg, float& l_reg, f32x16* o, const ACtx& c) {
    float pmax = p0[0];
#pragma unroll
    for (int r = 1; r < 16; ++r) pmax = fmaxf(pmax, p0[r]);
#pragma unroll
    for (int r = 0; r < 16; ++r) pmax = fmaxf(pmax, p1[r]);
    pmax = swap_max(pmax);
    constexpr float C2 = LOG2E * SCALE;
    float mn, alpha;
    if (__all((pmax - m_reg) * SCALE <= THR)) { mn = m_reg; alpha = 1.f; }
    else { mn = fmaxf(m_reg, pmax); alpha = __builtin_amdgcn_exp2f((m_reg - mn) * C2); m_reg = mn; }
    const float mnL = -mn * C2;
#pragma unroll
    for (int r = 0; r < 16; ++r) { p0[r] = __builtin_amdgcn_exp2f(fmaf(p0[r], C2, mnL)); p1[r] = __builtin_amdgcn_exp2f(fmaf(p1[r], C2, mnL)); }
    float ps = 0.f;
#pragma unroll
    for (int r = 0; r < 16; ++r) ps += p0[r] + p1[r];
    ps = swap_sum(ps);
    l_reg = l_reg * alpha + ps;
    if (__any(alpha < 1.f)) {
        if (c.hi == 0) c.ws[32 + c.r32] = alpha;
        LDS_WAIT();
#pragma unroll
        for (int r = 0; r < 16; ++r) { const float a = c.ws[32 + crow(r, c.hi)];
#pragma unroll
            for (int d = 0; d < 4; ++d) o[d][r] *= a; }
    }
}
__device__ __forceinline__ void row_factors(float f, float (&fr)[16], const ACtx& c) {
    LDS_WAIT();
    if (c.hi == 0) c.ws[c.r32] = f;
    LDS_WAIT();
#pragma unroll
    for (int r = 0; r < 16; ++r) fr[r] = c.ws[crow(r, c.hi)];
    LDS_WAIT();
}
template <bool ROPE>
__device__ __forceinline__ void load_q(bf16x8 (&qr)[8], const bf16_t* qrow, const float* cosr, const float* sinr, int hi) {
#pragma unroll
    for (int d0 = 0; d0 < 8; ++d0) qr[d0] = *(const bf16x8*)(qrow + d0 * 16 + hi * 8);
    if constexpr (ROPE) {
#pragma unroll
        for (int d0 = 0; d0 < 4; ++d0) {
            const int i0 = d0 * 16 + hi * 8;
            const f32x4 c0 = *(const f32x4*)(cosr + i0), c1 = *(const f32x4*)(cosr + i0 + 4), s0 = *(const f32x4*)(sinr + i0), s1 = *(const f32x4*)(sinr + i0 + 4);
            f32x4 a0, a1, b0, b1; unpack8(qr[d0], a0, a1); unpack8(qr[d0 + 4], b0, b1);
            qr[d0] = pack8(a0 * c0 - b0 * s0, a1 * c1 - b1 * s1);
            qr[d0 + 4] = pack8(b0 * c0 + a0 * s0, b1 * c1 + a1 * s1);
        }
    }
}
__device__ __forceinline__ void store_o_bf16(const f32x16* o, bf16_t* Ow  , int pitch, const ACtx& c) {
#pragma unroll
    for (int r = 0; r < 16; ++r) { const int orow = crow(r, c.hi);
#pragma unroll
        for (int d0 = 0; d0 < 4; ++d0) { const float v = o[d0][r]; const float vn = __shfl_xor(v, 1);
            if ((c.r32 & 1) == 0) *(unsigned*)(Ow + (size_t)orow * pitch + d0 * 32 + c.r32) = cvtpk(v, vn); } }
}

__device__ __forceinline__ void add_o_bf16(f32x16* o, const bf16_t* Ow, int pitch, const ACtx& c) {
#pragma unroll
    for (int r = 0; r < 16; ++r) { const int orow = crow(r, c.hi);
#pragma unroll
        for (int d0 = 0; d0 < 4; ++d0) o[d0][r] += bf2f(Ow[(size_t)orow * pitch + d0 * 32 + c.r32]); }
}
__device__ __forceinline__ int wq_next(gu32* ctr, LAS int* slot, int tid) {
    __syncthreads();
    if (tid == 0) *slot = (int)__hip_atomic_fetch_add(ctr, 1u, RLX_AGENT);
    __syncthreads();
    return *slot;
}
template <int MODE>
__device__ __forceinline__ void softmax_sweep(const ACtx& c, const bf16x8 (&qr)[8], f32x16 (&o)[4], float& l_out, const bf16_t* Kp, const bf16_t* Vp, int pitch,
                                              int j_lo, int j_hi, int qpos, int qlo, unsigned selbits) {
    float m_reg = -1e30f, l_reg = 0.f;
#pragma unroll
    for (int d = 0; d < 4; ++d) o[d] = (f32x16){};
    Stage S; stage_load(S, Kp, Vp, pitch, j_lo * 64, c);
    for (int j = j_lo; j < j_hi; ++j) {
        const int buf = (j - j_lo) & 1;
        stage_write(S, buf, c);
        __syncthreads();
        if (j + 1 < j_hi) stage_load(S, Kp, Vp, pitch, (j + 1) * 64, c);
        const int kb = j * 64;
        bool act = true;
        if (MODE == 1) act = (kb <= qlo + 31) && (kb + 63 >= qlo - (WINDOW - 1));
        if (MODE == 2) act = (kb <= qlo + 31) && __any((int)((selbits >> j) & 1u));
        if (act) {
            f32x16 p0, p1; qkt(p0, p1, buf, c, qr);
            if (MODE == 1) { if (kb + 63 > qlo || kb < qlo + 31 - (WINDOW - 1)) mask_tile(p0, p1, qpos - kb - 4 * c.hi, (unsigned)WINDOW); }
            if (MODE == 2) { if (kb + 63 > qlo) mask_tile(p0, p1, qpos - kb - 4 * c.hi, 0x7fffffffu);
                if (!__all((int)((selbits >> j) & 1u))) { if (!((selbits >> j) & 1u)) { const float NEG = -__builtin_inff();
#pragma unroll
                    for (int r = 0; r < 16; ++r) { p0[r] = NEG; p1[r] = NEG; } } } }
            softmax_tile(p0, p1, m_reg, l_reg, o, c);
            bf16x8 pa0, pa1, pa2, pa3; pack_p(p0, p1, pa0, pa1, pa2, pa3);
            pv_tile(o, buf, c, pa0, pa1, pa2, pa3);
        }
    }
    __syncthreads();
    l_out = l_reg;
}

struct Params {
    const float* x; const float* mem; const int* positions; const float* norm_g; const float* w_in_sb; const float* w_in_nsa; const float* cmp_pe; const float* cmp_w1; const float* cmp_w2;
    const float* w_mem_kv; const float* w_o; const float* w_gate; const float* w_up; const float* conv_w; const float* conv_b; const float* w_down;
    float* out; unsigned char* ws; int ph_lo, ph_hi;
};
struct Frame {
    LAS unsigned char* lds; int tid, lane, wave, G, bid;
};
#define WSP(T, off) ((T*)(p.ws + (off)))

__device__ __forceinline__ void tr_item(const float* W, int K, int Nsrc, int src_col0, int ncols, const float* gain, bf16_t* WT, int dst_row0, int mode, int item, int lane) {
    const int nblk = (ncols + 255) >> 8, kb = item / nblk, nb = item - kb * nblk, k0 = 16 * kb, n = nb * 256 + 4 * lane;
    if (n >= ncols) return;
    f32x4 v[16];
    if (W != nullptr) {
        const float* src = W + (size_t)k0 * Nsrc + src_col0 + n;
#pragma unroll
        for (int j = 0; j < 16; ++j) v[j] = *(const f32x4*)(src + (size_t)j * Nsrc);
        if (gain) {
#pragma unroll
            for (int j = 0; j < 16; ++j) v[j] = v[j] * gain[k0 + j];
        }
    } else {
#pragma unroll
        for (int j = 0; j < 16; ++j) v[j] = (f32x4){0.f, 0.f, 0.f, 0.f};
    }
#pragma unroll
    for (int e = 0; e < 4; ++e) {
        const int nn = n + e; const int drow = dst_row0 + (mode == 0 ? nn : 256 * (nn >> 7) + (nn & 127));
        v4u o0, o1;
        o0.x = cvtpk(v[0][e], v[1][e]); o0.y = cvtpk(v[2][e], v[3][e]); o0.z = cvtpk(v[4][e], v[5][e]); o0.w = cvtpk(v[6][e], v[7][e]);
        o1.x = cvtpk(v[8][e], v[9][e]); o1.y = cvtpk(v[10][e], v[11][e]); o1.z = cvtpk(v[12][e], v[13][e]); o1.w = cvtpk(v[14][e], v[15][e]);
        v4u* dst = (v4u*)(WT + (size_t)drow * K + k0); dst[0] = o0; dst[1] = o1;
    }
}
__device__ __forceinline__ void row_to_bf16_rstd(const float* xrow, bf16_t* orow, float* rstd_out, int lane) {
    const f32x4* xr = (const f32x4*)xrow + lane; f32x4 v[8]; float s = 0.f;
#pragma unroll
    for (int j = 0; j < 8; ++j) { v[j] = xr[64 * j]; s += (v[j].x * v[j].x + v[j].y * v[j].y) + (v[j].z * v[j].z + v[j].w * v[j].w); }
    s = wave_sum(s);
    v2u* o8 = (v2u*)orow + lane;
#pragma unroll
    for (int j = 0; j < 8; ++j) { v2u w; w.x = cvtpk(v[j].x, v[j].y); w.y = cvtpk(v[j].z, v[j].w); o8[64 * j] = w; }
    if (lane == 0) *rstd_out = 1.0f / sqrtf(s * (1.0f / DM) + NORM_EPS);
}
template <class PP> __device__ __forceinline__ void phase_convert(const PP& p, const Frame& F, int L) {
    const int gw = F.bid * NWAVES + F.wave, NGW = F.G * NWAVES;
    int it0 = gw;
#define TR(W, K, Nsrc, sc0, nc, gain, WT, dr0, mode) do { const int n_ = ((K) / 16) * (((nc) + 255) >> 8); for (; it0 < n_; it0 += NGW) tr_item(W, K, Nsrc, sc0, nc, gain, WT, dr0, mode, it0, F.lane); it0 -= n_; } while (0)
    const float* g = p.norm_g + (size_t)L * 5 * DM;
    const int j = L >> 1;
    bf16_t* WIN = WSP(bf16_t, WS_WIN);
    if ((L & 1) == 0) {
        TR(p.w_in_sb + (size_t)j * DM * SB_N, DM, SB_N, 0, SB_N, g, WIN, 0, 0);
    } else {
        const float* W = p.w_in_nsa + (size_t)j * DM * NSA_SRC;
        TR(W, DM, NSA_SRC, 0, 3072, g, WIN, 0, 0);
        TR(W, DM, NSA_SRC, 3108, 512, g, WIN, NQM, 0);
        TR(W, DM, NSA_SRC, 3072, 36, g, WIN, NGL, 0);
        TR((const float*)nullptr, DM, NSA_SRC, 0, 220, (const float*)nullptr, WIN, NGL + 36, 0);
        for (int wh = 0; wh < 2; ++wh) {
            TR(p.cmp_w1 + (size_t)(j * 2 + wh) * 4096 * 256, 4096, 256, 0, 256, (const float*)nullptr, WSP(bf16_t, WS_CW1) + (size_t)wh * 256 * 4096, 0, 0);
            TR(p.cmp_w2 + (size_t)(j * 2 + wh) * 256 * 128, 256, 128, 0, 128, (const float*)nullptr, WSP(bf16_t, WS_CW2) + (size_t)wh * 128 * 256, 0, 0);
        }
    }
    if ((L & 1) && F.bid < 16) {
        const int wh = F.bid >> 3, n = 32 * (F.bid & 7) + (F.tid & 31), kg = F.tid >> 5;
        const float* pe = p.cmp_pe + (size_t)(j * 2 + wh) * 4096; const float* w1 = p.cmp_w1 + (size_t)(j * 2 + wh) * 4096 * 256;
        float s = 0.f;
        for (int k = kg * 256; k < kg * 256 + 256; ++k) s += pe[k] * w1[(size_t)k * 256 + n];
        LAS float* red = (LAS float*)F.lds;
        red[kg * 32 + (F.tid & 31)] = s;
        __syncthreads();
        if (F.tid < 32) { float t = 0.f;
#pragma unroll
            for (int q = 0; q < 16; ++q) t += red[q * 32 + F.tid];
            WSP(float, WS_BIAS1)[wh * 256 + n] = t; }
        __syncthreads();
    }
    TR(p.w_o + (size_t)L * DM * DM, DM, DM, 0, DM, (const float*)nullptr, WSP(bf16_t, WS_WO), 0, 0);
    TR(p.w_gate + (size_t)L * DM * DFF, DM, DFF, 0, DFF, g + 2 * DM, WSP(bf16_t, WS_WGU), 0, 1);
    TR(p.w_up + (size_t)L * DM * DFF, DM, DFF, 0, DFF, g + 2 * DM, WSP(bf16_t, WS_WGU), 128, 1);
    TR(p.w_down + (size_t)L * DFF * DM, DFF, DM, 0, DM, (const float*)nullptr, WSP(bf16_t, WS_WD), 0, 0);
    if (L == 0) {
        for (int l = 0; l < DEPTH; ++l)
            TR(p.w_mem_kv + (size_t)l * DM * 1024, DM, 1024, 0, 1024, p.norm_g + (size_t)(l * 5 + 4) * DM, WSP(bf16_t, WS_WKV), l * 1024, 0);
        float* rstd = WSP(float, WS_RSTD);
        for (int m = gw; m < MTOK; m += NGW) row_to_bf16_rstd(p.x + (size_t)m * DM, WSP(bf16_t, WS_XB) + (size_t)m * DM, rstd + m, F.lane);
        for (int m = gw; m < NB * NMEM; m += NGW) row_to_bf16_rstd(p.mem + (size_t)m * DM, WSP(bf16_t, WS_MEMB) + (size_t)m * DM, rstd + 16384 + m, F.lane);
        float* cosT = WSP(float, WS_COS); float* sinT = WSP(float, WS_SIN);
        for (int idx = F.bid * NTHR + F.tid; idx < MTOK * 64; idx += F.G * NTHR) {
            const int row = idx >> 6, i = idx & 63;
            const float ang = (float)p.positions[row] * INV_FREQ[i];
            double t = (double)ang * 0.15915494309189535; t -= __builtin_rint(t);
            const float fr = (float)t;
            cosT[idx] = __builtin_amdgcn_cosf(fr); sinT[idx] = __builtin_amdgcn_sinf(fr);
        }
    }
#undef TR
}

template <class PP> __device__ __forceinline__ void phase_resid(const PP& p, const Frame& F, const float* xin, const float* gpost, float* xout, bf16_t* XB, float* rstd) {
    const int gw = F.bid * NWAVES + F.wave, NGW = F.G * NWAVES;
    const bf16_t* T = WSP(bf16_t, WS_TMP);
    for (int m = gw; m < MTOK; m += NGW) {
        const bf16x8* ar = (const bf16x8*)(T + (size_t)m * DM) + F.lane;
        f32x4 a[8]; float s = 0.f;
#pragma unroll
        for (int j = 0; j < 4; ++j) { unpack8(ar[64 * j], a[2 * j], a[2 * j + 1]); }
#pragma unroll
        for (int j = 0; j < 8; ++j) s += (a[j].x * a[j].x + a[j].y * a[j].y) + (a[j].z * a[j].z + a[j].w * a[j].w);
        const float ra = 1.0f / sqrtf(wave_sum(s) * (1.0f / DM) + NORM_EPS);
        float s2 = 0.f;
#pragma unroll
        for (int j = 0; j < 4; ++j) {
            const int e0 = (j * 64 + F.lane) * 8;
#pragma unroll
            for (int h = 0; h < 2; ++h) {
                const f32x4 xv = *(const f32x4*)(xin + (size_t)m * DM + e0 + 4 * h), gv = *(const f32x4*)(gpost + e0 + 4 * h);
                const f32x4 y = xv + a[2 * j + h] * ra * gv;
                a[2 * j + h] = y; s2 += (y.x * y.x + y.y * y.y) + (y.z * y.z + y.w * y.w);
                *(f32x4*)(xout + (size_t)m * DM + e0 + 4 * h) = y;
            }
            *((bf16x8*)(XB + (size_t)m * DM) + 64 * j + F.lane) = pack8(a[2 * j], a[2 * j + 1]);
        }
        s2 = wave_sum(s2);
        if (F.lane == 0) rstd[m] = 1.0f / sqrtf(s2 * (1.0f / DM) + NORM_EPS);
    }
}
template <class PP> __device__ __forceinline__ void phase_convfix(const PP& p, const Frame& F, int L) {
    bf16_t* ACT = WSP(bf16_t, WS_ACT); const float* HG = WSP(float, WS_HG); const float* FP = WSP(float, WS_FP); const float* FU = WSP(float, WS_FU);
    const float* cw = p.conv_w + (size_t)L * 3 * DFF;
    constexpr int NCH = DFF / 4;
    for (int it = F.bid * NTHR + F.tid; it < 64 * 2 * NCH; it += F.G * NTHR) {
        const int pm = it / (2 * NCH), rem = it - pm * 2 * NCH, i = rem / NCH, f0 = (rem - i * NCH) * 4;
        if ((pm & 7) == 0) continue;
        const f32x4 h0 = *(const f32x4*)(HG + (size_t)((pm - 1) * 2 + 0) * DFF + f0), h1 = *(const f32x4*)(HG + (size_t)((pm - 1) * 2 + 1) * DFF + f0);
        const f32x4 w0 = *(const f32x4*)(cw + f0), w1 = *(const f32x4*)(cw + DFF + f0);
        f32x4 gc = *(const f32x4*)(FP + (size_t)(pm * 2 + i) * DFF + f0); const f32x4 uu = *(const f32x4*)(FU + (size_t)(pm * 2 + i) * DFF + f0);
        if (i == 0) gc += w0 * h0 + w1 * h1; else gc += w0 * h1;
        v2u o; o.x = cvtpk(gc[0] * sigmoidf_(gc[0]) * uu[0], gc[1] * sigmoidf_(gc[1]) * uu[1]); o.y = cvtpk(gc[2] * sigmoidf_(gc[2]) * uu[2], gc[3] * sigmoidf_(gc[3]) * uu[3]);
        *(v2u*)(ACT + (size_t)(pm * 256 + i) * DFF + f0) = o;
    }
}

template <class PP> __device__ __forceinline__ void sb_unit(const PP& p, const ACtx& c, int b, int h, int qt) {
    const bf16_t* PR = WSP(bf16_t, WS_PROJ); bf16_t* OC = WSP(bf16_t, WS_OCAT);
    const int P0 = qt * 256, qlo = P0 + c.wid * 32, qpos = qlo + c.r32;
    const size_t rowb = (size_t)b * SEQ;
    bf16x8 qr[8]; load_q<false>(qr, PR + (rowb + qpos) * SB_N + SBQ + h * HD, nullptr, nullptr, c.hi);
    const bf16_t* Kp = PR + rowb * SB_N + SBK + h * HD; const bf16_t* Vp = PR + rowb * SB_N + SBV + h * HD;
    f32x16 o[4];
#pragma unroll
    for (int d = 0; d < 4; ++d) o[d] = (f32x16){};
    float C2 = 0.f;
    const int jt = (P0 >> 6) + 3;
    LAS int* flags = (LAS int*)(c.lds + A_FLAGS);
    int done_w = 0;
    Stage S; stage_load(S, Kp, Vp, SB_N, jt * 64, c);
    constexpr float ZS = SCALE * LOG2E;
    for (int it = 0; it <= jt; ++it) {
        const int j = jt - it, buf = it & 1;
        stage_write(S, buf, c);
        if (c.lane == 0) flags[buf * 8 + c.wid] = done_w;
        __syncthreads();
        int alld = 1;
#pragma unroll
        for (int w = 0; w < 8; ++w) alld &= flags[buf * 8 + w];
        if (alld) break;
        if (j > 0) stage_load(S, Kp, Vp, SB_N, (j - 1) * 64, c);
        const int kb = j * 64;
        if (!done_w && kb <= qlo + 30) {
            f32x16 p0, p1; qkt(p0, p1, buf, c, qr);
            const int dq = qpos - kb - 4 * c.hi;
#pragma unroll
            for (int r = 0; r < 16; ++r) { const int cc = (r & 3) + 8 * (r >> 2);
                { const float z = p0[r] * ZS; const float t = __builtin_amdgcn_exp2f(-fabsf(z)); const float v = -(fmaxf(z, 0.f) + __builtin_amdgcn_logf(1.f + t)); p0[r] = (cc < dq) ? v : 0.f; }
                { const float z = p1[r] * ZS; const float t = __builtin_amdgcn_exp2f(-fabsf(z)); const float v = -(fmaxf(z, 0.f) + __builtin_amdgcn_logf(1.f + t)); p1[r] = (cc + 32 < dq) ? v : 0.f; } }
            float E[8], Od[8];
#pragma unroll
            for (int q = 0; q < 4; ++q) { const float g0 = (p0[4 * q] + p0[4 * q + 1]) + (p0[4 * q + 2] + p0[4 * q + 3]); swap_both(g0, E[q], Od[q]);
                                          const float g1 = (p1[4 * q] + p1[4 * q + 1]) + (p1[4 * q + 2] + p1[4 * q + 3]); swap_both(g1, E[4 + q], Od[4 + q]); }
            float T = 0.f, ex[8];
#pragma unroll
            for (int q = 7; q >= 0; --q) { const float to = T; T += Od[q]; const float te = T; T += E[q]; ex[q] = c.hi ? to : te; }
#pragma unroll
            for (int q = 0; q < 4; ++q) {
                { float R = C2 + ex[q]; float ep = __builtin_amdgcn_exp2f(R);
#pragma unroll
                  for (int i = 3; i >= 0; --i) { R += p0[4 * q + i]; const float e = __builtin_amdgcn_exp2f(R); p0[4 * q + i] = ep - e; ep = e; } }
                { float R = C2 + ex[4 + q]; float ep = __builtin_amdgcn_exp2f(R);
#pragma unroll
                  for (int i = 3; i >= 0; --i) { R += p1[4 * q + i]; const float e = __builtin_amdgcn_exp2f(R); p1[4 * q + i] = ep - e; ep = e; } }
            }
            C2 += T;
            bf16x8 pa0, pa1, pa2, pa3; pack_p(p0, p1, pa0, pa1, pa2, pa3);
            pv_tile(o, buf, c, pa0, pa1, pa2, pa3);
            done_w = __all(C2 < -72.f) ? 1 : 0;
        }
    }
    __syncthreads();
    store_o_bf16(o, OC + (rowb + qlo) * DM + h * HD, DM, c);
}
template <class PP> __device__ __forceinline__ void mem_unit(const PP& p, const ACtx& c, int L, int b, int hm, int qt, int projN, int qmcol) {
    const bf16_t* PR = WSP(bf16_t, WS_PROJ); bf16_t* OC = WSP(bf16_t, WS_OCAT); const bf16_t* MKV = WSP(bf16_t, WS_MEMKV);
    const int P0 = qt * 256, qlo = P0 + c.wid * 32, qpos = qlo + c.r32;
    const size_t rowb = (size_t)b * SEQ;
    bf16x8 qr[8]; load_q<false>(qr, PR + (rowb + qpos) * projN + qmcol + hm * HD, nullptr, nullptr, c.hi);
    const bf16_t* Kp = MKV + (size_t)b * NMEM * 4096 + L * 1024 + hm * HD; const bf16_t* Vp = Kp + 512;
    f32x16 o[4]; float l;
    softmax_sweep<0>(c, qr, o, l, Kp, Vp, 4096, 0, 4, qpos, qlo, 0u);
    float fr[16]; row_factors(1.0f / l, fr, c);
#pragma unroll
    for (int d = 0; d < 4; ++d)
#pragma unroll
        for (int r = 0; r < 16; ++r) o[d][r] *= fr[r];
    store_o_bf16(o, OC + (rowb + qlo) * DM + NMIX * HD + hm * HD, DM, c);
}
template <class PP> __device__ __forceinline__ void phase_attn_sb(const PP& p, const Frame& F, int L, gu32* ctr) {
    const ACtx c = make_actx(F.lds);
    LAS int* slot = (LAS int*)(F.lds + MISC_OFF) + 16;
    constexpr int NSBU = NB * NMIX * 8, NMU = NB * NMEMH * 8;
    for (;;) { const int u = wq_next(ctr, slot, c.tid); if (u >= NSBU + NMU) break;
        if (u < NSBU) { const int qt = 7 - (u / (NB * NMIX)), bh = u % (NB * NMIX); sb_unit(p, c, bh / NMIX, bh % NMIX, qt); }
        else { const int v = u - NSBU; const int qt = v % 8, bh = v / 8; mem_unit(p, c, L, bh / NMEMH, bh % NMEMH, qt, SB_N, SBQM); }
    }
}

template <class PP> __device__ __forceinline__ void phase_rope(const PP& p, const Frame& F) {
    bf16_t* PR = WSP(bf16_t, WS_PROJ); const float* cosT = WSP(float, WS_COS); const float* sinT = WSP(float, WS_SIN);
    const int lane = F.lane, gw = F.bid * NWAVES + F.wave, NGW = F.G * NWAVES;
    for (int m = gw; m < MTOK; m += NGW) {
        const float cv = cosT[(size_t)m * 64 + lane], sv = sinT[(size_t)m * 64 + lane];
        bf16_t* rowp = PR + (size_t)m * NSA_N;
        float x1[6], x2[6];
#pragma unroll
        for (int q = 0; q < 6; ++q) { const int base = ((q < 2) ? NKC : (q < 4) ? NKS : NKW) + (q & 1) * HD; x1[q] = bf2f(rowp[base + lane]); x2[q] = bf2f(rowp[base + 64 + lane]); }
#pragma unroll
        for (int q = 0; q < 6; ++q) { const int base = ((q < 2) ? NKC : (q < 4) ? NKS : NKW) + (q & 1) * HD;
            const float y1 = x1[q] * cv - x2[q] * sv, y2 = x2[q] * cv + x1[q] * sv;
            rowp[base + lane] = (bf16_t)(cvtpk(y1, y1) & 0xffffu); rowp[base + 64 + lane] = (bf16_t)(cvtpk(y2, y2) & 0xffffu); }
    }
}
template <class PP> __device__ __forceinline__ void phase_cmp_stage2(const PP& p, const Frame& F) {
    const int lane = F.lane, r32 = lane & 31, hi = lane >> 5;
    for (int u = F.bid; u < 128; u += F.G) {
        const int wh = u & 1, rt = u >> 1;
        if (F.wave < 4) {
            const bf16_t* hid = WSP(bf16_t, WS_HID) + (size_t)wh * 2048 * 256 + (size_t)(rt * 32 + r32) * 256;
            const bf16_t* w2 = WSP(bf16_t, WS_CW2) + (size_t)wh * 128 * 256 + (size_t)(F.wave * 32 + r32) * 256;
            f32x16 a2 = (f32x16){};
#pragma unroll
            for (int kk = 0; kk < 16; ++kk) { const int k = kk * 16 + hi * 8;
                a2 = __builtin_amdgcn_mfma_f32_32x32x16_bf16(*(const bf16x8*)(hid + k), *(const bf16x8*)(w2 + k), a2, 0, 0, 0); }
            bf16_t* outp = WSP(bf16_t, WS_KCMP) + (size_t)wh * 16 * 128 * 128;
#pragma unroll
            for (int r = 0; r < 16; ++r) { const int ro = rt * 32 + crow(r, hi);
                outp[(size_t)ro * 128 + F.wave * 32 + r32] = ((ro & 127) == 127) ? (bf16_t)0 : (bf16_t)(cvtpk(a2[r], a2[r]) & 0xffffu); }
        }
    }
}

template <class PP> __device__ __forceinline__ void cmp_unit(const PP& p, const ACtx& c, int b, int g, int qt) {
    const bf16_t* PR = WSP(bf16_t, WS_PROJ); bf16_t* OC = WSP(bf16_t, WS_OCAT); const float* cosT = WSP(float, WS_COS); const float* sinT = WSP(float, WS_SIN);
    const int P0 = qt * 256, qlo = P0 + c.wid * 32, qpos = qlo + c.r32, hi = c.hi;
    const size_t rowb = (size_t)b * SEQ, row = rowb + qpos;
    const bf16_t* Kp = WSP(bf16_t, WS_KCMP) + (size_t)(b * 2 + g) * 128 * 128; const bf16_t* Vp = Kp + (size_t)16 * 128 * 128;
    { Stage S; stage_load(S, Kp, Vp, 128, 0, c); stage_write(S, 0, c); stage_load(S, Kp, Vp, 128, 64, c); stage_write(S, 1, c); }
    __syncthreads();
    const int cmax = (qpos >= 31) ? (((qpos - 31) >> 4) < 126 ? ((qpos - 31) >> 4) : 126) : -1;
    LAS float* acc_l = (LAS float*)(c.lds + A_STASH) + c.wid * 2048 + c.lane;
    const float NEG = -__builtin_inff();
    constexpr float C2 = LOG2E * SCALE;
#pragma nounroll
    for (int hh = 0; hh < HPG; ++hh) {
        const int h = g * HPG + hh;
        bf16x8 qr[8]; load_q<true>(qr, PR + row * NSA_N + NQ + h * HD, cosT + row * 64, sinT + row * 64, hi);
        f32x16 pA0, pA1, pB0, pB1; qkt(pA0, pA1, 0, c, qr); qkt(pB0, pB1, 1, c, qr);
        float mx = NEG;
#pragma unroll
        for (int r = 0; r < 16; ++r) { const int ci = crow(r, hi);
            if (ci > cmax) pA0[r] = NEG; if (ci + 32 > cmax) pA1[r] = NEG; if (ci + 64 > cmax) pB0[r] = NEG; if (ci + 96 > cmax) pB1[r] = NEG;
            mx = fmaxf(fmaxf(mx, pA0[r]), fmaxf(pA1[r], fmaxf(pB0[r], pB1[r]))); }
        mx = swap_max(mx); if (mx == NEG) mx = 0.f;
        const float mL = -mx * C2; float ls = 0.f;
#pragma unroll
        for (int r = 0; r < 16; ++r) { pA0[r] = __builtin_amdgcn_exp2f(fmaf(pA0[r], C2, mL)); pA1[r] = __builtin_amdgcn_exp2f(fmaf(pA1[r], C2, mL));
            pB0[r] = __builtin_amdgcn_exp2f(fmaf(pB0[r], C2, mL)); pB1[r] = __builtin_amdgcn_exp2f(fmaf(pB1[r], C2, mL)); ls += (pA0[r] + pA1[r]) + (pB0[r] + pB1[r]); }
        ls = swap_sum(ls);
        const float inv = ls > 0.f ? 1.0f / ls : 0.f;
#pragma unroll
        for (int r = 0; r < 16; ++r) { pA0[r] *= inv; pA1[r] *= inv; pB0[r] *= inv; pB1[r] *= inv; }
#define ACC_AB(P, Q0) do { _Pragma("unroll") for (int q = 0; q < 4; ++q) { \
            const float a_ = 2.f * (P[4 * q] + P[4 * q + 1] + P[4 * q + 2]) + P[4 * q + 3], b_ = P[4 * q + 3]; \
            LAS float* pa_ = acc_l + (2 * (Q0 + q)) * 64; \
            if (hh == 0) { pa_[0] = a_; pa_[64] = b_; } else { pa_[0] += a_; pa_[64] += b_; } } } while (0)
        ACC_AB(pA0, 0); ACC_AB(pA1, 4); ACC_AB(pB0, 8); ACC_AB(pB1, 12);
#undef ACC_AB
        f32x16 o[4];
#pragma unroll
        for (int d = 0; d < 4; ++d) o[d] = (f32x16){};
        { bf16x8 pa0, pa1, pa2, pa3; pack_p(pA0, pA1, pa0, pa1, pa2, pa3); pv_tile(o, 0, c, pa0, pa1, pa2, pa3); }
        { bf16x8 pa0, pa1, pa2, pa3; pack_p(pB0, pB1, pa0, pa1, pa2, pa3); pv_tile(o, 1, c, pa0, pa1, pa2, pa3); }
        const float gc = sigmoidf_(bf2f(PR[row * NSA_N + NGL + h * 3 + 0]));
        float fr[16]; row_factors(gc, fr, c);
#pragma unroll
        for (int d = 0; d < 4; ++d)
#pragma unroll
            for (int r = 0; r < 16; ++r) o[d][r] *= fr[r];
        add_o_bf16(o, OC + (rowb + qlo) * DM + h * HD, DM, c);
        store_o_bf16(o, OC + (rowb + qlo) * DM + h * HD, DM, c);
    }
    float Ie[16], Io[16];
    {
        float imp[16], Bb[16];
#pragma unroll
        for (int q = 0; q < 16; ++q) { float blo, bhi; swap_both(acc_l[(2 * q + 1) * 64], blo, bhi); Bb[q] = hi ? blo : bhi; }
#pragma unroll
        for (int q = 0; q < 16; ++q) imp[q] = acc_l[(2 * q) * 64] + (hi ? Bb[q] : (q > 0 ? Bb[q - 1] : 0.f));
#pragma unroll
        for (int q = 0; q < 16; ++q) swap_both(imp[q], Ie[q], Io[q]);
    }
    const int cur = qpos >> 6;
    unsigned bits;
    if (cur < 16) bits = (2u << cur) - 1u;
    else {
#pragma unroll
        for (int q = 0; q < 16; ++q) { const int je = 2 * q, jo = 2 * q + 1;
            if (!(je >= 1 && je <= cur - 2)) Ie[q] = -1.f; if (!(jo >= 1 && jo <= cur - 2)) Io[q] = -1.f; }
        bits = 0u;
#pragma unroll
        for (int q = 0; q < 16; ++q) {
            const int jm = 2 * q + hi; const float vj = hi ? Io[q] : Ie[q];
            int rank = 0;
#pragma unroll
            for (int q2 = 0; q2 < 16; ++q2) {
                const bool lt_e = (q2 < q) || (q2 == q && hi);
                const bool lt_o = (q2 < q);
                rank += (Ie[q2] > vj || (Ie[q2] == vj && lt_e)) ? 1 : 0;
                rank += (Io[q2] > vj || (Io[q2] == vj && lt_o)) ? 1 : 0;
            }
            const bool forced = (jm == 0) || (jm == cur) || (jm == cur - 1);
            const bool sel = forced || (vj >= 0.f && rank < 13);
            bits |= sel ? (1u << jm) : 0u;
        }
        { auto rr = __builtin_amdgcn_permlane32_swap(bits, bits, false, false); bits = rr[0] | rr[1]; }
    }
    if (hi == 0) WSP(unsigned, WS_SEL)[(size_t)(b * 2 + g) * SEQ + qpos] = bits;
    __syncthreads();
}
template <class PP> __device__ __forceinline__ void phase_attn_cmp(const PP& p, const Frame& F) {
    const ACtx c = make_actx(F.lds);
    constexpr int NCU = NB * NGRP * 8;
    for (int u = F.bid; u < NCU; u += F.G) { const int qt = 7 - (u % 8), bg = u / 8; cmp_unit(p, c, bg >> 1, bg & 1, qt); }
}
template <class PP> __device__ __forceinline__ void win_unit(const PP& p, const ACtx& c, int b, int h, int qt) {
    const bf16_t* PR = WSP(bf16_t, WS_PROJ); bf16_t* OC = WSP(bf16_t, WS_OCAT); const float* cosT = WSP(float, WS_COS); const float* sinT = WSP(float, WS_SIN);
    const int P0 = qt * 256, qlo = P0 + c.wid * 32, qpos = qlo + c.r32, g = h / HPG;
    const size_t rowb = (size_t)b * SEQ, row = rowb + qpos;
    bf16x8 qr[8]; load_q<true>(qr, PR + row * NSA_N + NQ + h * HD, cosT + row * 64, sinT + row * 64, c.hi);
    const float gwn = sigmoidf_(bf2f(PR[row * NSA_N + NGL + h * 3 + 2]));
    f32x16 o[4]; float l;
    const int jlo = (P0 - (WINDOW - 1)) > 0 ? ((P0 - (WINDOW - 1)) >> 6) : 0;
    softmax_sweep<1>(c, qr, o, l, PR + rowb * NSA_N + NKW + g * HD, PR + rowb * NSA_N + NVW + g * HD, NSA_N, jlo, (P0 >> 6) + 4, qpos, qlo, 0u);
    float fr[16]; row_factors(l > 0.f ? gwn / l : 0.f, fr, c);
#pragma unroll
    for (int d = 0; d < 4; ++d)
#pragma unroll
        for (int r = 0; r < 16; ++r) o[d][r] *= fr[r];
    store_o_bf16(o, OC + (rowb + qlo) * DM + h * HD, DM, c);
}
template <class PP> __device__ __forceinline__ void nsa_win_mem_units(const PP& p, const Frame& F, int L, gu32* ctr) {
    const ACtx c = make_actx(F.lds);
    LAS int* slot = (LAS int*)(F.lds + MISC_OFF) + 16;
    constexpr int NWU = NB * NMIX * 8, NMU = NB * NMEMH * 8;
    for (;;) { const int u = wq_next(ctr, slot, c.tid); if (u >= NWU + NMU) break;
        if (u < NWU) { const int qt = 7 - (u / (NB * NMIX)), bh = u % (NB * NMIX); win_unit(p, c, bh / NMIX, bh % NMIX, qt); }
        else { const int v = u - NWU; const int qt = v % 8, bh = v / 8; mem_unit(p, c, L, bh / NMEMH, bh % NMEMH, qt, NSA_N, NQM); }
    }
}
template <class PP> __device__ __forceinline__ void sel_unit(const PP& p, const ACtx& c, int b, int h, int qt, bf16_t* OUT) {
    const bf16_t* PR = WSP(bf16_t, WS_PROJ); const bf16_t* OC = WSP(bf16_t, WS_OCAT); const float* cosT = WSP(float, WS_COS); const float* sinT = WSP(float, WS_SIN);
    const int P0 = qt * 256, qlo = P0 + c.wid * 32, qpos = qlo + c.r32, g = h / HPG;
    const size_t rowb = (size_t)b * SEQ, row = rowb + qpos;
    bf16x8 qr[8]; load_q<true>(qr, PR + row * NSA_N + NQ + h * HD, cosT + row * 64, sinT + row * 64, c.hi);
    const unsigned selbits = WSP(unsigned, WS_SEL)[(size_t)(b * 2 + g) * SEQ + qpos];
    const float gs = sigmoidf_(bf2f(PR[row * NSA_N + NGL + h * 3 + 1]));
    f32x16 o[4]; float l;
    softmax_sweep<2>(c, qr, o, l, PR + rowb * NSA_N + NKS + g * HD, PR + rowb * NSA_N + NVS + g * HD, NSA_N, 0, (P0 >> 6) + 4, qpos, qlo, selbits);
    float fr[16]; row_factors(l > 0.f ? gs / l : 0.f, fr, c);
#pragma unroll
    for (int d = 0; d < 4; ++d)
#pragma unroll
        for (int r = 0; r < 16; ++r) o[d][r] *= fr[r];
    add_o_bf16(o, OC + (rowb + qlo) * DM + h * HD, DM, c);
    store_o_bf16(o, OUT + (rowb + qlo) * DM + h * HD, DM, c);
}
template <class PP> __device__ __forceinline__ void phase_attn_sel(const PP& p, const Frame& F, bf16_t* OUT, gu32* ctr) {
    const ACtx c = make_actx(F.lds);
    LAS int* slot = (LAS int*)(F.lds + MISC_OFF) + 16;
    constexpr int NU = NB * NMIX * 8;
    for (;;) { const int u = wq_next(ctr, slot, c.tid); if (u >= NU) break;
        const int qt = 7 - (u / (NB * NMIX)), bh = u % (NB * NMIX); sel_unit(p, c, bh / NMIX, bh % NMIX, qt, OUT); }
}

#define LAST_() (rep_ == nrep_ - 1)
#define WQ_(k) ((gu32*)(p.ws + WS_CTL) + 64 * (8 + ((lp * 3 + (k)) * 2 + rep_)))
#ifndef PROBE_REPEAT
#define PROBE_REPEAT 0
#endif
constexpr int NPH_SB = 9, NPH_NSA = 13, NPH = 2 * (NPH_SB + NPH_NSA);
__global__ void __launch_bounds__(NTHR, 2) mk_fwd(Params p) {
    extern __shared__ __attribute__((aligned(16))) unsigned char lds_raw[];
    LAS unsigned char* const lds0 = (LAS unsigned char*)lds_raw;
typedef const Params __attribute__((address_space(4))) KParams;
#define MKFRAME() KParams* pp_ = (KParams*)__builtin_amdgcn_kernarg_segment_ptr(); asm volatile("" : "+s"(pp_)); KParams& p = *pp_; Frame F; F.lds = lds0; { int t_ = threadIdx.x; asm volatile("" : "+v"(t_)); F.tid = t_; } F.lane = F.tid & 63; F.wave = __builtin_amdgcn_readfirstlane(F.tid >> 6); F.G = gridDim.x; F.bid = blockIdx.x
    for (int u = threadIdx.x; u < (LDS_BYTES - LDSCTL_OFF) / 4; u += NTHR) ((LAS unsigned*)(lds0 + LDSCTL_OFF))[u] = 0u;
    __syncthreads();
    gu32* ctl = (gu32*)(p.ws + WS_CTL);
    XcdBarrier bar; bar.bar = (unsigned*)(ctl + CW_BAR); bar.x = 0; bar.st = nullptr;
#if !MK_PER_PHASE
    bar = xcd_barrier_post((unsigned*)(ctl + CW_BAR), (volatile LAS unsigned*)(lds0 + MISC_OFF) + 8);
#endif
    const int lo = p.ph_lo, hi = p.ph_hi;
    int ph = 0;
#define IN() (lo <= ph && ph < hi)
#if MK_PER_PHASE
#define END_PHASE() do { ++ph; } while (0)
#else
#define END_PHASE() do { if (IN() && ph + 1 < hi) { xcd_barrier(bar); if (PROBE_REPEAT & 256) xcd_barrier(bar); } ++ph; } while (0)
#endif
#define GEMM_RS(Aoff, Boff, M_, N_, K_, Ooff, ldc_, rs_) do { pg8::Gemm g{WSP(pg8::bf16_t, Aoff), WSP(pg8::bf16_t, Boff), M_, N_, K_}; pg8::StaticOrder S; S.init(M_, N_, F.G, F.bid); \
        pg8::EpiRS E{WSP(pg8::bf16_t, Ooff), ldc_, rs_}; pg8::gemm_phase<pg8::EpiRS, pg8::StaticOrder, true, true>(F.lds, g, S, E); } while (0)

#define GEMM_GU(L_) do { pg8::Gemm g{WSP(pg8::bf16_t, WS_XB), WSP(pg8::bf16_t, WS_WGU), MTOK, NGU, DM}; pg8::StaticOrder S; S.init(MTOK, NGU, F.G, F.bid); \
        pg8::EpiConv E{WSP(pg8::bf16_t, WS_ACT), WSP(float, WS_RSTD), p.conv_w + (size_t)(L_) * 3 * DFF, p.conv_b + (size_t)(L_) * DFF, WSP(float, WS_HG), WSP(float, WS_FP), WSP(float, WS_FU), (LAS float*)(F.lds + HALO_OFF), DFF}; \
        pg8::gemm_phase<pg8::EpiConv, pg8::StaticOrder, true, true>(F.lds, g, S, E); } while (0)

    for (int lp = 0; lp < 2; ++lp) {
        {
            const int L = 2 * lp;
            if (IN()) { MKFRAME(); for (int rep_ = 0, nrep_ = ((PROBE_REPEAT & 1) ? 2 : 1); rep_ < nrep_; ++rep_) { phase_convert(p, F, L); } }
            END_PHASE();
            if (IN()) { MKFRAME(); for (int rep_ = 0, nrep_ = ((PROBE_REPEAT & 2) ? 2 : 1); rep_ < nrep_; ++rep_) { GEMM_RS(WS_XB, WS_WIN, MTOK, SB_N, DM, WS_PROJ, SB_N, WSP(float, WS_RSTD));
                        if (L == 0) GEMM_RS(WS_MEMB, WS_WKV, NB * NMEM, 4096, DM, WS_MEMKV, 4096, WSP(float, WS_RSTD) + 16384); } }
            END_PHASE();
            if (IN()) { MKFRAME(); for (int rep_ = 0, nrep_ = ((PROBE_REPEAT & 4) ? 2 : 1); rep_ < nrep_; ++rep_) { phase_attn_sb(p, F, L, WQ_(0)); } }
            END_PHASE();
            if (IN()) { MKFRAME(); for (int rep_ = 0, nrep_ = ((PROBE_REPEAT & 2) ? 2 : 1); rep_ < nrep_; ++rep_) { GEMM_RS(WS_OCAT, WS_WO, MTOK, DM, DM, WS_TMP, DM, (const float*)nullptr); } }
            END_PHASE();
            if (IN()) { MKFRAME(); for (int rep_ = 0, nrep_ = ((PROBE_REPEAT & 8) ? 2 : 1); rep_ < nrep_; ++rep_) { phase_resid(p, F, (L == 0) ? p.x : (const float*)p.out, p.norm_g + (size_t)(L * 5 + 1) * DM, LAST_() ? p.out : WSP(float, WS_ACT), LAST_() ? WSP(bf16_t, WS_XB) : WSP(bf16_t, WS_PROJ), LAST_() ? WSP(float, WS_RSTD) : WSP(float, WS_FP)); } }
            END_PHASE();
            if (IN()) { MKFRAME(); for (int rep_ = 0, nrep_ = ((PROBE_REPEAT & 2) ? 2 : 1); rep_ < nrep_; ++rep_) { GEMM_GU(L); } }
            END_PHASE();
            if (IN()) { MKFRAME(); for (int rep_ = 0, nrep_ = ((PROBE_REPEAT & 16) ? 2 : 1); rep_ < nrep_; ++rep_) { phase_convfix(p, F, L); } }
            END_PHASE();
            if (IN()) { MKFRAME(); for (int rep_ = 0, nrep_ = ((PROBE_REPEAT & 2) ? 2 : 1); rep_ < nrep_; ++rep_) { GEMM_RS(WS_ACT, WS_WD, MTOK, DM, DFF, WS_TMP, DM, (const float*)nullptr); } }
            END_PHASE();
            if (IN()) { MKFRAME(); for (int rep_ = 0, nrep_ = ((PROBE_REPEAT & 8) ? 2 : 1); rep_ < nrep_; ++rep_) { phase_resid(p, F, (const float*)p.out, p.norm_g + (size_t)(L * 5 + 3) * DM, LAST_() ? p.out : WSP(float, WS_ACT), LAST_() ? WSP(bf16_t, WS_XB) : WSP(bf16_t, WS_PROJ), LAST_() ? WSP(float, WS_RSTD) : WSP(float, WS_FP)); } }
            END_PHASE();
        }
        {
            const int L = 2 * lp + 1;
            if (IN()) { MKFRAME(); for (int rep_ = 0, nrep_ = ((PROBE_REPEAT & 1) ? 2 : 1); rep_ < nrep_; ++rep_) { phase_convert(p, F, L); } }
            END_PHASE();
            if (IN()) { MKFRAME(); for (int rep_ = 0, nrep_ = ((PROBE_REPEAT & 2) ? 2 : 1); rep_ < nrep_; ++rep_) { GEMM_RS(WS_XB, WS_WIN, MTOK, NSA_N, DM, WS_PROJ, NSA_N, WSP(float, WS_RSTD)); } }
            END_PHASE();
            if (IN()) { MKFRAME(); phase_rope(p, F); }
            END_PHASE();
            if (IN()) { MKFRAME(); for (int rep_ = 0, nrep_ = ((PROBE_REPEAT & 32) ? 2 : 1); rep_ < nrep_; ++rep_) {
                if (F.bid < 16) { const int wh = F.bid >> 3;
                    pg8::Gemm g{WSP(pg8::bf16_t, WS_PROJ) + (wh ? NVC : NKC), WSP(pg8::bf16_t, WS_CW1) + (size_t)wh * 256 * 4096, 2048, 256, 4096, 16 * NSA_N, 256u, (unsigned)(NSA_N * 2), (size_t)SEQ * NSA_N * 2};
                    pg8::StaticOrder S; S.init(2048, 256, F.G, F.bid & 7);
                    pg8::EpiSiluBias E{WSP(pg8::bf16_t, WS_HID) + (size_t)wh * 2048 * 256, 256, WSP(float, WS_BIAS1) + wh * 256};
                    pg8::gemm_phase<pg8::EpiSiluBias, pg8::StaticOrder, true, true, true>(F.lds, g, S, E);
                }
                nsa_win_mem_units(p, F, L, WQ_(1)); } }
            END_PHASE();
            if (IN()) { MKFRAME(); phase_cmp_stage2(p, F); }
            END_PHASE();
            if (IN()) { MKFRAME(); for (int rep_ = 0, nrep_ = ((PROBE_REPEAT & 64) ? 2 : 1); rep_ < nrep_; ++rep_) { phase_attn_cmp(p, F); } }
            END_PHASE();
            if (IN()) { MKFRAME(); for (int rep_ = 0, nrep_ = ((PROBE_REPEAT & 128) ? 2 : 1); rep_ < nrep_; ++rep_) { phase_attn_sel(p, F, LAST_() ? WSP(bf16_t, WS_OCAT) : WSP(bf16_t, WS_TMP), WQ_(2)); } }
            END_PHASE();
            if (IN()) { MKFRAME(); for (int rep_ = 0, nrep_ = ((PROBE_REPEAT & 2) ? 2 : 1); rep_ < nrep_; ++rep_) { GEMM_RS(WS_OCAT, WS_WO, MTOK, DM, DM, WS_TMP, DM, (const float*)nullptr); } }
            END_PHASE();
            if (IN()) { MKFRAME(); for (int rep_ = 0, nrep_ = ((PROBE_REPEAT & 8) ? 2 : 1); rep_ < nrep_; ++rep_) { phase_resid(p, F, (const float*)p.out, p.norm_g + (size_t)(L * 5 + 1) * DM, LAST_() ? p.out : WSP(float, WS_ACT), LAST_() ? WSP(bf16_t, WS_XB) : WSP(bf16_t, WS_PROJ), LAST_() ? WSP(float, WS_RSTD) : WSP(float, WS_FP)); } }
            END_PHASE();
            if (IN()) { MKFRAME(); for (int rep_ = 0, nrep_ = ((PROBE_REPEAT & 2) ? 2 : 1); rep_ < nrep_; ++rep_) { GEMM_GU(L); } }
            END_PHASE();
            if (IN()) { MKFRAME(); for (int rep_ = 0, nrep_ = ((PROBE_REPEAT & 16) ? 2 : 1); rep_ < nrep_; ++rep_) { phase_convfix(p, F, L); } }
            END_PHASE();
            if (IN()) { MKFRAME(); for (int rep_ = 0, nrep_ = ((PROBE_REPEAT & 2) ? 2 : 1); rep_ < nrep_; ++rep_) { GEMM_RS(WS_ACT, WS_WD, MTOK, DM, DFF, WS_TMP, DM, (const float*)nullptr); } }
            END_PHASE();
            if (IN()) { MKFRAME(); for (int rep_ = 0, nrep_ = ((PROBE_REPEAT & 8) ? 2 : 1); rep_ < nrep_; ++rep_) { phase_resid(p, F, (const float*)p.out, p.norm_g + (size_t)(L * 5 + 3) * DM, LAST_() ? p.out : WSP(float, WS_ACT), LAST_() ? WSP(bf16_t, WS_XB) : WSP(bf16_t, WS_PROJ), LAST_() ? WSP(float, WS_RSTD) : WSP(float, WS_FP)); } }
            END_PHASE();
        }
    }
#undef IN
#undef END_PHASE
#undef GEMM_RS
#undef GEMM_GU
}

extern "C" void kernel_launch(void* const* d_in, const int* in_sizes, int n_in, void* d_out, int out_size, void* d_ws, size_t ws_size, hipStream_t stream) {
    static int grid = 0;
    if (grid == 0) {
        if (n_in != 16 || out_size != MTOK * DM || ws_size < WS_END) { fprintf(stderr, "kernel_launch: unexpected shapes (n_in %d, out %d, ws %zu < %zu)\n", n_in, out_size, ws_size, (size_t)WS_END); grid = -1; return; }
        int dev = 0, cus = 0, per_cu = 0;
        if (hipGetDevice(&dev) != hipSuccess || hipDeviceGetAttribute(&cus, hipDeviceAttributeMultiprocessorCount, dev) != hipSuccess) { grid = -1; return; }
        if (hipFuncSetAttribute((const void*)mk_fwd, hipFuncAttributeMaxDynamicSharedMemorySize, LDS_BYTES) != hipSuccess) { fprintf(stderr, "kernel_launch: hipFuncSetAttribute failed\n"); grid = -1; return; }
        if (hipOccupancyMaxActiveBlocksPerMultiprocessor(&per_cu, (const void*)mk_fwd, NTHR, LDS_BYTES) != hipSuccess || per_cu < 1) { fprintf(stderr, "kernel_launch: occupancy query says %d\n", per_cu); (void)hipGetLastError(); }
        grid = cus;
    }
    if (grid < 0) return;
    (void)hipMemsetAsync((char*)d_ws + WS_CTL, 0, CTL_ZERO_BYTES, stream);
    Params p{};
    p.x = (const float*)d_in[0]; p.mem = (const float*)d_in[1]; p.positions = (const int*)d_in[2]; p.norm_g = (const float*)d_in[3]; p.w_in_sb = (const float*)d_in[4]; p.w_in_nsa = (const float*)d_in[5];
    p.cmp_pe = (const float*)d_in[6]; p.cmp_w1 = (const float*)d_in[7]; p.cmp_w2 = (const float*)d_in[8]; p.w_mem_kv = (const float*)d_in[9]; p.w_o = (const float*)d_in[10];
    p.w_gate = (const float*)d_in[11]; p.w_up = (const float*)d_in[12]; p.conv_w = (const float*)d_in[13]; p.conv_b = (const float*)d_in[14]; p.w_down = (const float*)d_in[15];
    p.out = (float*)d_out; p.ws = (unsigned char*)d_ws;
#if MK_PER_PHASE
    for (int ph = 0; ph < NPH; ++ph) { p.ph_lo = ph; p.ph_hi = ph + 1; hipLaunchKernelGGL(mk_fwd, dim3(grid), dim3(NTHR), LDS_BYTES, stream, p); }
#else
    p.ph_lo = 0; p.ph_hi = NPH;
    hipLaunchKernelGGL(mk_fwd, dim3(grid), dim3(NTHR), LDS_BYTES, stream, p);
#endif
}
```

```cpp
#include <hip/hip_runtime.h>
#include <cstdio>
#include <cstdint>
namespace pg8 {
#define PG8_LAS __attribute__((address_space(3)))
typedef unsigned short bf16_t;
typedef short bf16x8 __attribute__((ext_vector_type(8)));
typedef float f32x4 __attribute__((ext_vector_type(4)));
typedef unsigned u32x4 __attribute__((ext_vector_type(4)));
constexpr int BM = 256, BK = 64, HALF = 128, HTB = HALF * BK * 2  , STAGE_BYTES = 8 * HTB, NXCD = 8, WGM = 8;

__host__ __device__ __forceinline__ int lds_byte(int r, int c) { const int st = (r >> 4) * 2 + (c >> 5), rr = r & 15, cc = c & 31, ob = rr * 64 + cc * 2; return st * 1024 + (ob ^ (((ob >> 9) & 1) << 5)); }
__host__ __device__ __forceinline__ void stage_rc(int b, int& R, int& C) { const int st = b / 1024, sb = b % 1024, swz = sb ^ (((sb >> 9) & 1) << 5); R = (st >> 1) * 16 + swz / 64; C = (st & 1) * 32 + (swz % 64) / 2; }
__host__ __device__ __forceinline__ int perm32(int rho) { const int n = rho >> 4, i = rho & 15; return 8 * (i >> 2) + 4 * n + (i & 3); }

struct Unit { int pm, pn; };
struct Gemm { const bf16_t* A; const bf16_t* Bt; int M, N, K; int lda; unsigned hstepA, kpairA; size_t tstepA; };

struct StaticOrder {
    int nM, nN, nwg, G, c;
    __host__ __device__ void init(int M, int N, int G_, int c_) { nM = M / BM; nN = N / BM; nwg = nM * nN; G = G_; c = c_; }
    __host__ __device__ bool next(int i, Unit& u) const {
        const long L = (long)i * G + c; if (L >= nwg) return false;
        int wgid = (int)L; { const int q = nwg / NXCD, r = nwg % NXCD, xcd = wgid % NXCD, off = wgid / NXCD; wgid = (xcd < r ? xcd * (q + 1) : r * (q + 1) + (xcd - r) * q) + off; }
        const int nig = WGM * nN, gid = wgid / nig, fm = gid * WGM, gsz = (nM - fm) < WGM ? (nM - fm) : WGM;
        u.pm = fm + ((wgid % nig) % gsz); u.pn = (wgid % nig) / gsz; return true;
    }
    __device__ __forceinline__ void a_ready(const Unit&) const {}
    __device__ __forceinline__ void done(const Unit&) const {}
};

__device__ __forceinline__ unsigned cvt_pk_bf16(float lo, float hi) { unsigned r; asm volatile("v_cvt_pk_bf16_f32 %0, %1, %2" : "=v"(r) : "v"(lo), "v"(hi)); return r; }
typedef float f32x2 __attribute__((ext_vector_type(2)));
struct EpiRS {
    static constexpr bool PERM = true, AFTER_DRAIN = false;
    bf16_t* O; int ldc; const float* rs;
    __device__ __forceinline__ void operator()(const f32x4 (&acc)[2][2][4][2], const Unit& u, int wr, int wc, int fr, int fq) const {
        const int row0 = u.pm * BM + wr * 64 + fr; const int col0 = u.pn * BM + wc * 32 + 8 * fq;
#pragma unroll
        for (int ai = 0; ai < 2; ++ai)
#pragma unroll
            for (int m = 0; m < 4; ++m) { const int row = row0 + ai * HALF + m * 16; const float sc = rs ? rs[row] : 1.f; bf16_t* rowp = O + (size_t)row * ldc + col0;
#pragma unroll
                for (int bj = 0; bj < 2; ++bj) { const f32x4 v0 = acc[ai][bj][m][0] * sc, v1 = acc[ai][bj][m][1] * sc;
                    u32x4 w; w.x = cvt_pk_bf16(v0[0], v0[1]); w.y = cvt_pk_bf16(v0[2], v0[3]); w.z = cvt_pk_bf16(v1[0], v1[1]); w.w = cvt_pk_bf16(v1[2], v1[3]);
                    *(u32x4*)(rowp + bj * HALF) = w; } }
    }
};
__device__ __forceinline__ float dpp_ror1(float v) { return __builtin_bit_cast(float, __builtin_amdgcn_update_dpp(0, __builtin_bit_cast(int, v), 0x121, 0xf, 0xf, false)); }
__device__ __forceinline__ float dpp_ror2(float v) { return __builtin_bit_cast(float, __builtin_amdgcn_update_dpp(0, __builtin_bit_cast(int, v), 0x122, 0xf, 0xf, false)); }
__device__ __forceinline__ float silu_fast(float x) { return x * __builtin_amdgcn_rcpf(1.f + __builtin_amdgcn_exp2f(-x * 1.4426950408889634f)); }
struct EpiConv {
    static constexpr bool PERM = true, AFTER_DRAIN = false;
    bf16_t* ACT; const float* rs; const float* cw; const float* cb; float* HG; float* FP; float* FU; PG8_LAS float* halo; int dff;
    __device__ __forceinline__ void operator()(const f32x4 (&acc)[2][2][4][2], const Unit& u, int wr, int wc, int fr, int fq) const {
        const int fl = wc * 32 + 8 * fq, f0 = u.pn * 128 + fl;
        f32x4 w0[2], w1[2], w2[2], bb[2];
#pragma unroll
        for (int n = 0; n < 2; ++n) { w0[n] = *(const f32x4*)(cw + f0 + 4 * n); w1[n] = *(const f32x4*)(cw + dff + f0 + 4 * n); w2[n] = *(const f32x4*)(cw + 2 * dff + f0 + 4 * n); bb[n] = *(const f32x4*)(cb + f0 + 4 * n); }
#pragma unroll
        for (int ai = 0; ai < 2; ++ai) { const float sc = rs[u.pm * BM + ai * HALF + wr * 64 + 48 + fr];
            if (fr >= 14) {
#pragma unroll
                for (int n = 0; n < 2; ++n) *(PG8_LAS f32x4*)(halo + ((ai * 2 + wr) * 2 + (fr - 14)) * 128 + fl + 4 * n) = acc[ai][0][3][n] * sc; } }
        asm volatile("s_waitcnt lgkmcnt(0)" ::: "memory"); __builtin_amdgcn_s_barrier(); asm volatile("" ::: "memory");
#pragma unroll
        for (int ai = 0; ai < 2; ++ai) {
            const int s = ai * 2 + wr;
            f32x4 a1p[2], a2p[2];
#pragma unroll
            for (int n = 0; n < 2; ++n) { f32x4 vp = {0.f, 0.f, 0.f, 0.f};
                if (s > 0 && fr >= 14) vp = *(const PG8_LAS f32x4*)(halo + ((s - 1) * 2 + (fr - 14)) * 128 + fl + 4 * n);
#pragma unroll
                for (int e = 0; e < 4; ++e) { a1p[n][e] = dpp_ror1(vp[e]); a2p[n][e] = dpp_ror2(vp[e]); } }
#pragma unroll
            for (int m = 0; m < 4; ++m) {
                const int row = u.pm * BM + ai * HALF + wr * 64 + m * 16 + fr; const float sc = rs[row];
                u32x4 wv; unsigned pk[4];
#pragma unroll
                for (int n = 0; n < 2; ++n) {
                    const f32x4 v = acc[ai][0][m][n] * sc, uu = acc[ai][1][m][n] * sc; f32x4 a1, a2, gc, ac;
#pragma unroll
                    for (int e = 0; e < 4; ++e) { a1[e] = dpp_ror1(v[e]); a2[e] = dpp_ror2(v[e]); }
#pragma unroll
                    for (int e = 0; e < 4; ++e) { const float p1 = (fr >= 1) ? a1[e] : a1p[n][e], p2 = (fr >= 2) ? a2[e] : a2p[n][e];
                        gc[e] = bb[n][e] + w0[n][e] * p2 + w1[n][e] * p1 + w2[n][e] * v[e];
                        ac[e] = silu_fast(gc[e]) * uu[e]; }
                    if (s == 0 && m == 0 && fr < 2) { *(f32x4*)(FP + (size_t)(u.pm * 2 + fr) * dff + f0 + 4 * n) = gc; *(f32x4*)(FU + (size_t)(u.pm * 2 + fr) * dff + f0 + 4 * n) = uu; }
                    if (s == 3 && m == 3 && fr >= 14) *(f32x4*)(HG + (size_t)(u.pm * 2 + fr - 14) * dff + f0 + 4 * n) = v;
                    pk[2 * n] = cvt_pk_bf16(ac[0], ac[1]); pk[2 * n + 1] = cvt_pk_bf16(ac[2], ac[3]);
                    a1p[n] = a1; a2p[n] = a2;
                }
                wv.x = pk[0]; wv.y = pk[1]; wv.z = pk[2]; wv.w = pk[3];
                *(u32x4*)(ACT + (size_t)row * dff + f0) = wv;
            }
        }
    }
};
struct EpiSiluBias {
    static constexpr bool PERM = true, AFTER_DRAIN = false;
    bf16_t* O; int ldc; const float* bias;
    __device__ __forceinline__ void operator()(const f32x4 (&acc)[2][2][4][2], const Unit& u, int wr, int wc, int fr, int fq) const {
        const int row0 = u.pm * BM + wr * 64 + fr; const int col0 = u.pn * BM + wc * 32 + 8 * fq;
        f32x4 bv[2][2];
#pragma unroll
        for (int bj = 0; bj < 2; ++bj)
#pragma unroll
            for (int n = 0; n < 2; ++n) bv[bj][n] = *(const f32x4*)(bias + col0 + bj * HALF + 4 * n);
#pragma unroll
        for (int ai = 0; ai < 2; ++ai)
#pragma unroll
            for (int m = 0; m < 4; ++m) { bf16_t* rowp = O + (size_t)(row0 + ai * HALF + m * 16) * ldc + col0;
#pragma unroll
                for (int bj = 0; bj < 2; ++bj) { f32x4 v0 = acc[ai][bj][m][0] + bv[bj][0], v1 = acc[ai][bj][m][1] + bv[bj][1];
#pragma unroll
                    for (int e = 0; e < 4; ++e) { v0[e] = v0[e] * __builtin_amdgcn_rcpf(1.f + __builtin_amdgcn_exp2f(-v0[e] * 1.4426950408889634f)); v1[e] = v1[e] * __builtin_amdgcn_rcpf(1.f + __builtin_amdgcn_exp2f(-v1[e] * 1.4426950408889634f)); }
                    u32x4 w; w.x = cvt_pk_bf16(v0[0], v0[1]); w.y = cvt_pk_bf16(v0[2], v0[3]); w.z = cvt_pk_bf16(v1[0], v1[1]); w.w = cvt_pk_bf16(v1[2], v1[3]);
                    *(u32x4*)(rowp + bj * HALF) = w; } }
    }
};
struct EpiCmpMlp {
    static constexpr bool PERM = true, AFTER_DRAIN = true;
    const float* bias; const bf16_t* w2t; bf16_t* OUT;
    __device__ __forceinline__ void fused(f32x4 (&acc)[2][2][4][2], const Unit& u, int wr, int wc, int fr, int fq, PG8_LAS unsigned char* lds, int wid, int lane) const {
        typedef float f32x16v __attribute__((ext_vector_type(16)));
        PG8_LAS bf16_t* hid = (PG8_LAS bf16_t*)lds;
        const int col0 = wc * 32 + 8 * fq;
#pragma unroll
        for (int bj = 0; bj < 2; ++bj) { const f32x4 b0 = *(const f32x4*)(bias + col0 + bj * HALF), b1 = *(const f32x4*)(bias + col0 + bj * HALF + 4);
#pragma unroll
            for (int ai = 0; ai < 2; ++ai)
#pragma unroll
                for (int m = 0; m < 4; ++m) { f32x4 v0 = acc[ai][bj][m][0] + b0, v1 = acc[ai][bj][m][1] + b1;
#pragma unroll
                    for (int e = 0; e < 4; ++e) { v0[e] = v0[e] * __builtin_amdgcn_rcpf(1.f + __builtin_amdgcn_exp2f(-v0[e] * 1.4426950408889634f)); v1[e] = v1[e] * __builtin_amdgcn_rcpf(1.f + __builtin_amdgcn_exp2f(-v1[e] * 1.4426950408889634f)); }
                    u32x4 w; w.x = cvt_pk_bf16(v0[0], v0[1]); w.y = cvt_pk_bf16(v0[2], v0[3]); w.z = cvt_pk_bf16(v1[0], v1[1]); w.w = cvt_pk_bf16(v1[2], v1[3]);
                    *(PG8_LAS u32x4*)(hid + (ai * HALF + wr * 64 + m * 16 + fr) * 264 + col0 + bj * HALF) = w; } }
        asm volatile("s_waitcnt lgkmcnt(0)" ::: "memory"); __builtin_amdgcn_s_barrier(); asm volatile("" ::: "memory");
        const int r32 = lane & 31, hi = lane >> 5, ct = wid & 3;
        const bf16_t* w2 = w2t + (size_t)(ct * 32 + r32) * 256;
#pragma unroll 1
        for (int k4 = 0; k4 < 4; ++k4) {
            const int rt = (wid >> 2) + 2 * k4;
            f32x16v a2 = (f32x16v){};
#pragma unroll
            for (int kk = 0; kk < 16; ++kk) { const int k = kk * 16 + hi * 8;
                a2 = __builtin_amdgcn_mfma_f32_32x32x16_bf16(*(const PG8_LAS bf16x8*)(hid + (rt * 32 + r32) * 264 + k), *(const bf16x8*)(w2 + k), a2, 0, 0, 0); }
#pragma unroll
            for (int r = 0; r < 16; ++r) { const int rl = rt * 32 + (r & 3) + 8 * (r >> 2) + 4 * hi; const int ro = u.pm * BM + rl;
                const float av_ = a2[r]; const unsigned ub = __float_as_uint(av_); const unsigned rb = (ub + 0x7fffu + ((ub >> 16) & 1u)) >> 16;
                OUT[(size_t)ro * 128 + ct * 32 + r32] = ((ro & 127) == 127) ? (bf16_t)0 : (bf16_t)rb; }
        }
        asm volatile("s_waitcnt lgkmcnt(0)" ::: "memory"); __builtin_amdgcn_s_barrier(); asm volatile("" ::: "memory");
    }
};
template <class Epi, class Sched, bool ALIGN_EPI = false, bool SP2 = false, bool AGEN = false>
__device__ __forceinline__ void gemm_phase(PG8_LAS unsigned char* lds, const Gemm g, const Sched& S, const Epi& E) {
    int tid_ = threadIdx.x; asm volatile("" : "+v"(tid_));
    const int tid = tid_, wid = __builtin_amdgcn_readfirstlane(tid >> 6), lane = tid & 63, wr = wid >> 2, wc = wid & 3, fr = lane & 15, fq = lane >> 4;
    const int K = g.K, nt = K / BK;
    unsigned voffA[2], voffB[2];
#pragma unroll
    for (int i = 0; i < 2; ++i) { int R, C; stage_rc(tid * 16 + i * 8192, R, C); const int Rb = Epi::PERM ? ((R & ~31) + perm32(R & 31)) : R;
        voffA[i] = (unsigned)(R * (AGEN ? g.lda : K) + C) * 2u; voffB[i] = (unsigned)(Rb * K + C) * 2u; }
    const size_t kstep = (size_t)(BK * 2);
    const size_t hstep = (size_t)HALF * K * 2;
    const size_t tstep = 2 * hstep;
    const size_t hstepA = AGEN ? (size_t)g.hstepA : hstep, tstepA = AGEN ? g.tstepA : tstep, kpairA = AGEN ? (size_t)g.kpairA : 2 * kstep;
    const unsigned ldsw = (unsigned)wid * 1024u;
    const int aoff = lds_byte(wr * 64 + fr, fq * 8), boff = lds_byte(wc * 32 + fr, fq * 8);
#define PG8_SA(b, h) (((b) * 2 + (h)) * HTB)
#define PG8_SB(b, h) ((4 + (b) * 2 + (h)) * HTB)
#define PG8_STAGE(bufoff, gbase, voff) do { _Pragma("unroll") for (int _i = 0; _i < 2; ++_i) \
        __builtin_amdgcn_global_load_lds((const unsigned*)((const char*)(gbase) + (voff)[_i]), (PG8_LAS unsigned*)(lds + (bufoff) + ldsw + _i * 8192), 16, 0, 0); } while (0)
#define PG8_LDA(dst, b, h) do { _Pragma("unroll") for (int m = 0; m < 4; ++m) _Pragma("unroll") for (int k = 0; k < 2; ++k) dst[m][k] = *(const PG8_LAS bf16x8*)(lds + PG8_SA(b, h) + aoff + m * 2048 + k * 1024); } while (0)
#define PG8_LDB(dst, b, h) do { _Pragma("unroll") for (int n = 0; n < 2; ++n) _Pragma("unroll") for (int k = 0; k < 2; ++k) dst[n][k] = *(const PG8_LAS bf16x8*)(lds + PG8_SB(b, h) + boff + n * 2048 + k * 1024); } while (0)
#define PG8_MMA(ai, bj, At, Bt) do { __builtin_amdgcn_s_setprio(1); _Pragma("unroll") for (int m = 0; m < 4; ++m) _Pragma("unroll") for (int n = 0; n < 2; ++n) _Pragma("unroll") for (int k = 0; k < 2; ++k) \
        acc[ai][bj][m][n] = __builtin_amdgcn_mfma_f32_16x16x32_bf16(Bt[n][k], At[m][k], acc[ai][bj][m][n], 0, 0, 0); __builtin_amdgcn_s_setprio(0); } while (0)
#define PG8_WAIT_V(n) asm volatile("s_waitcnt vmcnt(" #n ")" ::: "memory")
#define PG8_WAIT_L(n) asm volatile("s_waitcnt lgkmcnt(" #n ")" ::: "memory")
#define PG8_BAR __builtin_amdgcn_s_barrier()
#define PG8_SCHED __builtin_amdgcn_sched_barrier(0)
    Unit cur, nxt; int ui = 0;
    if (!S.next(0, cur)) return;
    f32x4 acc[2][2][4][2];
#pragma unroll
    for (int a = 0; a < 2; ++a)
#pragma unroll
        for (int b = 0; b < 2; ++b)
#pragma unroll
            for (int m = 0; m < 4; ++m)
#pragma unroll
                for (int n = 0; n < 2; ++n) acc[a][b][m][n] = (f32x4){0.f, 0.f, 0.f, 0.f};
    bf16x8 At[4][2], B0[2][2], B1[2][2];
    const char* cA = (const char*)g.A + (size_t)cur.pm * tstepA; const char* cB = (const char*)g.Bt + (size_t)cur.pn * tstep;
    S.a_ready(cur);
    if constexpr (SP2) {
        PG8_STAGE(PG8_SB(0, 0), cB, voffB); PG8_STAGE(PG8_SB(0, 1), cB + hstep, voffB); PG8_STAGE(PG8_SA(0, 0), cA, voffA); PG8_STAGE(PG8_SA(0, 1), cA + hstepA, voffA);
        if (wr == 1) PG8_BAR;
        PG8_WAIT_V(2); PG8_BAR;
        PG8_STAGE(PG8_SB(1, 0), cB + kstep, voffB); PG8_STAGE(PG8_SA(1, 0), cA + kstep, voffA); PG8_STAGE(PG8_SB(1, 1), cB + hstep + kstep, voffB);
        PG8_WAIT_V(6); PG8_BAR;
    } else {
        PG8_STAGE(PG8_SB(0, 0), cB, voffB); PG8_STAGE(PG8_SA(0, 0), cA, voffA); PG8_STAGE(PG8_SB(0, 1), cB + hstep, voffB); PG8_STAGE(PG8_SA(0, 1), cA + hstepA, voffA);
        if (wr == 1) PG8_BAR;
        PG8_WAIT_V(4); PG8_BAR;
        PG8_STAGE(PG8_SB(1, 0), cB + kstep, voffB); PG8_STAGE(PG8_SA(1, 0), cA + kstep, voffA); PG8_STAGE(PG8_SB(1, 1), cB + hstep + kstep, voffB);
        PG8_WAIT_V(6); PG8_BAR;
    }
    for (;;) {
        const bool has_next = S.next(ui + 1, nxt);
        const char* nA = has_next ? (const char*)g.A + (size_t)nxt.pm * tstepA : cA; const char* nB = has_next ? (const char*)g.Bt + (size_t)nxt.pn * tstep : cB;
        for (int t = 0; t < nt; t += 2) {
            const bool last = (t == nt - 2);
            const char* a1 = cA + (size_t)(t >> 1) * kpairA + kstep;
            const char* a2 = last ? nA : cA + (size_t)((t >> 1) + 1) * kpairA; const char* b2 = last ? nB : cB + (size_t)(t + 2) * kstep;
            const char* a3 = a2 + kstep; const char* b3 = b2 + kstep;
            if (last && has_next) S.a_ready(nxt);
            if constexpr (SP2) {
            PG8_LDB(B0, 0, 0); PG8_LDB(B1, 0, 1); PG8_SCHED; PG8_LDA(At, 0, 0); PG8_STAGE(PG8_SA(1, 1), a1 + hstepA, voffA);
            PG8_WAIT_V(8); PG8_WAIT_L(0); PG8_BAR; PG8_MMA(0, 0, At, B0); PG8_MMA(0, 1, At, B1); PG8_BAR; PG8_SCHED;
            PG8_LDA(At, 0, 1); PG8_STAGE(PG8_SB(0, 0), b2, voffB); PG8_STAGE(PG8_SB(0, 1), b2 + hstep, voffB); PG8_STAGE(PG8_SA(0, 0), a2, voffA);
            PG8_WAIT_V(8); PG8_WAIT_L(0); PG8_BAR; PG8_MMA(1, 0, At, B0); PG8_MMA(1, 1, At, B1); PG8_BAR; PG8_SCHED;
            PG8_LDB(B0, 1, 0); PG8_LDB(B1, 1, 1); PG8_SCHED; PG8_LDA(At, 1, 0); PG8_STAGE(PG8_SA(0, 1), a2 + hstepA, voffA);
            PG8_WAIT_V(8); PG8_WAIT_L(0); PG8_BAR; PG8_MMA(0, 0, At, B0); PG8_MMA(0, 1, At, B1); PG8_BAR; PG8_SCHED;
            PG8_LDA(At, 1, 1); PG8_STAGE(PG8_SB(1, 0), b3, voffB); PG8_STAGE(PG8_SB(1, 1), b3 + hstep, voffB); PG8_STAGE(PG8_SA(1, 0), a3, voffA);
            PG8_WAIT_V(8); PG8_WAIT_L(0); PG8_BAR; PG8_MMA(1, 0, At, B0); PG8_MMA(1, 1, At, B1); PG8_BAR; PG8_SCHED;
            } else {
            PG8_LDB(B0, 0, 0); PG8_SCHED; PG8_LDA(At, 0, 0); PG8_STAGE(PG8_SA(1, 1), a1 + hstepA, voffA);
            PG8_WAIT_L(8); PG8_BAR; PG8_WAIT_L(0); PG8_MMA(0, 0, At, B0); PG8_BAR; PG8_SCHED;
            PG8_LDB(B1, 0, 1); PG8_STAGE(PG8_SB(0, 0), b2, voffB);
            PG8_BAR; PG8_WAIT_L(0); PG8_MMA(0, 1, At, B1); PG8_BAR;
            PG8_LDA(At, 0, 1); PG8_STAGE(PG8_SA(0, 0), a2, voffA);
            PG8_BAR; PG8_WAIT_L(0); PG8_MMA(1, 0, At, B0); PG8_BAR; PG8_SCHED;
            PG8_STAGE(PG8_SB(0, 1), b2 + hstep, voffB);
            PG8_WAIT_V(6); PG8_BAR; PG8_MMA(1, 1, At, B1); PG8_BAR;
            PG8_LDB(B0, 1, 0); PG8_SCHED; PG8_LDA(At, 1, 0); PG8_STAGE(PG8_SA(0, 1), a2 + hstepA, voffA);
            PG8_WAIT_L(8); PG8_BAR; PG8_WAIT_L(0); PG8_MMA(0, 0, At, B0); PG8_BAR; PG8_SCHED;
            PG8_LDB(B1, 1, 1); PG8_STAGE(PG8_SB(1, 0), b3, voffB);
            PG8_BAR; PG8_WAIT_L(0); PG8_MMA(0, 1, At, B1); PG8_BAR;
            PG8_LDA(At, 1, 1); PG8_STAGE(PG8_SA(1, 0), a3, voffA);
            PG8_BAR; PG8_WAIT_L(0); PG8_MMA(1, 0, At, B0); PG8_BAR; PG8_SCHED;
            PG8_STAGE(PG8_SB(1, 1), b3 + hstep, voffB);
            PG8_WAIT_V(6); PG8_BAR; PG8_MMA(1, 1, At, B1); PG8_BAR;
            }
        }
        if constexpr (ALIGN_EPI) { if (wr == 0) PG8_BAR; }
        if constexpr (!Epi::AFTER_DRAIN) { E(acc, cur, wr, wc, fr, fq); S.done(cur); }
        if (!has_next) break;
#pragma unroll
        for (int a = 0; a < 2; ++a)
#pragma unroll
            for (int b = 0; b < 2; ++b)
#pragma unroll
                for (int m = 0; m < 4; ++m)
#pragma unroll
                    for (int n = 0; n < 2; ++n) acc[a][b][m][n] = (f32x4){0.f, 0.f, 0.f, 0.f};
        cur = nxt; cA = nA; cB = nB; ++ui;
        if constexpr (ALIGN_EPI) { if (wr == 1) PG8_BAR; }
    }
    PG8_WAIT_V(0);
    if constexpr (!ALIGN_EPI) { if (wr == 0) PG8_BAR; }
    PG8_BAR;
    if constexpr (Epi::AFTER_DRAIN) { E.fused(acc, cur, wr, wc, fr, fq, lds, wid, lane); S.done(cur); }
#undef PG8_SA
#undef PG8_SB
#undef PG8_STAGE
#undef PG8_LDA
#undef PG8_LDB
#undef PG8_MMA
#undef PG8_WAIT_V
#undef PG8_WAIT_L
#undef PG8_BAR
#undef PG8_SCHED
}
}

#ifndef MK_PER_PHASE
#define MK_PER_PHASE 0
#endif
constexpr int NB = 8, SEQ = 2048, DM = 2048, MTOK = NB * SEQ, DEPTH = 4, HD = 128;
constexpr int NMIX = 12, NMEMH = 4, NMEM = 256, DFF = 5632, NGU = 2 * DFF, NGRP = 2, HPG = 6;
constexpr int SB_N = 5120, NSA_N = 3840, NSA_SRC = 3620;
constexpr int SBQ = 0, SBK = 1536, SBV = 3072, SBQM = 4608;
constexpr int NQ = 0, NKC = 1536, NVC = 1792, NKS = 2048, NVS = 2304, NKW = 2560, NVW = 2816, NQM = 3072, NGL = 3584;
constexpr int NCMP = 127, CMPROWS = NB * NGRP * NCMP;
constexpr int WINDOW = 512;
constexpr float NORM_EPS = 1e-6f;
constexpr float SCALE = 0.08838834764831845f;
constexpr float LOG2E = 1.4426950408889634f;
constexpr int NWAVES = 8, NTHR = 512;

constexpr size_t MiB = 1u << 20;
constexpr size_t WS_CTL = 0, CTL_ZERO_BYTES = 1 * MiB;
constexpr size_t WS_WIN = 2 * MiB;
constexpr size_t WS_WO = 22 * MiB;
constexpr size_t WS_WGU = 30 * MiB;
constexpr size_t WS_WD = 74 * MiB;
constexpr size_t WS_WKV = 96 * MiB;
constexpr size_t WS_CW1 = 112 * MiB;
constexpr size_t WS_CW2 = 116 * MiB;
constexpr size_t WS_MEMB = 117 * MiB;
constexpr size_t WS_MEMKV = 125 * MiB;
constexpr size_t WS_COS = 141 * MiB, WS_SIN = 145 * MiB;
constexpr size_t WS_RSTD = 149 * MiB;
constexpr size_t WS_SEL = 150 * MiB;
constexpr size_t WS_KCMP = 151 * MiB;
constexpr size_t WS_XB = 152 * MiB;
constexpr size_t WS_TMP = 216 * MiB;
constexpr size_t WS_ACT = 280 * MiB;
constexpr size_t WS_GU = 456 * MiB;
constexpr size_t WS_PROJ = 456 * MiB;
constexpr size_t WS_OCAT = 616 * MiB;
constexpr size_t WS_HG = 680 * MiB, WS_FP = 684 * MiB, WS_FU = 688 * MiB;
constexpr size_t WS_HID = 692 * MiB;
constexpr size_t WS_BIAS1 = 694 * MiB;
constexpr size_t WS_END = 808 * MiB;
constexpr int CW_BAR = 4096;

constexpr int RING_BYTES = 131072;
constexpr int LDSCTL_OFF = 143360, MISC_OFF = LDSCTL_OFF + 320;
constexpr int LDS_BYTES = 147456;
constexpr int HALO_OFF = RING_BYTES;
constexpr int SHM_T = 16384;
constexpr int A_V = 0, A_K = 2 * SHM_T, A_WS = 4 * SHM_T, A_FLAGS = A_WS + NWAVES * 64 * 4, A_STASH = 67584;

#define GAS __attribute__((address_space(1)))
#define LAS __attribute__((address_space(3)))
typedef unsigned short bf16_t;
typedef unsigned v4u __attribute__((ext_vector_type(4)));
typedef unsigned v2u __attribute__((ext_vector_type(2)));
typedef float f32x4 __attribute__((ext_vector_type(4)));
typedef float f32x16 __attribute__((ext_vector_type(16)));
typedef short bf16x8 __attribute__((ext_vector_type(8)));
typedef short s16x4 __attribute__((ext_vector_type(4)));
typedef GAS unsigned gu32;
#define RLX_AGENT __ATOMIC_RELAXED, __HIP_MEMORY_SCOPE_AGENT
#define LDS_WAIT() asm volatile("s_waitcnt lgkmcnt(0)" ::: "memory")
#define VM_WAIT() asm volatile("s_waitcnt vmcnt(0)" ::: "memory")
#define SBAR() __builtin_amdgcn_sched_barrier(0)
__device__ __forceinline__ unsigned cvtpk(float lo, float hi) { unsigned r; asm volatile("v_cvt_pk_bf16_f32 %0, %1, %2" : "=v"(r) : "v"(lo), "v"(hi)); return r; }
__device__ __forceinline__ float bf2f(unsigned short b) { return __uint_as_float((unsigned)b << 16); }
__device__ __forceinline__ float bflo(unsigned w) { return __uint_as_float(w << 16); }
__device__ __forceinline__ float bfhi(unsigned w) { return __uint_as_float(w & 0xffff0000u); }
__device__ __forceinline__ bf16x8 pack8(f32x4 a, f32x4 b) { v4u w = {cvtpk(a[0], a[1]), cvtpk(a[2], a[3]), cvtpk(b[0], b[1]), cvtpk(b[2], b[3])}; return __builtin_bit_cast(bf16x8, w); }
__device__ __forceinline__ void unpack8(bf16x8 v, f32x4& a, f32x4& b) { const v4u w = __builtin_bit_cast(v4u, v); a = (f32x4){bflo(w.x), bfhi(w.x), bflo(w.y), bfhi(w.y)}; b = (f32x4){bflo(w.z), bfhi(w.z), bflo(w.w), bfhi(w.w)}; }
__device__ __forceinline__ float wave_sum(float v) {
#pragma unroll
    for (int o = 1; o < 64; o <<= 1) v += __shfl_xor(v, o);
    return v;
}
__device__ __forceinline__ float sigmoidf_(float x) { return __builtin_amdgcn_rcpf(1.f + __builtin_amdgcn_exp2f(-x * LOG2E)); }

__device__ const float INV_FREQ[64] = {1.000000000e+00f, 8.659643531e-01f, 7.498942018e-01f, 6.493816376e-01f, 5.623413324e-01f, 4.869675338e-01f, 4.216965139e-01f, 3.651741147e-01f, 3.162277639e-01f, 2.738419771e-01f, 2.371373773e-01f, 2.053525001e-01f, 1.778279394e-01f, 1.539926529e-01f, 1.333521456e-01f, 1.154781953e-01f, 1.000000015e-01f, 8.659642935e-02f, 7.498942316e-02f, 6.493816525e-02f, 5.623413250e-02f, 4.869675264e-02f, 4.216964915e-02f, 3.651741147e-02f, 3.162277490e-02f, 2.738419548e-02f, 2.371373773e-02f, 2.053525113e-02f, 1.778279431e-02f, 1.539926510e-02f, 1.333521400e-02f, 1.154781971e-02f, 9.999999776e-03f, 8.659643121e-03f, 7.498942316e-03f, 6.493816152e-03f, 5.623413250e-03f, 4.869675264e-03f, 4.216964822e-03f, 3.651741194e-03f, 3.162277630e-03f, 2.738419687e-03f, 2.371373819e-03f, 2.053525066e-03f, 1.778279431e-03f, 1.539926510e-03f, 1.333521446e-03f, 1.154782018e-03f, 1.000000047e-03f, 8.659643354e-04f, 7.498941850e-04f, 6.493816036e-04f, 5.623413017e-04f, 4.869675322e-04f, 4.216965172e-04f, 3.651741135e-04f, 3.162277571e-04f, 2.738419571e-04f, 2.371373703e-04f, 2.053525095e-04f, 1.778279402e-04f, 1.539926598e-04f, 1.333521504e-04f, 1.154782003e-04f};
#define XB_TMO      128
#define XB_XCNT(j)  (256  + 64 * (j))
#define XB_XSUB(j)  (1280 + 64 * (j))
#define XB_XGEN(j)  (2304 + 64 * (j))
#define XB_TOP      3328
#define XB_TOPGEN   3392
#define XCD_BAR_WORDS 3456
#define XB_SPIN_CAP (1u << 18)

__device__ __forceinline__ unsigned xb_ld(unsigned* p)              { return __hip_atomic_load(p, __ATOMIC_RELAXED, __HIP_MEMORY_SCOPE_AGENT); }
__device__ __forceinline__ unsigned xb_add(unsigned* p, unsigned v) { return __hip_atomic_fetch_add(p, v, __ATOMIC_RELAXED, __HIP_MEMORY_SCOPE_AGENT); }
__device__ __forceinline__ unsigned xb_xcc_id() { return (unsigned)__builtin_amdgcn_s_getreg((3 << 11) | 20) & 0xFu; }
#define XB_SPIN(cond, bar) do { unsigned _sp = 0; while (cond) { __builtin_amdgcn_s_sleep(1); \
    if ((++_sp & 255u) == 0u) { if (xb_ld(&(bar)[XB_TMO])) break; if (_sp > XB_SPIN_CAP) { atomicAdd(&(bar)[XB_TMO], 1u); break; } } } } while (0)

struct XcdBarrier {
    unsigned* bar; unsigned x;
    volatile LAS unsigned* st;
};

__device__ __forceinline__ XcdBarrier xcd_barrier_post(unsigned* bar, volatile LAS unsigned* st) {
    XcdBarrier b; b.bar = bar; b.x = xb_xcc_id(); b.st = st;
    if (threadIdx.x == 0) (void)xb_add(&bar[XB_XCNT(b.x)], 1u);
    return b;
}
__device__ __forceinline__ void xcd_barrier_complete(unsigned* bar, unsigned x, unsigned& nloc, unsigned& nx) {
    const unsigned G = gridDim.x * gridDim.y * gridDim.z;
    unsigned sum, cnt, mine, sp = 0u;
    for (;;) {
        sum = 0u; cnt = 0u; mine = 0u;
#pragma unroll
        for (unsigned j = 0; j < 16; ++j) { const unsigned c = xb_ld(&bar[XB_XCNT(j)]); sum += c; cnt += (c > 0u) ? 1u : 0u; mine = (j == x) ? c : mine; }
        if (sum == G) break;
        __builtin_amdgcn_s_sleep(1);
        if ((++sp & 255u) == 0u) { if (xb_ld(&bar[XB_TMO])) break; if (sp > XB_SPIN_CAP) { atomicAdd(&bar[XB_TMO], 1u); break; } }
    }
    nloc = mine > 0u ? mine : 1u; nx = cnt > 0u ? cnt : 1u;
}

__device__ __forceinline__ void xcd_barrier(const XcdBarrier& b) {
    asm volatile("s_waitcnt vmcnt(0)" ::: "memory");
    __syncthreads();
    if (threadIdx.x == 0) {
        unsigned* bar = b.bar;
        __builtin_amdgcn_s_waitcnt(0);
        unsigned nloc = b.st[0], nx = b.st[1];
        if (nloc == 0u) { xcd_barrier_complete(bar, b.x, nloc, nx); b.st[0] = nloc; b.st[1] = nx; }
        const unsigned old = xb_add(&bar[XB_XSUB(b.x)], 1u);
        const unsigned gen = old / nloc;
        if (old + 1u == (gen + 1u) * nloc) {
            __builtin_amdgcn_fence(__ATOMIC_RELEASE, "agent");
            asm volatile("s_waitcnt vmcnt(0)" ::: "memory");
            const unsigned og = xb_add(&bar[XB_TOP], 1u);
            const unsigned tg = og / nx;
            if (og + 1u == (tg + 1u) * nx) xb_add(&bar[XB_TOPGEN], 1u);
            else XB_SPIN(xb_ld(&bar[XB_TOPGEN]) == tg, bar);
            __builtin_amdgcn_fence(__ATOMIC_ACQUIRE, "agent");
            xb_add(&bar[XB_XGEN(b.x)], 1u);
            asm volatile("s_waitcnt vmcnt(0)" ::: "memory");
        } else {
            XB_SPIN(xb_ld(&bar[XB_XGEN(b.x)]) == gen, bar);
            __builtin_amdgcn_fence(__ATOMIC_ACQUIRE, "agent");
            asm volatile("s_waitcnt vmcnt(0)" ::: "memory");
        }
    }
    __syncthreads();
}

#define KSWZ(row, colB) ((row) * 256 + ((colB) ^ (((row) & 7) << 4)))
__device__ __forceinline__ int v_st(int k, int c) { const int kk = (k & ~0xC) | ((k & 4) << 1) | ((k & 8) >> 1); return ((kk >> 3) * 4 + (c >> 5)) * 512 + ((kk & 7) * 32 + (c & 31)) * 2; }
__device__ __forceinline__ int v_rd_base(int lane) { return ((lane & 3) << 3) | (((lane >> 2) & 3) << 6) | (((lane >> 4) & 1) << 5) | (((lane >> 5) & 1) << 8); }
constexpr int v_rd_off(int d0, int ks, int half) { return d0 * 512 + ks * 4096 + half * 2048; }
__device__ __forceinline__ int crow(int r, int hi) { return (r & 3) + 8 * (r >> 2) + 4 * hi; }

struct ACtx {
    LAS unsigned char* lds;
    int tid, wid, lane, r32, hi, sr, sc, kws, vst0, vst1, vb0;
    LAS float* ws;
};
__device__ __forceinline__ ACtx make_actx(LAS unsigned char* lds) {
    ACtx c; c.lds = lds; { int t_ = threadIdx.x; asm volatile("" : "+v"(t_)); c.tid = t_; } c.wid = __builtin_amdgcn_readfirstlane(c.tid >> 6); c.lane = c.tid & 63; c.r32 = c.lane & 31; c.hi = c.lane >> 5;
    c.sr = c.tid >> 4; c.sc = (c.tid & 15) * 8; c.kws = KSWZ(c.sr, c.sc * 2); c.vst0 = v_st(c.sr, c.sc); c.vst1 = v_st(32 + c.sr, c.sc);
    c.vb0 = (int)(unsigned)(size_t)(lds + A_V) + v_rd_base(c.lane);
    c.ws = (LAS float*)(lds + A_WS) + c.wid * 64;
    return c;
}
struct Stage { bf16x8 k0, k1, v0, v1; };
__device__ __forceinline__ void stage_load(Stage& S, const bf16_t* Kp, const bf16_t* Vp, int pitch, int kb, const ACtx& c) {
    S.v0 = *(const bf16x8*)(Vp + (size_t)(kb + c.sr) * pitch + c.sc); S.v1 = *(const bf16x8*)(Vp + (size_t)(kb + 32 + c.sr) * pitch + c.sc);
    S.k0 = *(const bf16x8*)(Kp + (size_t)(kb + c.sr) * pitch + c.sc); S.k1 = *(const bf16x8*)(Kp + (size_t)(kb + 32 + c.sr) * pitch + c.sc);
}
__device__ __forceinline__ void stage_write(const Stage& S, int buf, const ACtx& c) {
    LAS unsigned char* Kb = c.lds + A_K + buf * SHM_T; LAS unsigned char* Vb = c.lds + A_V + buf * SHM_T;
    *(LAS bf16x8*)(Kb + c.kws) = S.k0; *(LAS bf16x8*)(Kb + c.kws + 32 * 256) = S.k1;
    *(LAS bf16x8*)(Vb + c.vst0) = S.v0; *(LAS bf16x8*)(Vb + c.vst1) = S.v1;
}
__device__ __forceinline__ void qkt(f32x16& p0, f32x16& p1, int buf, const ACtx& c, const bf16x8* qr) {
    p0 = (f32x16){}; p1 = (f32x16){};
    const LAS unsigned char* Kb = c.lds + A_K + buf * SHM_T;
    const LAS unsigned char* kb[4];
#pragma unroll
    for (int dd = 0; dd < 4; ++dd) kb[dd] = Kb + KSWZ(c.r32, (dd * 16 + c.hi * 8) * 2);
#pragma unroll
    for (int d0 = 0; d0 < 8; ++d0) { const LAS unsigned char* a = kb[d0 & 3] + (d0 >> 2) * 128;
        const bf16x8 b0 = *(const LAS bf16x8*)a; const bf16x8 b1 = *(const LAS bf16x8*)(a + 32 * 256);
        p0 = __builtin_amdgcn_mfma_f32_32x32x16_bf16(b0, qr[d0], p0, 0, 0, 0);
        p1 = __builtin_amdgcn_mfma_f32_32x32x16_bf16(b1, qr[d0], p1, 0, 0, 0); }
}
__device__ __forceinline__ void pv_tile(f32x16* o, int buf, const ACtx& c, bf16x8 pa0, bf16x8 pa1, bf16x8 pa2, bf16x8 pa3) {
    const int vb = c.vb0 + buf * SHM_T;
#define TRRD(dst, off) asm volatile("ds_read_b64_tr_b16 %0, %1 offset:%2" : "=&v"(dst) : "v"(vb), "i"(off) : "memory")
#define PV_D0(d0) do { s16x4 l0, l1, l2, l3, h0, h1, h2, h3; constexpr int b_ = v_rd_off(d0, 0, 0); \
        TRRD(l0, b_); TRRD(h0, b_ + 2048); TRRD(l1, b_ + 4096); TRRD(h1, b_ + 6144); TRRD(l2, b_ + 8192); TRRD(h2, b_ + 10240); TRRD(l3, b_ + 12288); TRRD(h3, b_ + 14336); \
        asm volatile("s_waitcnt lgkmcnt(0)" ::: "memory"); SBAR(); \
        o[d0] = __builtin_amdgcn_mfma_f32_32x32x16_bf16(pa0, (bf16x8){l0[0], l0[1], l0[2], l0[3], h0[0], h0[1], h0[2], h0[3]}, o[d0], 0, 0, 0); \
        o[d0] = __builtin_amdgcn_mfma_f32_32x32x16_bf16(pa1, (bf16x8){l1[0], l1[1], l1[2], l1[3], h1[0], h1[1], h1[2], h1[3]}, o[d0], 0, 0, 0); \
        o[d0] = __builtin_amdgcn_mfma_f32_32x32x16_bf16(pa2, (bf16x8){l2[0], l2[1], l2[2], l2[3], h2[0], h2[1], h2[2], h2[3]}, o[d0], 0, 0, 0); \
        o[d0] = __builtin_amdgcn_mfma_f32_32x32x16_bf16(pa3, (bf16x8){l3[0], l3[1], l3[2], l3[3], h3[0], h3[1], h3[2], h3[3]}, o[d0], 0, 0, 0); } while (0)
    PV_D0(0); PV_D0(1); PV_D0(2); PV_D0(3);
#undef PV_D0
#undef TRRD
}
__device__ __forceinline__ float swap_max(float v) { auto rr = __builtin_amdgcn_permlane32_swap(__float_as_uint(v), __float_as_uint(v), false, false); return fmaxf(__uint_as_float(rr[0]), __uint_as_float(rr[1])); }
__device__ __forceinline__ float swap_sum(float v) { auto rr = __builtin_amdgcn_permlane32_swap(__float_as_uint(v), __float_as_uint(v), false, false); return __uint_as_float(rr[0]) + __uint_as_float(rr[1]); }
__device__ __forceinline__ void swap_both(float v, float& lo, float& hi) { auto rr = __builtin_amdgcn_permlane32_swap(__float_as_uint(v), __float_as_uint(v), false, false); lo = __uint_as_float(rr[0]); hi = __uint_as_float(rr[1]); }
__device__ __forceinline__ void pack_p(const f32x16& p0, const f32x16& p1, bf16x8& pa0, bf16x8& pa1, bf16x8& pa2, bf16x8& pa3) {
#define PK4(P, B_, OUT) do { unsigned a0 = cvtpk(P[B_+0], P[B_+1]), a1 = cvtpk(P[B_+2], P[B_+3]); \
        unsigned b0 = cvtpk(P[B_+4], P[B_+5]), b1 = cvtpk(P[B_+6], P[B_+7]); \
        auto r0 = __builtin_amdgcn_permlane32_swap(a0, b0, false, false); auto r1 = __builtin_amdgcn_permlane32_swap(a1, b1, false, false); \
        v4u w = {r0[0], r1[0], r0[1], r1[1]}; OUT = __builtin_bit_cast(bf16x8, w); } while (0)
    PK4(p0, 0, pa0); PK4(p0, 8, pa1); PK4(p1, 0, pa2); PK4(p1, 8, pa3);
#undef PK4
}
__device__ __forceinline__ void mask_tile(f32x16& p0, f32x16& p1, int dq, unsigned W) {
    const float NEG = -__builtin_inff();
#pragma unroll
    for (int r = 0; r < 16; ++r) { const int cc = (r & 3) + 8 * (r >> 2);
        if ((unsigned)(dq - cc) >= W) p0[r] = NEG;
        if ((unsigned)(dq - cc - 32) >= W) p1[r] = NEG; }
}
constexpr float THR = 8.f;
__device__ __forceinline__ void softmax_tile(f32x16& p0, f32x16& p1, float& m_reg, float& l_reg, f32x16* o, const ACtx& c) {
    float pmax = p0[0];
#pragma unroll
    for (int r = 1; r < 16; ++r) pmax = fmaxf(pmax, p0[r]);
#pragma unroll
    for (int r = 0; r < 16; ++r) pmax = fmaxf(pmax, p1[r]);
    pmax = swap_max(pmax);
    constexpr float C2 = LOG2E * SCALE;
    float mn, alpha;
    if (__all((pmax - m_reg) * SCALE <= THR)) { mn = m_reg; alpha = 1.f; }
    else { mn = fmaxf(m_reg, pmax); alpha = __builtin_amdgcn_exp2f((m_reg - mn) * C2); m_reg = mn; }
    const float mnL = -mn * C2;
#pragma unroll
    for (int r = 0; r < 16; ++r) { p0[r] = __builtin_amdgcn_exp2f(fmaf(p0[r], C2, mnL)); p1[r] = __builtin_amdgcn_exp2f(fmaf(p1[r], C2, mnL)); }
    float ps = 0.f;
#pragma unroll
    for (int r = 0; r < 16; ++r) ps += p0[r] + p1[r];
    ps = swap_sum(ps);
    l_reg = l_reg * alpha + ps;
    if (__any(alpha < 1.f)) {
        if (c.hi == 0) c.ws[32 + c.r32] = alpha;
        LDS_WAIT();
#pragma unroll
        for (int r = 0; r < 16; ++r) { const float a = c.ws[32 + crow(r, c.hi)];
#pragma unroll
            for (int d = 0; d < 4; ++d) o[d][r] *= a; }
    }
}
__device__ __forceinline__ void row_factors(float f, float (&fr)[16], const ACtx& c) {
    LDS_WAIT();
    if (c.hi == 0) c.ws[c.r32] = f;
    LDS_WAIT();
#pragma unroll
    for (int r = 0; r < 16; ++r) fr[r] = c.ws[crow(r, c.hi)];
    LDS_WAIT();
}
template <bool ROPE>
__device__ __forceinline__ void load_q(bf16x8 (&qr)[8], const bf16_t* qrow, const float* cosr, const float* sinr, int hi) {
#pragma unroll
    for (int d0 = 0; d0 < 8; ++d0) qr[d0] = *(const bf16x8*)(qrow + d0 * 16 + hi * 8);
    if constexpr (ROPE) {
#pragma unroll
        for (int d0 = 0; d0 < 4; ++d0) {
            const int i0 = d0 * 16 + hi * 8;
            const f32x4 c0 = *(const f32x4*)(cosr + i0), c1 = *(const f32x4*)(cosr + i0 + 4), s0 = *(const f32x4*)(sinr + i0), s1 = *(const f32x4*)(sinr + i0 + 4);
            f32x4 a0, a1, b0, b1; unpack8(qr[d0], a0, a1); unpack8(qr[d0 + 4], b0, b1);
            qr[d0] = pack8(a0 * c0 - b0 * s0, a1 * c1 - b1 * s1);
            qr[d0 + 4] = pack8(b0 * c0 + a0 * s0, b1 * c1 + a1 * s1);
        }
    }
}
__device__ __forceinline__ void store_o_bf16(const f32x16* o, bf16_t* Ow  , int pitch, const ACtx& c) {
#pragma unroll
    for (int r = 0; r < 16; ++r) { const int orow = crow(r, c.hi);
#pragma unroll
        for (int d0 = 0; d0 < 4; ++d0) { const float v = o[d0][r]; const float vn = __shfl_xor(v, 1);
            if ((c.r32 & 1) == 0) *(unsigned*)(Ow + (size_t)orow * pitch + d0 * 32 + c.r32) = cvtpk(v, vn); } }
}

__device__ __forceinline__ void add_o_bf16(f32x16* o, const bf16_t* Ow, int pitch, const ACtx& c) {
#pragma unroll
    for (int r = 0; r < 16; ++r) { const int orow = crow(r, c.hi);
#pragma unroll
        for (int d0 = 0; d0 < 4; ++d0) o[d0][r] += bf2f(Ow[(size_t)orow * pitch + d0 * 32 + c.r32]); }
}
__device__ __forceinline__ int wq_next(gu32* ctr, LAS int* slot, int tid) {
    __syncthreads();
    if (tid == 0) *slot = (int)__hip_atomic_fetch_add(ctr, 1u, RLX_AGENT);
    __syncthreads();
    return *slot;
}
template <int MODE>
__device__ __forceinline__ void softmax_sweep(const ACtx& c, const bf16x8 (&qr)[8], f32x16 (&o)[4], float& l_out, const bf16_t* Kp, const bf16_t* Vp, int pitch,
                                              int j_lo, int j_hi, int qpos, int qlo, unsigned selbits) {
    float m_reg = -1e30f, l_reg = 0.f;
#pragma unroll
    for (int d = 0; d < 4; ++d) o[d] = (f32x16){};
    Stage S; stage_load(S, Kp, Vp, pitch, j_lo * 64, c);
    for (int j = j_lo; j < j_hi; ++j) {
        const int buf = (j - j_lo) & 1;
        stage_write(S, buf, c);
        __syncthreads();
        if (j + 1 < j_hi) stage_load(S, Kp, Vp, pitch, (j + 1) * 64, c);
        const int kb = j * 64;
        bool act = true;
        if (MODE == 1) act = (kb <= qlo + 31) && (kb + 63 >= qlo - (WINDOW - 1));
        if (MODE == 2) act = (kb <= qlo + 31) && __any((int)((selbits >> j) & 1u));
        if (act) {
            f32x16 p0, p1; qkt(p0, p1, buf, c, qr);
            if (MODE == 1) { if (kb + 63 > qlo || kb < qlo + 31 - (WINDOW - 1)) mask_tile(p0, p1, qpos - kb - 4 * c.hi, (unsigned)WINDOW); }
            if (MODE == 2) { if (kb + 63 > qlo) mask_tile(p0, p1, qpos - kb - 4 * c.hi, 0x7fffffffu);
                if (!__all((int)((selbits >> j) & 1u))) { if (!((selbits >> j) & 1u)) { const float NEG = -__builtin_inff();
#pragma unroll
                    for (int r = 0; r < 16; ++r) { p0[r] = NEG; p1[r] = NEG; } } } }
            softmax_tile(p0, p1, m_reg, l_reg, o, c);
            bf16x8 pa0, pa1, pa2, pa3; pack_p(p0, p1, pa0, pa1, pa2, pa3);
            pv_tile(o, buf, c, pa0, pa1, pa2, pa3);
        }
    }
    __syncthreads();
    l_out = l_reg;
}

struct Params {
    const float* x; const float* mem; const int* positions; const float* norm_g; const float* w_in_sb; const float* w_in_nsa; const float* cmp_pe; const float* cmp_w1; const float* cmp_w2;
    const float* w_mem_kv; const float* w_o; const float* w_gate; const float* w_up; const float* conv_w; const float* conv_b; const float* w_down;
    float* out; unsigned char* ws; int ph_lo, ph_hi;
};
struct Frame {
    LAS unsigned char* lds; int tid, lane, wave, G, bid;
};
#define WSP(T, off) ((T*)(p.ws + (off)))

__device__ __forceinline__ void tr_item(const float* W, int K, int Nsrc, int src_col0, int ncols, const float* gain, bf16_t* WT, int dst_row0, int mode, int item, int lane) {
    const int nblk = (ncols + 255) >> 8, kb = item / nblk, nb = item - kb * nblk, k0 = 16 * kb, n = nb * 256 + 4 * lane;
    if (n >= ncols) return;
    f32x4 v[16];
    if (W != nullptr) {
        const float* src = W + (size_t)k0 * Nsrc + src_col0 + n;
#pragma unroll
        for (int j = 0; j < 16; ++j) v[j] = *(const f32x4*)(src + (size_t)j * Nsrc);
        if (gain) {
#pragma unroll
            for (int j = 0; j < 16; ++j) v[j] = v[j] * gain[k0 + j];
        }
    } else {
#pragma unroll
        for (int j = 0; j < 16; ++j) v[j] = (f32x4){0.f, 0.f, 0.f, 0.f};
    }
#pragma unroll
    for (int e = 0; e < 4; ++e) {
        const int nn = n + e; const int drow = dst_row0 + (mode == 0 ? nn : 256 * (nn >> 7) + (nn & 127));
        v4u o0, o1;
        o0.x = cvtpk(v[0][e], v[1][e]); o0.y = cvtpk(v[2][e], v[3][e]); o0.z = cvtpk(v[4][e], v[5][e]); o0.w = cvtpk(v[6][e], v[7][e]);
        o1.x = cvtpk(v[8][e], v[9][e]); o1.y = cvtpk(v[10][e], v[11][e]); o1.z = cvtpk(v[12][e], v[13][e]); o1.w = cvtpk(v[14][e], v[15][e]);
        v4u* dst = (v4u*)(WT + (size_t)drow * K + k0); dst[0] = o0; dst[1] = o1;
    }
}
__device__ __forceinline__ void row_to_bf16_rstd(const float* xrow, bf16_t* orow, float* rstd_out, int lane) {
    const f32x4* xr = (const f32x4*)xrow + lane; f32x4 v[8]; float s = 0.f;
#pragma unroll
    for (int j = 0; j < 8; ++j) { v[j] = xr[64 * j]; s += (v[j].x * v[j].x + v[j].y * v[j].y) + (v[j].z * v[j].z + v[j].w * v[j].w); }
    s = wave_sum(s);
    v2u* o8 = (v2u*)orow + lane;
#pragma unroll
    for (int j = 0; j < 8; ++j) { v2u w; w.x = cvtpk(v[j].x, v[j].y); w.y = cvtpk(v[j].z, v[j].w); o8[64 * j] = w; }
    if (lane == 0) *rstd_out = 1.0f / sqrtf(s * (1.0f / DM) + NORM_EPS);
}
template <class PP> __device__ __forceinline__ void phase_convert(const PP& p, const Frame& F, int L) {
    const int gw = F.bid * NWAVES + F.wave, NGW = F.G * NWAVES;
    int it0 = gw;
#define TR(W, K, Nsrc, sc0, nc, gain, WT, dr0, mode) do { const int n_ = ((K) / 16) * (((nc) + 255) >> 8); for (; it0 < n_; it0 += NGW) tr_item(W, K, Nsrc, sc0, nc, gain, WT, dr0, mode, it0, F.lane); it0 -= n_; } while (0)
    const float* g = p.norm_g + (size_t)L * 5 * DM;
    const int j = L >> 1;
    bf16_t* WIN = WSP(bf16_t, WS_WIN);
    if ((L & 1) == 0) {
        TR(p.w_in_sb + (size_t)j * DM * SB_N, DM, SB_N, 0, SB_N, g, WIN, 0, 0);
    } else {
        const float* W = p.w_in_nsa + (size_t)j * DM * NSA_SRC;
        TR(W, DM, NSA_SRC, 0, 3072, g, WIN, 0, 0);
        TR(W, DM, NSA_SRC, 3108, 512, g, WIN, NQM, 0);
        TR(W, DM, NSA_SRC, 3072, 36, g, WIN, NGL, 0);
        TR((const float*)nullptr, DM, NSA_SRC, 0, 220, (const float*)nullptr, WIN, NGL + 36, 0);
        for (int wh = 0; wh < 2; ++wh) {
            TR(p.cmp_w1 + (size_t)(j * 2 + wh) * 4096 * 256, 4096, 256, 0, 256, (const float*)nullptr, WSP(bf16_t, WS_CW1) + (size_t)wh * 256 * 4096, 0, 0);
            TR(p.cmp_w2 + (size_t)(j * 2 + wh) * 256 * 128, 256, 128, 0, 128, (const float*)nullptr, WSP(bf16_t, WS_CW2) + (size_t)wh * 128 * 256, 0, 0);
        }
    }
    if ((L & 1) && F.bid < 16) {
        const int wh = F.bid >> 3, n = 32 * (F.bid & 7) + (F.tid & 31), kg = F.tid >> 5;
        const float* pe = p.cmp_pe + (size_t)(j * 2 + wh) * 4096; const float* w1 = p.cmp_w1 + (size_t)(j * 2 + wh) * 4096 * 256;
        float s = 0.f;
        for (int k = kg * 256; k < kg * 256 + 256; ++k) s += pe[k] * w1[(size_t)k * 256 + n];
        LAS float* red = (LAS float*)F.lds;
        red[kg * 32 + (F.tid & 31)] = s;
        __syncthreads();
        if (F.tid < 32) { float t = 0.f;
#pragma unroll
            for (int q = 0; q < 16; ++q) t += red[q * 32 + F.tid];
            WSP(float, WS_BIAS1)[wh * 256 + n] = t; }
        __syncthreads();
    }
    TR(p.w_o + (size_t)L * DM * DM, DM, DM, 0, DM, (const float*)nullptr, WSP(bf16_t, WS_WO), 0, 0);
    TR(p.w_gate + (size_t)L * DM * DFF, DM, DFF, 0, DFF, g + 2 * DM, WSP(bf16_t, WS_WGU), 0, 1);
    TR(p.w_up + (size_t)L * DM * DFF, DM, DFF, 0, DFF, g + 2 * DM, WSP(bf16_t, WS_WGU), 128, 1);
    TR(p.w_down + (size_t)L * DFF * DM, DFF, DM, 0, DM, (const float*)nullptr, WSP(bf16_t, WS_WD), 0, 0);
    if (L == 0) {
        for (int l = 0; l < DEPTH; ++l)
            TR(p.w_mem_kv + (size_t)l * DM * 1024, DM, 1024, 0, 1024, p.norm_g + (size_t)(l * 5 + 4) * DM, WSP(bf16_t, WS_WKV), l * 1024, 0);
        float* rstd = WSP(float, WS_RSTD);
        for (int m = gw; m < MTOK; m += NGW) row_to_bf16_rstd(p.x + (size_t)m * DM, WSP(bf16_t, WS_XB) + (size_t)m * DM, rstd + m, F.lane);
        for (int m = gw; m < NB * NMEM; m += NGW) row_to_bf16_rstd(p.mem + (size_t)m * DM, WSP(bf16_t, WS_MEMB) + (size_t)m * DM, rstd + 16384 + m, F.lane);
        float* cosT = WSP(float, WS_COS); float* sinT = WSP(float, WS_SIN);
        for (int idx = F.bid * NTHR + F.tid; idx < MTOK * 64; idx += F.G * NTHR) {
            const int row = idx >> 6, i = idx & 63;
            const float ang = (float)p.positions[row] * INV_FREQ[i];
            double t = (double)ang * 0.15915494309189535; t -= __builtin_rint(t);
            const float fr = (float)t;
            cosT[idx] = __builtin_amdgcn_cosf(fr); sinT[idx] = __builtin_amdgcn_sinf(fr);
        }
    }
#undef TR
}

template <class PP> __device__ __forceinline__ void phase_resid(const PP& p, const Frame& F, const float* xin, const float* gpost, float* xout, bf16_t* XB, float* rstd) {
    const int gw = F.bid * NWAVES + F.wave, NGW = F.G * NWAVES;
    const bf16_t* T = WSP(bf16_t, WS_TMP);
    for (int m = gw; m < MTOK; m += NGW) {
        const bf16x8* ar = (const bf16x8*)(T + (size_t)m * DM) + F.lane;
        f32x4 a[8]; float s = 0.f;
#pragma unroll
        for (int j = 0; j < 4; ++j) { unpack8(ar[64 * j], a[2 * j], a[2 * j + 1]); }
#pragma unroll
        for (int j = 0; j < 8; ++j) s += (a[j].x * a[j].x + a[j].y * a[j].y) + (a[j].z * a[j].z + a[j].w * a[j].w);
        const float ra = 1.0f / sqrtf(wave_sum(s) * (1.0f / DM) + NORM_EPS);
        float s2 = 0.f;
#pragma unroll
        for (int j = 0; j < 4; ++j) {
            const int e0 = (j * 64 + F.lane) * 8;
#pragma unroll
            for (int h = 0; h < 2; ++h) {
                const f32x4 xv = *(const f32x4*)(xin + (size_t)m * DM + e0 + 4 * h), gv = *(const f32x4*)(gpost + e0 + 4 * h);
                const f32x4 y = xv + a[2 * j + h] * ra * gv;
                a[2 * j + h] = y; s2 += (y.x * y.x + y.y * y.y) + (y.z * y.z + y.w * y.w);
                *(f32x4*)(xout + (size_t)m * DM + e0 + 4 * h) = y;
            }
            *((bf16x8*)(XB + (size_t)m * DM) + 64 * j + F.lane) = pack8(a[2 * j], a[2 * j + 1]);
        }
        s2 = wave_sum(s2);
        if (F.lane == 0) rstd[m] = 1.0f / sqrtf(s2 * (1.0f / DM) + NORM_EPS);
    }
}
template <class PP> __device__ __forceinline__ void phase_convfix(const PP& p, const Frame& F, int L) {
    bf16_t* ACT = WSP(bf16_t, WS_ACT); const float* HG = WSP(float, WS_HG); const float* FP = WSP(float, WS_FP); const float* FU = WSP(float, WS_FU);
    const float* cw = p.conv_w + (size_t)L * 3 * DFF;
    constexpr int NCH = DFF / 4;
    for (int it = F.bid * NTHR + F.tid; it < 64 * 2 * NCH; it += F.G * NTHR) {
        const int pm = it / (2 * NCH), rem = it - pm * 2 * NCH, i = rem / NCH, f0 = (rem - i * NCH) * 4;
        if ((pm & 7) == 0) continue;
        const f32x4 h0 = *(const f32x4*)(HG + (size_t)((pm - 1) * 2 + 0) * DFF + f0), h1 = *(const f32x4*)(HG + (size_t)((pm - 1) * 2 + 1) * DFF + f0);
        const f32x4 w0 = *(const f32x4*)(cw + f0), w1 = *(const f32x4*)(cw + DFF + f0);
        f32x4 gc = *(const f32x4*)(FP + (size_t)(pm * 2 + i) * DFF + f0); const f32x4 uu = *(const f32x4*)(FU + (size_t)(pm * 2 + i) * DFF + f0);
        if (i == 0) gc += w0 * h0 + w1 * h1; else gc += w0 * h1;
        v2u o; o.x = cvtpk(gc[0] * sigmoidf_(gc[0]) * uu[0], gc[1] * sigmoidf_(gc[1]) * uu[1]); o.y = cvtpk(gc[2] * sigmoidf_(gc[2]) * uu[2], gc[3] * sigmoidf_(gc[3]) * uu[3]);
        *(v2u*)(ACT + (size_t)(pm * 256 + i) * DFF + f0) = o;
    }
}

template <class PP> __device__ __forceinline__ void sb_unit(const PP& p, const ACtx& c, int b, int h, int qt) {
    const bf16_t* PR = WSP(bf16_t, WS_PROJ); bf16_t* OC = WSP(bf16_t, WS_OCAT);
    const int P0 = qt * 256, qlo = P0 + c.wid * 32, qpos = qlo + c.r32;
    const size_t rowb = (size_t)b * SEQ;
    bf16x8 qr[8]; load_q<false>(qr, PR + (rowb + qpos) * SB_N + SBQ + h * HD, nullptr, nullptr, c.hi);
    const bf16_t* Kp = PR + rowb * SB_N + SBK + h * HD; const bf16_t* Vp = PR + rowb * SB_N + SBV + h * HD;
    f32x16 o[4];
#pragma unroll
    for (int d = 0; d < 4; ++d) o[d] = (f32x16){};
    float C2 = 0.f;
    const int jt = (P0 >> 6) + 3;
    LAS int* flags = (LAS int*)(c.lds + A_FLAGS);
    int done_w = 0;
    Stage S; stage_load(S, Kp, Vp, SB_N, jt * 64, c);
    constexpr float ZS = SCALE * LOG2E;
    for (int it = 0; it <= jt; ++it) {
        const int j = jt - it, buf = it & 1;
        stage_write(S, buf, c);
        if (c.lane == 0) flags[buf * 8 + c.wid] = done_w;
        __syncthreads();
        int alld = 1;
#pragma unroll
        for (int w = 0; w < 8; ++w) alld &= flags[buf * 8 + w];
        if (alld) break;
        if (j > 0) stage_load(S, Kp, Vp, SB_N, (j - 1) * 64, c);
        const int kb = j * 64;
        if (!done_w && kb <= qlo + 30) {
            f32x16 p0, p1; qkt(p0, p1, buf, c, qr);
            const int dq = qpos - kb - 4 * c.hi;
#pragma unroll
            for (int r = 0; r < 16; ++r) { const int cc = (r & 3) + 8 * (r >> 2);
                { const float z = p0[r] * ZS; const float t = __builtin_amdgcn_exp2f(-fabsf(z)); const float v = -(fmaxf(z, 0.f) + __builtin_amdgcn_logf(1.f + t)); p0[r] = (cc < dq) ? v : 0.f; }
                { const float z = p1[r] * ZS; const float t = __builtin_amdgcn_exp2f(-fabsf(z)); const float v = -(fmaxf(z, 0.f) + __builtin_amdgcn_logf(1.f + t)); p1[r] = (cc + 32 < dq) ? v : 0.f; } }
            float E[8], Od[8];
#pragma unroll
            for (int q = 0; q < 4; ++q) { const float g0 = (p0[4 * q] + p0[4 * q + 1]) + (p0[4 * q + 2] + p0[4 * q + 3]); swap_both(g0, E[q], Od[q]);
                                          const float g1 = (p1[4 * q] + p1[4 * q + 1]) + (p1[4 * q + 2] + p1[4 * q + 3]); swap_both(g1, E[4 + q], Od[4 + q]); }
            float T = 0.f, ex[8];
#pragma unroll
            for (int q = 7; q >= 0; --q) { const float to = T; T += Od[q]; const float te = T; T += E[q]; ex[q] = c.hi ? to : te; }
#pragma unroll
            for (int q = 0; q < 4; ++q) {
                { float R = C2 + ex[q]; float ep = __builtin_amdgcn_exp2f(R);
#pragma unroll
                  for (int i = 3; i >= 0; --i) { R += p0[4 * q + i]; const float e = __builtin_amdgcn_exp2f(R); p0[4 * q + i] = ep - e; ep = e; } }
                { float R = C2 + ex[4 + q]; float ep = __builtin_amdgcn_exp2f(R);
#pragma unroll
                  for (int i = 3; i >= 0; --i) { R += p1[4 * q + i]; const float e = __builtin_amdgcn_exp2f(R); p1[4 * q + i] = ep - e; ep = e; } }
            }
            C2 += T;
            bf16x8 pa0, pa1, pa2, pa3; pack_p(p0, p1, pa0, pa1, pa2, pa3);
            pv_tile(o, buf, c, pa0, pa1, pa2, pa3);
            done_w = __all(C2 < -72.f) ? 1 : 0;
        }
    }
    __syncthreads();
    store_o_bf16(o, OC + (rowb + qlo) * DM + h * HD, DM, c);
}
template <class PP> __device__ __forceinline__ void mem_unit(const PP& p, const ACtx& c, int L, int b, int hm, int qt, int projN, int qmcol) {
    const bf16_t* PR = WSP(bf16_t, WS_PROJ); bf16_t* OC = WSP(bf16_t, WS_OCAT); const bf16_t* MKV = WSP(bf16_t, WS_MEMKV);
    const int P0 = qt * 256, qlo = P0 + c.wid * 32, qpos = qlo + c.r32;
    const size_t rowb = (size_t)b * SEQ;
    bf16x8 qr[8]; load_q<false>(qr, PR + (rowb + qpos) * projN + qmcol + hm * HD, nullptr, nullptr, c.hi);
    const bf16_t* Kp = MKV + (size_t)b * NMEM * 4096 + L * 1024 + hm * HD; const bf16_t* Vp = Kp + 512;
    f32x16 o[4]; float l;
    softmax_sweep<0>(c, qr, o, l, Kp, Vp, 4096, 0, 4, qpos, qlo, 0u);
    float fr[16]; row_factors(1.0f / l, fr, c);
#pragma unroll
    for (int d = 0; d < 4; ++d)
#pragma unroll
        for (int r = 0; r < 16; ++r) o[d][r] *= fr[r];
    store_o_bf16(o, OC + (rowb + qlo) * DM + NMIX * HD + hm * HD, DM, c);
}
template <class PP> __device__ __forceinline__ void phase_attn_sb(const PP& p, const Frame& F, int L, gu32* ctr) {
    const ACtx c = make_actx(F.lds);
    LAS int* slot = (LAS int*)(F.lds + MISC_OFF) + 16;
    constexpr int NSBU = NB * NMIX * 8, NMU = NB * NMEMH * 8;
    for (;;) { const int u = wq_next(ctr, slot, c.tid); if (u >= NSBU + NMU) break;
        if (u < NSBU) { const int qt = 7 - (u / (NB * NMIX)), bh = u % (NB * NMIX); sb_unit(p, c, bh / NMIX, bh % NMIX, qt); }
        else { const int v = u - NSBU; const int qt = v % 8, bh = v / 8; mem_unit(p, c, L, bh / NMEMH, bh % NMEMH, qt, SB_N, SBQM); }
    }
}

template <class PP> __device__ __forceinline__ void phase_rope(const PP& p, const Frame& F) {
    bf16_t* PR = WSP(bf16_t, WS_PROJ); const float* cosT = WSP(float, WS_COS); const float* sinT = WSP(float, WS_SIN);
    const int lane = F.lane, gw = F.bid * NWAVES + F.wave, NGW = F.G * NWAVES;
    for (int m = gw; m < MTOK; m += NGW) {
        const float cv = cosT[(size_t)m * 64 + lane], sv = sinT[(size_t)m * 64 + lane];
        bf16_t* rowp = PR + (size_t)m * NSA_N;
        float x1[6], x2[6];
#pragma unroll
        for (int q = 0; q < 6; ++q) { const int base = ((q < 2) ? NKC : (q < 4) ? NKS : NKW) + (q & 1) * HD; x1[q] = bf2f(rowp[base + lane]); x2[q] = bf2f(rowp[base + 64 + lane]); }
#pragma unroll
        for (int q = 0; q < 6; ++q) { const int base = ((q < 2) ? NKC : (q < 4) ? NKS : NKW) + (q & 1) * HD;
            const float y1 = x1[q] * cv - x2[q] * sv, y2 = x2[q] * cv + x1[q] * sv;
            rowp[base + lane] = (bf16_t)(cvtpk(y1, y1) & 0xffffu); rowp[base + 64 + lane] = (bf16_t)(cvtpk(y2, y2) & 0xffffu); }
    }
}
template <class PP> __device__ __forceinline__ void phase_cmp_stage2(const PP& p, const Frame& F) {
    const int lane = F.lane, r32 = lane & 31, hi = lane >> 5;
    for (int u = F.bid; u < 128; u += F.G) {
        const int wh = u & 1, rt = u >> 1;
        if (F.wave < 4) {
            const bf16_t* hid = WSP(bf16_t, WS_HID) + (size_t)wh * 2048 * 256 + (size_t)(rt * 32 + r32) * 256;
            const bf16_t* w2 = WSP(bf16_t, WS_CW2) + (size_t)wh * 128 * 256 + (size_t)(F.wave * 32 + r32) * 256;
            f32x16 a2 = (f32x16){};
#pragma unroll
            for (int kk = 0; kk < 16; ++kk) { const int k = kk * 16 + hi * 8;
                a2 = __builtin_amdgcn_mfma_f32_32x32x16_bf16(*(const bf16x8*)(hid + k), *(const bf16x8*)(w2 + k), a2, 0, 0, 0); }
            bf16_t* outp = WSP(bf16_t, WS_KCMP) + (size_t)wh * 16 * 128 * 128;
#pragma unroll
            for (int r = 0; r < 16; ++r) { const int ro = rt * 32 + crow(r, hi);
                const float av_ = a2[r]; const unsigned ub = __float_as_uint(av_); const unsigned rb = (ub + 0x7fffu + ((ub >> 16) & 1u)) >> 16;
                outp[(size_t)ro * 128 + F.wave * 32 + r32] = ((ro & 127) == 127) ? (bf16_t)0 : (bf16_t)rb; }
        }
    }
}

template <class PP> __device__ __forceinline__ void cmp_unit(const PP& p, const ACtx& c, int b, int g, int qt) {
    const bf16_t* PR = WSP(bf16_t, WS_PROJ); bf16_t* OC = WSP(bf16_t, WS_OCAT); const float* cosT = WSP(float, WS_COS); const float* sinT = WSP(float, WS_SIN);
    const int P0 = qt * 256, qlo = P0 + c.wid * 32, qpos = qlo + c.r32, hi = c.hi;
    const size_t rowb = (size_t)b * SEQ, row = rowb + qpos;
    const bf16_t* Kp = WSP(bf16_t, WS_KCMP) + (size_t)(b * 2 + g) * 128 * 128; const bf16_t* Vp = Kp + (size_t)16 * 128 * 128;
    { Stage S; stage_load(S, Kp, Vp, 128, 0, c); stage_write(S, 0, c); stage_load(S, Kp, Vp, 128, 64, c); stage_write(S, 1, c); }
    __syncthreads();
    const int cmax = (qpos >= 31) ? (((qpos - 31) >> 4) < 126 ? ((qpos - 31) >> 4) : 126) : -1;
    LAS float* acc_l = (LAS float*)(c.lds + A_STASH) + c.wid * 2048 + c.lane;
    const float NEG = -__builtin_inff();
    constexpr float C2 = LOG2E * SCALE;
#pragma nounroll
    for (int hh = 0; hh < HPG; ++hh) {
        const int h = g * HPG + hh;
        bf16x8 qr[8]; load_q<true>(qr, PR + row * NSA_N + NQ + h * HD, cosT + row * 64, sinT + row * 64, hi);
        f32x16 pA0, pA1, pB0, pB1; qkt(pA0, pA1, 0, c, qr); qkt(pB0, pB1, 1, c, qr);
        float mx = NEG;
#pragma unroll
        for (int r = 0; r < 16; ++r) { const int ci = crow(r, hi);
            if (ci > cmax) pA0[r] = NEG; if (ci + 32 > cmax) pA1[r] = NEG; if (ci + 64 > cmax) pB0[r] = NEG; if (ci + 96 > cmax) pB1[r] = NEG;
            mx = fmaxf(fmaxf(mx, pA0[r]), fmaxf(pA1[r], fmaxf(pB0[r], pB1[r]))); }
        mx = swap_max(mx); if (mx == NEG) mx = 0.f;
        const float mL = -mx * C2; float ls = 0.f;
#pragma unroll
        for (int r = 0; r < 16; ++r) { pA0[r] = __builtin_amdgcn_exp2f(fmaf(pA0[r], C2, mL)); pA1[r] = __builtin_amdgcn_exp2f(fmaf(pA1[r], C2, mL));
            pB0[r] = __builtin_amdgcn_exp2f(fmaf(pB0[r], C2, mL)); pB1[r] = __builtin_amdgcn_exp2f(fmaf(pB1[r], C2, mL)); ls += (pA0[r] + pA1[r]) + (pB0[r] + pB1[r]); }
        ls = swap_sum(ls);
        const float inv = ls > 0.f ? 1.0f / ls : 0.f;
#pragma unroll
        for (int r = 0; r < 16; ++r) { pA0[r] *= inv; pA1[r] *= inv; pB0[r] *= inv; pB1[r] *= inv; }
#define ACC_AB(P, Q0) do { _Pragma("unroll") for (int q = 0; q < 4; ++q) { \
            const float a_ = 2.f * (P[4 * q] + P[4 * q + 1] + P[4 * q + 2]) + P[4 * q + 3], b_ = P[4 * q + 3]; \
            LAS float* pa_ = acc_l + (2 * (Q0 + q)) * 64; \
            if (hh == 0) { pa_[0] = a_; pa_[64] = b_; } else { pa_[0] += a_; pa_[64] += b_; } } } while (0)
        ACC_AB(pA0, 0); ACC_AB(pA1, 4); ACC_AB(pB0, 8); ACC_AB(pB1, 12);
#undef ACC_AB
        f32x16 o[4];
#pragma unroll
        for (int d = 0; d < 4; ++d) o[d] = (f32x16){};
        { bf16x8 pa0, pa1, pa2, pa3; pack_p(pA0, pA1, pa0, pa1, pa2, pa3); pv_tile(o, 0, c, pa0, pa1, pa2, pa3); }
        { bf16x8 pa0, pa1, pa2, pa3; pack_p(pB0, pB1, pa0, pa1, pa2, pa3); pv_tile(o, 1, c, pa0, pa1, pa2, pa3); }
        const float gc = sigmoidf_(bf2f(PR[row * NSA_N + NGL + h * 3 + 0]));
        float fr[16]; row_factors(gc, fr, c);
#pragma unroll
        for (int d = 0; d < 4; ++d)
#pragma unroll
            for (int r = 0; r < 16; ++r) o[d][r] *= fr[r];
        add_o_bf16(o, OC + (rowb + qlo) * DM + h * HD, DM, c);
        store_o_bf16(o, OC + (rowb + qlo) * DM + h * HD, DM, c);
    }
    float Ie[16], Io[16];
    {
        float imp[16], Bb[16];
#pragma unroll
        for (int q = 0; q < 16; ++q) { float blo, bhi; swap_both(acc_l[(2 * q + 1) * 64], blo, bhi); Bb[q] = hi ? blo : bhi; }
#pragma unroll
        for (int q = 0; q < 16; ++q) imp[q] = acc_l[(2 * q) * 64] + (hi ? Bb[q] : (q > 0 ? Bb[q - 1] : 0.f));
#pragma unroll
        for (int q = 0; q < 16; ++q) swap_both(imp[q], Ie[q], Io[q]);
    }
    const int cur = qpos >> 6;
    unsigned bits;
    if (cur < 16) bits = (2u << cur) - 1u;
    else {
#pragma unroll
        for (int q = 0; q < 16; ++q) { const int je = 2 * q, jo = 2 * q + 1;
            if (!(je >= 1 && je <= cur - 2)) Ie[q] = -1.f; if (!(jo >= 1 && jo <= cur - 2)) Io[q] = -1.f; }
        bits = 0u;
#pragma unroll
        for (int q = 0; q < 16; ++q) {
            const int jm = 2 * q + hi; const float vj = hi ? Io[q] : Ie[q];
            int rank = 0;
#pragma unroll
            for (int q2 = 0; q2 < 16; ++q2) {
                const bool lt_e = (q2 < q) || (q2 == q && hi);
                const bool lt_o = (q2 < q);
                rank += (Ie[q2] > vj || (Ie[q2] == vj && lt_e)) ? 1 : 0;
                rank += (Io[q2] > vj || (Io[q2] == vj && lt_o)) ? 1 : 0;
            }
            const bool forced = (jm == 0) || (jm == cur) || (jm == cur - 1);
            const bool sel = forced || (vj >= 0.f && rank < 13);
            bits |= sel ? (1u << jm) : 0u;
        }
        { auto rr = __builtin_amdgcn_permlane32_swap(bits, bits, false, false); bits = rr[0] | rr[1]; }
    }
    if (hi == 0) WSP(unsigned, WS_SEL)[(size_t)(b * 2 + g) * SEQ + qpos] = bits;
    __syncthreads();
}
template <class PP> __device__ __forceinline__ void phase_attn_cmp(const PP& p, const Frame& F) {
    const ACtx c = make_actx(F.lds);
    constexpr int NCU = NB * NGRP * 8;
    for (int u = F.bid; u < NCU; u += F.G) { const int qt = 7 - (u % 8), bg = u / 8; cmp_unit(p, c, bg >> 1, bg & 1, qt); }
}
template <class PP> __device__ __forceinline__ void win_unit(const PP& p, const ACtx& c, int b, int h, int qt) {
    const bf16_t* PR = WSP(bf16_t, WS_PROJ); bf16_t* OC = WSP(bf16_t, WS_OCAT); const float* cosT = WSP(float, WS_COS); const float* sinT = WSP(float, WS_SIN);
    const int P0 = qt * 256, qlo = P0 + c.wid * 32, qpos = qlo + c.r32, g = h / HPG;
    const size_t rowb = (size_t)b * SEQ, row = rowb + qpos;
    bf16x8 qr[8]; load_q<true>(qr, PR + row * NSA_N + NQ + h * HD, cosT + row * 64, sinT + row * 64, c.hi);
    const float gwn = sigmoidf_(bf2f(PR[row * NSA_N + NGL + h * 3 + 2]));
    f32x16 o[4]; float l;
    const int jlo = (P0 - (WINDOW - 1)) > 0 ? ((P0 - (WINDOW - 1)) >> 6) : 0;
    softmax_sweep<1>(c, qr, o, l, PR + rowb * NSA_N + NKW + g * HD, PR + rowb * NSA_N + NVW + g * HD, NSA_N, jlo, (P0 >> 6) + 4, qpos, qlo, 0u);
    float fr[16]; row_factors(l > 0.f ? gwn / l : 0.f, fr, c);
#pragma unroll
    for (int d = 0; d < 4; ++d)
#pragma unroll
        for (int r = 0; r < 16; ++r) o[d][r] *= fr[r];
    store_o_bf16(o, OC + (rowb + qlo) * DM + h * HD, DM, c);
}
template <class PP> __device__ __forceinline__ void nsa_win_mem_units(const PP& p, const Frame& F, int L, gu32* ctr) {
    const ACtx c = make_actx(F.lds);
    LAS int* slot = (LAS int*)(F.lds + MISC_OFF) + 16;
    constexpr int NWU = NB * NMIX * 8, NMU = NB * NMEMH * 8;
    for (;;) { const int u = wq_next(ctr, slot, c.tid); if (u >= NWU + NMU) break;
        if (u < NWU) { const int qt = 7 - (u / (NB * NMIX)), bh = u % (NB * NMIX); win_unit(p, c, bh / NMIX, bh % NMIX, qt); }
        else { const int v = u - NWU; const int qt = v % 8, bh = v / 8; mem_unit(p, c, L, bh / NMEMH, bh % NMEMH, qt, NSA_N, NQM); }
    }
}
template <class PP> __device__ __forceinline__ void sel_unit(const PP& p, const ACtx& c, int b, int h, int qt, bf16_t* OUT) {
    const bf16_t* PR = WSP(bf16_t, WS_PROJ); const bf16_t* OC = WSP(bf16_t, WS_OCAT); const float* cosT = WSP(float, WS_COS); const float* sinT = WSP(float, WS_SIN);
    const int P0 = qt * 256, qlo = P0 + c.wid * 32, qpos = qlo + c.r32, g = h / HPG;
    const size_t rowb = (size_t)b * SEQ, row = rowb + qpos;
    bf16x8 qr[8]; load_q<true>(qr, PR + row * NSA_N + NQ + h * HD, cosT + row * 64, sinT + row * 64, c.hi);
    const unsigned selbits = WSP(unsigned, WS_SEL)[(size_t)(b * 2 + g) * SEQ + qpos];
    const float gs = sigmoidf_(bf2f(PR[row * NSA_N + NGL + h * 3 + 1]));
    f32x16 o[4]; float l;
    softmax_sweep<2>(c, qr, o, l, PR + rowb * NSA_N + NKS + g * HD, PR + rowb * NSA_N + NVS + g * HD, NSA_N, 0, (P0 >> 6) + 4, qpos, qlo, selbits);
    float fr[16]; row_factors(l > 0.f ? gs / l : 0.f, fr, c);
#pragma unroll
    for (int d = 0; d < 4; ++d)
#pragma unroll
        for (int r = 0; r < 16; ++r) o[d][r] *= fr[r];
    add_o_bf16(o, OC + (rowb + qlo) * DM + h * HD, DM, c);
    store_o_bf16(o, OUT + (rowb + qlo) * DM + h * HD, DM, c);
}
template <class PP> __device__ __forceinline__ void phase_attn_sel(const PP& p, const Frame& F, bf16_t* OUT, gu32* ctr) {
    const ACtx c = make_actx(F.lds);
    LAS int* slot = (LAS int*)(F.lds + MISC_OFF) + 16;
    constexpr int NU = NB * NMIX * 8;
    for (;;) { const int u = wq_next(ctr, slot, c.tid); if (u >= NU) break;
        const int qt = 7 - (u / (NB * NMIX)), bh = u % (NB * NMIX); sel_unit(p, c, bh / NMIX, bh % NMIX, qt, OUT); }
}

#define LAST_() (rep_ == nrep_ - 1)
#define WQ_(k) ((gu32*)(p.ws + WS_CTL) + 64 * (8 + ((lp * 3 + (k)) * 2 + rep_)))
#ifndef PROBE_REPEAT
#define PROBE_REPEAT 0
#endif
constexpr int NPH = 48;
__global__ void __launch_bounds__(NTHR, 2) mk_fwd(Params p) {
    extern __shared__ __attribute__((aligned(16))) unsigned char lds_raw[];
    LAS unsigned char* const lds0 = (LAS unsigned char*)lds_raw;
typedef const Params __attribute__((address_space(4))) KParams;
#define MKFRAME() KParams* pp_ = (KParams*)__builtin_amdgcn_kernarg_segment_ptr(); asm volatile("" : "+s"(pp_)); KParams& p = *pp_; Frame F; F.lds = lds0; { int t_ = threadIdx.x; asm volatile("" : "+v"(t_)); F.tid = t_; } F.lane = F.tid & 63; F.wave = __builtin_amdgcn_readfirstlane(F.tid >> 6); F.G = gridDim.x; F.bid = blockIdx.x
    for (int u = threadIdx.x; u < (LDS_BYTES - LDSCTL_OFF) / 4; u += NTHR) ((LAS unsigned*)(lds0 + LDSCTL_OFF))[u] = 0u;
    __syncthreads();
    gu32* ctl = (gu32*)(p.ws + WS_CTL);
    XcdBarrier bar; bar.bar = (unsigned*)(ctl + CW_BAR); bar.x = 0; bar.st = nullptr;
#if !MK_PER_PHASE
    bar = xcd_barrier_post((unsigned*)(ctl + CW_BAR), (volatile LAS unsigned*)(lds0 + MISC_OFF) + 8);
#endif
    const int lo = p.ph_lo, hi = p.ph_hi;
    int ph = 0;
#define IN() (lo <= ph && ph < hi)
#if MK_PER_PHASE
#define END_PHASE() do { ++ph; } while (0)
#else
#define END_PHASE() do { if (IN() && ph + 1 < hi) { xcd_barrier(bar); if (PROBE_REPEAT & 256) xcd_barrier(bar); } ++ph; } while (0)
#endif
#define GEMM_RS(Aoff, Boff, M_, N_, K_, Ooff, ldc_, rs_) do { pg8::Gemm g{WSP(pg8::bf16_t, Aoff), WSP(pg8::bf16_t, Boff), M_, N_, K_}; pg8::StaticOrder S; S.init(M_, N_, F.G, F.bid); \
        pg8::EpiRS E{WSP(pg8::bf16_t, Ooff), ldc_, rs_}; pg8::gemm_phase<pg8::EpiRS, pg8::StaticOrder, true, true>(F.lds, g, S, E); } while (0)

#define GEMM_GU(L_) do { pg8::Gemm g{WSP(pg8::bf16_t, WS_XB), WSP(pg8::bf16_t, WS_WGU), MTOK, NGU, DM}; pg8::StaticOrder S; S.init(MTOK, NGU, F.G, F.bid); \
        pg8::EpiConv E{WSP(pg8::bf16_t, WS_ACT), WSP(float, WS_RSTD), p.conv_w + (size_t)(L_) * 3 * DFF, p.conv_b + (size_t)(L_) * DFF, WSP(float, WS_HG), WSP(float, WS_FP), WSP(float, WS_FU), (LAS float*)(F.lds + HALO_OFF), DFF}; \
        pg8::gemm_phase<pg8::EpiConv, pg8::StaticOrder, true, true>(F.lds, g, S, E); } while (0)

    for (int lp = 0; lp < 2; ++lp) {
        {
            const int L = 2 * lp;
            if (lp == 0) { if (IN()) { MKFRAME(); for (int rep_ = 0, nrep_ = ((PROBE_REPEAT & 1) ? 2 : 1); rep_ < nrep_; ++rep_) { phase_convert(p, F, L); } }
            END_PHASE(); }
            if (IN()) { MKFRAME(); for (int rep_ = 0, nrep_ = ((PROBE_REPEAT & 2) ? 2 : 1); rep_ < nrep_; ++rep_) { GEMM_RS(WS_XB, WS_WIN, MTOK, SB_N, DM, WS_PROJ, SB_N, WSP(float, WS_RSTD));
                        if (L == 0) GEMM_RS(WS_MEMB, WS_WKV, NB * NMEM, 4096, DM, WS_MEMKV, 4096, WSP(float, WS_RSTD) + 16384); } }
            END_PHASE();
            if (IN()) { MKFRAME(); for (int rep_ = 0, nrep_ = ((PROBE_REPEAT & 4) ? 2 : 1); rep_ < nrep_; ++rep_) { phase_attn_sb(p, F, L, WQ_(0)); } }
            END_PHASE();
            if (IN()) { MKFRAME(); for (int rep_ = 0, nrep_ = ((PROBE_REPEAT & 2) ? 2 : 1); rep_ < nrep_; ++rep_) { GEMM_RS(WS_OCAT, WS_WO, MTOK, DM, DM, WS_TMP, DM, (const float*)nullptr); } }
            END_PHASE();
            if (IN()) { MKFRAME(); for (int rep_ = 0, nrep_ = ((PROBE_REPEAT & 8) ? 2 : 1); rep_ < nrep_; ++rep_) { phase_resid(p, F, (L == 0) ? p.x : (const float*)p.out, p.norm_g + (size_t)(L * 5 + 1) * DM, LAST_() ? p.out : WSP(float, WS_ACT), LAST_() ? WSP(bf16_t, WS_XB) : WSP(bf16_t, WS_PROJ), LAST_() ? WSP(float, WS_RSTD) : WSP(float, WS_FP)); } }
            END_PHASE();
            if (IN()) { MKFRAME(); for (int rep_ = 0, nrep_ = ((PROBE_REPEAT & 2) ? 2 : 1); rep_ < nrep_; ++rep_) { GEMM_GU(L); } }
            END_PHASE();
            if (IN()) { MKFRAME(); for (int rep_ = 0, nrep_ = ((PROBE_REPEAT & 16) ? 2 : 1); rep_ < nrep_; ++rep_) { phase_convfix(p, F, L); } }
            END_PHASE();
            if (IN()) { MKFRAME(); for (int rep_ = 0, nrep_ = ((PROBE_REPEAT & 2) ? 2 : 1); rep_ < nrep_; ++rep_) { GEMM_RS(WS_ACT, WS_WD, MTOK, DM, DFF, WS_TMP, DM, (const float*)nullptr); } }
            END_PHASE();
            if (IN()) { MKFRAME(); for (int rep_ = 0, nrep_ = ((PROBE_REPEAT & 8) ? 2 : 1); rep_ < nrep_; ++rep_) { phase_resid(p, F, (const float*)p.out, p.norm_g + (size_t)(L * 5 + 3) * DM, LAST_() ? p.out : WSP(float, WS_ACT), LAST_() ? WSP(bf16_t, WS_XB) : WSP(bf16_t, WS_PROJ), LAST_() ? WSP(float, WS_RSTD) : WSP(float, WS_FP)); }  if (L + 1 < DEPTH) phase_convert(p, F, L + 1); }
            END_PHASE();
        }
        {
            const int L = 2 * lp + 1;
            if (IN()) { MKFRAME(); for (int rep_ = 0, nrep_ = ((PROBE_REPEAT & 2) ? 2 : 1); rep_ < nrep_; ++rep_) { GEMM_RS(WS_XB, WS_WIN, MTOK, NSA_N, DM, WS_PROJ, NSA_N, WSP(float, WS_RSTD)); } }
            END_PHASE();
            if (IN()) { MKFRAME(); phase_rope(p, F); }
            END_PHASE();
            if (IN()) { MKFRAME(); for (int rep_ = 0, nrep_ = ((PROBE_REPEAT & 32) ? 2 : 1); rep_ < nrep_; ++rep_) {
                if (F.bid < 16) { const int wh = F.bid >> 3;
                    pg8::Gemm g{WSP(pg8::bf16_t, WS_PROJ) + (wh ? NVC : NKC), WSP(pg8::bf16_t, WS_CW1) + (size_t)wh * 256 * 4096, 2048, 256, 4096, 16 * NSA_N, 256u, (unsigned)(NSA_N * 2), (size_t)SEQ * NSA_N * 2};
                    pg8::StaticOrder S; S.init(2048, 256, F.G, F.bid & 7);
                    pg8::EpiCmpMlp E{WSP(float, WS_BIAS1) + wh * 256, WSP(pg8::bf16_t, WS_CW2) + (size_t)wh * 128 * 256, WSP(pg8::bf16_t, WS_KCMP) + (size_t)wh * 16 * 128 * 128};
                    pg8::gemm_phase<pg8::EpiCmpMlp, pg8::StaticOrder, false, true, true>(F.lds, g, S, E);
                }
                nsa_win_mem_units(p, F, L, WQ_(1)); } }
            END_PHASE();
            if (IN()) { MKFRAME(); for (int rep_ = 0, nrep_ = ((PROBE_REPEAT & 64) ? 2 : 1); rep_ < nrep_; ++rep_) { phase_attn_cmp(p, F); } }
            END_PHASE();
            if (IN()) { MKFRAME(); for (int rep_ = 0, nrep_ = ((PROBE_REPEAT & 128) ? 2 : 1); rep_ < nrep_; ++rep_) { phase_attn_sel(p, F, LAST_() ? WSP(bf16_t, WS_OCAT) : WSP(bf16_t, WS_TMP), WQ_(2)); } }
            END_PHASE();
            if (IN()) { MKFRAME(); for (int rep_ = 0, nrep_ = ((PROBE_REPEAT & 2) ? 2 : 1); rep_ < nrep_; ++rep_) { GEMM_RS(WS_OCAT, WS_WO, MTOK, DM, DM, WS_TMP, DM, (const float*)nullptr); } }
            END_PHASE();
            if (IN()) { MKFRAME(); for (int rep_ = 0, nrep_ = ((PROBE_REPEAT & 8) ? 2 : 1); rep_ < nrep_; ++rep_) { phase_resid(p, F, (const float*)p.out, p.norm_g + (size_t)(L * 5 + 1) * DM, LAST_() ? p.out : WSP(float, WS_ACT), LAST_() ? WSP(bf16_t, WS_XB) : WSP(bf16_t, WS_PROJ), LAST_() ? WSP(float, WS_RSTD) : WSP(float, WS_FP)); } }
            END_PHASE();
            if (IN()) { MKFRAME(); for (int rep_ = 0, nrep_ = ((PROBE_REPEAT & 2) ? 2 : 1); rep_ < nrep_; ++rep_) { GEMM_GU(L); } }
            END_PHASE();
            if (IN()) { MKFRAME(); for (int rep_ = 0, nrep_ = ((PROBE_REPEAT & 16) ? 2 : 1); rep_ < nrep_; ++rep_) { phase_convfix(p, F, L); } }
            END_PHASE();
            if (IN()) { MKFRAME(); for (int rep_ = 0, nrep_ = ((PROBE_REPEAT & 2) ? 2 : 1); rep_ < nrep_; ++rep_) { GEMM_RS(WS_ACT, WS_WD, MTOK, DM, DFF, WS_TMP, DM, (const float*)nullptr); } }
            END_PHASE();
            if (IN()) { MKFRAME(); for (int rep_ = 0, nrep_ = ((PROBE_REPEAT & 8) ? 2 : 1); rep_ < nrep_; ++rep_) { phase_resid(p, F, (const float*)p.out, p.norm_g + (size_t)(L * 5 + 3) * DM, LAST_() ? p.out : WSP(float, WS_ACT), LAST_() ? WSP(bf16_t, WS_XB) : WSP(bf16_t, WS_PROJ), LAST_() ? WSP(float, WS_RSTD) : WSP(float, WS_FP)); }  if (L + 1 < DEPTH) phase_convert(p, F, L + 1); }
            END_PHASE();
        }
    }
#undef IN
#undef END_PHASE
#undef GEMM_RS
#undef GEMM_GU
}

extern "C" void kernel_launch(void* const* d_in, const int* in_sizes, int n_in, void* d_out, int out_size, void* d_ws, size_t ws_size, hipStream_t stream) {
    static int grid = 0;
    if (grid == 0) {
        if (n_in != 16 || out_size != MTOK * DM || ws_size < WS_END) { fprintf(stderr, "kernel_launch: unexpected shapes (n_in %d, out %d, ws %zu < %zu)\n", n_in, out_size, ws_size, (size_t)WS_END); grid = -1; return; }
        int dev = 0, cus = 0, per_cu = 0;
        if (hipGetDevice(&dev) != hipSuccess || hipDeviceGetAttribute(&cus, hipDeviceAttributeMultiprocessorCount, dev) != hipSuccess) { grid = -1; return; }
        if (hipFuncSetAttribute((const void*)mk_fwd, hipFuncAttributeMaxDynamicSharedMemorySize, LDS_BYTES) != hipSuccess) { fprintf(stderr, "kernel_launch: hipFuncSetAttribute failed\n"); grid = -1; return; }
        if (hipOccupancyMaxActiveBlocksPerMultiprocessor(&per_cu, (const void*)mk_fwd, NTHR, LDS_BYTES) != hipSuccess || per_cu < 1) { fprintf(stderr, "kernel_launch: occupancy query says %d\n", per_cu); (void)hipGetLastError(); }
        grid = cus;
    }
    if (grid < 0) return;
    (void)hipMemsetAsync((char*)d_ws + WS_CTL, 0, CTL_ZERO_BYTES, stream);
    Params p{};
    p.x = (const float*)d_in[0]; p.mem = (const float*)d_in[1]; p.positions = (const int*)d_in[2]; p.norm_g = (const float*)d_in[3]; p.w_in_sb = (const float*)d_in[4]; p.w_in_nsa = (const float*)d_in[5];
    p.cmp_pe = (const float*)d_in[6]; p.cmp_w1 = (const float*)d_in[7]; p.cmp_w2 = (const float*)d_in[8]; p.w_mem_kv = (const float*)d_in[9]; p.w_o = (const float*)d_in[10];
    p.w_gate = (const float*)d_in[11]; p.w_up = (const float*)d_in[12]; p.conv_w = (const float*)d_in[13]; p.conv_b = (const float*)d_in[14]; p.w_down = (const float*)d_in[15];
    p.out = (float*)d_out; p.ws = (unsigned char*)d_ws;
#if MK_PER_PHASE
    for (int ph = 0; ph < NPH; ++ph) { p.ph_lo = ph; p.ph_hi = ph + 1; hipLaunchKernelGGL(mk_fwd, dim3(grid), dim3(NTHR), LDS_BYTES, stream, p); }
#else
    p.ph_lo = 0; p.ph_hi = NPH;
    hipLaunchKernelGGL(mk_fwd, dim3(grid), dim3(NTHR), LDS_BYTES, stream, p);
#endif
}
```

```cpp
#include <hip/hip_runtime.h>
#include <cstdio>
#include <cstdint>
namespace pg8 {
#define PG8_LAS __attribute__((address_space(3)))
typedef unsigned short bf16_t;
typedef short bf16x8 __attribute__((ext_vector_type(8)));
typedef float f32x4 __attribute__((ext_vector_type(4)));
typedef unsigned u32x4 __attribute__((ext_vector_type(4)));
constexpr int BM = 256, BK = 64, HALF = 128, HTB = HALF * BK * 2  , STAGE_BYTES = 8 * HTB, NXCD = 8, WGM = 8;

__host__ __device__ __forceinline__ int lds_byte(int r, int c) { const int st = (r >> 4) * 2 + (c >> 5), rr = r & 15, cc = c & 31, ob = rr * 64 + cc * 2; return st * 1024 + (ob ^ (((ob >> 9) & 1) << 5)); }
__host__ __device__ __forceinline__ void stage_rc(int b, int& R, int& C) { const int st = b / 1024, sb = b % 1024, swz = sb ^ (((sb >> 9) & 1) << 5); R = (st >> 1) * 16 + swz / 64; C = (st & 1) * 32 + (swz % 64) / 2; }
__host__ __device__ __forceinline__ int perm32(int rho) { const int n = rho >> 4, i = rho & 15; return 8 * (i >> 2) + 4 * n + (i & 3); }

struct Unit { int pm, pn; };
struct Gemm { const bf16_t* A; const bf16_t* Bt; int M, N, K; int lda; unsigned hstepA, kpairA; size_t tstepA; };

struct StaticOrder {
    int nM, nN, nwg, G, c;
    __host__ __device__ void init(int M, int N, int G_, int c_) { nM = M / BM; nN = N / BM; nwg = nM * nN; G = G_; c = c_; }
    __host__ __device__ bool next(int i, Unit& u) const {
        const long L = (long)i * G + c; if (L >= nwg) return false;
        int wgid = (int)L; { const int q = nwg / NXCD, r = nwg % NXCD, xcd = wgid % NXCD, off = wgid / NXCD; wgid = (xcd < r ? xcd * (q + 1) : r * (q + 1) + (xcd - r) * q) + off; }
        const int nig = WGM * nN, gid = wgid / nig, fm = gid * WGM, gsz = (nM - fm) < WGM ? (nM - fm) : WGM;
        u.pm = fm + ((wgid % nig) % gsz); u.pn = (wgid % nig) / gsz; return true;
    }
    __device__ __forceinline__ void a_ready(const Unit&) const {}
    __device__ __forceinline__ void done(const Unit&) const {}
};

__device__ __forceinline__ unsigned cvt_pk_bf16(float lo, float hi) { unsigned r; asm volatile("v_cvt_pk_bf16_f32 %0, %1, %2" : "=v"(r) : "v"(lo), "v"(hi)); return r; }
typedef float f32x2 __attribute__((ext_vector_type(2)));
struct EpiRS {
    static constexpr bool PERM = true, AFTER_DRAIN = false;
    bf16_t* O; int ldc; const float* rs;
    __device__ __forceinline__ void operator()(const f32x4 (&acc)[2][2][4][2], const Unit& u, int wr, int wc, int fr, int fq) const {
        const int row0 = u.pm * BM + wr * 64 + fr; const int col0 = u.pn * BM + wc * 32 + 8 * fq;
#pragma unroll
        for (int ai = 0; ai < 2; ++ai)
#pragma unroll
            for (int m = 0; m < 4; ++m) { const int row = row0 + ai * HALF + m * 16; const float sc = rs ? rs[row] : 1.f; bf16_t* rowp = O + (size_t)row * ldc + col0;
#pragma unroll
                for (int bj = 0; bj < 2; ++bj) { const f32x4 v0 = acc[ai][bj][m][0] * sc, v1 = acc[ai][bj][m][1] * sc;
                    u32x4 w; w.x = cvt_pk_bf16(v0[0], v0[1]); w.y = cvt_pk_bf16(v0[2], v0[3]); w.z = cvt_pk_bf16(v1[0], v1[1]); w.w = cvt_pk_bf16(v1[2], v1[3]);
                    *(u32x4*)(rowp + bj * HALF) = w; } }
    }
};
__device__ __forceinline__ float dpp_ror1(float v) { return __builtin_bit_cast(float, __builtin_amdgcn_update_dpp(0, __builtin_bit_cast(int, v), 0x121, 0xf, 0xf, false)); }
__device__ __forceinline__ float dpp_ror2(float v) { return __builtin_bit_cast(float, __builtin_amdgcn_update_dpp(0, __builtin_bit_cast(int, v), 0x122, 0xf, 0xf, false)); }
__device__ __forceinline__ float silu_fast(float x) { return x * __builtin_amdgcn_rcpf(1.f + __builtin_amdgcn_exp2f(-x * 1.4426950408889634f)); }
struct EpiConv {
    static constexpr bool PERM = true, AFTER_DRAIN = false;
    bf16_t* ACT; const float* rs; const float* cw; const float* cb; float* HG; float* FP; float* FU; PG8_LAS float* halo; int dff;
    __device__ __forceinline__ void operator()(const f32x4 (&acc)[2][2][4][2], const Unit& u, int wr, int wc, int fr, int fq) const {
        const int fl = wc * 32 + 8 * fq, f0 = u.pn * 128 + fl;
        f32x4 w0[2], w1[2], w2[2], bb[2];
#pragma unroll
        for (int n = 0; n < 2; ++n) { w0[n] = *(const f32x4*)(cw + f0 + 4 * n); w1[n] = *(const f32x4*)(cw + dff + f0 + 4 * n); w2[n] = *(const f32x4*)(cw + 2 * dff + f0 + 4 * n); bb[n] = *(const f32x4*)(cb + f0 + 4 * n); }
#pragma unroll
        for (int ai = 0; ai < 2; ++ai) { const float sc = rs[u.pm * BM + ai * HALF + wr * 64 + 48 + fr];
            if (fr >= 14) {
#pragma unroll
                for (int n = 0; n < 2; ++n) *(PG8_LAS f32x4*)(halo + ((ai * 2 + wr) * 2 + (fr - 14)) * 128 + fl + 4 * n) = acc[ai][0][3][n] * sc; } }
        asm volatile("s_waitcnt lgkmcnt(0)" ::: "memory"); __builtin_amdgcn_s_barrier(); asm volatile("" ::: "memory");
#pragma unroll
        for (int ai = 0; ai < 2; ++ai) {
            const int s = ai * 2 + wr;
            f32x4 a1p[2], a2p[2];
#pragma unroll
            for (int n = 0; n < 2; ++n) { f32x4 vp = {0.f, 0.f, 0.f, 0.f};
                if (s > 0 && fr >= 14) vp = *(const PG8_LAS f32x4*)(halo + ((s - 1) * 2 + (fr - 14)) * 128 + fl + 4 * n);
#pragma unroll
                for (int e = 0; e < 4; ++e) { a1p[n][e] = dpp_ror1(vp[e]); a2p[n][e] = dpp_ror2(vp[e]); } }
#pragma unroll
            for (int m = 0; m < 4; ++m) {
                const int row = u.pm * BM + ai * HALF + wr * 64 + m * 16 + fr; const float sc = rs[row];
                u32x4 wv; unsigned pk[4];
#pragma unroll
                for (int n = 0; n < 2; ++n) {
                    const f32x4 v = acc[ai][0][m][n] * sc, uu = acc[ai][1][m][n] * sc; f32x4 a1, a2, gc, ac;
#pragma unroll
                    for (int e = 0; e < 4; ++e) { a1[e] = dpp_ror1(v[e]); a2[e] = dpp_ror2(v[e]); }
#pragma unroll
                    for (int e = 0; e < 4; ++e) { const float p1 = (fr >= 1) ? a1[e] : a1p[n][e], p2 = (fr >= 2) ? a2[e] : a2p[n][e];
                        gc[e] = bb[n][e] + w0[n][e] * p2 + w1[n][e] * p1 + w2[n][e] * v[e];
                        ac[e] = silu_fast(gc[e]) * uu[e]; }
                    if (s == 0 && m == 0 && fr < 2) { *(f32x4*)(FP + (size_t)(u.pm * 2 + fr) * dff + f0 + 4 * n) = gc; *(f32x4*)(FU + (size_t)(u.pm * 2 + fr) * dff + f0 + 4 * n) = uu; }
                    if (s == 3 && m == 3 && fr >= 14) *(f32x4*)(HG + (size_t)(u.pm * 2 + fr - 14) * dff + f0 + 4 * n) = v;
                    pk[2 * n] = cvt_pk_bf16(ac[0], ac[1]); pk[2 * n + 1] = cvt_pk_bf16(ac[2], ac[3]);
                    a1p[n] = a1; a2p[n] = a2;
                }
                wv.x = pk[0]; wv.y = pk[1]; wv.z = pk[2]; wv.w = pk[3];
                *(u32x4*)(ACT + (size_t)row * dff + f0) = wv;
            }
        }
    }
};
struct EpiSiluBias {
    static constexpr bool PERM = true, AFTER_DRAIN = false;
    bf16_t* O; int ldc; const float* bias;
    __device__ __forceinline__ void operator()(const f32x4 (&acc)[2][2][4][2], const Unit& u, int wr, int wc, int fr, int fq) const {
        const int row0 = u.pm * BM + wr * 64 + fr; const int col0 = u.pn * BM + wc * 32 + 8 * fq;
        f32x4 bv[2][2];
#pragma unroll
        for (int bj = 0; bj < 2; ++bj)
#pragma unroll
            for (int n = 0; n < 2; ++n) bv[bj][n] = *(const f32x4*)(bias + col0 + bj * HALF + 4 * n);
#pragma unroll
        for (int ai = 0; ai < 2; ++ai)
#pragma unroll
            for (int m = 0; m < 4; ++m) { bf16_t* rowp = O + (size_t)(row0 + ai * HALF + m * 16) * ldc + col0;
#pragma unroll
                for (int bj = 0; bj < 2; ++bj) { f32x4 v0 = acc[ai][bj][m][0] + bv[bj][0], v1 = acc[ai][bj][m][1] + bv[bj][1];
#pragma unroll
                    for (int e = 0; e < 4; ++e) { v0[e] = v0[e] * __builtin_amdgcn_rcpf(1.f + __builtin_amdgcn_exp2f(-v0[e] * 1.4426950408889634f)); v1[e] = v1[e] * __builtin_amdgcn_rcpf(1.f + __builtin_amdgcn_exp2f(-v1[e] * 1.4426950408889634f)); }
                    u32x4 w; w.x = cvt_pk_bf16(v0[0], v0[1]); w.y = cvt_pk_bf16(v0[2], v0[3]); w.z = cvt_pk_bf16(v1[0], v1[1]); w.w = cvt_pk_bf16(v1[2], v1[3]);
                    *(u32x4*)(rowp + bj * HALF) = w; } }
    }
};
struct EpiCmpMlp {
    static constexpr bool PERM = true, AFTER_DRAIN = true;
    const float* bias; const bf16_t* w2t; bf16_t* OUT;
    __device__ __forceinline__ void fused(f32x4 (&acc)[2][2][4][2], const Unit& u, int wr, int wc, int fr, int fq, PG8_LAS unsigned char* lds, int wid, int lane) const {
        typedef float f32x16v __attribute__((ext_vector_type(16)));
        PG8_LAS bf16_t* hid = (PG8_LAS bf16_t*)lds;
        const int col0 = wc * 32 + 8 * fq;
#pragma unroll
        for (int bj = 0; bj < 2; ++bj) { const f32x4 b0 = *(const f32x4*)(bias + col0 + bj * HALF), b1 = *(const f32x4*)(bias + col0 + bj * HALF + 4);
#pragma unroll
            for (int ai = 0; ai < 2; ++ai)
#pragma unroll
                for (int m = 0; m < 4; ++m) { f32x4 v0 = acc[ai][bj][m][0] + b0, v1 = acc[ai][bj][m][1] + b1;
#pragma unroll
                    for (int e = 0; e < 4; ++e) { v0[e] = v0[e] * __builtin_amdgcn_rcpf(1.f + __builtin_amdgcn_exp2f(-v0[e] * 1.4426950408889634f)); v1[e] = v1[e] * __builtin_amdgcn_rcpf(1.f + __builtin_amdgcn_exp2f(-v1[e] * 1.4426950408889634f)); }
                    u32x4 w; w.x = cvt_pk_bf16(v0[0], v0[1]); w.y = cvt_pk_bf16(v0[2], v0[3]); w.z = cvt_pk_bf16(v1[0], v1[1]); w.w = cvt_pk_bf16(v1[2], v1[3]);
                    *(PG8_LAS u32x4*)(hid + (ai * HALF + wr * 64 + m * 16 + fr) * 264 + col0 + bj * HALF) = w; } }
        asm volatile("s_waitcnt lgkmcnt(0)" ::: "memory"); __builtin_amdgcn_s_barrier(); asm volatile("" ::: "memory");
        const int r32 = lane & 31, hi = lane >> 5, ct = wid & 3;
        const bf16_t* w2 = w2t + (size_t)(ct * 32 + r32) * 256;
#pragma unroll 1
        for (int k4 = 0; k4 < 4; ++k4) {
            const int rt = (wid >> 2) + 2 * k4;
            f32x16v a2 = (f32x16v){};
#pragma unroll
            for (int kk = 0; kk < 16; ++kk) { const int k = kk * 16 + hi * 8;
                a2 = __builtin_amdgcn_mfma_f32_32x32x16_bf16(*(const PG8_LAS bf16x8*)(hid + (rt * 32 + r32) * 264 + k), *(const bf16x8*)(w2 + k), a2, 0, 0, 0); }
#pragma unroll
            for (int r = 0; r < 16; ++r) { const int rl = rt * 32 + (r & 3) + 8 * (r >> 2) + 4 * hi; const int ro = u.pm * BM + rl;
                const float av_ = a2[r]; const unsigned ub = __float_as_uint(av_); const unsigned rb = (ub + 0x7fffu + ((ub >> 16) & 1u)) >> 16;
                OUT[(size_t)ro * 128 + ct * 32 + r32] = ((ro & 127) == 127) ? (bf16_t)0 : (bf16_t)rb; }
        }
        asm volatile("s_waitcnt lgkmcnt(0)" ::: "memory"); __builtin_amdgcn_s_barrier(); asm volatile("" ::: "memory");
    }
};
struct EpiRopeRS {
    static constexpr bool PERM = true, AFTER_DRAIN = false;
    bf16_t* O; int ldc; const float* rs; const float* cosT; const float* sinT;
    __device__ __forceinline__ void operator()(const f32x4 (&acc)[2][2][4][2], const Unit& u, int wr, int wc, int fr, int fq) const {
        const int row0 = u.pm * BM + wr * 64 + fr; const int col0 = u.pn * BM + wc * 32 + 8 * fq;
        const bool rope = (u.pn < 7) || (u.pn == 8) || (u.pn == 10);
        const int i0 = (wc * 32 + 8 * fq) >> 1;
#pragma unroll
        for (int ai = 0; ai < 2; ++ai)
#pragma unroll
            for (int m = 0; m < 4; ++m) { const int row = row0 + ai * HALF + m * 16; const float sc = rs[row]; bf16_t* rowp = O + (size_t)row * ldc + col0;
                f32x4 cv = {1.f, 1.f, 1.f, 1.f}, sv = {0.f, 0.f, 0.f, 0.f};
                if (rope) { cv = *(const f32x4*)(cosT + (size_t)row * 64 + i0); sv = *(const f32x4*)(sinT + (size_t)row * 64 + i0); }
#pragma unroll
                for (int bj = 0; bj < 2; ++bj) { const f32x4 x0 = acc[ai][bj][m][0] * sc, x1 = acc[ai][bj][m][1] * sc;
                    const f32x4 v0 = {x0[0] * cv[0] - x0[1] * sv[0], x0[1] * cv[0] + x0[0] * sv[0], x0[2] * cv[1] - x0[3] * sv[1], x0[3] * cv[1] + x0[2] * sv[1]};
                    const f32x4 v1 = {x1[0] * cv[2] - x1[1] * sv[2], x1[1] * cv[2] + x1[0] * sv[2], x1[2] * cv[3] - x1[3] * sv[3], x1[3] * cv[3] + x1[2] * sv[3]};
                    u32x4 w; w.x = cvt_pk_bf16(v0[0], v0[1]); w.y = cvt_pk_bf16(v0[2], v0[3]); w.z = cvt_pk_bf16(v1[0], v1[1]); w.w = cvt_pk_bf16(v1[2], v1[3]);
                    *(u32x4*)(rowp + bj * HALF) = w; } }
    }
};
template <class Epi, class Sched, bool ALIGN_EPI = false, bool SP2 = false, bool AGEN = false>
__device__ __forceinline__ void gemm_phase(PG8_LAS unsigned char* lds, const Gemm g, const Sched& S, const Epi& E) {
    int tid_ = threadIdx.x; asm volatile("" : "+v"(tid_));
    const int tid = tid_, wid = __builtin_amdgcn_readfirstlane(tid >> 6), lane = tid & 63, wr = wid >> 2, wc = wid & 3, fr = lane & 15, fq = lane >> 4;
    const int K = g.K, nt = K / BK;
    unsigned voffA[2], voffB[2];
#pragma unroll
    for (int i = 0; i < 2; ++i) { int R, C; stage_rc(tid * 16 + i * 8192, R, C); const int Rb = Epi::PERM ? ((R & ~31) + perm32(R & 31)) : R;
        voffA[i] = (unsigned)(R * (AGEN ? g.lda : K) + C) * 2u; voffB[i] = (unsigned)(Rb * K + C) * 2u; }
    const size_t kstep = (size_t)(BK * 2);
    const size_t hstep = (size_t)HALF * K * 2;
    const size_t tstep = 2 * hstep;
    const size_t hstepA = AGEN ? (size_t)g.hstepA : hstep, tstepA = AGEN ? g.tstepA : tstep, kpairA = AGEN ? (size_t)g.kpairA : 2 * kstep;
    const unsigned ldsw = (unsigned)wid * 1024u;
    const int aoff = lds_byte(wr * 64 + fr, fq * 8), boff = lds_byte(wc * 32 + fr, fq * 8);
#define PG8_SA(b, h) (((b) * 2 + (h)) * HTB)
#define PG8_SB(b, h) ((4 + (b) * 2 + (h)) * HTB)
#define PG8_STAGE(bufoff, gbase, voff) do { _Pragma("unroll") for (int _i = 0; _i < 2; ++_i) \
        __builtin_amdgcn_global_load_lds((const unsigned*)((const char*)(gbase) + (voff)[_i]), (PG8_LAS unsigned*)(lds + (bufoff) + ldsw + _i * 8192), 16, 0, 0); } while (0)
#define PG8_LDA(dst, b, h) do { _Pragma("unroll") for (int m = 0; m < 4; ++m) _Pragma("unroll") for (int k = 0; k < 2; ++k) dst[m][k] = *(const PG8_LAS bf16x8*)(lds + PG8_SA(b, h) + aoff + m * 2048 + k * 1024); } while (0)
#define PG8_LDB(dst, b, h) do { _Pragma("unroll") for (int n = 0; n < 2; ++n) _Pragma("unroll") for (int k = 0; k < 2; ++k) dst[n][k] = *(const PG8_LAS bf16x8*)(lds + PG8_SB(b, h) + boff + n * 2048 + k * 1024); } while (0)
#define PG8_MMA(ai, bj, At, Bt) do { __builtin_amdgcn_s_setprio(1); _Pragma("unroll") for (int m = 0; m < 4; ++m) _Pragma("unroll") for (int n = 0; n < 2; ++n) _Pragma("unroll") for (int k = 0; k < 2; ++k) \
        acc[ai][bj][m][n] = __builtin_amdgcn_mfma_f32_16x16x32_bf16(Bt[n][k], At[m][k], acc[ai][bj][m][n], 0, 0, 0); __builtin_amdgcn_s_setprio(0); } while (0)
#define PG8_WAIT_V(n) asm volatile("s_waitcnt vmcnt(" #n ")" ::: "memory")
#define PG8_WAIT_L(n) asm volatile("s_waitcnt lgkmcnt(" #n ")" ::: "memory")
#define PG8_BAR __builtin_amdgcn_s_barrier()
#define PG8_SCHED __builtin_amdgcn_sched_barrier(0)
    Unit cur, nxt; int ui = 0;
    if (!S.next(0, cur)) return;
    f32x4 acc[2][2][4][2];
#pragma unroll
    for (int a = 0; a < 2; ++a)
#pragma unroll
        for (int b = 0; b < 2; ++b)
#pragma unroll
            for (int m = 0; m < 4; ++m)
#pragma unroll
                for (int n = 0; n < 2; ++n) acc[a][b][m][n] = (f32x4){0.f, 0.f, 0.f, 0.f};
    bf16x8 At[4][2], B0[2][2], B1[2][2];
    const char* cA = (const char*)g.A + (size_t)cur.pm * tstepA; const char* cB = (const char*)g.Bt + (size_t)cur.pn * tstep;
    S.a_ready(cur);
    if constexpr (SP2) {
        PG8_STAGE(PG8_SB(0, 0), cB, voffB); PG8_STAGE(PG8_SB(0, 1), cB + hstep, voffB); PG8_STAGE(PG8_SA(0, 0), cA, voffA); PG8_STAGE(PG8_SA(0, 1), cA + hstepA, voffA);
        if (wr == 1) PG8_BAR;
        PG8_WAIT_V(2); PG8_BAR;
        PG8_STAGE(PG8_SB(1, 0), cB + kstep, voffB); PG8_STAGE(PG8_SA(1, 0), cA + kstep, voffA); PG8_STAGE(PG8_SB(1, 1), cB + hstep + kstep, voffB);
        PG8_WAIT_V(6); PG8_BAR;
    } else {
        PG8_STAGE(PG8_SB(0, 0), cB, voffB); PG8_STAGE(PG8_SA(0, 0), cA, voffA); PG8_STAGE(PG8_SB(0, 1), cB + hstep, voffB); PG8_STAGE(PG8_SA(0, 1), cA + hstepA, voffA);
        if (wr == 1) PG8_BAR;
        PG8_WAIT_V(4); PG8_BAR;
        PG8_STAGE(PG8_SB(1, 0), cB + kstep, voffB); PG8_STAGE(PG8_SA(1, 0), cA + kstep, voffA); PG8_STAGE(PG8_SB(1, 1), cB + hstep + kstep, voffB);
        PG8_WAIT_V(6); PG8_BAR;
    }
    for (;;) {
        const bool has_next = S.next(ui + 1, nxt);
        const char* nA = has_next ? (const char*)g.A + (size_t)nxt.pm * tstepA : cA; const char* nB = has_next ? (const char*)g.Bt + (size_t)nxt.pn * tstep : cB;
        for (int t = 0; t < nt; t += 2) {
            const bool last = (t == nt - 2);
            const char* a1 = cA + (size_t)(t >> 1) * kpairA + kstep;
            const char* a2 = last ? nA : cA + (size_t)((t >> 1) + 1) * kpairA; const char* b2 = last ? nB : cB + (size_t)(t + 2) * kstep;
            const char* a3 = a2 + kstep; const char* b3 = b2 + kstep;
            if (last && has_next) S.a_ready(nxt);
            if constexpr (SP2) {
            PG8_LDB(B0, 0, 0); PG8_LDB(B1, 0, 1); PG8_SCHED; PG8_LDA(At, 0, 0); PG8_STAGE(PG8_SA(1, 1), a1 + hstepA, voffA);
            PG8_WAIT_V(8); PG8_WAIT_L(0); PG8_BAR; PG8_MMA(0, 0, At, B0); PG8_MMA(0, 1, At, B1); PG8_BAR; PG8_SCHED;
            PG8_LDA(At, 0, 1); PG8_STAGE(PG8_SB(0, 0), b2, voffB); PG8_STAGE(PG8_SB(0, 1), b2 + hstep, voffB); PG8_STAGE(PG8_SA(0, 0), a2, voffA);
            PG8_WAIT_V(8); PG8_WAIT_L(0); PG8_BAR; PG8_MMA(1, 0, At, B0); PG8_MMA(1, 1, At, B1); PG8_BAR; PG8_SCHED;
            PG8_LDB(B0, 1, 0); PG8_LDB(B1, 1, 1); PG8_SCHED; PG8_LDA(At, 1, 0); PG8_STAGE(PG8_SA(0, 1), a2 + hstepA, voffA);
            PG8_WAIT_V(8); PG8_WAIT_L(0); PG8_BAR; PG8_MMA(0, 0, At, B0); PG8_MMA(0, 1, At, B1); PG8_BAR; PG8_SCHED;
            PG8_LDA(At, 1, 1); PG8_STAGE(PG8_SB(1, 0), b3, voffB); PG8_STAGE(PG8_SB(1, 1), b3 + hstep, voffB); PG8_STAGE(PG8_SA(1, 0), a3, voffA);
            PG8_WAIT_V(8); PG8_WAIT_L(0); PG8_BAR; PG8_MMA(1, 0, At, B0); PG8_MMA(1, 1, At, B1); PG8_BAR; PG8_SCHED;
            } else {
            PG8_LDB(B0, 0, 0); PG8_SCHED; PG8_LDA(At, 0, 0); PG8_STAGE(PG8_SA(1, 1), a1 + hstepA, voffA);
            PG8_WAIT_L(8); PG8_BAR; PG8_WAIT_L(0); PG8_MMA(0, 0, At, B0); PG8_BAR; PG8_SCHED;
            PG8_LDB(B1, 0, 1); PG8_STAGE(PG8_SB(0, 0), b2, voffB);
            PG8_BAR; PG8_WAIT_L(0); PG8_MMA(0, 1, At, B1); PG8_BAR;
            PG8_LDA(At, 0, 1); PG8_STAGE(PG8_SA(0, 0), a2, voffA);
            PG8_BAR; PG8_WAIT_L(0); PG8_MMA(1, 0, At, B0); PG8_BAR; PG8_SCHED;
            PG8_STAGE(PG8_SB(0, 1), b2 + hstep, voffB);
            PG8_WAIT_V(6); PG8_BAR; PG8_MMA(1, 1, At, B1); PG8_BAR;
            PG8_LDB(B0, 1, 0); PG8_SCHED; PG8_LDA(At, 1, 0); PG8_STAGE(PG8_SA(0, 1), a2 + hstepA, voffA);
            PG8_WAIT_L(8); PG8_BAR; PG8_WAIT_L(0); PG8_MMA(0, 0, At, B0); PG8_BAR; PG8_SCHED;
            PG8_LDB(B1, 1, 1); PG8_STAGE(PG8_SB(1, 0), b3, voffB);
            PG8_BAR; PG8_WAIT_L(0); PG8_MMA(0, 1, At, B1); PG8_BAR;
            PG8_LDA(At, 1, 1); PG8_STAGE(PG8_SA(1, 0), a3, voffA);
            PG8_BAR; PG8_WAIT_L(0); PG8_MMA(1, 0, At, B0); PG8_BAR; PG8_SCHED;
            PG8_STAGE(PG8_SB(1, 1), b3 + hstep, voffB);
            PG8_WAIT_V(6); PG8_BAR; PG8_MMA(1, 1, At, B1); PG8_BAR;
            }
        }
        if constexpr (ALIGN_EPI) { if (wr == 0) PG8_BAR; }
        if constexpr (!Epi::AFTER_DRAIN) { E(acc, cur, wr, wc, fr, fq); S.done(cur); }
        if (!has_next) break;
#pragma unroll
        for (int a = 0; a < 2; ++a)
#pragma unroll
            for (int b = 0; b < 2; ++b)
#pragma unroll
                for (int m = 0; m < 4; ++m)
#pragma unroll
                    for (int n = 0; n < 2; ++n) acc[a][b][m][n] = (f32x4){0.f, 0.f, 0.f, 0.f};
        cur = nxt; cA = nA; cB = nB; ++ui;
        if constexpr (ALIGN_EPI) { if (wr == 1) PG8_BAR; }
    }
    PG8_WAIT_V(0);
    if constexpr (!ALIGN_EPI) { if (wr == 0) PG8_BAR; }
    PG8_BAR;
    if constexpr (Epi::AFTER_DRAIN) { E.fused(acc, cur, wr, wc, fr, fq, lds, wid, lane); S.done(cur); }
#undef PG8_SA
#undef PG8_SB
#undef PG8_STAGE
#undef PG8_LDA
#undef PG8_LDB
#undef PG8_MMA
#undef PG8_WAIT_V
#undef PG8_WAIT_L
#undef PG8_BAR
#undef PG8_SCHED
}
}

#ifndef MK_PER_PHASE
#define MK_PER_PHASE 0
#endif
constexpr int NB = 8, SEQ = 2048, DM = 2048, MTOK = NB * SEQ, DEPTH = 4, HD = 128;
constexpr int NMIX = 12, NMEMH = 4, NMEM = 256, DFF = 5632, NGU = 2 * DFF, NGRP = 2, HPG = 6;
constexpr int SB_N = 5120, NSA_N = 3840, NSA_SRC = 3620;
constexpr int SBQ = 0, SBK = 1536, SBV = 3072, SBQM = 4608;
constexpr int NQ = 0, NKC = 1536, NVC = 1792, NKS = 2048, NVS = 2304, NKW = 2560, NVW = 2816, NQM = 3072, NGL = 3584;
constexpr int NCMP = 127, CMPROWS = NB * NGRP * NCMP;
constexpr int WINDOW = 512;
constexpr float NORM_EPS = 1e-6f;
constexpr float SCALE = 0.08838834764831845f;
constexpr float LOG2E = 1.4426950408889634f;
constexpr int NWAVES = 8, NTHR = 512;

constexpr size_t MiB = 1u << 20;
constexpr size_t WS_CTL = 0, CTL_ZERO_BYTES = 1 * MiB;
constexpr size_t WS_WIN = 2 * MiB;
constexpr size_t WS_WO = 22 * MiB;
constexpr size_t WS_WGU = 30 * MiB;
constexpr size_t WS_WD = 74 * MiB;
constexpr size_t WS_WKV = 96 * MiB;
constexpr size_t WS_CW1 = 112 * MiB;
constexpr size_t WS_CW2 = 116 * MiB;
constexpr size_t WS_MEMB = 117 * MiB;
constexpr size_t WS_MEMKV = 125 * MiB;
constexpr size_t WS_COS = 141 * MiB, WS_SIN = 145 * MiB;
constexpr size_t WS_RSTD = 149 * MiB;
constexpr size_t WS_SEL = 150 * MiB;
constexpr size_t WS_KCMP = 151 * MiB;
constexpr size_t WS_XB = 152 * MiB;
constexpr size_t WS_TMP = 216 * MiB;
constexpr size_t WS_ACT = 280 * MiB;
constexpr size_t WS_GU = 456 * MiB;
constexpr size_t WS_PROJ = 456 * MiB;
constexpr size_t WS_OCAT = 616 * MiB;
constexpr size_t WS_HG = 680 * MiB, WS_FP = 684 * MiB, WS_FU = 688 * MiB;
constexpr size_t WS_HID = 692 * MiB;
constexpr size_t WS_BIAS1 = 694 * MiB;
constexpr size_t WS_END = 808 * MiB;
constexpr int CW_BAR = 4096;

constexpr int RING_BYTES = 131072;
constexpr int LDSCTL_OFF = 143360, MISC_OFF = LDSCTL_OFF + 320;
constexpr int LDS_BYTES = 147456;
constexpr int HALO_OFF = RING_BYTES;
constexpr int SHM_T = 16384;
constexpr int A_V = 0, A_K = 2 * SHM_T, A_WS = 4 * SHM_T, A_FLAGS = A_WS + NWAVES * 64 * 4, A_STASH = 67584;

#define GAS __attribute__((address_space(1)))
#define LAS __attribute__((address_space(3)))
typedef unsigned short bf16_t;
typedef unsigned v4u __attribute__((ext_vector_type(4)));
typedef unsigned v2u __attribute__((ext_vector_type(2)));
typedef float f32x4 __attribute__((ext_vector_type(4)));
typedef float f32x16 __attribute__((ext_vector_type(16)));
typedef short bf16x8 __attribute__((ext_vector_type(8)));
typedef short s16x4 __attribute__((ext_vector_type(4)));
typedef GAS unsigned gu32;
#define RLX_AGENT __ATOMIC_RELAXED, __HIP_MEMORY_SCOPE_AGENT
#define LDS_WAIT() asm volatile("s_waitcnt lgkmcnt(0)" ::: "memory")
#define VM_WAIT() asm volatile("s_waitcnt vmcnt(0)" ::: "memory")
#define SBAR() __builtin_amdgcn_sched_barrier(0)
__device__ __forceinline__ unsigned cvtpk(float lo, float hi) { unsigned r; asm volatile("v_cvt_pk_bf16_f32 %0, %1, %2" : "=v"(r) : "v"(lo), "v"(hi)); return r; }
__device__ __forceinline__ float bf2f(unsigned short b) { return __uint_as_float((unsigned)b << 16); }
__device__ __forceinline__ float bflo(unsigned w) { return __uint_as_float(w << 16); }
__device__ __forceinline__ float bfhi(unsigned w) { return __uint_as_float(w & 0xffff0000u); }
__device__ __forceinline__ bf16x8 pack8(f32x4 a, f32x4 b) { v4u w = {cvtpk(a[0], a[1]), cvtpk(a[2], a[3]), cvtpk(b[0], b[1]), cvtpk(b[2], b[3])}; return __builtin_bit_cast(bf16x8, w); }
__device__ __forceinline__ void unpack8(bf16x8 v, f32x4& a, f32x4& b) { const v4u w = __builtin_bit_cast(v4u, v); a = (f32x4){bflo(w.x), bfhi(w.x), bflo(w.y), bfhi(w.y)}; b = (f32x4){bflo(w.z), bfhi(w.z), bflo(w.w), bfhi(w.w)}; }
__device__ __forceinline__ float wave_sum(float v) {
#pragma unroll
    for (int o = 1; o < 64; o <<= 1) v += __shfl_xor(v, o);
    return v;
}
__device__ __forceinline__ float sigmoidf_(float x) { return __builtin_amdgcn_rcpf(1.f + __builtin_amdgcn_exp2f(-x * LOG2E)); }

__device__ const float INV_FREQ[64] = {1.000000000e+00f, 8.659643531e-01f, 7.498942018e-01f, 6.493816376e-01f, 5.623413324e-01f, 4.869675338e-01f, 4.216965139e-01f, 3.651741147e-01f, 3.162277639e-01f, 2.738419771e-01f, 2.371373773e-01f, 2.053525001e-01f, 1.778279394e-01f, 1.539926529e-01f, 1.333521456e-01f, 1.154781953e-01f, 1.000000015e-01f, 8.659642935e-02f, 7.498942316e-02f, 6.493816525e-02f, 5.623413250e-02f, 4.869675264e-02f, 4.216964915e-02f, 3.651741147e-02f, 3.162277490e-02f, 2.738419548e-02f, 2.371373773e-02f, 2.053525113e-02f, 1.778279431e-02f, 1.539926510e-02f, 1.333521400e-02f, 1.154781971e-02f, 9.999999776e-03f, 8.659643121e-03f, 7.498942316e-03f, 6.493816152e-03f, 5.623413250e-03f, 4.869675264e-03f, 4.216964822e-03f, 3.651741194e-03f, 3.162277630e-03f, 2.738419687e-03f, 2.371373819e-03f, 2.053525066e-03f, 1.778279431e-03f, 1.539926510e-03f, 1.333521446e-03f, 1.154782018e-03f, 1.000000047e-03f, 8.659643354e-04f, 7.498941850e-04f, 6.493816036e-04f, 5.623413017e-04f, 4.869675322e-04f, 4.216965172e-04f, 3.651741135e-04f, 3.162277571e-04f, 2.738419571e-04f, 2.371373703e-04f, 2.053525095e-04f, 1.778279402e-04f, 1.539926598e-04f, 1.333521504e-04f, 1.154782003e-04f};
#define XB_TMO      128
#define XB_XCNT(j)  (256  + 64 * (j))
#define XB_XSUB(j)  (1280 + 64 * (j))
#define XB_XGEN(j)  (2304 + 64 * (j))
#define XB_TOP      3328
#define XB_TOPGEN   3392
#define XCD_BAR_WORDS 3456
#define XB_SPIN_CAP (1u << 18)

__device__ __forceinline__ unsigned xb_ld(unsigned* p)              { return __hip_atomic_load(p, __ATOMIC_RELAXED, __HIP_MEMORY_SCOPE_AGENT); }
__device__ __forceinline__ unsigned xb_add(unsigned* p, unsigned v) { return __hip_atomic_fetch_add(p, v, __ATOMIC_RELAXED, __HIP_MEMORY_SCOPE_AGENT); }
__device__ __forceinline__ unsigned xb_xcc_id() { return (unsigned)__builtin_amdgcn_s_getreg((3 << 11) | 20) & 0xFu; }
#define XB_SPIN(cond, bar) do { unsigned _sp = 0; while (cond) { __builtin_amdgcn_s_sleep(1); \
    if ((++_sp & 255u) == 0u) { if (xb_ld(&(bar)[XB_TMO])) break; if (_sp > XB_SPIN_CAP) { atomicAdd(&(bar)[XB_TMO], 1u); break; } } } } while (0)

struct XcdBarrier {
    unsigned* bar; unsigned x;
    volatile LAS unsigned* st;
};

__device__ __forceinline__ XcdBarrier xcd_barrier_post(unsigned* bar, volatile LAS unsigned* st) {
    XcdBarrier b; b.bar = bar; b.x = xb_xcc_id(); b.st = st;
    if (threadIdx.x == 0) (void)xb_add(&bar[XB_XCNT(b.x)], 1u);
    return b;
}
__device__ __forceinline__ void xcd_barrier_complete(unsigned* bar, unsigned x, unsigned& nloc, unsigned& nx) {
    const unsigned G = gridDim.x * gridDim.y * gridDim.z;
    unsigned sum, cnt, mine, sp = 0u;
    for (;;) {
        sum = 0u; cnt = 0u; mine = 0u;
#pragma unroll
        for (unsigned j = 0; j < 16; ++j) { const unsigned c = xb_ld(&bar[XB_XCNT(j)]); sum += c; cnt += (c > 0u) ? 1u : 0u; mine = (j == x) ? c : mine; }
        if (sum == G) break;
        __builtin_amdgcn_s_sleep(1);
        if ((++sp & 255u) == 0u) { if (xb_ld(&bar[XB_TMO])) break; if (sp > XB_SPIN_CAP) { atomicAdd(&bar[XB_TMO], 1u); break; } }
    }
    nloc = mine > 0u ? mine : 1u; nx = cnt > 0u ? cnt : 1u;
}

__device__ __forceinline__ void xcd_barrier(const XcdBarrier& b) {
    asm volatile("s_waitcnt vmcnt(0)" ::: "memory");
    __syncthreads();
    if (threadIdx.x == 0) {
        unsigned* bar = b.bar;
        __builtin_amdgcn_s_waitcnt(0);
        unsigned nloc = b.st[0], nx = b.st[1];
        if (nloc == 0u) { xcd_barrier_complete(bar, b.x, nloc, nx); b.st[0] = nloc; b.st[1] = nx; }
        const unsigned old = xb_add(&bar[XB_XSUB(b.x)], 1u);
        const unsigned gen = old / nloc;
        if (old + 1u == (gen + 1u) * nloc) {
            __builtin_amdgcn_fence(__ATOMIC_RELEASE, "agent");
            asm volatile("s_waitcnt vmcnt(0)" ::: "memory");
            const unsigned og = xb_add(&bar[XB_TOP], 1u);
            const unsigned tg = og / nx;
            if (og + 1u == (tg + 1u) * nx) xb_add(&bar[XB_TOPGEN], 1u);
            else XB_SPIN(xb_ld(&bar[XB_TOPGEN]) == tg, bar);
            __builtin_amdgcn_fence(__ATOMIC_ACQUIRE, "agent");
            xb_add(&bar[XB_XGEN(b.x)], 1u);
            asm volatile("s_waitcnt vmcnt(0)" ::: "memory");
        } else {
            XB_SPIN(xb_ld(&bar[XB_XGEN(b.x)]) == gen, bar);
            __builtin_amdgcn_fence(__ATOMIC_ACQUIRE, "agent");
            asm volatile("s_waitcnt vmcnt(0)" ::: "memory");
        }
    }
    __syncthreads();
}

#define KSWZ(row, colB) ((row) * 256 + ((colB) ^ (((row) & 7) << 4)))
__device__ __forceinline__ int v_st(int k, int c) { const int kk = (k & ~0xC) | ((k & 4) << 1) | ((k & 8) >> 1); return ((kk >> 3) * 4 + (c >> 5)) * 512 + ((kk & 7) * 32 + (c & 31)) * 2; }
__device__ __forceinline__ int v_rd_base(int lane) { return ((lane & 3) << 3) | (((lane >> 2) & 3) << 6) | (((lane >> 4) & 1) << 5) | (((lane >> 5) & 1) << 8); }
constexpr int v_rd_off(int d0, int ks, int half) { return d0 * 512 + ks * 4096 + half * 2048; }
__device__ __forceinline__ int crow(int r, int hi) { return (r & 3) + 8 * (r >> 2) + 4 * hi; }

struct ACtx {
    LAS unsigned char* lds;
    int tid, wid, lane, r32, hi, sr, sc, kws, vst0, vst1, vb0;
    LAS float* ws;
};
__device__ __forceinline__ ACtx make_actx(LAS unsigned char* lds) {
    ACtx c; c.lds = lds; { int t_ = threadIdx.x; asm volatile("" : "+v"(t_)); c.tid = t_; } c.wid = __builtin_amdgcn_readfirstlane(c.tid >> 6); c.lane = c.tid & 63; c.r32 = c.lane & 31; c.hi = c.lane >> 5;
    c.sr = c.tid >> 4; c.sc = (c.tid & 15) * 8; c.kws = KSWZ(c.sr, c.sc * 2); c.vst0 = v_st(c.sr, c.sc); c.vst1 = v_st(32 + c.sr, c.sc);
    c.vb0 = (int)(unsigned)(size_t)(lds + A_V) + v_rd_base(c.lane);
    c.ws = (LAS float*)(lds + A_WS) + c.wid * 64;
    return c;
}
struct Stage { bf16x8 k0, k1, v0, v1; };
__device__ __forceinline__ void stage_load(Stage& S, const bf16_t* Kp, const bf16_t* Vp, int pitch, int kb, const ACtx& c) {
    S.v0 = *(const bf16x8*)(Vp + (size_t)(kb + c.sr) * pitch + c.sc); S.v1 = *(const bf16x8*)(Vp + (size_t)(kb + 32 + c.sr) * pitch + c.sc);
    S.k0 = *(const bf16x8*)(Kp + (size_t)(kb + c.sr) * pitch + c.sc); S.k1 = *(const bf16x8*)(Kp + (size_t)(kb + 32 + c.sr) * pitch + c.sc);
}
__device__ __forceinline__ void stage_write(const Stage& S, int buf, const ACtx& c) {
    LAS unsigned char* Kb = c.lds + A_K + buf * SHM_T; LAS unsigned char* Vb = c.lds + A_V + buf * SHM_T;
    *(LAS bf16x8*)(Kb + c.kws) = S.k0; *(LAS bf16x8*)(Kb + c.kws + 32 * 256) = S.k1;
    *(LAS bf16x8*)(Vb + c.vst0) = S.v0; *(LAS bf16x8*)(Vb + c.vst1) = S.v1;
}
__device__ __forceinline__ void qkt(f32x16& p0, f32x16& p1, int buf, const ACtx& c, const bf16x8* qr) {
    p0 = (f32x16){}; p1 = (f32x16){};
    const LAS unsigned char* Kb = c.lds + A_K + buf * SHM_T;
    const LAS unsigned char* kb[4];
#pragma unroll
    for (int dd = 0; dd < 4; ++dd) kb[dd] = Kb + KSWZ(c.r32, (dd * 16 + c.hi * 8) * 2);
#pragma unroll
    for (int d0 = 0; d0 < 8; ++d0) { const LAS unsigned char* a = kb[d0 & 3] + (d0 >> 2) * 128;
        const bf16x8 b0 = *(const LAS bf16x8*)a; const bf16x8 b1 = *(const LAS bf16x8*)(a + 32 * 256);
        p0 = __builtin_amdgcn_mfma_f32_32x32x16_bf16(b0, qr[d0], p0, 0, 0, 0);
        p1 = __builtin_amdgcn_mfma_f32_32x32x16_bf16(b1, qr[d0], p1, 0, 0, 0); }
}
__device__ __forceinline__ void pv_tile(f32x16* o, int buf, const ACtx& c, bf16x8 pa0, bf16x8 pa1, bf16x8 pa2, bf16x8 pa3) {
    const int vb = c.vb0 + buf * SHM_T;
#define TRRD(dst, off) asm volatile("ds_read_b64_tr_b16 %0, %1 offset:%2" : "=&v"(dst) : "v"(vb), "i"(off) : "memory")
#define PV_D0(d0) do { s16x4 l0, l1, l2, l3, h0, h1, h2, h3; constexpr int b_ = v_rd_off(d0, 0, 0); \
        TRRD(l0, b_); TRRD(h0, b_ + 2048); TRRD(l1, b_ + 4096); TRRD(h1, b_ + 6144); TRRD(l2, b_ + 8192); TRRD(h2, b_ + 10240); TRRD(l3, b_ + 12288); TRRD(h3, b_ + 14336); \
        asm volatile("s_waitcnt lgkmcnt(0)" ::: "memory"); SBAR(); \
        o[d0] = __builtin_amdgcn_mfma_f32_32x32x16_bf16(pa0, (bf16x8){l0[0], l0[1], l0[2], l0[3], h0[0], h0[1], h0[2], h0[3]}, o[d0], 0, 0, 0); \
        o[d0] = __builtin_amdgcn_mfma_f32_32x32x16_bf16(pa1, (bf16x8){l1[0], l1[1], l1[2], l1[3], h1[0], h1[1], h1[2], h1[3]}, o[d0], 0, 0, 0); \
        o[d0] = __builtin_amdgcn_mfma_f32_32x32x16_bf16(pa2, (bf16x8){l2[0], l2[1], l2[2], l2[3], h2[0], h2[1], h2[2], h2[3]}, o[d0], 0, 0, 0); \
        o[d0] = __builtin_amdgcn_mfma_f32_32x32x16_bf16(pa3, (bf16x8){l3[0], l3[1], l3[2], l3[3], h3[0], h3[1], h3[2], h3[3]}, o[d0], 0, 0, 0); } while (0)
    PV_D0(0); PV_D0(1); PV_D0(2); PV_D0(3);
#undef PV_D0
#undef TRRD
}
__device__ __forceinline__ float swap_max(float v) { auto rr = __builtin_amdgcn_permlane32_swap(__float_as_uint(v), __float_as_uint(v), false, false); return fmaxf(__uint_as_float(rr[0]), __uint_as_float(rr[1])); }
__device__ __forceinline__ float swap_sum(float v) { auto rr = __builtin_amdgcn_permlane32_swap(__float_as_uint(v), __float_as_uint(v), false, false); return __uint_as_float(rr[0]) + __uint_as_float(rr[1]); }
__device__ __forceinline__ void swap_both(float v, float& lo, float& hi) { auto rr = __builtin_amdgcn_permlane32_swap(__float_as_uint(v), __float_as_uint(v), false, false); lo = __uint_as_float(rr[0]); hi = __uint_as_float(rr[1]); }
__device__ __forceinline__ void pack_p(const f32x16& p0, const f32x16& p1, bf16x8& pa0, bf16x8& pa1, bf16x8& pa2, bf16x8& pa3) {
#define PK4(P, B_, OUT) do { unsigned a0 = cvtpk(P[B_+0], P[B_+1]), a1 = cvtpk(P[B_+2], P[B_+3]); \
        unsigned b0 = cvtpk(P[B_+4], P[B_+5]), b1 = cvtpk(P[B_+6], P[B_+7]); \
        auto r0 = __builtin_amdgcn_permlane32_swap(a0, b0, false, false); auto r1 = __builtin_amdgcn_permlane32_swap(a1, b1, false, false); \
        v4u w = {r0[0], r1[0], r0[1], r1[1]}; OUT = __builtin_bit_cast(bf16x8, w); } while (0)
    PK4(p0, 0, pa0); PK4(p0, 8, pa1); PK4(p1, 0, pa2); PK4(p1, 8, pa3);
#undef PK4
}
__device__ __forceinline__ void mask_tile(f32x16& p0, f32x16& p1, int dq, unsigned W) {
    const float NEG = -__builtin_inff();
#pragma unroll
    for (int r = 0; r < 16; ++r) { const int cc = (r & 3) + 8 * (r >> 2);
        if ((unsigned)(dq - cc) >= W) p0[r] = NEG;
        if ((unsigned)(dq - cc - 32) >= W) p1[r] = NEG; }
}
constexpr float THR = 8.f;
__device__ __forceinline__ void softmax_tile(f32x16& p0, f32x16& p1, float& m_reg, float& l_reg, f32x16* o, const ACtx& c) {
    float pmax = p0[0];
#pragma unroll
    for (int r = 1; r < 16; ++r) pmax = fmaxf(pmax, p0[r]);
#pragma unroll
    for (int r = 0; r < 16; ++r) pmax = fmaxf(pmax, p1[r]);
    pmax = swap_max(pmax);
    constexpr float C2 = LOG2E * SCALE;
    float mn, alpha;
    if (__all((pmax - m_reg) * SCALE <= THR)) { mn = m_reg; alpha = 1.f; }
    else { mn = fmaxf(m_reg, pmax); alpha = __builtin_amdgcn_exp2f((m_reg - mn) * C2); m_reg = mn; }
    const float mnL = -mn * C2;
#pragma unroll
    for (int r = 0; r < 16; ++r) { p0[r] = __builtin_amdgcn_exp2f(fmaf(p0[r], C2, mnL)); p1[r] = __builtin_amdgcn_exp2f(fmaf(p1[r], C2, mnL)); }
    float ps = 0.f;
#pragma unroll
    for (int r = 0; r < 16; ++r) ps += p0[r] + p1[r];
    ps = swap_sum(ps);
    l_reg = l_reg * alpha + ps;
    if (__any(alpha < 1.f)) {
        if (c.hi == 0) c.ws[32 + c.r32] = alpha;
        LDS_WAIT();
#pragma unroll
        for (int r = 0; r < 16; ++r) { const float a = c.ws[32 + crow(r, c.hi)];
#pragma unroll
            for (int d = 0; d < 4; ++d) o[d][r] *= a; }
    }
}
__device__ __forceinline__ void row_factors(float f, float (&fr)[16], const ACtx& c) {
    LDS_WAIT();
    if (c.hi == 0) c.ws[c.r32] = f;
    LDS_WAIT();
#pragma unroll
    for (int r = 0; r < 16; ++r) fr[r] = c.ws[crow(r, c.hi)];
    LDS_WAIT();
}
template <bool ROPE>
__device__ __forceinline__ void load_q(bf16x8 (&qr)[8], const bf16_t* qrow, const float* cosr, const float* sinr, int hi) {
#pragma unroll
    for (int d0 = 0; d0 < 8; ++d0) qr[d0] = *(const bf16x8*)(qrow + d0 * 16 + hi * 8);
    if constexpr (ROPE) {
#pragma unroll
        for (int d0 = 0; d0 < 4; ++d0) {
            const int i0 = d0 * 16 + hi * 8;
            const f32x4 c0 = *(const f32x4*)(cosr + i0), c1 = *(const f32x4*)(cosr + i0 + 4), s0 = *(const f32x4*)(sinr + i0), s1 = *(const f32x4*)(sinr + i0 + 4);
            f32x4 a0, a1, b0, b1; unpack8(qr[d0], a0, a1); unpack8(qr[d0 + 4], b0, b1);
            qr[d0] = pack8(a0 * c0 - b0 * s0, a1 * c1 - b1 * s1);
            qr[d0 + 4] = pack8(b0 * c0 + a0 * s0, b1 * c1 + a1 * s1);
        }
    }
}
__device__ __forceinline__ void store_o_bf16(const f32x16* o, bf16_t* Ow  , int pitch, const ACtx& c) {
#pragma unroll
    for (int r = 0; r < 16; ++r) { const int orow = crow(r, c.hi);
#pragma unroll
        for (int d0 = 0; d0 < 4; ++d0) { const float v = o[d0][r]; const float vn = __shfl_xor(v, 1);
            if ((c.r32 & 1) == 0) *(unsigned*)(Ow + (size_t)orow * pitch + d0 * 32 + c.r32) = cvtpk(v, vn); } }
}

__device__ __forceinline__ void add_o_bf16(f32x16* o, const bf16_t* Ow, int pitch, const ACtx& c) {
#pragma unroll
    for (int r = 0; r < 16; ++r) { const int orow = crow(r, c.hi);
#pragma unroll
        for (int d0 = 0; d0 < 4; ++d0) o[d0][r] += bf2f(Ow[(size_t)orow * pitch + d0 * 32 + c.r32]); }
}
__device__ __forceinline__ int wq_next(gu32* ctr, LAS int* slot, int tid) {
    __syncthreads();
    if (tid == 0) *slot = (int)__hip_atomic_fetch_add(ctr, 1u, RLX_AGENT);
    __syncthreads();
    return *slot;
}
template <int MODE>
__device__ __forceinline__ void softmax_sweep(const ACtx& c, const bf16x8 (&qr)[8], f32x16 (&o)[4], float& l_out, const bf16_t* Kp, const bf16_t* Vp, int pitch,
                                              int j_lo, int j_hi, int qpos, int qlo, unsigned selbits) {
    float m_reg = -1e30f, l_reg = 0.f;
#pragma unroll
    for (int d = 0; d < 4; ++d) o[d] = (f32x16){};
    Stage S; stage_load(S, Kp, Vp, pitch, j_lo * 64, c);
    for (int j = j_lo; j < j_hi; ++j) {
        const int buf = (j - j_lo) & 1;
        stage_write(S, buf, c);
        __syncthreads();
        if (j + 1 < j_hi) stage_load(S, Kp, Vp, pitch, (j + 1) * 64, c);
        const int kb = j * 64;
        bool act = true;
        if (MODE == 1) act = (kb <= qlo + 31) && (kb + 63 >= qlo - (WINDOW - 1));
        if (MODE == 2) act = (kb <= qlo + 31) && __any((int)((selbits >> j) & 1u));
        if (act) {
            f32x16 p0, p1; qkt(p0, p1, buf, c, qr);
            if (MODE == 1) { if (kb + 63 > qlo || kb < qlo + 31 - (WINDOW - 1)) mask_tile(p0, p1, qpos - kb - 4 * c.hi, (unsigned)WINDOW); }
            if (MODE == 2) { if (kb + 63 > qlo) mask_tile(p0, p1, qpos - kb - 4 * c.hi, 0x7fffffffu);
                if (!__all((int)((selbits >> j) & 1u))) { if (!((selbits >> j) & 1u)) { const float NEG = -__builtin_inff();
#pragma unroll
                    for (int r = 0; r < 16; ++r) { p0[r] = NEG; p1[r] = NEG; } } } }
            softmax_tile(p0, p1, m_reg, l_reg, o, c);
            bf16x8 pa0, pa1, pa2, pa3; pack_p(p0, p1, pa0, pa1, pa2, pa3);
            pv_tile(o, buf, c, pa0, pa1, pa2, pa3);
        }
    }
    __syncthreads();
    l_out = l_reg;
}

struct Params {
    const float* x; const float* mem; const int* positions; const float* norm_g; const float* w_in_sb; const float* w_in_nsa; const float* cmp_pe; const float* cmp_w1; const float* cmp_w2;
    const float* w_mem_kv; const float* w_o; const float* w_gate; const float* w_up; const float* conv_w; const float* conv_b; const float* w_down;
    float* out; unsigned char* ws; int ph_lo, ph_hi;
};
struct Frame {
    LAS unsigned char* lds; int tid, lane, wave, G, bid;
};
#define WSP(T, off) ((T*)(p.ws + (off)))

__device__ __forceinline__ void tr_item(const float* W, int K, int Nsrc, int src_col0, int ncols, const float* gain, bf16_t* WT, int dst_row0, int mode, int item, int lane) {
    const int nblk = (ncols + 255) >> 8, kb = item / nblk, nb = item - kb * nblk, k0 = 16 * kb, n = nb * 256 + 4 * lane;
    if (n >= ncols) return;
    f32x4 v[16];
    if (W != nullptr) {
        const float* src = W + (size_t)k0 * Nsrc + src_col0 + n;
#pragma unroll
        for (int j = 0; j < 16; ++j) { const int kp = k0 + j, jj = kp & 127; const int ks = (mode & 4) ? (kp & ~127) + (jj >> 1) + 64 * (jj & 1) : kp;
            v[j] = *(const f32x4*)(W + (size_t)ks * Nsrc + src_col0 + n); }
        if (gain) {
#pragma unroll
            for (int j = 0; j < 16; ++j) v[j] = v[j] * gain[k0 + j];
        }
    } else {
#pragma unroll
        for (int j = 0; j < 16; ++j) v[j] = (f32x4){0.f, 0.f, 0.f, 0.f};
    }
#pragma unroll
    for (int e = 0; e < 4; ++e) {
        const int nn = n + e, dd = nn & 127; const int drow = dst_row0 + ((mode & 1) ? 256 * (nn >> 7) + dd : (mode & 2) ? (nn & ~127) + (dd < 64 ? 2 * dd : 2 * (dd - 64) + 1) : nn);
        v4u o0, o1;
        o0.x = cvtpk(v[0][e], v[1][e]); o0.y = cvtpk(v[2][e], v[3][e]); o0.z = cvtpk(v[4][e], v[5][e]); o0.w = cvtpk(v[6][e], v[7][e]);
        o1.x = cvtpk(v[8][e], v[9][e]); o1.y = cvtpk(v[10][e], v[11][e]); o1.z = cvtpk(v[12][e], v[13][e]); o1.w = cvtpk(v[14][e], v[15][e]);
        v4u* dst = (v4u*)(WT + (size_t)drow * K + k0); dst[0] = o0; dst[1] = o1;
    }
}
__device__ __forceinline__ void row_to_bf16_rstd(const float* xrow, bf16_t* orow, float* rstd_out, int lane) {
    const f32x4* xr = (const f32x4*)xrow + lane; f32x4 v[8]; float s = 0.f;
#pragma unroll
    for (int j = 0; j < 8; ++j) { v[j] = xr[64 * j]; s += (v[j].x * v[j].x + v[j].y * v[j].y) + (v[j].z * v[j].z + v[j].w * v[j].w); }
    s = wave_sum(s);
    v2u* o8 = (v2u*)orow + lane;
#pragma unroll
    for (int j = 0; j < 8; ++j) { v2u w; w.x = cvtpk(v[j].x, v[j].y); w.y = cvtpk(v[j].z, v[j].w); o8[64 * j] = w; }
    if (lane == 0) *rstd_out = 1.0f / sqrtf(s * (1.0f / DM) + NORM_EPS);
}
template <class PP> __device__ __forceinline__ void phase_convert(const PP& p, const Frame& F, int L) {
    const int gw = F.bid * NWAVES + F.wave, NGW = F.G * NWAVES;
    int it0 = gw;
#define TR(W, K, Nsrc, sc0, nc, gain, WT, dr0, mode) do { const int n_ = ((K) / 16) * (((nc) + 255) >> 8); for (; it0 < n_; it0 += NGW) tr_item(W, K, Nsrc, sc0, nc, gain, WT, dr0, mode, it0, F.lane); it0 -= n_; } while (0)
    const float* g = p.norm_g + (size_t)L * 5 * DM;
    const int j = L >> 1;
    bf16_t* WIN = WSP(bf16_t, WS_WIN);
    if ((L & 1) == 0) {
        TR(p.w_in_sb + (size_t)j * DM * SB_N, DM, SB_N, 0, SB_N, g, WIN, 0, 0);
    } else {
        const float* W = p.w_in_nsa + (size_t)j * DM * NSA_SRC;
        TR(W, DM, NSA_SRC, 0, 1536, g, WIN, NQ, 2);
        TR(W, DM, NSA_SRC, 1536, 256, g, WIN, NKC, 2);
        TR(W, DM, NSA_SRC, 1792, 256, g, WIN, NVC, 0);
        TR(W, DM, NSA_SRC, 2048, 256, g, WIN, NKS, 2);
        TR(W, DM, NSA_SRC, 2304, 256, g, WIN, NVS, 0);
        TR(W, DM, NSA_SRC, 2560, 256, g, WIN, NKW, 2);
        TR(W, DM, NSA_SRC, 2816, 256, g, WIN, NVW, 0);
        TR(W, DM, NSA_SRC, 3108, 512, g, WIN, NQM, 0);
        TR(W, DM, NSA_SRC, 3072, 36, g, WIN, NGL, 0);
        TR((const float*)nullptr, DM, NSA_SRC, 0, 220, (const float*)nullptr, WIN, NGL + 36, 0);
        for (int wh = 0; wh < 2; ++wh) {
            TR(p.cmp_w1 + (size_t)(j * 2 + wh) * 4096 * 256, 4096, 256, 0, 256, (const float*)nullptr, WSP(bf16_t, WS_CW1) + (size_t)wh * 256 * 4096, 0, wh == 0 ? 4 : 0);
            TR(p.cmp_w2 + (size_t)(j * 2 + wh) * 256 * 128, 256, 128, 0, 128, (const float*)nullptr, WSP(bf16_t, WS_CW2) + (size_t)wh * 128 * 256, 0, wh == 0 ? 2 : 0);
        }
    }
    if ((L & 1) && F.bid < 16) {
        const int wh = F.bid >> 3, n = 32 * (F.bid & 7) + (F.tid & 31), kg = F.tid >> 5;
        const float* pe = p.cmp_pe + (size_t)(j * 2 + wh) * 4096; const float* w1 = p.cmp_w1 + (size_t)(j * 2 + wh) * 4096 * 256;
        float s = 0.f;
        for (int k = kg * 256; k < kg * 256 + 256; ++k) s += pe[k] * w1[(size_t)k * 256 + n];
        LAS float* red = (LAS float*)F.lds;
        red[kg * 32 + (F.tid & 31)] = s;
        __syncthreads();
        if (F.tid < 32) { float t = 0.f;
#pragma unroll
            for (int q = 0; q < 16; ++q) t += red[q * 32 + F.tid];
            WSP(float, WS_BIAS1)[wh * 256 + n] = t; }
        __syncthreads();
    }
    TR(p.w_o + (size_t)L * DM * DM, DM, DM, 0, DM, (const float*)nullptr, WSP(bf16_t, WS_WO), 0, 0);
    TR(p.w_gate + (size_t)L * DM * DFF, DM, DFF, 0, DFF, g + 2 * DM, WSP(bf16_t, WS_WGU), 0, 1);
    TR(p.w_up + (size_t)L * DM * DFF, DM, DFF, 0, DFF, g + 2 * DM, WSP(bf16_t, WS_WGU), 128, 1);
    TR(p.w_down + (size_t)L * DFF * DM, DFF, DM, 0, DM, (const float*)nullptr, WSP(bf16_t, WS_WD), 0, 0);
    if (L == 0) {
        for (int l = 0; l < DEPTH; ++l)
            TR(p.w_mem_kv + (size_t)l * DM * 1024, DM, 1024, 0, 1024, p.norm_g + (size_t)(l * 5 + 4) * DM, WSP(bf16_t, WS_WKV), l * 1024, 0);
        float* rstd = WSP(float, WS_RSTD);
        for (int m = gw; m < MTOK; m += NGW) row_to_bf16_rstd(p.x + (size_t)m * DM, WSP(bf16_t, WS_XB) + (size_t)m * DM, rstd + m, F.lane);
        for (int m = gw; m < NB * NMEM; m += NGW) row_to_bf16_rstd(p.mem + (size_t)m * DM, WSP(bf16_t, WS_MEMB) + (size_t)m * DM, rstd + 16384 + m, F.lane);
        float* cosT = WSP(float, WS_COS); float* sinT = WSP(float, WS_SIN);
        for (int idx = F.bid * NTHR + F.tid; idx < MTOK * 64; idx += F.G * NTHR) {
            const int row = idx >> 6, i = idx & 63;
            const float ang = (float)p.positions[row] * INV_FREQ[i];
            double t = (double)ang * 0.15915494309189535; t -= __builtin_rint(t);
            const float fr = (float)t;
            cosT[idx] = __builtin_amdgcn_cosf(fr); sinT[idx] = __builtin_amdgcn_sinf(fr);
        }
    }
#undef TR
}

template <class PP> __device__ __forceinline__ void phase_resid(const PP& p, const Frame& F, const float* xin, const float* gpost, float* xout, bf16_t* XB, float* rstd) {
    const int gw = F.bid * NWAVES + F.wave, NGW = F.G * NWAVES;
    const bf16_t* T = WSP(bf16_t, WS_TMP);
    for (int m = gw; m < MTOK; m += NGW) {
        const bf16x8* ar = (const bf16x8*)(T + (size_t)m * DM) + F.lane;
        f32x4 a[8]; float s = 0.f;
#pragma unroll
        for (int j = 0; j < 4; ++j) { unpack8(ar[64 * j], a[2 * j], a[2 * j + 1]); }
#pragma unroll
        for (int j = 0; j < 8; ++j) s += (a[j].x * a[j].x + a[j].y * a[j].y) + (a[j].z * a[j].z + a[j].w * a[j].w);
        const float ra = 1.0f / sqrtf(wave_sum(s) * (1.0f / DM) + NORM_EPS);
        float s2 = 0.f;
#pragma unroll
        for (int j = 0; j < 4; ++j) {
            const int e0 = (j * 64 + F.lane) * 8;
#pragma unroll
            for (int h = 0; h < 2; ++h) {
                const f32x4 xv = *(const f32x4*)(xin + (size_t)m * DM + e0 + 4 * h), gv = *(const f32x4*)(gpost + e0 + 4 * h);
                const f32x4 y = xv + a[2 * j + h] * ra * gv;
                a[2 * j + h] = y; s2 += (y.x * y.x + y.y * y.y) + (y.z * y.z + y.w * y.w);
                *(f32x4*)(xout + (size_t)m * DM + e0 + 4 * h) = y;
            }
            *((bf16x8*)(XB + (size_t)m * DM) + 64 * j + F.lane) = pack8(a[2 * j], a[2 * j + 1]);
        }
        s2 = wave_sum(s2);
        if (F.lane == 0) rstd[m] = 1.0f / sqrtf(s2 * (1.0f / DM) + NORM_EPS);
    }
}
template <class PP> __device__ __forceinline__ void phase_convfix(const PP& p, const Frame& F, int L) {
    bf16_t* ACT = WSP(bf16_t, WS_ACT); const float* HG = WSP(float, WS_HG); const float* FP = WSP(float, WS_FP); const float* FU = WSP(float, WS_FU);
    const float* cw = p.conv_w + (size_t)L * 3 * DFF;
    constexpr int NCH = DFF / 4;
    for (int it = F.bid * NTHR + F.tid; it < 64 * 2 * NCH; it += F.G * NTHR) {
        const int pm = it / (2 * NCH), rem = it - pm * 2 * NCH, i = rem / NCH, f0 = (rem - i * NCH) * 4;
        if ((pm & 7) == 0) continue;
        const f32x4 h0 = *(const f32x4*)(HG + (size_t)((pm - 1) * 2 + 0) * DFF + f0), h1 = *(const f32x4*)(HG + (size_t)((pm - 1) * 2 + 1) * DFF + f0);
        const f32x4 w0 = *(const f32x4*)(cw + f0), w1 = *(const f32x4*)(cw + DFF + f0);
        f32x4 gc = *(const f32x4*)(FP + (size_t)(pm * 2 + i) * DFF + f0); const f32x4 uu = *(const f32x4*)(FU + (size_t)(pm * 2 + i) * DFF + f0);
        if (i == 0) gc += w0 * h0 + w1 * h1; else gc += w0 * h1;
        v2u o; o.x = cvtpk(gc[0] * sigmoidf_(gc[0]) * uu[0], gc[1] * sigmoidf_(gc[1]) * uu[1]); o.y = cvtpk(gc[2] * sigmoidf_(gc[2]) * uu[2], gc[3] * sigmoidf_(gc[3]) * uu[3]);
        *(v2u*)(ACT + (size_t)(pm * 256 + i) * DFF + f0) = o;
    }
}

template <class PP> __device__ __forceinline__ void sb_unit(const PP& p, const ACtx& c, int b, int h, int qt) {
    const bf16_t* PR = WSP(bf16_t, WS_PROJ); bf16_t* OC = WSP(bf16_t, WS_OCAT);
    const int P0 = qt * 256, qlo = P0 + c.wid * 32, qpos = qlo + c.r32;
    const size_t rowb = (size_t)b * SEQ;
    bf16x8 qr[8]; load_q<false>(qr, PR + (rowb + qpos) * SB_N + SBQ + h * HD, nullptr, nullptr, c.hi);
    const bf16_t* Kp = PR + rowb * SB_N + SBK + h * HD; const bf16_t* Vp = PR + rowb * SB_N + SBV + h * HD;
    f32x16 o[4];
#pragma unroll
    for (int d = 0; d < 4; ++d) o[d] = (f32x16){};
    float C2 = 0.f;
    const int jt = (P0 >> 6) + 3;
    LAS int* flags = (LAS int*)(c.lds + A_FLAGS);
    int done_w = 0;
    Stage S; stage_load(S, Kp, Vp, SB_N, jt * 64, c);
    constexpr float ZS = SCALE * LOG2E;
    for (int it = 0; it <= jt; ++it) {
        const int j = jt - it, buf = it & 1;
        stage_write(S, buf, c);
        if (c.lane == 0) flags[buf * 8 + c.wid] = done_w;
        __syncthreads();
        int alld = 1;
#pragma unroll
        for (int w = 0; w < 8; ++w) alld &= flags[buf * 8 + w];
        if (alld) break;
        if (j > 0) stage_load(S, Kp, Vp, SB_N, (j - 1) * 64, c);
        const int kb = j * 64;
        if (!done_w && kb <= qlo + 30) {
            f32x16 p0, p1; qkt(p0, p1, buf, c, qr);
            const int dq = qpos - kb - 4 * c.hi;
#pragma unroll
            for (int r = 0; r < 16; ++r) { const int cc = (r & 3) + 8 * (r >> 2);
                { const float z = p0[r] * ZS; const float t = __builtin_amdgcn_exp2f(-fabsf(z)); const float v = -(fmaxf(z, 0.f) + __builtin_amdgcn_logf(1.f + t)); p0[r] = (cc < dq) ? v : 0.f; }
                { const float z = p1[r] * ZS; const float t = __builtin_amdgcn_exp2f(-fabsf(z)); const float v = -(fmaxf(z, 0.f) + __builtin_amdgcn_logf(1.f + t)); p1[r] = (cc + 32 < dq) ? v : 0.f; } }
            float E[8], Od[8];
#pragma unroll
            for (int q = 0; q < 4; ++q) { const float g0 = (p0[4 * q] + p0[4 * q + 1]) + (p0[4 * q + 2] + p0[4 * q + 3]); swap_both(g0, E[q], Od[q]);
                                          const float g1 = (p1[4 * q] + p1[4 * q + 1]) + (p1[4 * q + 2] + p1[4 * q + 3]); swap_both(g1, E[4 + q], Od[4 + q]); }
            float T = 0.f, ex[8];
#pragma unroll
            for (int q = 7; q >= 0; --q) { const float to = T; T += Od[q]; const float te = T; T += E[q]; ex[q] = c.hi ? to : te; }
#pragma unroll
            for (int q = 0; q < 4; ++q) {
                { float R = C2 + ex[q]; float ep = __builtin_amdgcn_exp2f(R);
#pragma unroll
                  for (int i = 3; i >= 0; --i) { R += p0[4 * q + i]; const float e = __builtin_amdgcn_exp2f(R); p0[4 * q + i] = ep - e; ep = e; } }
                { float R = C2 + ex[4 + q]; float ep = __builtin_amdgcn_exp2f(R);
#pragma unroll
                  for (int i = 3; i >= 0; --i) { R += p1[4 * q + i]; const float e = __builtin_amdgcn_exp2f(R); p1[4 * q + i] = ep - e; ep = e; } }
            }
            C2 += T;
            bf16x8 pa0, pa1, pa2, pa3; pack_p(p0, p1, pa0, pa1, pa2, pa3);
            pv_tile(o, buf, c, pa0, pa1, pa2, pa3);
            done_w = __all(C2 < -72.f) ? 1 : 0;
        }
    }
    __syncthreads();
    store_o_bf16(o, OC + (rowb + qlo) * DM + h * HD, DM, c);
}
template <class PP> __device__ __forceinline__ void mem_unit(const PP& p, const ACtx& c, int L, int b, int hm, int qt, int projN, int qmcol) {
    const bf16_t* PR = WSP(bf16_t, WS_PROJ); bf16_t* OC = WSP(bf16_t, WS_OCAT); const bf16_t* MKV = WSP(bf16_t, WS_MEMKV);
    const int P0 = qt * 256, qlo = P0 + c.wid * 32, qpos = qlo + c.r32;
    const size_t rowb = (size_t)b * SEQ;
    bf16x8 qr[8]; load_q<false>(qr, PR + (rowb + qpos) * projN + qmcol + hm * HD, nullptr, nullptr, c.hi);
    const bf16_t* Kp = MKV + (size_t)b * NMEM * 4096 + L * 1024 + hm * HD; const bf16_t* Vp = Kp + 512;
    f32x16 o[4]; float l;
    softmax_sweep<0>(c, qr, o, l, Kp, Vp, 4096, 0, 4, qpos, qlo, 0u);
    float fr[16]; row_factors(1.0f / l, fr, c);
#pragma unroll
    for (int d = 0; d < 4; ++d)
#pragma unroll
        for (int r = 0; r < 16; ++r) o[d][r] *= fr[r];
    store_o_bf16(o, OC + (rowb + qlo) * DM + NMIX * HD + hm * HD, DM, c);
}
template <class PP> __device__ __forceinline__ void phase_attn_sb(const PP& p, const Frame& F, int L, gu32* ctr) {
    const ACtx c = make_actx(F.lds);
    LAS int* slot = (LAS int*)(F.lds + MISC_OFF) + 16;
    constexpr int NSBU = NB * NMIX * 8, NMU = NB * NMEMH * 8;
    for (;;) { const int u = wq_next(ctr, slot, c.tid); if (u >= NSBU + NMU) break;
        if (u < NSBU) { const int qt = 7 - (u / (NB * NMIX)), bh = u % (NB * NMIX); sb_unit(p, c, bh / NMIX, bh % NMIX, qt); }
        else { const int v = u - NSBU; const int qt = v % 8, bh = v / 8; mem_unit(p, c, L, bh / NMEMH, bh % NMEMH, qt, SB_N, SBQM); }
    }
}

template <class PP> __device__ __forceinline__ void phase_rope(const PP& p, const Frame& F) {
    bf16_t* PR = WSP(bf16_t, WS_PROJ); const float* cosT = WSP(float, WS_COS); const float* sinT = WSP(float, WS_SIN);
    const int lane = F.lane, gw = F.bid * NWAVES + F.wave, NGW = F.G * NWAVES;
    for (int m = gw; m < MTOK; m += NGW) {
        const float cv = cosT[(size_t)m * 64 + lane], sv = sinT[(size_t)m * 64 + lane];
        bf16_t* rowp = PR + (size_t)m * NSA_N;
        float x1[6], x2[6];
#pragma unroll
        for (int q = 0; q < 6; ++q) { const int base = ((q < 2) ? NKC : (q < 4) ? NKS : NKW) + (q & 1) * HD; x1[q] = bf2f(rowp[base + lane]); x2[q] = bf2f(rowp[base + 64 + lane]); }
#pragma unroll
        for (int q = 0; q < 6; ++q) { const int base = ((q < 2) ? NKC : (q < 4) ? NKS : NKW) + (q & 1) * HD;
            const float y1 = x1[q] * cv - x2[q] * sv, y2 = x2[q] * cv + x1[q] * sv;
            rowp[base + lane] = (bf16_t)(cvtpk(y1, y1) & 0xffffu); rowp[base + 64 + lane] = (bf16_t)(cvtpk(y2, y2) & 0xffffu); }
    }
}
template <class PP> __device__ __forceinline__ void phase_cmp_stage2(const PP& p, const Frame& F) {
    const int lane = F.lane, r32 = lane & 31, hi = lane >> 5;
    for (int u = F.bid; u < 128; u += F.G) {
        const int wh = u & 1, rt = u >> 1;
        if (F.wave < 4) {
            const bf16_t* hid = WSP(bf16_t, WS_HID) + (size_t)wh * 2048 * 256 + (size_t)(rt * 32 + r32) * 256;
            const bf16_t* w2 = WSP(bf16_t, WS_CW2) + (size_t)wh * 128 * 256 + (size_t)(F.wave * 32 + r32) * 256;
            f32x16 a2 = (f32x16){};
#pragma unroll
            for (int kk = 0; kk < 16; ++kk) { const int k = kk * 16 + hi * 8;
                a2 = __builtin_amdgcn_mfma_f32_32x32x16_bf16(*(const bf16x8*)(hid + k), *(const bf16x8*)(w2 + k), a2, 0, 0, 0); }
            bf16_t* outp = WSP(bf16_t, WS_KCMP) + (size_t)wh * 16 * 128 * 128;
#pragma unroll
            for (int r = 0; r < 16; ++r) { const int ro = rt * 32 + crow(r, hi);
                const float av_ = a2[r]; const unsigned ub = __float_as_uint(av_); const unsigned rb = (ub + 0x7fffu + ((ub >> 16) & 1u)) >> 16;
                outp[(size_t)ro * 128 + F.wave * 32 + r32] = ((ro & 127) == 127) ? (bf16_t)0 : (bf16_t)rb; }
        }
    }
}

template <class PP> __device__ __forceinline__ void cmp_unit(const PP& p, const ACtx& c, int b, int g, int qt) {
    const bf16_t* PR = WSP(bf16_t, WS_PROJ); bf16_t* OC = WSP(bf16_t, WS_OCAT); const float* cosT = WSP(float, WS_COS); const float* sinT = WSP(float, WS_SIN);
    const int P0 = qt * 256, qlo = P0 + c.wid * 32, qpos = qlo + c.r32, hi = c.hi;
    const size_t rowb = (size_t)b * SEQ, row = rowb + qpos;
    const bf16_t* Kp = WSP(bf16_t, WS_KCMP) + (size_t)(b * 2 + g) * 128 * 128; const bf16_t* Vp = Kp + (size_t)16 * 128 * 128;
    { Stage S; stage_load(S, Kp, Vp, 128, 0, c); stage_write(S, 0, c); stage_load(S, Kp, Vp, 128, 64, c); stage_write(S, 1, c); }
    __syncthreads();
    const int cmax = (qpos >= 31) ? (((qpos - 31) >> 4) < 126 ? ((qpos - 31) >> 4) : 126) : -1;
    LAS float* acc_l = (LAS float*)(c.lds + A_STASH) + c.wid * 2048 + c.lane;
    const float NEG = -__builtin_inff();
    constexpr float C2 = LOG2E * SCALE;
#pragma nounroll
    for (int hh = 0; hh < HPG; ++hh) {
        const int h = g * HPG + hh;
        bf16x8 qr[8]; load_q<false>(qr, PR + row * NSA_N + NQ + h * HD, nullptr, nullptr, hi);
        f32x16 pA0, pA1, pB0, pB1; qkt(pA0, pA1, 0, c, qr); qkt(pB0, pB1, 1, c, qr);
        float mx = NEG;
#pragma unroll
        for (int r = 0; r < 16; ++r) { const int ci = crow(r, hi);
            if (ci > cmax) pA0[r] = NEG; if (ci + 32 > cmax) pA1[r] = NEG; if (ci + 64 > cmax) pB0[r] = NEG; if (ci + 96 > cmax) pB1[r] = NEG;
            mx = fmaxf(fmaxf(mx, pA0[r]), fmaxf(pA1[r], fmaxf(pB0[r], pB1[r]))); }
        mx = swap_max(mx); if (mx == NEG) mx = 0.f;
        const float mL = -mx * C2; float ls = 0.f;
#pragma unroll
        for (int r = 0; r < 16; ++r) { pA0[r] = __builtin_amdgcn_exp2f(fmaf(pA0[r], C2, mL)); pA1[r] = __builtin_amdgcn_exp2f(fmaf(pA1[r], C2, mL));
            pB0[r] = __builtin_amdgcn_exp2f(fmaf(pB0[r], C2, mL)); pB1[r] = __builtin_amdgcn_exp2f(fmaf(pB1[r], C2, mL)); ls += (pA0[r] + pA1[r]) + (pB0[r] + pB1[r]); }
        ls = swap_sum(ls);
        const float inv = ls > 0.f ? 1.0f / ls : 0.f;
#pragma unroll
        for (int r = 0; r < 16; ++r) { pA0[r] *= inv; pA1[r] *= inv; pB0[r] *= inv; pB1[r] *= inv; }
#define ACC_AB(P, Q0) do { _Pragma("unroll") for (int q = 0; q < 4; ++q) { \
            const float a_ = 2.f * (P[4 * q] + P[4 * q + 1] + P[4 * q + 2]) + P[4 * q + 3], b_ = P[4 * q + 3]; \
            LAS float* pa_ = acc_l + (2 * (Q0 + q)) * 64; \
            if (hh == 0) { pa_[0] = a_; pa_[64] = b_; } else { pa_[0] += a_; pa_[64] += b_; } } } while (0)
        ACC_AB(pA0, 0); ACC_AB(pA1, 4); ACC_AB(pB0, 8); ACC_AB(pB1, 12);
#undef ACC_AB
        f32x16 o[4];
#pragma unroll
        for (int d = 0; d < 4; ++d) o[d] = (f32x16){};
        { bf16x8 pa0, pa1, pa2, pa3; pack_p(pA0, pA1, pa0, pa1, pa2, pa3); pv_tile(o, 0, c, pa0, pa1, pa2, pa3); }
        { bf16x8 pa0, pa1, pa2, pa3; pack_p(pB0, pB1, pa0, pa1, pa2, pa3); pv_tile(o, 1, c, pa0, pa1, pa2, pa3); }
        const float gc = sigmoidf_(bf2f(PR[row * NSA_N + NGL + h * 3 + 0]));
        float fr[16]; row_factors(gc, fr, c);
#pragma unroll
        for (int d = 0; d < 4; ++d)
#pragma unroll
            for (int r = 0; r < 16; ++r) o[d][r] *= fr[r];
        add_o_bf16(o, OC + (rowb + qlo) * DM + h * HD, DM, c);
        store_o_bf16(o, OC + (rowb + qlo) * DM + h * HD, DM, c);
    }
    float Ie[16], Io[16];
    {
        float imp[16], Bb[16];
#pragma unroll
        for (int q = 0; q < 16; ++q) { float blo, bhi; swap_both(acc_l[(2 * q + 1) * 64], blo, bhi); Bb[q] = hi ? blo : bhi; }
#pragma unroll
        for (int q = 0; q < 16; ++q) imp[q] = acc_l[(2 * q) * 64] + (hi ? Bb[q] : (q > 0 ? Bb[q - 1] : 0.f));
#pragma unroll
        for (int q = 0; q < 16; ++q) swap_both(imp[q], Ie[q], Io[q]);
    }
    const int cur = qpos >> 6;
    unsigned bits;
    if (cur < 16) bits = (2u << cur) - 1u;
    else {
#pragma unroll
        for (int q = 0; q < 16; ++q) { const int je = 2 * q, jo = 2 * q + 1;
            if (!(je >= 1 && je <= cur - 2)) Ie[q] = -1.f; if (!(jo >= 1 && jo <= cur - 2)) Io[q] = -1.f; }
        bits = 0u;
#pragma unroll
        for (int q = 0; q < 16; ++q) {
            const int jm = 2 * q + hi; const float vj = hi ? Io[q] : Ie[q];
            int rank = 0;
#pragma unroll
            for (int q2 = 0; q2 < 16; ++q2) {
                const bool lt_e = (q2 < q) || (q2 == q && hi);
                const bool lt_o = (q2 < q);
                rank += (Ie[q2] > vj || (Ie[q2] == vj && lt_e)) ? 1 : 0;
                rank += (Io[q2] > vj || (Io[q2] == vj && lt_o)) ? 1 : 0;
            }
            const bool forced = (jm == 0) || (jm == cur) || (jm == cur - 1);
            const bool sel = forced || (vj >= 0.f && rank < 13);
            bits |= sel ? (1u << jm) : 0u;
        }
        { auto rr = __builtin_amdgcn_permlane32_swap(bits, bits, false, false); bits = rr[0] | rr[1]; }
    }
    if (hi == 0) WSP(unsigned, WS_SEL)[(size_t)(b * 2 + g) * SEQ + qpos] = bits;
    __syncthreads();
}
template <class PP> __device__ __forceinline__ void phase_attn_cmp(const PP& p, const Frame& F) {
    const ACtx c = make_actx(F.lds);
    constexpr int NCU = NB * NGRP * 8;
    for (int u = F.bid; u < NCU; u += F.G) { const int qt = 7 - (u % 8), bg = u / 8; cmp_unit(p, c, bg >> 1, bg & 1, qt); }
}
template <class PP> __device__ __forceinline__ void win_unit(const PP& p, const ACtx& c, int b, int h, int qt) {
    const bf16_t* PR = WSP(bf16_t, WS_PROJ); bf16_t* OC = WSP(bf16_t, WS_OCAT); const float* cosT = WSP(float, WS_COS); const float* sinT = WSP(float, WS_SIN);
    const int P0 = qt * 256, qlo = P0 + c.wid * 32, qpos = qlo + c.r32, g = h / HPG;
    const size_t rowb = (size_t)b * SEQ, row = rowb + qpos;
    bf16x8 qr[8]; load_q<false>(qr, PR + row * NSA_N + NQ + h * HD, nullptr, nullptr, c.hi);
    const float gwn = sigmoidf_(bf2f(PR[row * NSA_N + NGL + h * 3 + 2]));
    f32x16 o[4]; float l;
    const int jlo = (P0 - (WINDOW - 1)) > 0 ? ((P0 - (WINDOW - 1)) >> 6) : 0;
    softmax_sweep<1>(c, qr, o, l, PR + rowb * NSA_N + NKW + g * HD, PR + rowb * NSA_N + NVW + g * HD, NSA_N, jlo, (P0 >> 6) + 4, qpos, qlo, 0u);
    float fr[16]; row_factors(l > 0.f ? gwn / l : 0.f, fr, c);
#pragma unroll
    for (int d = 0; d < 4; ++d)
#pragma unroll
        for (int r = 0; r < 16; ++r) o[d][r] *= fr[r];
    store_o_bf16(o, OC + (rowb + qlo) * DM + h * HD, DM, c);
}
template <class PP> __device__ __forceinline__ void nsa_win_mem_units(const PP& p, const Frame& F, int L, gu32* ctr) {
    const ACtx c = make_actx(F.lds);
    LAS int* slot = (LAS int*)(F.lds + MISC_OFF) + 16;
    constexpr int NWU = NB * NMIX * 8, NMU = NB * NMEMH * 8;
    for (;;) { const int u = wq_next(ctr, slot, c.tid); if (u >= NWU + NMU) break;
        if (u < NWU) { const int qt = 7 - (u / (NB * NMIX)), bh = u % (NB * NMIX); win_unit(p, c, bh / NMIX, bh % NMIX, qt); }
        else { const int v = u - NWU; const int qt = v % 8, bh = v / 8; mem_unit(p, c, L, bh / NMEMH, bh % NMEMH, qt, NSA_N, NQM); }
    }
}
template <class PP> __device__ __forceinline__ void sel_unit(const PP& p, const ACtx& c, int b, int h, int qt, bf16_t* OUT) {
    const bf16_t* PR = WSP(bf16_t, WS_PROJ); const bf16_t* OC = WSP(bf16_t, WS_OCAT); const float* cosT = WSP(float, WS_COS); const float* sinT = WSP(float, WS_SIN);
    const int P0 = qt * 256, qlo = P0 + c.wid * 32, qpos = qlo + c.r32, g = h / HPG;
    const size_t rowb = (size_t)b * SEQ, row = rowb + qpos;
    bf16x8 qr[8]; load_q<false>(qr, PR + row * NSA_N + NQ + h * HD, nullptr, nullptr, c.hi);
    const unsigned selbits = WSP(unsigned, WS_SEL)[(size_t)(b * 2 + g) * SEQ + qpos];
    const float gs = sigmoidf_(bf2f(PR[row * NSA_N + NGL + h * 3 + 1]));
    f32x16 o[4]; float l;
    softmax_sweep<2>(c, qr, o, l, PR + rowb * NSA_N + NKS + g * HD, PR + rowb * NSA_N + NVS + g * HD, NSA_N, 0, (P0 >> 6) + 4, qpos, qlo, selbits);
    float fr[16]; row_factors(l > 0.f ? gs / l : 0.f, fr, c);
#pragma unroll
    for (int d = 0; d < 4; ++d)
#pragma unroll
        for (int r = 0; r < 16; ++r) o[d][r] *= fr[r];
    add_o_bf16(o, OC + (rowb + qlo) * DM + h * HD, DM, c);
    store_o_bf16(o, OUT + (rowb + qlo) * DM + h * HD, DM, c);
}
template <class PP> __device__ __forceinline__ void phase_attn_sel(const PP& p, const Frame& F, bf16_t* OUT, gu32* ctr) {
    const ACtx c = make_actx(F.lds);
    LAS int* slot = (LAS int*)(F.lds + MISC_OFF) + 16;
    constexpr int NU = NB * NMIX * 8;
    for (;;) { const int u = wq_next(ctr, slot, c.tid); if (u >= NU) break;
        const int qt = 7 - (u / (NB * NMIX)), bh = u % (NB * NMIX); sel_unit(p, c, bh / NMIX, bh % NMIX, qt, OUT); }
}

#define LAST_() (rep_ == nrep_ - 1)
#define WQ_(k) ((gu32*)(p.ws + WS_CTL) + 64 * (8 + ((lp * 3 + (k)) * 2 + rep_)))
#ifndef PROBE_REPEAT
#define PROBE_REPEAT 0
#endif
constexpr int NPH = 48;
__global__ void __launch_bounds__(NTHR, 2) mk_fwd(Params p) {
    extern __shared__ __attribute__((aligned(16))) unsigned char lds_raw[];
    LAS unsigned char* const lds0 = (LAS unsigned char*)lds_raw;
typedef const Params __attribute__((address_space(4))) KParams;
#define MKFRAME() KParams* pp_ = (KParams*)__builtin_amdgcn_kernarg_segment_ptr(); asm volatile("" : "+s"(pp_)); KParams& p = *pp_; Frame F; F.lds = lds0; { int t_ = threadIdx.x; asm volatile("" : "+v"(t_)); F.tid = t_; } F.lane = F.tid & 63; F.wave = __builtin_amdgcn_readfirstlane(F.tid >> 6); F.G = gridDim.x; F.bid = blockIdx.x
    for (int u = threadIdx.x; u < (LDS_BYTES - LDSCTL_OFF) / 4; u += NTHR) ((LAS unsigned*)(lds0 + LDSCTL_OFF))[u] = 0u;
    __syncthreads();
    gu32* ctl = (gu32*)(p.ws + WS_CTL);
    XcdBarrier bar; bar.bar = (unsigned*)(ctl + CW_BAR); bar.x = 0; bar.st = nullptr;
#if !MK_PER_PHASE
    bar = xcd_barrier_post((unsigned*)(ctl + CW_BAR), (volatile LAS unsigned*)(lds0 + MISC_OFF) + 8);
#endif
    const int lo = p.ph_lo, hi = p.ph_hi;
    int ph = 0;
#define IN() (lo <= ph && ph < hi)
#if MK_PER_PHASE
#define END_PHASE() do { ++ph; } while (0)
#else
#define END_PHASE() do { if (IN() && ph + 1 < hi) { xcd_barrier(bar); if (PROBE_REPEAT & 256) xcd_barrier(bar); } ++ph; } while (0)
#endif
#define GEMM_RS(Aoff, Boff, M_, N_, K_, Ooff, ldc_, rs_) do { pg8::Gemm g{WSP(pg8::bf16_t, Aoff), WSP(pg8::bf16_t, Boff), M_, N_, K_}; pg8::StaticOrder S; S.init(M_, N_, F.G, F.bid); \
        pg8::EpiRS E{WSP(pg8::bf16_t, Ooff), ldc_, rs_}; pg8::gemm_phase<pg8::EpiRS, pg8::StaticOrder, true, true>(F.lds, g, S, E); } while (0)

#define GEMM_GU(L_) do { pg8::Gemm g{WSP(pg8::bf16_t, WS_XB), WSP(pg8::bf16_t, WS_WGU), MTOK, NGU, DM}; pg8::StaticOrder S; S.init(MTOK, NGU, F.G, F.bid); \
        pg8::EpiConv E{WSP(pg8::bf16_t, WS_ACT), WSP(float, WS_RSTD), p.conv_w + (size_t)(L_) * 3 * DFF, p.conv_b + (size_t)(L_) * DFF, WSP(float, WS_HG), WSP(float, WS_FP), WSP(float, WS_FU), (LAS float*)(F.lds + HALO_OFF), DFF}; \
        pg8::gemm_phase<pg8::EpiConv, pg8::StaticOrder, true, true>(F.lds, g, S, E); } while (0)

    for (int lp = 0; lp < 2; ++lp) {
        {
            const int L = 2 * lp;
            if (lp == 0) { if (IN()) { MKFRAME(); for (int rep_ = 0, nrep_ = ((PROBE_REPEAT & 1) ? 2 : 1); rep_ < nrep_; ++rep_) { phase_convert(p, F, L); } }
            END_PHASE(); }
            if (IN()) { MKFRAME(); for (int rep_ = 0, nrep_ = ((PROBE_REPEAT & 2) ? 2 : 1); rep_ < nrep_; ++rep_) { GEMM_RS(WS_XB, WS_WIN, MTOK, SB_N, DM, WS_PROJ, SB_N, WSP(float, WS_RSTD));
                        if (L == 0) GEMM_RS(WS_MEMB, WS_WKV, NB * NMEM, 4096, DM, WS_MEMKV, 4096, WSP(float, WS_RSTD) + 16384); } }
            END_PHASE();
            if (IN()) { MKFRAME(); for (int rep_ = 0, nrep_ = ((PROBE_REPEAT & 4) ? 2 : 1); rep_ < nrep_; ++rep_) { phase_attn_sb(p, F, L, WQ_(0)); } }
            END_PHASE();
            if (IN()) { MKFRAME(); for (int rep_ = 0, nrep_ = ((PROBE_REPEAT & 2) ? 2 : 1); rep_ < nrep_; ++rep_) { GEMM_RS(WS_OCAT, WS_WO, MTOK, DM, DM, WS_TMP, DM, (const float*)nullptr); } }
            END_PHASE();
            if (IN()) { MKFRAME(); for (int rep_ = 0, nrep_ = ((PROBE_REPEAT & 8) ? 2 : 1); rep_ < nrep_; ++rep_) { phase_resid(p, F, (L == 0) ? p.x : (const float*)p.out, p.norm_g + (size_t)(L * 5 + 1) * DM, LAST_() ? p.out : WSP(float, WS_ACT), LAST_() ? WSP(bf16_t, WS_XB) : WSP(bf16_t, WS_PROJ), LAST_() ? WSP(float, WS_RSTD) : WSP(float, WS_FP)); } }
            END_PHASE();
            if (IN()) { MKFRAME(); for (int rep_ = 0, nrep_ = ((PROBE_REPEAT & 2) ? 2 : 1); rep_ < nrep_; ++rep_) { GEMM_GU(L); } }
            END_PHASE();
            if (IN()) { MKFRAME(); for (int rep_ = 0, nrep_ = ((PROBE_REPEAT & 16) ? 2 : 1); rep_ < nrep_; ++rep_) { phase_convfix(p, F, L); } }
            END_PHASE();
            if (IN()) { MKFRAME(); for (int rep_ = 0, nrep_ = ((PROBE_REPEAT & 2) ? 2 : 1); rep_ < nrep_; ++rep_) { GEMM_RS(WS_ACT, WS_WD, MTOK, DM, DFF, WS_TMP, DM, (const float*)nullptr); } }
            END_PHASE();
            if (IN()) { MKFRAME(); for (int rep_ = 0, nrep_ = ((PROBE_REPEAT & 8) ? 2 : 1); rep_ < nrep_; ++rep_) { phase_resid(p, F, (const float*)p.out, p.norm_g + (size_t)(L * 5 + 3) * DM, LAST_() ? p.out : WSP(float, WS_ACT), LAST_() ? WSP(bf16_t, WS_XB) : WSP(bf16_t, WS_PROJ), LAST_() ? WSP(float, WS_RSTD) : WSP(float, WS_FP)); }  if (L + 1 < DEPTH) phase_convert(p, F, L + 1); }
            END_PHASE();
        }
        {
            const int L = 2 * lp + 1;
            if (IN()) { MKFRAME(); for (int rep_ = 0, nrep_ = ((PROBE_REPEAT & 2) ? 2 : 1); rep_ < nrep_; ++rep_) { { pg8::Gemm g{WSP(pg8::bf16_t, WS_XB), WSP(pg8::bf16_t, WS_WIN), MTOK, NSA_N, DM}; pg8::StaticOrder S; S.init(MTOK, NSA_N, F.G, F.bid); pg8::EpiRopeRS E{WSP(pg8::bf16_t, WS_PROJ), NSA_N, WSP(float, WS_RSTD), WSP(float, WS_COS), WSP(float, WS_SIN)}; pg8::gemm_phase<pg8::EpiRopeRS, pg8::StaticOrder, true, true>(F.lds, g, S, E); } } }
            END_PHASE();
            if (IN()) { MKFRAME(); for (int rep_ = 0, nrep_ = ((PROBE_REPEAT & 32) ? 2 : 1); rep_ < nrep_; ++rep_) {
                if (F.bid < 16) { const int wh = F.bid >> 3;
                    pg8::Gemm g{WSP(pg8::bf16_t, WS_PROJ) + (wh ? NVC : NKC), WSP(pg8::bf16_t, WS_CW1) + (size_t)wh * 256 * 4096, 2048, 256, 4096, 16 * NSA_N, 256u, (unsigned)(NSA_N * 2), (size_t)SEQ * NSA_N * 2};
                    pg8::StaticOrder S; S.init(2048, 256, F.G, F.bid & 7);
                    pg8::EpiCmpMlp E{WSP(float, WS_BIAS1) + wh * 256, WSP(pg8::bf16_t, WS_CW2) + (size_t)wh * 128 * 256, WSP(pg8::bf16_t, WS_KCMP) + (size_t)wh * 16 * 128 * 128};
                    pg8::gemm_phase<pg8::EpiCmpMlp, pg8::StaticOrder, false, true, true>(F.lds, g, S, E);
                }
                nsa_win_mem_units(p, F, L, WQ_(1)); } }
            END_PHASE();
            if (IN()) { MKFRAME(); for (int rep_ = 0, nrep_ = ((PROBE_REPEAT & 64) ? 2 : 1); rep_ < nrep_; ++rep_) { phase_attn_cmp(p, F); } }
            END_PHASE();
            if (IN()) { MKFRAME(); for (int rep_ = 0, nrep_ = ((PROBE_REPEAT & 128) ? 2 : 1); rep_ < nrep_; ++rep_) { phase_attn_sel(p, F, LAST_() ? WSP(bf16_t, WS_OCAT) : WSP(bf16_t, WS_TMP), WQ_(2)); } }
            END_PHASE();
            if (IN()) { MKFRAME(); for (int rep_ = 0, nrep_ = ((PROBE_REPEAT & 2) ? 2 : 1); rep_ < nrep_; ++rep_) { GEMM_RS(WS_OCAT, WS_WO, MTOK, DM, DM, WS_TMP, DM, (const float*)nullptr); } }
            END_PHASE();
            if (IN()) { MKFRAME(); for (int rep_ = 0, nrep_ = ((PROBE_REPEAT & 8) ? 2 : 1); rep_ < nrep_; ++rep_) { phase_resid(p, F, (const float*)p.out, p.norm_g + (size_t)(L * 5 + 1) * DM, LAST_() ? p.out : WSP(float, WS_ACT), LAST_() ? WSP(bf16_t, WS_XB) : WSP(bf16_t, WS_PROJ), LAST_() ? WSP(float, WS_RSTD) : WSP(float, WS_FP)); } }
            END_PHASE();
            if (IN()) { MKFRAME(); for (int rep_ = 0, nrep_ = ((PROBE_REPEAT & 2) ? 2 : 1); rep_ < nrep_; ++rep_) { GEMM_GU(L); } }
            END_PHASE();
            if (IN()) { MKFRAME(); for (int rep_ = 0, nrep_ = ((PROBE_REPEAT & 16) ? 2 : 1); rep_ < nrep_; ++rep_) { phase_convfix(p, F, L); } }
            END_PHASE();
            if (IN()) { MKFRAME(); for (int rep_ = 0, nrep_ = ((PROBE_REPEAT & 2) ? 2 : 1); rep_ < nrep_; ++rep_) { GEMM_RS(WS_ACT, WS_WD, MTOK, DM, DFF, WS_TMP, DM, (const float*)nullptr); } }
            END_PHASE();
            if (IN()) { MKFRAME(); for (int rep_ = 0, nrep_ = ((PROBE_REPEAT & 8) ? 2 : 1); rep_ < nrep_; ++rep_) { phase_resid(p, F, (const float*)p.out, p.norm_g + (size_t)(L * 5 + 3) * DM, LAST_() ? p.out : WSP(float, WS_ACT), LAST_() ? WSP(bf16_t, WS_XB) : WSP(bf16_t, WS_PROJ), LAST_() ? WSP(float, WS_RSTD) : WSP(float, WS_FP)); }  if (L + 1 < DEPTH) phase_convert(p, F, L + 1); }
            END_PHASE();
        }
    }
#undef IN
#undef END_PHASE
#undef GEMM_RS
#undef GEMM_GU
}

extern "C" void kernel_launch(void* const* d_in, const int* in_sizes, int n_in, void* d_out, int out_size, void* d_ws, size_t ws_size, hipStream_t stream) {
    static int grid = 0;
    if (grid == 0) {
        if (n_in != 16 || out_size != MTOK * DM || ws_size < WS_END) { fprintf(stderr, "kernel_launch: unexpected shapes (n_in %d, out %d, ws %zu < %zu)\n", n_in, out_size, ws_size, (size_t)WS_END); grid = -1; return; }
        int dev = 0, cus = 0, per_cu = 0;
        if (hipGetDevice(&dev) != hipSuccess || hipDeviceGetAttribute(&cus, hipDeviceAttributeMultiprocessorCount, dev) != hipSuccess) { grid = -1; return; }
        if (hipFuncSetAttribute((const void*)mk_fwd, hipFuncAttributeMaxDynamicSharedMemorySize, LDS_BYTES) != hipSuccess) { fprintf(stderr, "kernel_launch: hipFuncSetAttribute failed\n"); grid = -1; return; }
        if (hipOccupancyMaxActiveBlocksPerMultiprocessor(&per_cu, (const void*)mk_fwd, NTHR, LDS_BYTES) != hipSuccess || per_cu < 1) { fprintf(stderr, "kernel_launch: occupancy query says %d\n", per_cu); (void)hipGetLastError(); }
        grid = cus;
    }
    if (grid < 0) return;
    (void)hipMemsetAsync((char*)d_ws + WS_CTL, 0, CTL_ZERO_BYTES, stream);
    Params p{};
    p.x = (const float*)d_in[0]; p.mem = (const float*)d_in[1]; p.positions = (const int*)d_in[2]; p.norm_g = (const float*)d_in[3]; p.w_in_sb = (const float*)d_in[4]; p.w_in_nsa = (const float*)d_in[5];
    p.cmp_pe = (const float*)d_in[6]; p.cmp_w1 = (const float*)d_in[7]; p.cmp_w2 = (const float*)d_in[8]; p.w_mem_kv = (const float*)d_in[9]; p.w_o = (const float*)d_in[10];
    p.w_gate = (const float*)d_in[11]; p.w_up = (const float*)d_in[12]; p.conv_w = (const float*)d_in[13]; p.conv_b = (const float*)d_in[14]; p.w_down = (const float*)d_in[15];
    p.out = (float*)d_out; p.ws = (unsigned char*)d_ws;
#if MK_PER_PHASE
    for (int ph = 0; ph < NPH; ++ph) { p.ph_lo = ph; p.ph_hi = ph + 1; hipLaunchKernelGGL(mk_fwd, dim3(grid), dim3(NTHR), LDS_BYTES, stream, p); }
#else
    p.ph_lo = 0; p.ph_hi = NPH;
    hipLaunchKernelGGL(mk_fwd, dim3(grid), dim3(NTHR), LDS_BYTES, stream, p);
#endif
}
```

```cpp
#include <hip/hip_runtime.h>
#include <cstdio>
#include <cstdint>
namespace pg8 {
#define PG8_LAS __attribute__((address_space(3)))
typedef unsigned short bf16_t;
typedef short bf16x8 __attribute__((ext_vector_type(8)));
typedef float f32x4 __attribute__((ext_vector_type(4)));
typedef unsigned u32x4 __attribute__((ext_vector_type(4)));
constexpr int BM = 256, BK = 64, HALF = 128, HTB = HALF * BK * 2  , STAGE_BYTES = 8 * HTB, NXCD = 8, WGM = 8;

__host__ __device__ __forceinline__ int lds_byte(int r, int c) { const int st = (r >> 4) * 2 + (c >> 5), rr = r & 15, cc = c & 31, ob = rr * 64 + cc * 2; return st * 1024 + (ob ^ (((ob >> 9) & 1) << 5)); }
__host__ __device__ __forceinline__ void stage_rc(int b, int& R, int& C) { const int st = b / 1024, sb = b % 1024, swz = sb ^ (((sb >> 9) & 1) << 5); R = (st >> 1) * 16 + swz / 64; C = (st & 1) * 32 + (swz % 64) / 2; }
__host__ __device__ __forceinline__ int perm32(int rho) { const int n = rho >> 4, i = rho & 15; return 8 * (i >> 2) + 4 * n + (i & 3); }

struct Unit { int pm, pn; };
struct Gemm { const bf16_t* A; const bf16_t* Bt; int M, N, K; int lda; unsigned hstepA, kpairA; size_t tstepA; };

struct StaticOrder {
    int nM, nN, nwg, G, c;
    __host__ __device__ void init(int M, int N, int G_, int c_) { nM = M / BM; nN = N / BM; nwg = nM * nN; G = G_; c = c_; }
    __host__ __device__ bool next(int i, Unit& u) const {
        const long L = (long)i * G + c; if (L >= nwg) return false;
        int wgid = (int)L; { const int q = nwg / NXCD, r = nwg % NXCD, xcd = wgid % NXCD, off = wgid / NXCD; wgid = (xcd < r ? xcd * (q + 1) : r * (q + 1) + (xcd - r) * q) + off; }
        const int nig = WGM * nN, gid = wgid / nig, fm = gid * WGM, gsz = (nM - fm) < WGM ? (nM - fm) : WGM;
        u.pm = fm + ((wgid % nig) % gsz); u.pn = (wgid % nig) / gsz; return true;
    }
    __device__ __forceinline__ void a_ready(const Unit&) const {}
    __device__ __forceinline__ void done(const Unit&) const {}
};

__device__ __forceinline__ unsigned cvt_pk_bf16(float lo, float hi) { unsigned r; asm volatile("v_cvt_pk_bf16_f32 %0, %1, %2" : "=v"(r) : "v"(lo), "v"(hi)); return r; }
typedef float f32x2 __attribute__((ext_vector_type(2)));
struct EpiRS {
    static constexpr bool PERM = true, AFTER_DRAIN = false;
    bf16_t* O; int ldc; const float* rs;
    __device__ __forceinline__ void operator()(const f32x4 (&acc)[2][2][4][2], const Unit& u, int wr, int wc, int fr, int fq) const {
        const int row0 = u.pm * BM + wr * 64 + fr; const int col0 = u.pn * BM + wc * 32 + 8 * fq;
#pragma unroll
        for (int ai = 0; ai < 2; ++ai)
#pragma unroll
            for (int m = 0; m < 4; ++m) { const int row = row0 + ai * HALF + m * 16; const float sc = rs ? rs[row] : 1.f; bf16_t* rowp = O + (size_t)row * ldc + col0;
#pragma unroll
                for (int bj = 0; bj < 2; ++bj) { const f32x4 v0 = acc[ai][bj][m][0] * sc, v1 = acc[ai][bj][m][1] * sc;
                    u32x4 w; w.x = cvt_pk_bf16(v0[0], v0[1]); w.y = cvt_pk_bf16(v0[2], v0[3]); w.z = cvt_pk_bf16(v1[0], v1[1]); w.w = cvt_pk_bf16(v1[2], v1[3]);
                    *(u32x4*)(rowp + bj * HALF) = w; } }
    }
};
__device__ __forceinline__ float dpp_ror1(float v) { return __builtin_bit_cast(float, __builtin_amdgcn_update_dpp(0, __builtin_bit_cast(int, v), 0x121, 0xf, 0xf, false)); }
__device__ __forceinline__ float dpp_ror2(float v) { return __builtin_bit_cast(float, __builtin_amdgcn_update_dpp(0, __builtin_bit_cast(int, v), 0x122, 0xf, 0xf, false)); }
__device__ __forceinline__ float silu_fast(float x) { return x * __builtin_amdgcn_rcpf(1.f + __builtin_amdgcn_exp2f(-x * 1.4426950408889634f)); }
struct EpiConv {
    static constexpr bool PERM = true, AFTER_DRAIN = false;
    bf16_t* ACT; const float* rs; const float* cw; const float* cb; float* HG; float* FP; float* FU; PG8_LAS float* halo; int dff;
    __device__ __forceinline__ void operator()(const f32x4 (&acc)[2][2][4][2], const Unit& u, int wr, int wc, int fr, int fq) const {
        const int fl = wc * 32 + 8 * fq, f0 = u.pn * 128 + fl;
        f32x4 w0[2], w1[2], w2[2], bb[2];
#pragma unroll
        for (int n = 0; n < 2; ++n) { w0[n] = *(const f32x4*)(cw + f0 + 4 * n); w1[n] = *(const f32x4*)(cw + dff + f0 + 4 * n); w2[n] = *(const f32x4*)(cw + 2 * dff + f0 + 4 * n); bb[n] = *(const f32x4*)(cb + f0 + 4 * n); }
#pragma unroll
        for (int ai = 0; ai < 2; ++ai) { const float sc = rs[u.pm * BM + ai * HALF + wr * 64 + 48 + fr];
            if (fr >= 14) {
#pragma unroll
                for (int n = 0; n < 2; ++n) *(PG8_LAS f32x4*)(halo + ((ai * 2 + wr) * 2 + (fr - 14)) * 128 + fl + 4 * n) = acc[ai][0][3][n] * sc; } }
        asm volatile("s_waitcnt lgkmcnt(0)" ::: "memory"); __builtin_amdgcn_s_barrier(); asm volatile("" ::: "memory");
#pragma unroll
        for (int ai = 0; ai < 2; ++ai) {
            const int s = ai * 2 + wr;
            f32x4 a1p[2], a2p[2];
#pragma unroll
            for (int n = 0; n < 2; ++n) { f32x4 vp = {0.f, 0.f, 0.f, 0.f};
                if (s > 0 && fr >= 14) vp = *(const PG8_LAS f32x4*)(halo + ((s - 1) * 2 + (fr - 14)) * 128 + fl + 4 * n);
#pragma unroll
                for (int e = 0; e < 4; ++e) { a1p[n][e] = dpp_ror1(vp[e]); a2p[n][e] = dpp_ror2(vp[e]); } }
#pragma unroll
            for (int m = 0; m < 4; ++m) {
                const int row = u.pm * BM + ai * HALF + wr * 64 + m * 16 + fr; const float sc = rs[row];
                u32x4 wv; unsigned pk[4];
#pragma unroll
                for (int n = 0; n < 2; ++n) {
                    const f32x4 v = acc[ai][0][m][n] * sc, uu = acc[ai][1][m][n] * sc; f32x4 a1, a2, gc, ac;
#pragma unroll
                    for (int e = 0; e < 4; ++e) { a1[e] = dpp_ror1(v[e]); a2[e] = dpp_ror2(v[e]); }
#pragma unroll
                    for (int e = 0; e < 4; ++e) { const float p1 = (fr >= 1) ? a1[e] : a1p[n][e], p2 = (fr >= 2) ? a2[e] : a2p[n][e];
                        gc[e] = bb[n][e] + w0[n][e] * p2 + w1[n][e] * p1 + w2[n][e] * v[e];
                        ac[e] = silu_fast(gc[e]) * uu[e]; }
                    if (s == 0 && m == 0 && fr < 2) { *(f32x4*)(FP + (size_t)(u.pm * 2 + fr) * dff + f0 + 4 * n) = gc; *(f32x4*)(FU + (size_t)(u.pm * 2 + fr) * dff + f0 + 4 * n) = uu; }
                    if (s == 3 && m == 3 && fr >= 14) *(f32x4*)(HG + (size_t)(u.pm * 2 + fr - 14) * dff + f0 + 4 * n) = v;
                    pk[2 * n] = cvt_pk_bf16(ac[0], ac[1]); pk[2 * n + 1] = cvt_pk_bf16(ac[2], ac[3]);
                    a1p[n] = a1; a2p[n] = a2;
                }
                wv.x = pk[0]; wv.y = pk[1]; wv.z = pk[2]; wv.w = pk[3];
                *(u32x4*)(ACT + (size_t)row * dff + f0) = wv;
            }
        }
    }
};
struct EpiSiluBias {
    static constexpr bool PERM = true, AFTER_DRAIN = false;
    bf16_t* O; int ldc; const float* bias;
    __device__ __forceinline__ void operator()(const f32x4 (&acc)[2][2][4][2], const Unit& u, int wr, int wc, int fr, int fq) const {
        const int row0 = u.pm * BM + wr * 64 + fr; const int col0 = u.pn * BM + wc * 32 + 8 * fq;
        f32x4 bv[2][2];
#pragma unroll
        for (int bj = 0; bj < 2; ++bj)
#pragma unroll
            for (int n = 0; n < 2; ++n) bv[bj][n] = *(const f32x4*)(bias + col0 + bj * HALF + 4 * n);
#pragma unroll
        for (int ai = 0; ai < 2; ++ai)
#pragma unroll
            for (int m = 0; m < 4; ++m) { bf16_t* rowp = O + (size_t)(row0 + ai * HALF + m * 16) * ldc + col0;
#pragma unroll
                for (int bj = 0; bj < 2; ++bj) { f32x4 v0 = acc[ai][bj][m][0] + bv[bj][0], v1 = acc[ai][bj][m][1] + bv[bj][1];
#pragma unroll
                    for (int e = 0; e < 4; ++e) { v0[e] = v0[e] * __builtin_amdgcn_rcpf(1.f + __builtin_amdgcn_exp2f(-v0[e] * 1.4426950408889634f)); v1[e] = v1[e] * __builtin_amdgcn_rcpf(1.f + __builtin_amdgcn_exp2f(-v1[e] * 1.4426950408889634f)); }
                    u32x4 w; w.x = cvt_pk_bf16(v0[0], v0[1]); w.y = cvt_pk_bf16(v0[2], v0[3]); w.z = cvt_pk_bf16(v1[0], v1[1]); w.w = cvt_pk_bf16(v1[2], v1[3]);
                    *(u32x4*)(rowp + bj * HALF) = w; } }
    }
};
struct EpiCmpMlp {
    static constexpr bool PERM = true, AFTER_DRAIN = true;
    const float* bias; const bf16_t* w2t; bf16_t* OUT;
    __device__ __forceinline__ void fused(f32x4 (&acc)[2][2][4][2], const Unit& u, int wr, int wc, int fr, int fq, PG8_LAS unsigned char* lds, int wid, int lane) const {
        typedef float f32x16v __attribute__((ext_vector_type(16)));
        PG8_LAS bf16_t* hid = (PG8_LAS bf16_t*)lds;
        const int col0 = wc * 32 + 8 * fq;
#pragma unroll
        for (int bj = 0; bj < 2; ++bj) { const f32x4 b0 = *(const f32x4*)(bias + col0 + bj * HALF), b1 = *(const f32x4*)(bias + col0 + bj * HALF + 4);
#pragma unroll
            for (int ai = 0; ai < 2; ++ai)
#pragma unroll
                for (int m = 0; m < 4; ++m) { f32x4 v0 = acc[ai][bj][m][0] + b0, v1 = acc[ai][bj][m][1] + b1;
#pragma unroll
                    for (int e = 0; e < 4; ++e) { v0[e] = v0[e] * __builtin_amdgcn_rcpf(1.f + __builtin_amdgcn_exp2f(-v0[e] * 1.4426950408889634f)); v1[e] = v1[e] * __builtin_amdgcn_rcpf(1.f + __builtin_amdgcn_exp2f(-v1[e] * 1.4426950408889634f)); }
                    u32x4 w; w.x = cvt_pk_bf16(v0[0], v0[1]); w.y = cvt_pk_bf16(v0[2], v0[3]); w.z = cvt_pk_bf16(v1[0], v1[1]); w.w = cvt_pk_bf16(v1[2], v1[3]);
                    *(PG8_LAS u32x4*)(hid + (ai * HALF + wr * 64 + m * 16 + fr) * 264 + col0 + bj * HALF) = w; } }
        asm volatile("s_waitcnt lgkmcnt(0)" ::: "memory"); __builtin_amdgcn_s_barrier(); asm volatile("" ::: "memory");
        const int r32 = lane & 31, hi = lane >> 5, ct = wid & 3;
        const bf16_t* w2 = w2t + (size_t)(ct * 32 + r32) * 256;
#pragma unroll 1
        for (int k4 = 0; k4 < 4; ++k4) {
            const int rt = (wid >> 2) + 2 * k4;
            f32x16v a2 = (f32x16v){};
#pragma unroll
            for (int kk = 0; kk < 16; ++kk) { const int k = kk * 16 + hi * 8;
                a2 = __builtin_amdgcn_mfma_f32_32x32x16_bf16(*(const PG8_LAS bf16x8*)(hid + (rt * 32 + r32) * 264 + k), *(const bf16x8*)(w2 + k), a2, 0, 0, 0); }
#pragma unroll
            for (int r = 0; r < 16; ++r) { const int rl = rt * 32 + (r & 3) + 8 * (r >> 2) + 4 * hi; const int ro = u.pm * BM + rl;
                const float av_ = a2[r]; const unsigned ub = __float_as_uint(av_); const unsigned rb = (ub + 0x7fffu + ((ub >> 16) & 1u)) >> 16;
                OUT[(size_t)ro * 128 + ct * 32 + r32] = ((ro & 127) == 127) ? (bf16_t)0 : (bf16_t)rb; }
        }
        asm volatile("s_waitcnt lgkmcnt(0)" ::: "memory"); __builtin_amdgcn_s_barrier(); asm volatile("" ::: "memory");
    }
};
struct EpiRopeRS {
    static constexpr bool PERM = true, AFTER_DRAIN = false;
    bf16_t* O; int ldc; const float* rs; const float* cosT; const float* sinT;
    __device__ __forceinline__ void operator()(const f32x4 (&acc)[2][2][4][2], const Unit& u, int wr, int wc, int fr, int fq) const {
        const int row0 = u.pm * BM + wr * 64 + fr; const int col0 = u.pn * BM + wc * 32 + 8 * fq;
        const bool rope = (u.pn < 7) || (u.pn == 8) || (u.pn == 10);
        const int i0 = (wc * 32 + 8 * fq) >> 1;
#pragma unroll
        for (int ai = 0; ai < 2; ++ai)
#pragma unroll
            for (int m = 0; m < 4; ++m) { const int row = row0 + ai * HALF + m * 16; const float sc = rs[row]; bf16_t* rowp = O + (size_t)row * ldc + col0;
                f32x4 cv = {1.f, 1.f, 1.f, 1.f}, sv = {0.f, 0.f, 0.f, 0.f};
                if (rope) { cv = *(const f32x4*)(cosT + (size_t)row * 64 + i0); sv = *(const f32x4*)(sinT + (size_t)row * 64 + i0); }
#pragma unroll
                for (int bj = 0; bj < 2; ++bj) { const f32x4 x0 = acc[ai][bj][m][0] * sc, x1 = acc[ai][bj][m][1] * sc;
                    const f32x4 v0 = {x0[0] * cv[0] - x0[1] * sv[0], x0[1] * cv[0] + x0[0] * sv[0], x0[2] * cv[1] - x0[3] * sv[1], x0[3] * cv[1] + x0[2] * sv[1]};
                    const f32x4 v1 = {x1[0] * cv[2] - x1[1] * sv[2], x1[1] * cv[2] + x1[0] * sv[2], x1[2] * cv[3] - x1[3] * sv[3], x1[3] * cv[3] + x1[2] * sv[3]};
                    u32x4 w; w.x = cvt_pk_bf16(v0[0], v0[1]); w.y = cvt_pk_bf16(v0[2], v0[3]); w.z = cvt_pk_bf16(v1[0], v1[1]); w.w = cvt_pk_bf16(v1[2], v1[3]);
                    *(u32x4*)(rowp + bj * HALF) = w; } }
    }
};
template <class Epi, class Sched, bool ALIGN_EPI = false, bool SP2 = false, bool AGEN = false>
__device__ __forceinline__ void gemm_phase(PG8_LAS unsigned char* lds, const Gemm g, const Sched& S, const Epi& E) {
    int tid_ = threadIdx.x; asm volatile("" : "+v"(tid_));
    const int tid = tid_, wid = __builtin_amdgcn_readfirstlane(tid >> 6), lane = tid & 63, wr = wid >> 2, wc = wid & 3, fr = lane & 15, fq = lane >> 4;
    const int K = g.K, nt = K / BK;
    unsigned voffA[2], voffB[2];
#pragma unroll
    for (int i = 0; i < 2; ++i) { int R, C; stage_rc(tid * 16 + i * 8192, R, C); const int Rb = Epi::PERM ? ((R & ~31) + perm32(R & 31)) : R;
        voffA[i] = (unsigned)(R * (AGEN ? g.lda : K) + C) * 2u; voffB[i] = (unsigned)(Rb * K + C) * 2u; }
    const size_t kstep = (size_t)(BK * 2);
    const size_t hstep = (size_t)HALF * K * 2;
    const size_t tstep = 2 * hstep;
    const size_t hstepA = AGEN ? (size_t)g.hstepA : hstep, tstepA = AGEN ? g.tstepA : tstep, kpairA = AGEN ? (size_t)g.kpairA : 2 * kstep;
    const unsigned ldsw = (unsigned)wid * 1024u;
    const int aoff = lds_byte(wr * 64 + fr, fq * 8), boff = lds_byte(wc * 32 + fr, fq * 8);
#define PG8_SA(b, h) (((b) * 2 + (h)) * HTB)
#define PG8_SB(b, h) ((4 + (b) * 2 + (h)) * HTB)
#define PG8_STAGE(bufoff, gbase, voff) do { _Pragma("unroll") for (int _i = 0; _i < 2; ++_i) \
        __builtin_amdgcn_global_load_lds((const unsigned*)((const char*)(gbase) + (voff)[_i]), (PG8_LAS unsigned*)(lds + (bufoff) + ldsw + _i * 8192), 16, 0, 0); } while (0)
#define PG8_LDA(dst, b, h) do { _Pragma("unroll") for (int m = 0; m < 4; ++m) _Pragma("unroll") for (int k = 0; k < 2; ++k) dst[m][k] = *(const PG8_LAS bf16x8*)(lds + PG8_SA(b, h) + aoff + m * 2048 + k * 1024); } while (0)
#define PG8_LDB(dst, b, h) do { _Pragma("unroll") for (int n = 0; n < 2; ++n) _Pragma("unroll") for (int k = 0; k < 2; ++k) dst[n][k] = *(const PG8_LAS bf16x8*)(lds + PG8_SB(b, h) + boff + n * 2048 + k * 1024); } while (0)
#define PG8_MMA(ai, bj, At, Bt) do { __builtin_amdgcn_s_setprio(1); _Pragma("unroll") for (int m = 0; m < 4; ++m) _Pragma("unroll") for (int n = 0; n < 2; ++n) _Pragma("unroll") for (int k = 0; k < 2; ++k) \
        acc[ai][bj][m][n] = __builtin_amdgcn_mfma_f32_16x16x32_bf16(Bt[n][k], At[m][k], acc[ai][bj][m][n], 0, 0, 0); __builtin_amdgcn_s_setprio(0); } while (0)
#define PG8_WAIT_V(n) asm volatile("s_waitcnt vmcnt(" #n ")" ::: "memory")
#define PG8_WAIT_L(n) asm volatile("s_waitcnt lgkmcnt(" #n ")" ::: "memory")
#define PG8_BAR __builtin_amdgcn_s_barrier()
#define PG8_SCHED __builtin_amdgcn_sched_barrier(0)
    Unit cur, nxt; int ui = 0;
    if (!S.next(0, cur)) return;
    f32x4 acc[2][2][4][2];
#pragma unroll
    for (int a = 0; a < 2; ++a)
#pragma unroll
        for (int b = 0; b < 2; ++b)
#pragma unroll
            for (int m = 0; m < 4; ++m)
#pragma unroll
                for (int n = 0; n < 2; ++n) acc[a][b][m][n] = (f32x4){0.f, 0.f, 0.f, 0.f};
    bf16x8 At[4][2], B0[2][2], B1[2][2];
    const char* cA = (const char*)g.A + (size_t)cur.pm * tstepA; const char* cB = (const char*)g.Bt + (size_t)cur.pn * tstep;
    S.a_ready(cur);
    if constexpr (SP2) {
        PG8_STAGE(PG8_SB(0, 0), cB, voffB); PG8_STAGE(PG8_SB(0, 1), cB + hstep, voffB); PG8_STAGE(PG8_SA(0, 0), cA, voffA); PG8_STAGE(PG8_SA(0, 1), cA + hstepA, voffA);
        if (wr == 1) PG8_BAR;
        PG8_WAIT_V(2); PG8_BAR;
        PG8_STAGE(PG8_SB(1, 0), cB + kstep, voffB); PG8_STAGE(PG8_SA(1, 0), cA + kstep, voffA); PG8_STAGE(PG8_SB(1, 1), cB + hstep + kstep, voffB);
        PG8_WAIT_V(6); PG8_BAR;
    } else {
        PG8_STAGE(PG8_SB(0, 0), cB, voffB); PG8_STAGE(PG8_SA(0, 0), cA, voffA); PG8_STAGE(PG8_SB(0, 1), cB + hstep, voffB); PG8_STAGE(PG8_SA(0, 1), cA + hstepA, voffA);
        if (wr == 1) PG8_BAR;
        PG8_WAIT_V(4); PG8_BAR;
        PG8_STAGE(PG8_SB(1, 0), cB + kstep, voffB); PG8_STAGE(PG8_SA(1, 0), cA + kstep, voffA); PG8_STAGE(PG8_SB(1, 1), cB + hstep + kstep, voffB);
        PG8_WAIT_V(6); PG8_BAR;
    }
    for (;;) {
        const bool has_next = S.next(ui + 1, nxt);
        const char* nA = has_next ? (const char*)g.A + (size_t)nxt.pm * tstepA : cA; const char* nB = has_next ? (const char*)g.Bt + (size_t)nxt.pn * tstep : cB;
        for (int t = 0; t < nt; t += 2) {
            const bool last = (t == nt - 2);
            const char* a1 = cA + (size_t)(t >> 1) * kpairA + kstep;
            const char* a2 = last ? nA : cA + (size_t)((t >> 1) + 1) * kpairA; const char* b2 = last ? nB : cB + (size_t)(t + 2) * kstep;
            const char* a3 = a2 + kstep; const char* b3 = b2 + kstep;
            if (last && has_next) S.a_ready(nxt);
            if constexpr (SP2) {
            PG8_LDB(B0, 0, 0); PG8_LDB(B1, 0, 1); PG8_SCHED; PG8_LDA(At, 0, 0); PG8_STAGE(PG8_SA(1, 1), a1 + hstepA, voffA);
            PG8_WAIT_V(8); PG8_WAIT_L(0); PG8_BAR; PG8_MMA(0, 0, At, B0); PG8_MMA(0, 1, At, B1); PG8_BAR; PG8_SCHED;
            PG8_LDA(At, 0, 1); PG8_STAGE(PG8_SB(0, 0), b2, voffB); PG8_STAGE(PG8_SB(0, 1), b2 + hstep, voffB); PG8_STAGE(PG8_SA(0, 0), a2, voffA);
            PG8_WAIT_V(8); PG8_WAIT_L(0); PG8_BAR; PG8_MMA(1, 0, At, B0); PG8_MMA(1, 1, At, B1); PG8_BAR; PG8_SCHED;
            PG8_LDB(B0, 1, 0); PG8_LDB(B1, 1, 1); PG8_SCHED; PG8_LDA(At, 1, 0); PG8_STAGE(PG8_SA(0, 1), a2 + hstepA, voffA);
            PG8_WAIT_V(8); PG8_WAIT_L(0); PG8_BAR; PG8_MMA(0, 0, At, B0); PG8_MMA(0, 1, At, B1); PG8_BAR; PG8_SCHED;
            PG8_LDA(At, 1, 1); PG8_STAGE(PG8_SB(1, 0), b3, voffB); PG8_STAGE(PG8_SB(1, 1), b3 + hstep, voffB); PG8_STAGE(PG8_SA(1, 0), a3, voffA);
            PG8_WAIT_V(8); PG8_WAIT_L(0); PG8_BAR; PG8_MMA(1, 0, At, B0); PG8_MMA(1, 1, At, B1); PG8_BAR; PG8_SCHED;
            } else {
            PG8_LDB(B0, 0, 0); PG8_SCHED; PG8_LDA(At, 0, 0); PG8_STAGE(PG8_SA(1, 1), a1 + hstepA, voffA);
            PG8_WAIT_L(8); PG8_BAR; PG8_WAIT_L(0); PG8_MMA(0, 0, At, B0); PG8_BAR; PG8_SCHED;
            PG8_LDB(B1, 0, 1); PG8_STAGE(PG8_SB(0, 0), b2, voffB);
            PG8_BAR; PG8_WAIT_L(0); PG8_MMA(0, 1, At, B1); PG8_BAR;
            PG8_LDA(At, 0, 1); PG8_STAGE(PG8_SA(0, 0), a2, voffA);
            PG8_BAR; PG8_WAIT_L(0); PG8_MMA(1, 0, At, B0); PG8_BAR; PG8_SCHED;
            PG8_STAGE(PG8_SB(0, 1), b2 + hstep, voffB);
            PG8_WAIT_V(6); PG8_BAR; PG8_MMA(1, 1, At, B1); PG8_BAR;
            PG8_LDB(B0, 1, 0); PG8_SCHED; PG8_LDA(At, 1, 0); PG8_STAGE(PG8_SA(0, 1), a2 + hstepA, voffA);
            PG8_WAIT_L(8); PG8_BAR; PG8_WAIT_L(0); PG8_MMA(0, 0, At, B0); PG8_BAR; PG8_SCHED;
            PG8_LDB(B1, 1, 1); PG8_STAGE(PG8_SB(1, 0), b3, voffB);
            PG8_BAR; PG8_WAIT_L(0); PG8_MMA(0, 1, At, B1); PG8_BAR;
            PG8_LDA(At, 1, 1); PG8_STAGE(PG8_SA(1, 0), a3, voffA);
            PG8_BAR; PG8_WAIT_L(0); PG8_MMA(1, 0, At, B0); PG8_BAR; PG8_SCHED;
            PG8_STAGE(PG8_SB(1, 1), b3 + hstep, voffB);
            PG8_WAIT_V(6); PG8_BAR; PG8_MMA(1, 1, At, B1); PG8_BAR;
            }
        }
        if constexpr (ALIGN_EPI) { if (wr == 0) PG8_BAR; }
        if constexpr (!Epi::AFTER_DRAIN) { E(acc, cur, wr, wc, fr, fq); S.done(cur); }
        if (!has_next) break;
#pragma unroll
        for (int a = 0; a < 2; ++a)
#pragma unroll
            for (int b = 0; b < 2; ++b)
#pragma unroll
                for (int m = 0; m < 4; ++m)
#pragma unroll
                    for (int n = 0; n < 2; ++n) acc[a][b][m][n] = (f32x4){0.f, 0.f, 0.f, 0.f};
        cur = nxt; cA = nA; cB = nB; ++ui;
        if constexpr (ALIGN_EPI) { if (wr == 1) PG8_BAR; }
    }
    PG8_WAIT_V(0);
    if constexpr (!ALIGN_EPI) { if (wr == 0) PG8_BAR; }
    PG8_BAR;
    if constexpr (Epi::AFTER_DRAIN) { E.fused(acc, cur, wr, wc, fr, fq, lds, wid, lane); S.done(cur); }
#undef PG8_SA
#undef PG8_SB
#undef PG8_STAGE
#undef PG8_LDA
#undef PG8_LDB
#undef PG8_MMA
#undef PG8_WAIT_V
#undef PG8_WAIT_L
#undef PG8_BAR
#undef PG8_SCHED
}
}

#ifndef MK_PER_PHASE
#define MK_PER_PHASE 0
#endif
constexpr int NB = 8, SEQ = 2048, DM = 2048, MTOK = NB * SEQ, DEPTH = 4, HD = 128;
constexpr int NMIX = 12, NMEMH = 4, NMEM = 256, DFF = 5632, NGU = 2 * DFF, NGRP = 2, HPG = 6;
constexpr int SB_N = 5120, NSA_N = 3840, NSA_SRC = 3620;
constexpr int SBQ = 0, SBK = 1536, SBV = 3072, SBQM = 4608;
constexpr int NQ = 0, NKC = 1536, NVC = 1792, NKS = 2048, NVS = 2304, NKW = 2560, NVW = 2816, NQM = 3072, NGL = 3584;
constexpr int NCMP = 127, CMPROWS = NB * NGRP * NCMP;
constexpr int WINDOW = 512;
constexpr float NORM_EPS = 1e-6f;
constexpr float SCALE = 0.08838834764831845f;
constexpr float LOG2E = 1.4426950408889634f;
constexpr int NWAVES = 8, NTHR = 512;

constexpr size_t MiB = 1u << 20;
constexpr size_t WS_CTL = 0, CTL_ZERO_BYTES = 1 * MiB;
constexpr size_t WS_WIN = 2 * MiB;
constexpr size_t WS_WO = 22 * MiB;
constexpr size_t WS_WGU = 30 * MiB;
constexpr size_t WS_WD = 74 * MiB;
constexpr size_t WS_WKV = 96 * MiB;
constexpr size_t WS_CW1 = 112 * MiB;
constexpr size_t WS_CW2 = 116 * MiB;
constexpr size_t WS_MEMB = 117 * MiB;
constexpr size_t WS_MEMKV = 125 * MiB;
constexpr size_t WS_COS = 141 * MiB, WS_SIN = 145 * MiB;
constexpr size_t WS_RSTD = 149 * MiB;
constexpr size_t WS_SEL = 150 * MiB;
constexpr size_t WS_KCMP = 151 * MiB;
constexpr size_t WS_XB = 152 * MiB;
constexpr size_t WS_TMP = 216 * MiB;
constexpr size_t WS_ACT = 280 * MiB;
constexpr size_t WS_GU = 456 * MiB;
constexpr size_t WS_PROJ = 456 * MiB;
constexpr size_t WS_OCAT = 616 * MiB;
constexpr size_t WS_HG = 680 * MiB, WS_FP = 684 * MiB, WS_FU = 688 * MiB;
constexpr size_t WS_HID = 692 * MiB;
constexpr size_t WS_BIAS1 = 694 * MiB;
constexpr size_t WS_END = 808 * MiB;
constexpr int CW_BAR = 4096;

constexpr int RING_BYTES = 131072;
constexpr int LDSCTL_OFF = 143360, MISC_OFF = LDSCTL_OFF + 320;
constexpr int LDS_BYTES = 147456;
constexpr int HALO_OFF = RING_BYTES;
constexpr int SHM_T = 16384;
constexpr int A_V = 0, A_K = 2 * SHM_T, A_WS = 4 * SHM_T, A_FLAGS = A_WS + NWAVES * 64 * 4, A_STASH = 67584;

#define GAS __attribute__((address_space(1)))
#define LAS __attribute__((address_space(3)))
typedef unsigned short bf16_t;
typedef unsigned v4u __attribute__((ext_vector_type(4)));
typedef unsigned v2u __attribute__((ext_vector_type(2)));
typedef float f32x4 __attribute__((ext_vector_type(4)));
typedef float f32x16 __attribute__((ext_vector_type(16)));
typedef short bf16x8 __attribute__((ext_vector_type(8)));
typedef short s16x4 __attribute__((ext_vector_type(4)));
typedef GAS unsigned gu32;
#define RLX_AGENT __ATOMIC_RELAXED, __HIP_MEMORY_SCOPE_AGENT
#define LDS_WAIT() asm volatile("s_waitcnt lgkmcnt(0)" ::: "memory")
#define VM_WAIT() asm volatile("s_waitcnt vmcnt(0)" ::: "memory")
#define SBAR() __builtin_amdgcn_sched_barrier(0)
__device__ __forceinline__ unsigned cvtpk(float lo, float hi) { unsigned r; asm volatile("v_cvt_pk_bf16_f32 %0, %1, %2" : "=v"(r) : "v"(lo), "v"(hi)); return r; }
__device__ __forceinline__ float bf2f(unsigned short b) { return __uint_as_float((unsigned)b << 16); }
__device__ __forceinline__ float bflo(unsigned w) { return __uint_as_float(w << 16); }
__device__ __forceinline__ float bfhi(unsigned w) { return __uint_as_float(w & 0xffff0000u); }
__device__ __forceinline__ bf16x8 pack8(f32x4 a, f32x4 b) { v4u w = {cvtpk(a[0], a[1]), cvtpk(a[2], a[3]), cvtpk(b[0], b[1]), cvtpk(b[2], b[3])}; return __builtin_bit_cast(bf16x8, w); }
__device__ __forceinline__ void unpack8(bf16x8 v, f32x4& a, f32x4& b) { const v4u w = __builtin_bit_cast(v4u, v); a = (f32x4){bflo(w.x), bfhi(w.x), bflo(w.y), bfhi(w.y)}; b = (f32x4){bflo(w.z), bfhi(w.z), bflo(w.w), bfhi(w.w)}; }
__device__ __forceinline__ float wave_sum(float v) {
#pragma unroll
    for (int o = 1; o < 64; o <<= 1) v += __shfl_xor(v, o);
    return v;
}
__device__ __forceinline__ float sigmoidf_(float x) { return __builtin_amdgcn_rcpf(1.f + __builtin_amdgcn_exp2f(-x * LOG2E)); }

__device__ const float INV_FREQ[64] = {1.000000000e+00f, 8.659643531e-01f, 7.498942018e-01f, 6.493816376e-01f, 5.623413324e-01f, 4.869675338e-01f, 4.216965139e-01f, 3.651741147e-01f, 3.162277639e-01f, 2.738419771e-01f, 2.371373773e-01f, 2.053525001e-01f, 1.778279394e-01f, 1.539926529e-01f, 1.333521456e-01f, 1.154781953e-01f, 1.000000015e-01f, 8.659642935e-02f, 7.498942316e-02f, 6.493816525e-02f, 5.623413250e-02f, 4.869675264e-02f, 4.216964915e-02f, 3.651741147e-02f, 3.162277490e-02f, 2.738419548e-02f, 2.371373773e-02f, 2.053525113e-02f, 1.778279431e-02f, 1.539926510e-02f, 1.333521400e-02f, 1.154781971e-02f, 9.999999776e-03f, 8.659643121e-03f, 7.498942316e-03f, 6.493816152e-03f, 5.623413250e-03f, 4.869675264e-03f, 4.216964822e-03f, 3.651741194e-03f, 3.162277630e-03f, 2.738419687e-03f, 2.371373819e-03f, 2.053525066e-03f, 1.778279431e-03f, 1.539926510e-03f, 1.333521446e-03f, 1.154782018e-03f, 1.000000047e-03f, 8.659643354e-04f, 7.498941850e-04f, 6.493816036e-04f, 5.623413017e-04f, 4.869675322e-04f, 4.216965172e-04f, 3.651741135e-04f, 3.162277571e-04f, 2.738419571e-04f, 2.371373703e-04f, 2.053525095e-04f, 1.778279402e-04f, 1.539926598e-04f, 1.333521504e-04f, 1.154782003e-04f};
#define XB_TMO      128
#define XB_XCNT(j)  (256  + 64 * (j))
#define XB_XSUB(j)  (1280 + 64 * (j))
#define XB_XGEN(j)  (2304 + 64 * (j))
#define XB_TOP      3328
#define XB_TOPGEN   3392
#define XCD_BAR_WORDS 3456
#define XB_SPIN_CAP (1u << 18)

__device__ __forceinline__ unsigned xb_ld(unsigned* p)              { return __hip_atomic_load(p, __ATOMIC_RELAXED, __HIP_MEMORY_SCOPE_AGENT); }
__device__ __forceinline__ unsigned xb_add(unsigned* p, unsigned v) { return __hip_atomic_fetch_add(p, v, __ATOMIC_RELAXED, __HIP_MEMORY_SCOPE_AGENT); }
__device__ __forceinline__ unsigned xb_xcc_id() { return (unsigned)__builtin_amdgcn_s_getreg((3 << 11) | 20) & 0xFu; }
#define XB_SPIN(cond, bar) do { unsigned _sp = 0; while (cond) { __builtin_amdgcn_s_sleep(1); \
    if ((++_sp & 255u) == 0u) { if (xb_ld(&(bar)[XB_TMO])) break; if (_sp > XB_SPIN_CAP) { atomicAdd(&(bar)[XB_TMO], 1u); break; } } } } while (0)

struct XcdBarrier {
    unsigned* bar; unsigned x;
    volatile LAS unsigned* st;
};

__device__ __forceinline__ XcdBarrier xcd_barrier_post(unsigned* bar, volatile LAS unsigned* st) {
    XcdBarrier b; b.bar = bar; b.x = xb_xcc_id(); b.st = st;
    if (threadIdx.x == 0) (void)xb_add(&bar[XB_XCNT(b.x)], 1u);
    return b;
}
__device__ __forceinline__ void xcd_barrier_complete(unsigned* bar, unsigned x, unsigned& nloc, unsigned& nx) {
    const unsigned G = gridDim.x * gridDim.y * gridDim.z;
    unsigned sum, cnt, mine, sp = 0u;
    for (;;) {
        sum = 0u; cnt = 0u; mine = 0u;
#pragma unroll
        for (unsigned j = 0; j < 16; ++j) { const unsigned c = xb_ld(&bar[XB_XCNT(j)]); sum += c; cnt += (c > 0u) ? 1u : 0u; mine = (j == x) ? c : mine; }
        if (sum == G) break;
        __builtin_amdgcn_s_sleep(1);
        if ((++sp & 255u) == 0u) { if (xb_ld(&bar[XB_TMO])) break; if (sp > XB_SPIN_CAP) { atomicAdd(&bar[XB_TMO], 1u); break; } }
    }
    nloc = mine > 0u ? mine : 1u; nx = cnt > 0u ? cnt : 1u;
}

__device__ __forceinline__ void xcd_barrier(const XcdBarrier& b) {
    asm volatile("s_waitcnt vmcnt(0)" ::: "memory");
    __syncthreads();
    if (threadIdx.x == 0) {
        unsigned* bar = b.bar;
        __builtin_amdgcn_s_waitcnt(0);
        unsigned nloc = b.st[0], nx = b.st[1];
        if (nloc == 0u) { xcd_barrier_complete(bar, b.x, nloc, nx); b.st[0] = nloc; b.st[1] = nx; }
        const unsigned old = xb_add(&bar[XB_XSUB(b.x)], 1u);
        const unsigned gen = old / nloc;
        if (old + 1u == (gen + 1u) * nloc) {
            __builtin_amdgcn_fence(__ATOMIC_RELEASE, "agent");
            asm volatile("s_waitcnt vmcnt(0)" ::: "memory");
            const unsigned og = xb_add(&bar[XB_TOP], 1u);
            const unsigned tg = og / nx;
            if (og + 1u == (tg + 1u) * nx) xb_add(&bar[XB_TOPGEN], 1u);
            else XB_SPIN(xb_ld(&bar[XB_TOPGEN]) == tg, bar);
            __builtin_amdgcn_fence(__ATOMIC_ACQUIRE, "agent");
            xb_add(&bar[XB_XGEN(b.x)], 1u);
            asm volatile("s_waitcnt vmcnt(0)" ::: "memory");
        } else {
            XB_SPIN(xb_ld(&bar[XB_XGEN(b.x)]) == gen, bar);
            __builtin_amdgcn_fence(__ATOMIC_ACQUIRE, "agent");
            asm volatile("s_waitcnt vmcnt(0)" ::: "memory");
        }
    }
    __syncthreads();
}

#define KSWZ(row, colB) ((row) * 256 + ((colB) ^ (((row) & 7) << 4)))
__device__ __forceinline__ int v_st(int k, int c) { const int kk = (k & ~0xC) | ((k & 4) << 1) | ((k & 8) >> 1); return ((kk >> 3) * 4 + (c >> 5)) * 512 + ((kk & 7) * 32 + (c & 31)) * 2; }
__device__ __forceinline__ int v_rd_base(int lane) { return ((lane & 3) << 3) | (((lane >> 2) & 3) << 6) | (((lane >> 4) & 1) << 5) | (((lane >> 5) & 1) << 8); }
constexpr int v_rd_off(int d0, int ks, int half) { return d0 * 512 + ks * 4096 + half * 2048; }
__device__ __forceinline__ int crow(int r, int hi) { return (r & 3) + 8 * (r >> 2) + 4 * hi; }

struct ACtx {
    LAS unsigned char* lds;
    int tid, wid, lane, r32, hi, sr, sc, kws, vst0, vst1, vb0;
    LAS float* ws;
};
__device__ __forceinline__ ACtx make_actx(LAS unsigned char* lds) {
    ACtx c; c.lds = lds; { int t_ = threadIdx.x; asm volatile("" : "+v"(t_)); c.tid = t_; } c.wid = __builtin_amdgcn_readfirstlane(c.tid >> 6); c.lane = c.tid & 63; c.r32 = c.lane & 31; c.hi = c.lane >> 5;
    c.sr = c.tid >> 4; c.sc = (c.tid & 15) * 8; c.kws = KSWZ(c.sr, c.sc * 2); c.vst0 = v_st(c.sr, c.sc); c.vst1 = v_st(32 + c.sr, c.sc);
    c.vb0 = (int)(unsigned)(size_t)(lds + A_V) + v_rd_base(c.lane);
    c.ws = (LAS float*)(lds + A_WS) + c.wid * 64;
    return c;
}
struct Stage { bf16x8 k0, k1, v0, v1; };
__device__ __forceinline__ void stage_load(Stage& S, const bf16_t* Kp, const bf16_t* Vp, int pitch, int kb, const ACtx& c) {
    S.v0 = *(const bf16x8*)(Vp + (size_t)(kb + c.sr) * pitch + c.sc); S.v1 = *(const bf16x8*)(Vp + (size_t)(kb + 32 + c.sr) * pitch + c.sc);
    S.k0 = *(const bf16x8*)(Kp + (size_t)(kb + c.sr) * pitch + c.sc); S.k1 = *(const bf16x8*)(Kp + (size_t)(kb + 32 + c.sr) * pitch + c.sc);
}
__device__ __forceinline__ void stage_write(const Stage& S, int buf, const ACtx& c) {
    LAS unsigned char* Kb = c.lds + A_K + buf * SHM_T; LAS unsigned char* Vb = c.lds + A_V + buf * SHM_T;
    *(LAS bf16x8*)(Kb + c.kws) = S.k0; *(LAS bf16x8*)(Kb + c.kws + 32 * 256) = S.k1;
    *(LAS bf16x8*)(Vb + c.vst0) = S.v0; *(LAS bf16x8*)(Vb + c.vst1) = S.v1;
}
__device__ __forceinline__ void qkt(f32x16& p0, f32x16& p1, int buf, const ACtx& c, const bf16x8* qr) {
    p0 = (f32x16){}; p1 = (f32x16){};
    const LAS unsigned char* Kb = c.lds + A_K + buf * SHM_T;
    const LAS unsigned char* kb[4];
#pragma unroll
    for (int dd = 0; dd < 4; ++dd) kb[dd] = Kb + KSWZ(c.r32, (dd * 16 + c.hi * 8) * 2);
#pragma unroll
    for (int d0 = 0; d0 < 8; ++d0) { const LAS unsigned char* a = kb[d0 & 3] + (d0 >> 2) * 128;
        const bf16x8 b0 = *(const LAS bf16x8*)a; const bf16x8 b1 = *(const LAS bf16x8*)(a + 32 * 256);
        p0 = __builtin_amdgcn_mfma_f32_32x32x16_bf16(b0, qr[d0], p0, 0, 0, 0);
        p1 = __builtin_amdgcn_mfma_f32_32x32x16_bf16(b1, qr[d0], p1, 0, 0, 0); }
}
__device__ __forceinline__ void pv_tile(f32x16* o, int buf, const ACtx& c, bf16x8 pa0, bf16x8 pa1, bf16x8 pa2, bf16x8 pa3) {
    const int vb = c.vb0 + buf * SHM_T;
#define TRRD(dst, off) asm volatile("ds_read_b64_tr_b16 %0, %1 offset:%2" : "=&v"(dst) : "v"(vb), "i"(off) : "memory")
#define PV_D0(d0) do { s16x4 l0, l1, l2, l3, h0, h1, h2, h3; constexpr int b_ = v_rd_off(d0, 0, 0); \
        TRRD(l0, b_); TRRD(h0, b_ + 2048); TRRD(l1, b_ + 4096); TRRD(h1, b_ + 6144); TRRD(l2, b_ + 8192); TRRD(h2, b_ + 10240); TRRD(l3, b_ + 12288); TRRD(h3, b_ + 14336); \
        asm volatile("s_waitcnt lgkmcnt(0)" ::: "memory"); SBAR(); \
        o[d0] = __builtin_amdgcn_mfma_f32_32x32x16_bf16(pa0, (bf16x8){l0[0], l0[1], l0[2], l0[3], h0[0], h0[1], h0[2], h0[3]}, o[d0], 0, 0, 0); \
        o[d0] = __builtin_amdgcn_mfma_f32_32x32x16_bf16(pa1, (bf16x8){l1[0], l1[1], l1[2], l1[3], h1[0], h1[1], h1[2], h1[3]}, o[d0], 0, 0, 0); \
        o[d0] = __builtin_amdgcn_mfma_f32_32x32x16_bf16(pa2, (bf16x8){l2[0], l2[1], l2[2], l2[3], h2[0], h2[1], h2[2], h2[3]}, o[d0], 0, 0, 0); \
        o[d0] = __builtin_amdgcn_mfma_f32_32x32x16_bf16(pa3, (bf16x8){l3[0], l3[1], l3[2], l3[3], h3[0], h3[1], h3[2], h3[3]}, o[d0], 0, 0, 0); } while (0)
    PV_D0(0); PV_D0(1); PV_D0(2); PV_D0(3);
#undef PV_D0
#undef TRRD
}
__device__ __forceinline__ float swap_max(float v) { auto rr = __builtin_amdgcn_permlane32_swap(__float_as_uint(v), __float_as_uint(v), false, false); return fmaxf(__uint_as_float(rr[0]), __uint_as_float(rr[1])); }
__device__ __forceinline__ float swap_sum(float v) { auto rr = __builtin_amdgcn_permlane32_swap(__float_as_uint(v), __float_as_uint(v), false, false); return __uint_as_float(rr[0]) + __uint_as_float(rr[1]); }
__device__ __forceinline__ void swap_both(float v, float& lo, float& hi) { auto rr = __builtin_amdgcn_permlane32_swap(__float_as_uint(v), __float_as_uint(v), false, false); lo = __uint_as_float(rr[0]); hi = __uint_as_float(rr[1]); }
__device__ __forceinline__ void pack_p(const f32x16& p0, const f32x16& p1, bf16x8& pa0, bf16x8& pa1, bf16x8& pa2, bf16x8& pa3) {
#define PK4(P, B_, OUT) do { unsigned a0 = cvtpk(P[B_+0], P[B_+1]), a1 = cvtpk(P[B_+2], P[B_+3]); \
        unsigned b0 = cvtpk(P[B_+4], P[B_+5]), b1 = cvtpk(P[B_+6], P[B_+7]); \
        auto r0 = __builtin_amdgcn_permlane32_swap(a0, b0, false, false); auto r1 = __builtin_amdgcn_permlane32_swap(a1, b1, false, false); \
        v4u w = {r0[0], r1[0], r0[1], r1[1]}; OUT = __builtin_bit_cast(bf16x8, w); } while (0)
    PK4(p0, 0, pa0); PK4(p0, 8, pa1); PK4(p1, 0, pa2); PK4(p1, 8, pa3);
#undef PK4
}
__device__ __forceinline__ void mask_tile(f32x16& p0, f32x16& p1, int dq, unsigned W) {
    const float NEG = -__builtin_inff();
#pragma unroll
    for (int r = 0; r < 16; ++r) { const int cc = (r & 3) + 8 * (r >> 2);
        if ((unsigned)(dq - cc) >= W) p0[r] = NEG;
        if ((unsigned)(dq - cc - 32) >= W) p1[r] = NEG; }
}
constexpr float THR = 8.f;
__device__ __forceinline__ void softmax_tile(f32x16& p0, f32x16& p1, float& m_reg, float& l_reg, f32x16* o, const ACtx& c) {
    float pmax = p0[0];
#pragma unroll
    for (int r = 1; r < 16; ++r) pmax = fmaxf(pmax, p0[r]);
#pragma unroll
    for (int r = 0; r < 16; ++r) pmax = fmaxf(pmax, p1[r]);
    pmax = swap_max(pmax);
    constexpr float C2 = LOG2E * SCALE;
    float mn, alpha;
    if (__all((pmax - m_reg) * SCALE <= THR)) { mn = m_reg; alpha = 1.f; }
    else { mn = fmaxf(m_reg, pmax); alpha = __builtin_amdgcn_exp2f((m_reg - mn) * C2); m_reg = mn; }
    const float mnL = -mn * C2;
#pragma unroll
    for (int r = 0; r < 16; ++r) { p0[r] = __builtin_amdgcn_exp2f(fmaf(p0[r], C2, mnL)); p1[r] = __builtin_amdgcn_exp2f(fmaf(p1[r], C2, mnL)); }
    float ps = 0.f;
#pragma unroll
    for (int r = 0; r < 16; ++r) ps += p0[r] + p1[r];
    ps = swap_sum(ps);
    l_reg = l_reg * alpha + ps;
    if (__any(alpha < 1.f)) {
        if (c.hi == 0) c.ws[32 + c.r32] = alpha;
        LDS_WAIT();
#pragma unroll
        for (int r = 0; r < 16; ++r) { const float a = c.ws[32 + crow(r, c.hi)];
#pragma unroll
            for (int d = 0; d < 4; ++d) o[d][r] *= a; }
    }
}
__device__ __forceinline__ void row_factors(float f, float (&fr)[16], const ACtx& c) {
    LDS_WAIT();
    if (c.hi == 0) c.ws[c.r32] = f;
    LDS_WAIT();
#pragma unroll
    for (int r = 0; r < 16; ++r) fr[r] = c.ws[crow(r, c.hi)];
    LDS_WAIT();
}
template <bool ROPE>
__device__ __forceinline__ void load_q(bf16x8 (&qr)[8], const bf16_t* qrow, const float* cosr, const float* sinr, int hi) {
#pragma unroll
    for (int d0 = 0; d0 < 8; ++d0) qr[d0] = *(const bf16x8*)(qrow + d0 * 16 + hi * 8);
    if constexpr (ROPE) {
#pragma unroll
        for (int d0 = 0; d0 < 4; ++d0) {
            const int i0 = d0 * 16 + hi * 8;
            const f32x4 c0 = *(const f32x4*)(cosr + i0), c1 = *(const f32x4*)(cosr + i0 + 4), s0 = *(const f32x4*)(sinr + i0), s1 = *(const f32x4*)(sinr + i0 + 4);
            f32x4 a0, a1, b0, b1; unpack8(qr[d0], a0, a1); unpack8(qr[d0 + 4], b0, b1);
            qr[d0] = pack8(a0 * c0 - b0 * s0, a1 * c1 - b1 * s1);
            qr[d0 + 4] = pack8(b0 * c0 + a0 * s0, b1 * c1 + a1 * s1);
        }
    }
}
__device__ __forceinline__ void store_o_bf16(const f32x16* o, bf16_t* Ow  , int pitch, const ACtx& c) {
#pragma unroll
    for (int r = 0; r < 16; ++r) { const int orow = crow(r, c.hi);
#pragma unroll
        for (int d0 = 0; d0 < 4; ++d0) { const float v = o[d0][r]; const float vn = __shfl_xor(v, 1);
            if ((c.r32 & 1) == 0) *(unsigned*)(Ow + (size_t)orow * pitch + d0 * 32 + c.r32) = cvtpk(v, vn); } }
}

__device__ __forceinline__ void add_o_bf16(f32x16* o, const bf16_t* Ow, int pitch, const ACtx& c) {
#pragma unroll
    for (int r = 0; r < 16; ++r) { const int orow = crow(r, c.hi);
#pragma unroll
        for (int d0 = 0; d0 < 4; ++d0) o[d0][r] += bf2f(Ow[(size_t)orow * pitch + d0 * 32 + c.r32]); }
}
__device__ __forceinline__ int wq_next(gu32* ctr, LAS int* slot, int tid) {
    __syncthreads();
    if (tid == 0) *slot = (int)__hip_atomic_fetch_add(ctr, 1u, RLX_AGENT);
    __syncthreads();
    return *slot;
}
template <int MODE>
__device__ __forceinline__ void softmax_sweep(const ACtx& c, const bf16x8 (&qr)[8], f32x16 (&o)[4], float& l_out, const bf16_t* Kp, const bf16_t* Vp, int pitch,
                                              int j_lo, int j_hi, int qpos, int qlo, unsigned selbits) {
    float m_reg = -1e30f, l_reg = 0.f;
#pragma unroll
    for (int d = 0; d < 4; ++d) o[d] = (f32x16){};
    Stage S; stage_load(S, Kp, Vp, pitch, j_lo * 64, c);
    for (int j = j_lo; j < j_hi; ++j) {
        const int buf = (j - j_lo) & 1;
        stage_write(S, buf, c);
        __syncthreads();
        if (j + 1 < j_hi) stage_load(S, Kp, Vp, pitch, (j + 1) * 64, c);
        const int kb = j * 64;
        bool act = true;
        if (MODE == 1) act = (kb <= qlo + 31) && (kb + 63 >= qlo - (WINDOW - 1));
        if (MODE == 2) act = (kb <= qlo + 31) && __any((int)((selbits >> j) & 1u));
        if (act) {
            f32x16 p0, p1; qkt(p0, p1, buf, c, qr);
            if (MODE == 1) { if (kb + 63 > qlo || kb < qlo + 31 - (WINDOW - 1)) mask_tile(p0, p1, qpos - kb - 4 * c.hi, (unsigned)WINDOW); }
            if (MODE == 2) { if (kb + 63 > qlo) mask_tile(p0, p1, qpos - kb - 4 * c.hi, 0x7fffffffu);
                if (!__all((int)((selbits >> j) & 1u))) { if (!((selbits >> j) & 1u)) { const float NEG = -__builtin_inff();
#pragma unroll
                    for (int r = 0; r < 16; ++r) { p0[r] = NEG; p1[r] = NEG; } } } }
            softmax_tile(p0, p1, m_reg, l_reg, o, c);
            bf16x8 pa0, pa1, pa2, pa3; pack_p(p0, p1, pa0, pa1, pa2, pa3);
            pv_tile(o, buf, c, pa0, pa1, pa2, pa3);
        }
    }
    __syncthreads();
    l_out = l_reg;
}

struct Params {
    const float* x; const float* mem; const int* positions; const float* norm_g; const float* w_in_sb; const float* w_in_nsa; const float* cmp_pe; const float* cmp_w1; const float* cmp_w2;
    const float* w_mem_kv; const float* w_o; const float* w_gate; const float* w_up; const float* conv_w; const float* conv_b; const float* w_down;
    float* out; unsigned char* ws; int ph_lo, ph_hi;
};
struct Frame {
    LAS unsigned char* lds; int tid, lane, wave, G, bid;
};
#define WSP(T, off) ((T*)(p.ws + (off)))

__device__ __forceinline__ void tr_item(const float* W, int K, int Nsrc, int src_col0, int ncols, const float* gain, bf16_t* WT, int dst_row0, int mode, int item, int lane) {
    const int nblk = (ncols + 255) >> 8, kb = item / nblk, nb = item - kb * nblk, k0 = 16 * kb, n = nb * 256 + 4 * lane;
    if (n >= ncols) return;
    f32x4 v[16];
    if (W != nullptr) {
        const float* src = W + (size_t)k0 * Nsrc + src_col0 + n;
#pragma unroll
        for (int j = 0; j < 16; ++j) { const int kp = k0 + j, jj = kp & 127; const int ks = (mode & 4) ? (kp & ~127) + (jj >> 1) + 64 * (jj & 1) : kp;
            v[j] = *(const f32x4*)(W + (size_t)ks * Nsrc + src_col0 + n); }
        if (gain) {
#pragma unroll
            for (int j = 0; j < 16; ++j) v[j] = v[j] * gain[k0 + j];
        }
    } else {
#pragma unroll
        for (int j = 0; j < 16; ++j) v[j] = (f32x4){0.f, 0.f, 0.f, 0.f};
    }
#pragma unroll
    for (int e = 0; e < 4; ++e) {
        const int nn = n + e, dd = nn & 127; const int drow = dst_row0 + ((mode & 1) ? 256 * (nn >> 7) + dd : (mode & 2) ? (nn & ~127) + (dd < 64 ? 2 * dd : 2 * (dd - 64) + 1) : nn);
        v4u o0, o1;
        o0.x = cvtpk(v[0][e], v[1][e]); o0.y = cvtpk(v[2][e], v[3][e]); o0.z = cvtpk(v[4][e], v[5][e]); o0.w = cvtpk(v[6][e], v[7][e]);
        o1.x = cvtpk(v[8][e], v[9][e]); o1.y = cvtpk(v[10][e], v[11][e]); o1.z = cvtpk(v[12][e], v[13][e]); o1.w = cvtpk(v[14][e], v[15][e]);
        v4u* dst = (v4u*)(WT + (size_t)drow * K + k0); dst[0] = o0; dst[1] = o1;
    }
}
__device__ __forceinline__ void row_to_bf16_rstd(const float* xrow, bf16_t* orow, float* rstd_out, int lane) {
    const f32x4* xr = (const f32x4*)xrow + lane; f32x4 v[8]; float s = 0.f;
#pragma unroll
    for (int j = 0; j < 8; ++j) { v[j] = xr[64 * j]; s += (v[j].x * v[j].x + v[j].y * v[j].y) + (v[j].z * v[j].z + v[j].w * v[j].w); }
    s = wave_sum(s);
    v2u* o8 = (v2u*)orow + lane;
#pragma unroll
    for (int j = 0; j < 8; ++j) { v2u w; w.x = cvtpk(v[j].x, v[j].y); w.y = cvtpk(v[j].z, v[j].w); o8[64 * j] = w; }
    if (lane == 0) *rstd_out = 1.0f / sqrtf(s * (1.0f / DM) + NORM_EPS);
}
template <class PP> __device__ __forceinline__ void phase_convert(const PP& p, const Frame& F, int L) {
    const int gw = F.bid * NWAVES + F.wave, NGW = F.G * NWAVES;
    int it0 = gw;
#define TR(W, K, Nsrc, sc0, nc, gain, WT, dr0, mode) do { const int n_ = ((K) / 16) * (((nc) + 255) >> 8); for (; it0 < n_; it0 += NGW) tr_item(W, K, Nsrc, sc0, nc, gain, WT, dr0, mode, it0, F.lane); it0 -= n_; } while (0)
    const float* g = p.norm_g + (size_t)L * 5 * DM;
    const int j = L >> 1;
    bf16_t* WIN = WSP(bf16_t, WS_WIN);
    if ((L & 1) == 0) {
        TR(p.w_in_sb + (size_t)j * DM * SB_N, DM, SB_N, 0, SB_N, g, WIN, 0, 0);
    } else {
        const float* W = p.w_in_nsa + (size_t)j * DM * NSA_SRC;
        TR(W, DM, NSA_SRC, 0, 1536, g, WIN, NQ, 2);
        TR(W, DM, NSA_SRC, 1536, 256, g, WIN, NKC, 2);
        TR(W, DM, NSA_SRC, 1792, 256, g, WIN, NVC, 0);
        TR(W, DM, NSA_SRC, 2048, 256, g, WIN, NKS, 2);
        TR(W, DM, NSA_SRC, 2304, 256, g, WIN, NVS, 0);
        TR(W, DM, NSA_SRC, 2560, 256, g, WIN, NKW, 2);
        TR(W, DM, NSA_SRC, 2816, 256, g, WIN, NVW, 0);
        TR(W, DM, NSA_SRC, 3108, 512, g, WIN, NQM, 0);
        TR(W, DM, NSA_SRC, 3072, 36, g, WIN, NGL, 0);
        TR((const float*)nullptr, DM, NSA_SRC, 0, 220, (const float*)nullptr, WIN, NGL + 36, 0);
        for (int wh = 0; wh < 2; ++wh) {
            TR(p.cmp_w1 + (size_t)(j * 2 + wh) * 4096 * 256, 4096, 256, 0, 256, (const float*)nullptr, WSP(bf16_t, WS_CW1) + (size_t)wh * 256 * 4096, 0, wh == 0 ? 4 : 0);
            TR(p.cmp_w2 + (size_t)(j * 2 + wh) * 256 * 128, 256, 128, 0, 128, (const float*)nullptr, WSP(bf16_t, WS_CW2) + (size_t)wh * 128 * 256, 0, wh == 0 ? 2 : 0);
        }
    }
    if ((L & 1) && F.bid < 16) {
        const int wh = F.bid >> 3, n = 32 * (F.bid & 7) + (F.tid & 31), kg = F.tid >> 5;
        const float* pe = p.cmp_pe + (size_t)(j * 2 + wh) * 4096; const float* w1 = p.cmp_w1 + (size_t)(j * 2 + wh) * 4096 * 256;
        float s = 0.f;
        for (int k = kg * 256; k < kg * 256 + 256; ++k) s += pe[k] * w1[(size_t)k * 256 + n];
        LAS float* red = (LAS float*)F.lds;
        red[kg * 32 + (F.tid & 31)] = s;
        __syncthreads();
        if (F.tid < 32) { float t = 0.f;
#pragma unroll
            for (int q = 0; q < 16; ++q) t += red[q * 32 + F.tid];
            WSP(float, WS_BIAS1)[wh * 256 + n] = t; }
        __syncthreads();
    }
    TR(p.w_o + (size_t)L * DM * DM, DM, DM, 0, DM, (const float*)nullptr, WSP(bf16_t, WS_WO), 0, 0);
    TR(p.w_gate + (size_t)L * DM * DFF, DM, DFF, 0, DFF, g + 2 * DM, WSP(bf16_t, WS_WGU), 0, 1);
    TR(p.w_up + (size_t)L * DM * DFF, DM, DFF, 0, DFF, g + 2 * DM, WSP(bf16_t, WS_WGU), 128, 1);
    TR(p.w_down + (size_t)L * DFF * DM, DFF, DM, 0, DM, (const float*)nullptr, WSP(bf16_t, WS_WD), 0, 0);
    if (L == 0) {
        for (int l = 0; l < DEPTH; ++l)
            TR(p.w_mem_kv + (size_t)l * DM * 1024, DM, 1024, 0, 1024, p.norm_g + (size_t)(l * 5 + 4) * DM, WSP(bf16_t, WS_WKV), l * 1024, 0);
        float* rstd = WSP(float, WS_RSTD);
        for (int m = gw; m < MTOK; m += NGW) row_to_bf16_rstd(p.x + (size_t)m * DM, WSP(bf16_t, WS_XB) + (size_t)m * DM, rstd + m, F.lane);
        for (int m = gw; m < NB * NMEM; m += NGW) row_to_bf16_rstd(p.mem + (size_t)m * DM, WSP(bf16_t, WS_MEMB) + (size_t)m * DM, rstd + 16384 + m, F.lane);
        float* cosT = WSP(float, WS_COS); float* sinT = WSP(float, WS_SIN);
        for (int idx = F.bid * NTHR + F.tid; idx < MTOK * 64; idx += F.G * NTHR) {
            const int row = idx >> 6, i = idx & 63;
            const float ang = (float)p.positions[row] * INV_FREQ[i];
            double t = (double)ang * 0.15915494309189535; t -= __builtin_rint(t);
            const float fr = (float)t;
            cosT[idx] = __builtin_amdgcn_cosf(fr); sinT[idx] = __builtin_amdgcn_sinf(fr);
        }
    }
#undef TR
}

template <class PP> __device__ __forceinline__ void phase_resid(const PP& p, const Frame& F, const float* gpost, float* xout, const bf16_t* XBin, bf16_t* XB, float* rstd) {
    const int gw = F.bid * NWAVES + F.wave, NGW = F.G * NWAVES;
    const bf16_t* T = WSP(bf16_t, WS_TMP);
    for (int m = gw; m < MTOK; m += NGW) {
        const bf16x8* ar = (const bf16x8*)(T + (size_t)m * DM) + F.lane; const bf16x8* xr = (const bf16x8*)(XBin + (size_t)m * DM) + F.lane;
        f32x4 a[8], x[8]; float s = 0.f;
#pragma unroll
        for (int j = 0; j < 4; ++j) { unpack8(ar[64 * j], a[2 * j], a[2 * j + 1]); unpack8(xr[64 * j], x[2 * j], x[2 * j + 1]); }
#pragma unroll
        for (int j = 0; j < 8; ++j) s += (a[j].x * a[j].x + a[j].y * a[j].y) + (a[j].z * a[j].z + a[j].w * a[j].w);
        const float ra = 1.0f / sqrtf(wave_sum(s) * (1.0f / DM) + NORM_EPS);
        float s2 = 0.f;
#pragma unroll
        for (int j = 0; j < 4; ++j) {
            const int e0 = (j * 64 + F.lane) * 8;
#pragma unroll
            for (int h = 0; h < 2; ++h) {
                const f32x4 gv = *(const f32x4*)(gpost + e0 + 4 * h);
                const f32x4 y = x[2 * j + h] + a[2 * j + h] * ra * gv;
                a[2 * j + h] = y; s2 += (y.x * y.x + y.y * y.y) + (y.z * y.z + y.w * y.w);
                if (xout) *(f32x4*)(xout + (size_t)m * DM + e0 + 4 * h) = y;
            }
            *((bf16x8*)(XB + (size_t)m * DM) + 64 * j + F.lane) = pack8(a[2 * j], a[2 * j + 1]);
        }
        s2 = wave_sum(s2);
        if (F.lane == 0) rstd[m] = 1.0f / sqrtf(s2 * (1.0f / DM) + NORM_EPS);
    }
}
template <class PP> __device__ __forceinline__ void phase_convfix(const PP& p, const Frame& F, int L) {
    bf16_t* ACT = WSP(bf16_t, WS_ACT); const float* HG = WSP(float, WS_HG); const float* FP = WSP(float, WS_FP); const float* FU = WSP(float, WS_FU);
    const float* cw = p.conv_w + (size_t)L * 3 * DFF;
    constexpr int NCH = DFF / 4;
    for (int it = F.bid * NTHR + F.tid; it < 64 * 2 * NCH; it += F.G * NTHR) {
        const int pm = it / (2 * NCH), rem = it - pm * 2 * NCH, i = rem / NCH, f0 = (rem - i * NCH) * 4;
        if ((pm & 7) == 0) continue;
        const f32x4 h0 = *(const f32x4*)(HG + (size_t)((pm - 1) * 2 + 0) * DFF + f0), h1 = *(const f32x4*)(HG + (size_t)((pm - 1) * 2 + 1) * DFF + f0);
        const f32x4 w0 = *(const f32x4*)(cw + f0), w1 = *(const f32x4*)(cw + DFF + f0);
        f32x4 gc = *(const f32x4*)(FP + (size_t)(pm * 2 + i) * DFF + f0); const f32x4 uu = *(const f32x4*)(FU + (size_t)(pm * 2 + i) * DFF + f0);
        if (i == 0) gc += w0 * h0 + w1 * h1; else gc += w0 * h1;
        v2u o; o.x = cvtpk(gc[0] * sigmoidf_(gc[0]) * uu[0], gc[1] * sigmoidf_(gc[1]) * uu[1]); o.y = cvtpk(gc[2] * sigmoidf_(gc[2]) * uu[2], gc[3] * sigmoidf_(gc[3]) * uu[3]);
        *(v2u*)(ACT + (size_t)(pm * 256 + i) * DFF + f0) = o;
    }
}

template <class PP> __device__ __forceinline__ void sb_unit(const PP& p, const ACtx& c, int b, int h, int qt) {
    const bf16_t* PR = WSP(bf16_t, WS_PROJ); bf16_t* OC = WSP(bf16_t, WS_OCAT);
    const int P0 = qt * 256, qlo = P0 + c.wid * 32, qpos = qlo + c.r32;
    const size_t rowb = (size_t)b * SEQ;
    bf16x8 qr[8]; load_q<false>(qr, PR + (rowb + qpos) * SB_N + SBQ + h * HD, nullptr, nullptr, c.hi);
    const bf16_t* Kp = PR + rowb * SB_N + SBK + h * HD; const bf16_t* Vp = PR + rowb * SB_N + SBV + h * HD;
    f32x16 o[4];
#pragma unroll
    for (int d = 0; d < 4; ++d) o[d] = (f32x16){};
    float C2 = 0.f;
    const int jt = (P0 >> 6) + 3;
    LAS int* flags = (LAS int*)(c.lds + A_FLAGS);
    int done_w = 0;
    Stage S; stage_load(S, Kp, Vp, SB_N, jt * 64, c);
    constexpr float ZS = SCALE * LOG2E;
    for (int it = 0; it <= jt; ++it) {
        const int j = jt - it, buf = it & 1;
        stage_write(S, buf, c);
        if (c.lane == 0) flags[buf * 8 + c.wid] = done_w;
        __syncthreads();
        int alld = 1;
#pragma unroll
        for (int w = 0; w < 8; ++w) alld &= flags[buf * 8 + w];
        if (alld) break;
        if (j > 0) stage_load(S, Kp, Vp, SB_N, (j - 1) * 64, c);
        const int kb = j * 64;
        if (!done_w && kb <= qlo + 30) {
            f32x16 p0, p1; qkt(p0, p1, buf, c, qr);
            const int dq = qpos - kb - 4 * c.hi;
#pragma unroll
            for (int r = 0; r < 16; ++r) { const int cc = (r & 3) + 8 * (r >> 2);
                { const float z = p0[r] * ZS; const float t = __builtin_amdgcn_exp2f(-fabsf(z)); const float v = -(fmaxf(z, 0.f) + __builtin_amdgcn_logf(1.f + t)); p0[r] = (cc < dq) ? v : 0.f; }
                { const float z = p1[r] * ZS; const float t = __builtin_amdgcn_exp2f(-fabsf(z)); const float v = -(fmaxf(z, 0.f) + __builtin_amdgcn_logf(1.f + t)); p1[r] = (cc + 32 < dq) ? v : 0.f; } }
            float E[8], Od[8];
#pragma unroll
            for (int q = 0; q < 4; ++q) { const float g0 = (p0[4 * q] + p0[4 * q + 1]) + (p0[4 * q + 2] + p0[4 * q + 3]); swap_both(g0, E[q], Od[q]);
                                          const float g1 = (p1[4 * q] + p1[4 * q + 1]) + (p1[4 * q + 2] + p1[4 * q + 3]); swap_both(g1, E[4 + q], Od[4 + q]); }
            float T = 0.f, ex[8];
#pragma unroll
            for (int q = 7; q >= 0; --q) { const float to = T; T += Od[q]; const float te = T; T += E[q]; ex[q] = c.hi ? to : te; }
#pragma unroll
            for (int q = 0; q < 4; ++q) {
                { float R = C2 + ex[q]; float ep = __builtin_amdgcn_exp2f(R);
#pragma unroll
                  for (int i = 3; i >= 0; --i) { R += p0[4 * q + i]; const float e = __builtin_amdgcn_exp2f(R); p0[4 * q + i] = ep - e; ep = e; } }
                { float R = C2 + ex[4 + q]; float ep = __builtin_amdgcn_exp2f(R);
#pragma unroll
                  for (int i = 3; i >= 0; --i) { R += p1[4 * q + i]; const float e = __builtin_amdgcn_exp2f(R); p1[4 * q + i] = ep - e; ep = e; } }
            }
            C2 += T;
            bf16x8 pa0, pa1, pa2, pa3; pack_p(p0, p1, pa0, pa1, pa2, pa3);
            pv_tile(o, buf, c, pa0, pa1, pa2, pa3);
            done_w = __all(C2 < -72.f) ? 1 : 0;
        }
    }
    __syncthreads();
    store_o_bf16(o, OC + (rowb + qlo) * DM + h * HD, DM, c);
}
template <class PP> __device__ __forceinline__ void mem_unit(const PP& p, const ACtx& c, int L, int b, int hm, int qt, int projN, int qmcol) {
    const bf16_t* PR = WSP(bf16_t, WS_PROJ); bf16_t* OC = WSP(bf16_t, WS_OCAT); const bf16_t* MKV = WSP(bf16_t, WS_MEMKV);
    const int P0 = qt * 256, qlo = P0 + c.wid * 32, qpos = qlo + c.r32;
    const size_t rowb = (size_t)b * SEQ;
    bf16x8 qr[8]; load_q<false>(qr, PR + (rowb + qpos) * projN + qmcol + hm * HD, nullptr, nullptr, c.hi);
    const bf16_t* Kp = MKV + (size_t)b * NMEM * 4096 + L * 1024 + hm * HD; const bf16_t* Vp = Kp + 512;
    f32x16 o[4]; float l;
    softmax_sweep<0>(c, qr, o, l, Kp, Vp, 4096, 0, 4, qpos, qlo, 0u);
    float fr[16]; row_factors(1.0f / l, fr, c);
#pragma unroll
    for (int d = 0; d < 4; ++d)
#pragma unroll
        for (int r = 0; r < 16; ++r) o[d][r] *= fr[r];
    store_o_bf16(o, OC + (rowb + qlo) * DM + NMIX * HD + hm * HD, DM, c);
}
template <class PP> __device__ __forceinline__ void phase_attn_sb(const PP& p, const Frame& F, int L, gu32* ctr) {
    const ACtx c = make_actx(F.lds);
    LAS int* slot = (LAS int*)(F.lds + MISC_OFF) + 16;
    constexpr int NSBU = NB * NMIX * 8, NMU = NB * NMEMH * 8;
    for (;;) { const int u = wq_next(ctr, slot, c.tid); if (u >= NSBU + NMU) break;
        if (u < NSBU) { const int qt = 7 - (u / (NB * NMIX)), bh = u % (NB * NMIX); sb_unit(p, c, bh / NMIX, bh % NMIX, qt); }
        else { const int v = u - NSBU; const int qt = v % 8, bh = v / 8; mem_unit(p, c, L, bh / NMEMH, bh % NMEMH, qt, SB_N, SBQM); }
    }
}

template <class PP> __device__ __forceinline__ void phase_rope(const PP& p, const Frame& F) {
    bf16_t* PR = WSP(bf16_t, WS_PROJ); const float* cosT = WSP(float, WS_COS); const float* sinT = WSP(float, WS_SIN);
    const int lane = F.lane, gw = F.bid * NWAVES + F.wave, NGW = F.G * NWAVES;
    for (int m = gw; m < MTOK; m += NGW) {
        const float cv = cosT[(size_t)m * 64 + lane], sv = sinT[(size_t)m * 64 + lane];
        bf16_t* rowp = PR + (size_t)m * NSA_N;
        float x1[6], x2[6];
#pragma unroll
        for (int q = 0; q < 6; ++q) { const int base = ((q < 2) ? NKC : (q < 4) ? NKS : NKW) + (q & 1) * HD; x1[q] = bf2f(rowp[base + lane]); x2[q] = bf2f(rowp[base + 64 + lane]); }
#pragma unroll
        for (int q = 0; q < 6; ++q) { const int base = ((q < 2) ? NKC : (q < 4) ? NKS : NKW) + (q & 1) * HD;
            const float y1 = x1[q] * cv - x2[q] * sv, y2 = x2[q] * cv + x1[q] * sv;
            rowp[base + lane] = (bf16_t)(cvtpk(y1, y1) & 0xffffu); rowp[base + 64 + lane] = (bf16_t)(cvtpk(y2, y2) & 0xffffu); }
    }
}
template <class PP> __device__ __forceinline__ void phase_cmp_stage2(const PP& p, const Frame& F) {
    const int lane = F.lane, r32 = lane & 31, hi = lane >> 5;
    for (int u = F.bid; u < 128; u += F.G) {
        const int wh = u & 1, rt = u >> 1;
        if (F.wave < 4) {
            const bf16_t* hid = WSP(bf16_t, WS_HID) + (size_t)wh * 2048 * 256 + (size_t)(rt * 32 + r32) * 256;
            const bf16_t* w2 = WSP(bf16_t, WS_CW2) + (size_t)wh * 128 * 256 + (size_t)(F.wave * 32 + r32) * 256;
            f32x16 a2 = (f32x16){};
#pragma unroll
            for (int kk = 0; kk < 16; ++kk) { const int k = kk * 16 + hi * 8;
                a2 = __builtin_amdgcn_mfma_f32_32x32x16_bf16(*(const bf16x8*)(hid + k), *(const bf16x8*)(w2 + k), a2, 0, 0, 0); }
            bf16_t* outp = WSP(bf16_t, WS_KCMP) + (size_t)wh * 16 * 128 * 128;
#pragma unroll
            for (int r = 0; r < 16; ++r) { const int ro = rt * 32 + crow(r, hi);
                const float av_ = a2[r]; const unsigned ub = __float_as_uint(av_); const unsigned rb = (ub + 0x7fffu + ((ub >> 16) & 1u)) >> 16;
                outp[(size_t)ro * 128 + F.wave * 32 + r32] = ((ro & 127) == 127) ? (bf16_t)0 : (bf16_t)rb; }
        }
    }
}

template <class PP> __device__ __forceinline__ void cmp_unit(const PP& p, const ACtx& c, int b, int g, int qt) {
    const bf16_t* PR = WSP(bf16_t, WS_PROJ); bf16_t* OC = WSP(bf16_t, WS_OCAT); const float* cosT = WSP(float, WS_COS); const float* sinT = WSP(float, WS_SIN);
    const int P0 = qt * 256, qlo = P0 + c.wid * 32, qpos = qlo + c.r32, hi = c.hi;
    const size_t rowb = (size_t)b * SEQ, row = rowb + qpos;
    const bf16_t* Kp = WSP(bf16_t, WS_KCMP) + (size_t)(b * 2 + g) * 128 * 128; const bf16_t* Vp = Kp + (size_t)16 * 128 * 128;
    { Stage S; stage_load(S, Kp, Vp, 128, 0, c); stage_write(S, 0, c); stage_load(S, Kp, Vp, 128, 64, c); stage_write(S, 1, c); }
    __syncthreads();
    const int cmax = (qpos >= 31) ? (((qpos - 31) >> 4) < 126 ? ((qpos - 31) >> 4) : 126) : -1;
    LAS float* acc_l = (LAS float*)(c.lds + A_STASH) + c.wid * 2048 + c.lane;
    const float NEG = -__builtin_inff();
    constexpr float C2 = LOG2E * SCALE;
#pragma nounroll
    for (int hh = 0; hh < HPG; ++hh) {
        const int h = g * HPG + hh;
        bf16x8 qr[8]; load_q<false>(qr, PR + row * NSA_N + NQ + h * HD, nullptr, nullptr, hi);
        f32x16 pA0, pA1, pB0, pB1; qkt(pA0, pA1, 0, c, qr); qkt(pB0, pB1, 1, c, qr);
        float mx = NEG;
#pragma unroll
        for (int r = 0; r < 16; ++r) { const int ci = crow(r, hi);
            if (ci > cmax) pA0[r] = NEG; if (ci + 32 > cmax) pA1[r] = NEG; if (ci + 64 > cmax) pB0[r] = NEG; if (ci + 96 > cmax) pB1[r] = NEG;
            mx = fmaxf(fmaxf(mx, pA0[r]), fmaxf(pA1[r], fmaxf(pB0[r], pB1[r]))); }
        mx = swap_max(mx); if (mx == NEG) mx = 0.f;
        const float mL = -mx * C2; float ls = 0.f;
#pragma unroll
        for (int r = 0; r < 16; ++r) { pA0[r] = __builtin_amdgcn_exp2f(fmaf(pA0[r], C2, mL)); pA1[r] = __builtin_amdgcn_exp2f(fmaf(pA1[r], C2, mL));
            pB0[r] = __builtin_amdgcn_exp2f(fmaf(pB0[r], C2, mL)); pB1[r] = __builtin_amdgcn_exp2f(fmaf(pB1[r], C2, mL)); ls += (pA0[r] + pA1[r]) + (pB0[r] + pB1[r]); }
        ls = swap_sum(ls);
        const float inv = ls > 0.f ? 1.0f / ls : 0.f;
#pragma unroll
        for (int r = 0; r < 16; ++r) { pA0[r] *= inv; pA1[r] *= inv; pB0[r] *= inv; pB1[r] *= inv; }
#define ACC_AB(P, Q0) do { _Pragma("unroll") for (int q = 0; q < 4; ++q) { \
            const float a_ = 2.f * (P[4 * q] + P[4 * q + 1] + P[4 * q + 2]) + P[4 * q + 3], b_ = P[4 * q + 3]; \
            LAS float* pa_ = acc_l + (2 * (Q0 + q)) * 64; \
            if (hh == 0) { pa_[0] = a_; pa_[64] = b_; } else { pa_[0] += a_; pa_[64] += b_; } } } while (0)
        ACC_AB(pA0, 0); ACC_AB(pA1, 4); ACC_AB(pB0, 8); ACC_AB(pB1, 12);
#undef ACC_AB
        f32x16 o[4];
#pragma unroll
        for (int d = 0; d < 4; ++d) o[d] = (f32x16){};
        { bf16x8 pa0, pa1, pa2, pa3; pack_p(pA0, pA1, pa0, pa1, pa2, pa3); pv_tile(o, 0, c, pa0, pa1, pa2, pa3); }
        { bf16x8 pa0, pa1, pa2, pa3; pack_p(pB0, pB1, pa0, pa1, pa2, pa3); pv_tile(o, 1, c, pa0, pa1, pa2, pa3); }
        const float gc = sigmoidf_(bf2f(PR[row * NSA_N + NGL + h * 3 + 0]));
        float fr[16]; row_factors(gc, fr, c);
#pragma unroll
        for (int d = 0; d < 4; ++d)
#pragma unroll
            for (int r = 0; r < 16; ++r) o[d][r] *= fr[r];
        add_o_bf16(o, OC + (rowb + qlo) * DM + h * HD, DM, c);
        store_o_bf16(o, OC + (rowb + qlo) * DM + h * HD, DM, c);
    }
    float Ie[16], Io[16];
    {
        float imp[16], Bb[16];
#pragma unroll
        for (int q = 0; q < 16; ++q) { float blo, bhi; swap_both(acc_l[(2 * q + 1) * 64], blo, bhi); Bb[q] = hi ? blo : bhi; }
#pragma unroll
        for (int q = 0; q < 16; ++q) imp[q] = acc_l[(2 * q) * 64] + (hi ? Bb[q] : (q > 0 ? Bb[q - 1] : 0.f));
#pragma unroll
        for (int q = 0; q < 16; ++q) swap_both(imp[q], Ie[q], Io[q]);
    }
    const int cur = qpos >> 6;
    unsigned bits;
    if (cur < 16) bits = (2u << cur) - 1u;
    else {
#pragma unroll
        for (int q = 0; q < 16; ++q) { const int je = 2 * q, jo = 2 * q + 1;
            if (!(je >= 1 && je <= cur - 2)) Ie[q] = -1.f; if (!(jo >= 1 && jo <= cur - 2)) Io[q] = -1.f; }
        bits = 0u;
#pragma unroll
        for (int q = 0; q < 16; ++q) {
            const int jm = 2 * q + hi; const float vj = hi ? Io[q] : Ie[q];
            int rank = 0;
#pragma unroll
            for (int q2 = 0; q2 < 16; ++q2) {
                const bool lt_e = (q2 < q) || (q2 == q && hi);
                const bool lt_o = (q2 < q);
                rank += (Ie[q2] > vj || (Ie[q2] == vj && lt_e)) ? 1 : 0;
                rank += (Io[q2] > vj || (Io[q2] == vj && lt_o)) ? 1 : 0;
            }
            const bool forced = (jm == 0) || (jm == cur) || (jm == cur - 1);
            const bool sel = forced || (vj >= 0.f && rank < 13);
            bits |= sel ? (1u << jm) : 0u;
        }
        { auto rr = __builtin_amdgcn_permlane32_swap(bits, bits, false, false); bits = rr[0] | rr[1]; }
    }
    if (hi == 0) WSP(unsigned, WS_SEL)[(size_t)(b * 2 + g) * SEQ + qpos] = bits;
    __syncthreads();
}
template <class PP> __device__ __forceinline__ void phase_attn_cmp(const PP& p, const Frame& F) {
    const ACtx c = make_actx(F.lds);
    constexpr int NCU = NB * NGRP * 8;
    for (int u = F.bid; u < NCU; u += F.G) { const int qt = 7 - (u % 8), bg = u / 8; cmp_unit(p, c, bg >> 1, bg & 1, qt); }
}
template <class PP> __device__ __forceinline__ void win_unit(const PP& p, const ACtx& c, int b, int h, int qt) {
    const bf16_t* PR = WSP(bf16_t, WS_PROJ); bf16_t* OC = WSP(bf16_t, WS_OCAT); const float* cosT = WSP(float, WS_COS); const float* sinT = WSP(float, WS_SIN);
    const int P0 = qt * 256, qlo = P0 + c.wid * 32, qpos = qlo + c.r32, g = h / HPG;
    const size_t rowb = (size_t)b * SEQ, row = rowb + qpos;
    bf16x8 qr[8]; load_q<false>(qr, PR + row * NSA_N + NQ + h * HD, nullptr, nullptr, c.hi);
    const float gwn = sigmoidf_(bf2f(PR[row * NSA_N + NGL + h * 3 + 2]));
    f32x16 o[4]; float l;
    const int jlo = (P0 - (WINDOW - 1)) > 0 ? ((P0 - (WINDOW - 1)) >> 6) : 0;
    softmax_sweep<1>(c, qr, o, l, PR + rowb * NSA_N + NKW + g * HD, PR + rowb * NSA_N + NVW + g * HD, NSA_N, jlo, (P0 >> 6) + 4, qpos, qlo, 0u);
    float fr[16]; row_factors(l > 0.f ? gwn / l : 0.f, fr, c);
#pragma unroll
    for (int d = 0; d < 4; ++d)
#pragma unroll
        for (int r = 0; r < 16; ++r) o[d][r] *= fr[r];
    store_o_bf16(o, OC + (rowb + qlo) * DM + h * HD, DM, c);
}
template <class PP> __device__ __forceinline__ void nsa_win_mem_units(const PP& p, const Frame& F, int L, gu32* ctr) {
    const ACtx c = make_actx(F.lds);
    LAS int* slot = (LAS int*)(F.lds + MISC_OFF) + 16;
    constexpr int NWU = NB * NMIX * 8, NMU = NB * NMEMH * 8;
    for (;;) { const int u = wq_next(ctr, slot, c.tid); if (u >= NWU + NMU) break;
        if (u < NWU) { const int qt = 7 - (u / (NB * NMIX)), bh = u % (NB * NMIX); win_unit(p, c, bh / NMIX, bh % NMIX, qt); }
        else { const int v = u - NWU; const int qt = v % 8, bh = v / 8; mem_unit(p, c, L, bh / NMEMH, bh % NMEMH, qt, NSA_N, NQM); }
    }
}
template <class PP> __device__ __forceinline__ void sel_unit(const PP& p, const ACtx& c, int b, int h, int qt, bf16_t* OUT) {
    const bf16_t* PR = WSP(bf16_t, WS_PROJ); const bf16_t* OC = WSP(bf16_t, WS_OCAT); const float* cosT = WSP(float, WS_COS); const float* sinT = WSP(float, WS_SIN);
    const int P0 = qt * 256, qlo = P0 + c.wid * 32, qpos = qlo + c.r32, g = h / HPG;
    const size_t rowb = (size_t)b * SEQ, row = rowb + qpos;
    bf16x8 qr[8]; load_q<false>(qr, PR + row * NSA_N + NQ + h * HD, nullptr, nullptr, c.hi);
    const unsigned selbits = WSP(unsigned, WS_SEL)[(size_t)(b * 2 + g) * SEQ + qpos];
    const float gs = sigmoidf_(bf2f(PR[row * NSA_N + NGL + h * 3 + 1]));
    f32x16 o[4]; float l;
    softmax_sweep<2>(c, qr, o, l, PR + rowb * NSA_N + NKS + g * HD, PR + rowb * NSA_N + NVS + g * HD, NSA_N, 0, (P0 >> 6) + 4, qpos, qlo, selbits);
    float fr[16]; row_factors(l > 0.f ? gs / l : 0.f, fr, c);
#pragma unroll
    for (int d = 0; d < 4; ++d)
#pragma unroll
        for (int r = 0; r < 16; ++r) o[d][r] *= fr[r];
    add_o_bf16(o, OC + (rowb + qlo) * DM + h * HD, DM, c);
    store_o_bf16(o, OUT + (rowb + qlo) * DM + h * HD, DM, c);
}
template <class PP> __device__ __forceinline__ void phase_attn_sel(const PP& p, const Frame& F, bf16_t* OUT, gu32* ctr) {
    const ACtx c = make_actx(F.lds);
    LAS int* slot = (LAS int*)(F.lds + MISC_OFF) + 16;
    constexpr int NU = NB * NMIX * 8;
    for (;;) { const int u = wq_next(ctr, slot, c.tid); if (u >= NU) break;
        const int qt = 7 - (u / (NB * NMIX)), bh = u % (NB * NMIX); sel_unit(p, c, bh / NMIX, bh % NMIX, qt, OUT); }
}

#define LAST_() (rep_ == nrep_ - 1)
#define WQ_(k) ((gu32*)(p.ws + WS_CTL) + 64 * (8 + ((lp * 3 + (k)) * 2 + rep_)))
#ifndef PROBE_REPEAT
#define PROBE_REPEAT 0
#endif
constexpr int NPH = 48;
__global__ void __launch_bounds__(NTHR, 2) mk_fwd(Params p) {
    extern __shared__ __attribute__((aligned(16))) unsigned char lds_raw[];
    LAS unsigned char* const lds0 = (LAS unsigned char*)lds_raw;
typedef const Params __attribute__((address_space(4))) KParams;
#define MKFRAME() KParams* pp_ = (KParams*)__builtin_amdgcn_kernarg_segment_ptr(); asm volatile("" : "+s"(pp_)); KParams& p = *pp_; Frame F; F.lds = lds0; { int t_ = threadIdx.x; asm volatile("" : "+v"(t_)); F.tid = t_; } F.lane = F.tid & 63; F.wave = __builtin_amdgcn_readfirstlane(F.tid >> 6); F.G = gridDim.x; F.bid = blockIdx.x
    for (int u = threadIdx.x; u < (LDS_BYTES - LDSCTL_OFF) / 4; u += NTHR) ((LAS unsigned*)(lds0 + LDSCTL_OFF))[u] = 0u;
    __syncthreads();
    gu32* ctl = (gu32*)(p.ws + WS_CTL);
    XcdBarrier bar; bar.bar = (unsigned*)(ctl + CW_BAR); bar.x = 0; bar.st = nullptr;
#if !MK_PER_PHASE
    bar = xcd_barrier_post((unsigned*)(ctl + CW_BAR), (volatile LAS unsigned*)(lds0 + MISC_OFF) + 8);
#endif
    const int lo = p.ph_lo, hi = p.ph_hi;
    int ph = 0;
#define IN() (lo <= ph && ph < hi)
#if MK_PER_PHASE
#define END_PHASE() do { ++ph; } while (0)
#else
#define END_PHASE() do { if (IN() && ph + 1 < hi) { xcd_barrier(bar); if (PROBE_REPEAT & 256) xcd_barrier(bar); } ++ph; } while (0)
#endif
#define GEMM_RS(Aoff, Boff, M_, N_, K_, Ooff, ldc_, rs_) do { pg8::Gemm g{WSP(pg8::bf16_t, Aoff), WSP(pg8::bf16_t, Boff), M_, N_, K_}; pg8::StaticOrder S; S.init(M_, N_, F.G, F.bid); \
        pg8::EpiRS E{WSP(pg8::bf16_t, Ooff), ldc_, rs_}; pg8::gemm_phase<pg8::EpiRS, pg8::StaticOrder, true, true>(F.lds, g, S, E); } while (0)

#define GEMM_GU(L_) do { pg8::Gemm g{WSP(pg8::bf16_t, WS_XB), WSP(pg8::bf16_t, WS_WGU), MTOK, NGU, DM}; pg8::StaticOrder S; S.init(MTOK, NGU, F.G, F.bid); \
        pg8::EpiConv E{WSP(pg8::bf16_t, WS_ACT), WSP(float, WS_RSTD), p.conv_w + (size_t)(L_) * 3 * DFF, p.conv_b + (size_t)(L_) * DFF, WSP(float, WS_HG), WSP(float, WS_FP), WSP(float, WS_FU), (LAS float*)(F.lds + HALO_OFF), DFF}; \
        pg8::gemm_phase<pg8::EpiConv, pg8::StaticOrder, true, true>(F.lds, g, S, E); } while (0)

    for (int lp = 0; lp < 2; ++lp) {
        {
            const int L = 2 * lp;
            if (lp == 0) { if (IN()) { MKFRAME(); for (int rep_ = 0, nrep_ = ((PROBE_REPEAT & 1) ? 2 : 1); rep_ < nrep_; ++rep_) { phase_convert(p, F, L); } }
            END_PHASE(); }
            if (IN()) { MKFRAME(); for (int rep_ = 0, nrep_ = ((PROBE_REPEAT & 2) ? 2 : 1); rep_ < nrep_; ++rep_) { GEMM_RS(WS_XB, WS_WIN, MTOK, SB_N, DM, WS_PROJ, SB_N, WSP(float, WS_RSTD));
                        if (L == 0) GEMM_RS(WS_MEMB, WS_WKV, NB * NMEM, 4096, DM, WS_MEMKV, 4096, WSP(float, WS_RSTD) + 16384); } }
            END_PHASE();
            if (IN()) { MKFRAME(); for (int rep_ = 0, nrep_ = ((PROBE_REPEAT & 4) ? 2 : 1); rep_ < nrep_; ++rep_) { phase_attn_sb(p, F, L, WQ_(0)); } }
            END_PHASE();
            if (IN()) { MKFRAME(); for (int rep_ = 0, nrep_ = ((PROBE_REPEAT & 2) ? 2 : 1); rep_ < nrep_; ++rep_) { GEMM_RS(WS_OCAT, WS_WO, MTOK, DM, DM, WS_TMP, DM, (const float*)nullptr); } }
            END_PHASE();
            if (IN()) { MKFRAME(); for (int rep_ = 0, nrep_ = ((PROBE_REPEAT & 8) ? 2 : 1); rep_ < nrep_; ++rep_) { phase_resid(p, F, p.norm_g + (size_t)(L * 5 + 1) * DM, (LAST_() && false) ? p.out : (float*)nullptr, WSP(bf16_t, WS_XB), LAST_() ? WSP(bf16_t, WS_XB) : WSP(bf16_t, WS_PROJ), LAST_() ? WSP(float, WS_RSTD) : WSP(float, WS_FP)); } }
            END_PHASE();
            if (IN()) { MKFRAME(); for (int rep_ = 0, nrep_ = ((PROBE_REPEAT & 2) ? 2 : 1); rep_ < nrep_; ++rep_) { GEMM_GU(L); } }
            END_PHASE();
            if (IN()) { MKFRAME(); for (int rep_ = 0, nrep_ = ((PROBE_REPEAT & 16) ? 2 : 1); rep_ < nrep_; ++rep_) { phase_convfix(p, F, L); } }
            END_PHASE();
            if (IN()) { MKFRAME(); for (int rep_ = 0, nrep_ = ((PROBE_REPEAT & 2) ? 2 : 1); rep_ < nrep_; ++rep_) { GEMM_RS(WS_ACT, WS_WD, MTOK, DM, DFF, WS_TMP, DM, (const float*)nullptr); } }
            END_PHASE();
            if (IN()) { MKFRAME(); for (int rep_ = 0, nrep_ = ((PROBE_REPEAT & 8) ? 2 : 1); rep_ < nrep_; ++rep_) { phase_resid(p, F, p.norm_g + (size_t)(L * 5 + 3) * DM, (LAST_() && L == DEPTH - 1) ? p.out : (float*)nullptr, WSP(bf16_t, WS_XB), LAST_() ? WSP(bf16_t, WS_XB) : WSP(bf16_t, WS_PROJ), LAST_() ? WSP(float, WS_RSTD) : WSP(float, WS_FP)); }  if (L + 1 < DEPTH) phase_convert(p, F, L + 1); }
            END_PHASE();
        }
        {
            const int L = 2 * lp + 1;
            if (IN()) { MKFRAME(); for (int rep_ = 0, nrep_ = ((PROBE_REPEAT & 2) ? 2 : 1); rep_ < nrep_; ++rep_) { { pg8::Gemm g{WSP(pg8::bf16_t, WS_XB), WSP(pg8::bf16_t, WS_WIN), MTOK, NSA_N, DM}; pg8::StaticOrder S; S.init(MTOK, NSA_N, F.G, F.bid); pg8::EpiRopeRS E{WSP(pg8::bf16_t, WS_PROJ), NSA_N, WSP(float, WS_RSTD), WSP(float, WS_COS), WSP(float, WS_SIN)}; pg8::gemm_phase<pg8::EpiRopeRS, pg8::StaticOrder, true, true>(F.lds, g, S, E); } } }
            END_PHASE();
            if (IN()) { MKFRAME(); for (int rep_ = 0, nrep_ = ((PROBE_REPEAT & 32) ? 2 : 1); rep_ < nrep_; ++rep_) {
                if (F.bid < 16) { const int wh = F.bid >> 3;
                    pg8::Gemm g{WSP(pg8::bf16_t, WS_PROJ) + (wh ? NVC : NKC), WSP(pg8::bf16_t, WS_CW1) + (size_t)wh * 256 * 4096, 2048, 256, 4096, 16 * NSA_N, 256u, (unsigned)(NSA_N * 2), (size_t)SEQ * NSA_N * 2};
                    pg8::StaticOrder S; S.init(2048, 256, F.G, F.bid & 7);
                    pg8::EpiCmpMlp E{WSP(float, WS_BIAS1) + wh * 256, WSP(pg8::bf16_t, WS_CW2) + (size_t)wh * 128 * 256, WSP(pg8::bf16_t, WS_KCMP) + (size_t)wh * 16 * 128 * 128};
                    pg8::gemm_phase<pg8::EpiCmpMlp, pg8::StaticOrder, false, true, true>(F.lds, g, S, E);
                }
                nsa_win_mem_units(p, F, L, WQ_(1)); } }
            END_PHASE();
            if (IN()) { MKFRAME(); for (int rep_ = 0, nrep_ = ((PROBE_REPEAT & 64) ? 2 : 1); rep_ < nrep_; ++rep_) { phase_attn_cmp(p, F); } }
            END_PHASE();
            if (IN()) { MKFRAME(); for (int rep_ = 0, nrep_ = ((PROBE_REPEAT & 128) ? 2 : 1); rep_ < nrep_; ++rep_) { phase_attn_sel(p, F, LAST_() ? WSP(bf16_t, WS_OCAT) : WSP(bf16_t, WS_TMP), WQ_(2)); } }
            END_PHASE();
            if (IN()) { MKFRAME(); for (int rep_ = 0, nrep_ = ((PROBE_REPEAT & 2) ? 2 : 1); rep_ < nrep_; ++rep_) { GEMM_RS(WS_OCAT, WS_WO, MTOK, DM, DM, WS_TMP, DM, (const float*)nullptr); } }
            END_PHASE();
            if (IN()) { MKFRAME(); for (int rep_ = 0, nrep_ = ((PROBE_REPEAT & 8) ? 2 : 1); rep_ < nrep_; ++rep_) { phase_resid(p, F, p.norm_g + (size_t)(L * 5 + 1) * DM, (LAST_() && false) ? p.out : (float*)nullptr, WSP(bf16_t, WS_XB), LAST_() ? WSP(bf16_t, WS_XB) : WSP(bf16_t, WS_PROJ), LAST_() ? WSP(float, WS_RSTD) : WSP(float, WS_FP)); } }
            END_PHASE();
            if (IN()) { MKFRAME(); for (int rep_ = 0, nrep_ = ((PROBE_REPEAT & 2) ? 2 : 1); rep_ < nrep_; ++rep_) { GEMM_GU(L); } }
            END_PHASE();
            if (IN()) { MKFRAME(); for (int rep_ = 0, nrep_ = ((PROBE_REPEAT & 16) ? 2 : 1); rep_ < nrep_; ++rep_) { phase_convfix(p, F, L); } }
            END_PHASE();
            if (IN()) { MKFRAME(); for (int rep_ = 0, nrep_ = ((PROBE_REPEAT & 2) ? 2 : 1); rep_ < nrep_; ++rep_) { GEMM_RS(WS_ACT, WS_WD, MTOK, DM, DFF, WS_TMP, DM, (const float*)nullptr); } }
            END_PHASE();
            if (IN()) { MKFRAME(); for (int rep_ = 0, nrep_ = ((PROBE_REPEAT & 8) ? 2 : 1); rep_ < nrep_; ++rep_) { phase_resid(p, F, p.norm_g + (size_t)(L * 5 + 3) * DM, (LAST_() && L == DEPTH - 1) ? p.out : (float*)nullptr, WSP(bf16_t, WS_XB), LAST_() ? WSP(bf16_t, WS_XB) : WSP(bf16_t, WS_PROJ), LAST_() ? WSP(float, WS_RSTD) : WSP(float, WS_FP)); }  if (L + 1 < DEPTH) phase_convert(p, F, L + 1); }
            END_PHASE();
        }
    }
#undef IN
#undef END_PHASE
#undef GEMM_RS
#undef GEMM_GU
}

extern "C" void kernel_launch(void* const* d_in, const int* in_sizes, int n_in, void* d_out, int out_size, void* d_ws, size_t ws_size, hipStream_t stream) {
    static int grid = 0;
    if (grid == 0) {
        if (n_in != 16 || out_size != MTOK * DM || ws_size < WS_END) { fprintf(stderr, "kernel_launch: unexpected shapes (n_in %d, out %d, ws %zu < %zu)\n", n_in, out_size, ws_size, (size_t)WS_END); grid = -1; return; }
        int dev = 0, cus = 0, per_cu = 0;
        if (hipGetDevice(&dev) != hipSuccess || hipDeviceGetAttribute(&cus, hipDeviceAttributeMultiprocessorCount, dev) != hipSuccess) { grid = -1; return; }
        if (hipFuncSetAttribute((const void*)mk_fwd, hipFuncAttributeMaxDynamicSharedMemorySize, LDS_BYTES) != hipSuccess) { fprintf(stderr, "kernel_launch: hipFuncSetAttribute failed\n"); grid = -1; return; }
        if (hipOccupancyMaxActiveBlocksPerMultiprocessor(&per_cu, (const void*)mk_fwd, NTHR, LDS_BYTES) != hipSuccess || per_cu < 1) { fprintf(stderr, "kernel_launch: occupancy query says %d\n", per_cu); (void)hipGetLastError(); }
        grid = cus;
    }
    if (grid < 0) return;
    (void)hipMemsetAsync((char*)d_ws + WS_CTL, 0, CTL_ZERO_BYTES, stream);
    Params p{};
    p.x = (const float*)d_in[0]; p.mem = (const float*)d_in[1]; p.positions = (const int*)d_in[2]; p.norm_g = (const float*)d_in[3]; p.w_in_sb = (const float*)d_in[4]; p.w_in_nsa = (const float*)d_in[5];
    p.cmp_pe = (const float*)d_in[6]; p.cmp_w1 = (const float*)d_in[7]; p.cmp_w2 = (const float*)d_in[8]; p.w_mem_kv = (const float*)d_in[9]; p.w_o = (const float*)d_in[10];
    p.w_gate = (const float*)d_in[11]; p.w_up = (const float*)d_in[12]; p.conv_w = (const float*)d_in[13]; p.conv_b = (const float*)d_in[14]; p.w_down = (const float*)d_in[15];
    p.out = (float*)d_out; p.ws = (unsigned char*)d_ws;
#if MK_PER_PHASE
    for (int ph = 0; ph < NPH; ++ph) { p.ph_lo = ph; p.ph_hi = ph + 1; hipLaunchKernelGGL(mk_fwd, dim3(grid), dim3(NTHR), LDS_BYTES, stream, p); }
#else
    p.ph_lo = 0; p.ph_hi = NPH;
    hipLaunchKernelGGL(mk_fwd, dim3(grid), dim3(NTHR), LDS_BYTES, stream, p);
#endif
}
```

```cpp
#include <hip/hip_runtime.h>
#include <cstdio>
#include <cstdint>
namespace pg8 {
#define PG8_LAS __attribute__((address_space(3)))
typedef unsigned short bf16_t;
typedef short bf16x8 __attribute__((ext_vector_type(8)));
typedef float f32x4 __attribute__((ext_vector_type(4)));
typedef unsigned u32x4 __attribute__((ext_vector_type(4)));
constexpr int BM = 256, BK = 64, HALF = 128, HTB = HALF * BK * 2  , STAGE_BYTES = 8 * HTB, NXCD = 8, WGM = 8;

__host__ __device__ __forceinline__ int lds_byte(int r, int c) { const int st = (r >> 4) * 2 + (c >> 5), rr = r & 15, cc = c & 31, ob = rr * 64 + cc * 2; return st * 1024 + (ob ^ (((ob >> 9) & 1) << 5)); }
__host__ __device__ __forceinline__ void stage_rc(int b, int& R, int& C) { const int st = b / 1024, sb = b % 1024, swz = sb ^ (((sb >> 9) & 1) << 5); R = (st >> 1) * 16 + swz / 64; C = (st & 1) * 32 + (swz % 64) / 2; }
__host__ __device__ __forceinline__ int perm32(int rho) { const int n = rho >> 4, i = rho & 15; return 8 * (i >> 2) + 4 * n + (i & 3); }

struct Unit { int pm, pn; };
struct Gemm { const bf16_t* A; const bf16_t* Bt; int M, N, K; int lda; unsigned hstepA, kpairA; size_t tstepA; };

struct StaticOrder {
    int nM, nN, nwg, G, c;
    __host__ __device__ void init(int M, int N, int G_, int c_) { nM = M / BM; nN = N / BM; nwg = nM * nN; G = G_; c = c_; }
    __host__ __device__ bool next(int i, Unit& u) const {
        const long L = (long)i * G + c; if (L >= nwg) return false;
        int wgid = (int)L; { const int q = nwg / NXCD, r = nwg % NXCD, xcd = wgid % NXCD, off = wgid / NXCD; wgid = (xcd < r ? xcd * (q + 1) : r * (q + 1) + (xcd - r) * q) + off; }
        const int nig = WGM * nN, gid = wgid / nig, fm = gid * WGM, gsz = (nM - fm) < WGM ? (nM - fm) : WGM;
        u.pm = fm + ((wgid % nig) % gsz); u.pn = (wgid % nig) / gsz; return true;
    }
    __device__ __forceinline__ void a_ready(const Unit&) const {}
    __device__ __forceinline__ void done(const Unit&) const {}
};

__device__ __forceinline__ unsigned cvt_pk_bf16(float lo, float hi) { unsigned r; asm volatile("v_cvt_pk_bf16_f32 %0, %1, %2" : "=v"(r) : "v"(lo), "v"(hi)); return r; }
typedef float f32x2 __attribute__((ext_vector_type(2)));
struct EpiRS {
    static constexpr bool PERM = true, AFTER_DRAIN = false;
    bf16_t* O; int ldc; const float* rs;
    __device__ __forceinline__ void operator()(const f32x4 (&acc)[2][2][4][2], const Unit& u, int wr, int wc, int fr, int fq) const {
        const int row0 = u.pm * BM + wr * 64 + fr; const int col0 = u.pn * BM + wc * 32 + 8 * fq;
#pragma unroll
        for (int ai = 0; ai < 2; ++ai)
#pragma unroll
            for (int m = 0; m < 4; ++m) { const int row = row0 + ai * HALF + m * 16; const float sc = rs ? rs[row] : 1.f; bf16_t* rowp = O + (size_t)row * ldc + col0;
#pragma unroll
                for (int bj = 0; bj < 2; ++bj) { const f32x4 v0 = acc[ai][bj][m][0] * sc, v1 = acc[ai][bj][m][1] * sc;
                    u32x4 w; w.x = cvt_pk_bf16(v0[0], v0[1]); w.y = cvt_pk_bf16(v0[2], v0[3]); w.z = cvt_pk_bf16(v1[0], v1[1]); w.w = cvt_pk_bf16(v1[2], v1[3]);
                    *(u32x4*)(rowp + bj * HALF) = w; } }
    }
};
__device__ __forceinline__ float dpp_ror1(float v) { return __builtin_bit_cast(float, __builtin_amdgcn_update_dpp(0, __builtin_bit_cast(int, v), 0x121, 0xf, 0xf, false)); }
__device__ __forceinline__ float dpp_ror2(float v) { return __builtin_bit_cast(float, __builtin_amdgcn_update_dpp(0, __builtin_bit_cast(int, v), 0x122, 0xf, 0xf, false)); }
__device__ __forceinline__ float silu_fast(float x) { return x * __builtin_amdgcn_rcpf(1.f + __builtin_amdgcn_exp2f(-x * 1.4426950408889634f)); }
struct EpiConv {
    static constexpr bool PERM = true, AFTER_DRAIN = false;
    bf16_t* ACT; const float* rs; const float* cw; const float* cb; float* HG; float* FP; float* FU; PG8_LAS float* halo; int dff;
    __device__ __forceinline__ void operator()(const f32x4 (&acc)[2][2][4][2], const Unit& u, int wr, int wc, int fr, int fq) const {
        const int fl = wc * 32 + 8 * fq, f0 = u.pn * 128 + fl;
        f32x4 w0[2], w1[2], w2[2], bb[2];
#pragma unroll
        for (int n = 0; n < 2; ++n) { w0[n] = *(const f32x4*)(cw + f0 + 4 * n); w1[n] = *(const f32x4*)(cw + dff + f0 + 4 * n); w2[n] = *(const f32x4*)(cw + 2 * dff + f0 + 4 * n); bb[n] = *(const f32x4*)(cb + f0 + 4 * n); }
#pragma unroll
        for (int ai = 0; ai < 2; ++ai) { const float sc = rs[u.pm * BM + ai * HALF + wr * 64 + 48 + fr];
            if (fr >= 14) {
#pragma unroll
                for (int n = 0; n < 2; ++n) *(PG8_LAS f32x4*)(halo + ((ai * 2 + wr) * 2 + (fr - 14)) * 128 + fl + 4 * n) = acc[ai][0][3][n] * sc; } }
        asm volatile("s_waitcnt lgkmcnt(0)" ::: "memory"); __builtin_amdgcn_s_barrier(); asm volatile("" ::: "memory");
#pragma unroll
        for (int ai = 0; ai < 2; ++ai) {
            const int s = ai * 2 + wr;
            f32x4 a1p[2], a2p[2];
#pragma unroll
            for (int n = 0; n < 2; ++n) { f32x4 vp = {0.f, 0.f, 0.f, 0.f};
                if (s > 0 && fr >= 14) vp = *(const PG8_LAS f32x4*)(halo + ((s - 1) * 2 + (fr - 14)) * 128 + fl + 4 * n);
#pragma unroll
                for (int e = 0; e < 4; ++e) { a1p[n][e] = dpp_ror1(vp[e]); a2p[n][e] = dpp_ror2(vp[e]); } }
#pragma unroll
            for (int m = 0; m < 4; ++m) {
                const int row = u.pm * BM + ai * HALF + wr * 64 + m * 16 + fr; const float sc = rs[row];
                u32x4 wv; unsigned pk[4];
#pragma unroll
                for (int n = 0; n < 2; ++n) {
                    const f32x4 v = acc[ai][0][m][n] * sc, uu = acc[ai][1][m][n] * sc; f32x4 a1, a2, gc, ac;
#pragma unroll
                    for (int e = 0; e < 4; ++e) { a1[e] = dpp_ror1(v[e]); a2[e] = dpp_ror2(v[e]); }
#pragma unroll
                    for (int e = 0; e < 4; ++e) { const float p1 = (fr >= 1) ? a1[e] : a1p[n][e], p2 = (fr >= 2) ? a2[e] : a2p[n][e];
                        gc[e] = bb[n][e] + w0[n][e] * p2 + w1[n][e] * p1 + w2[n][e] * v[e];
                        ac[e] = silu_fast(gc[e]) * uu[e]; }
                    if (s == 0 && m == 0 && fr < 2) { *(f32x4*)(FP + (size_t)(u.pm * 2 + fr) * dff + f0 + 4 * n) = gc; *(f32x4*)(FU + (size_t)(u.pm * 2 + fr) * dff + f0 + 4 * n) = uu; }
                    if (s == 3 && m == 3 && fr >= 14) *(f32x4*)(HG + (size_t)(u.pm * 2 + fr - 14) * dff + f0 + 4 * n) = v;
                    pk[2 * n] = cvt_pk_bf16(ac[0], ac[1]); pk[2 * n + 1] = cvt_pk_bf16(ac[2], ac[3]);
                    a1p[n] = a1; a2p[n] = a2;
                }
                wv.x = pk[0]; wv.y = pk[1]; wv.z = pk[2]; wv.w = pk[3];
                *(u32x4*)(ACT + (size_t)row * dff + f0) = wv;
            }
        }
    }
};
struct EpiSiluBias {
    static constexpr bool PERM = true, AFTER_DRAIN = false;
    bf16_t* O; int ldc; const float* bias;
    __device__ __forceinline__ void operator()(const f32x4 (&acc)[2][2][4][2], const Unit& u, int wr, int wc, int fr, int fq) const {
        const int row0 = u.pm * BM + wr * 64 + fr; const int col0 = u.pn * BM + wc * 32 + 8 * fq;
        f32x4 bv[2][2];
#pragma unroll
        for (int bj = 0; bj < 2; ++bj)
#pragma unroll
            for (int n = 0; n < 2; ++n) bv[bj][n] = *(const f32x4*)(bias + col0 + bj * HALF + 4 * n);
#pragma unroll
        for (int ai = 0; ai < 2; ++ai)
#pragma unroll
            for (int m = 0; m < 4; ++m) { bf16_t* rowp = O + (size_t)(row0 + ai * HALF + m * 16) * ldc + col0;
#pragma unroll
                for (int bj = 0; bj < 2; ++bj) { f32x4 v0 = acc[ai][bj][m][0] + bv[bj][0], v1 = acc[ai][bj][m][1] + bv[bj][1];
#pragma unroll
                    for (int e = 0; e < 4; ++e) { v0[e] = v0[e] * __builtin_amdgcn_rcpf(1.f + __builtin_amdgcn_exp2f(-v0[e] * 1.4426950408889634f)); v1[e] = v1[e] * __builtin_amdgcn_rcpf(1.f + __builtin_amdgcn_exp2f(-v1[e] * 1.4426950408889634f)); }
                    u32x4 w; w.x = cvt_pk_bf16(v0[0], v0[1]); w.y = cvt_pk_bf16(v0[2], v0[3]); w.z = cvt_pk_bf16(v1[0], v1[1]); w.w = cvt_pk_bf16(v1[2], v1[3]);
                    *(u32x4*)(rowp + bj * HALF) = w; } }
    }
};
struct EpiCmpMlp {
    static constexpr bool PERM = true, AFTER_DRAIN = true;
    const float* bias; const bf16_t* w2t; bf16_t* OUT;
    __device__ __forceinline__ void fused(f32x4 (&acc)[2][2][4][2], const Unit& u, int wr, int wc, int fr, int fq, PG8_LAS unsigned char* lds, int wid, int lane) const {
        typedef float f32x16v __attribute__((ext_vector_type(16)));
        PG8_LAS bf16_t* hid = (PG8_LAS bf16_t*)lds;
        const int col0 = wc * 32 + 8 * fq;
#pragma unroll
        for (int bj = 0; bj < 2; ++bj) { f32x4 b0 = {0.f, 0.f, 0.f, 0.f}, b1 = {0.f, 0.f, 0.f, 0.f};
#pragma unroll
            for (int kq = 0; kq < 8; ++kq) { b0 += *(const f32x4*)(bias + kq * 512 + col0 + bj * HALF); b1 += *(const f32x4*)(bias + kq * 512 + col0 + bj * HALF + 4); }
#pragma unroll
            for (int ai = 0; ai < 2; ++ai)
#pragma unroll
                for (int m = 0; m < 4; ++m) { f32x4 v0 = acc[ai][bj][m][0] + b0, v1 = acc[ai][bj][m][1] + b1;
#pragma unroll
                    for (int e = 0; e < 4; ++e) { v0[e] = v0[e] * __builtin_amdgcn_rcpf(1.f + __builtin_amdgcn_exp2f(-v0[e] * 1.4426950408889634f)); v1[e] = v1[e] * __builtin_amdgcn_rcpf(1.f + __builtin_amdgcn_exp2f(-v1[e] * 1.4426950408889634f)); }
                    u32x4 w; w.x = cvt_pk_bf16(v0[0], v0[1]); w.y = cvt_pk_bf16(v0[2], v0[3]); w.z = cvt_pk_bf16(v1[0], v1[1]); w.w = cvt_pk_bf16(v1[2], v1[3]);
                    *(PG8_LAS u32x4*)(hid + (ai * HALF + wr * 64 + m * 16 + fr) * 264 + col0 + bj * HALF) = w; } }
        asm volatile("s_waitcnt lgkmcnt(0)" ::: "memory"); __builtin_amdgcn_s_barrier(); asm volatile("" ::: "memory");
        const int r32 = lane & 31, hi = lane >> 5, ct = wid & 3;
        const bf16_t* w2 = w2t + (size_t)(ct * 32 + r32) * 256;
#pragma unroll 1
        for (int k4 = 0; k4 < 4; ++k4) {
            const int rt = (wid >> 2) + 2 * k4;
            f32x16v a2 = (f32x16v){};
#pragma unroll
            for (int kk = 0; kk < 16; ++kk) { const int k = kk * 16 + hi * 8;
                a2 = __builtin_amdgcn_mfma_f32_32x32x16_bf16(*(const PG8_LAS bf16x8*)(hid + (rt * 32 + r32) * 264 + k), *(const bf16x8*)(w2 + k), a2, 0, 0, 0); }
#pragma unroll
            for (int r = 0; r < 16; ++r) { const int rl = rt * 32 + (r & 3) + 8 * (r >> 2) + 4 * hi; const int ro = u.pm * BM + rl;
                const float av_ = a2[r]; const unsigned ub = __float_as_uint(av_); const unsigned rb = (ub + 0x7fffu + ((ub >> 16) & 1u)) >> 16;
                OUT[(size_t)ro * 128 + ct * 32 + r32] = ((ro & 127) == 127) ? (bf16_t)0 : (bf16_t)rb; }
        }
        asm volatile("s_waitcnt lgkmcnt(0)" ::: "memory"); __builtin_amdgcn_s_barrier(); asm volatile("" ::: "memory");
    }
};
struct EpiRopeRS {
    static constexpr bool PERM = true, AFTER_DRAIN = false;
    bf16_t* O; int ldc; const float* rs; const float* cosT; const float* sinT;
    __device__ __forceinline__ void operator()(const f32x4 (&acc)[2][2][4][2], const Unit& u, int wr, int wc, int fr, int fq) const {
        const int row0 = u.pm * BM + wr * 64 + fr; const int col0 = u.pn * BM + wc * 32 + 8 * fq;
        const bool rope = (u.pn < 7) || (u.pn == 8) || (u.pn == 10);
        const int i0 = (wc * 32 + 8 * fq) >> 1;
#pragma unroll
        for (int ai = 0; ai < 2; ++ai)
#pragma unroll
            for (int m = 0; m < 4; ++m) { const int row = row0 + ai * HALF + m * 16; const float sc = rs[row]; bf16_t* rowp = O + (size_t)row * ldc + col0;
                f32x4 cv = {1.f, 1.f, 1.f, 1.f}, sv = {0.f, 0.f, 0.f, 0.f};
                if (rope) { cv = *(const f32x4*)(cosT + (size_t)row * 64 + i0); sv = *(const f32x4*)(sinT + (size_t)row * 64 + i0); }
#pragma unroll
                for (int bj = 0; bj < 2; ++bj) { const f32x4 x0 = acc[ai][bj][m][0] * sc, x1 = acc[ai][bj][m][1] * sc;
                    const f32x4 v0 = {x0[0] * cv[0] - x0[1] * sv[0], x0[1] * cv[0] + x0[0] * sv[0], x0[2] * cv[1] - x0[3] * sv[1], x0[3] * cv[1] + x0[2] * sv[1]};
                    const f32x4 v1 = {x1[0] * cv[2] - x1[1] * sv[2], x1[1] * cv[2] + x1[0] * sv[2], x1[2] * cv[3] - x1[3] * sv[3], x1[3] * cv[3] + x1[2] * sv[3]};
                    u32x4 w; w.x = cvt_pk_bf16(v0[0], v0[1]); w.y = cvt_pk_bf16(v0[2], v0[3]); w.z = cvt_pk_bf16(v1[0], v1[1]); w.w = cvt_pk_bf16(v1[2], v1[3]);
                    *(u32x4*)(rowp + bj * HALF) = w; } }
    }
};
template <class Epi, class Sched, bool ALIGN_EPI = false, bool SP2 = false, bool AGEN = false>
__device__ __forceinline__ void gemm_phase(PG8_LAS unsigned char* lds, const Gemm g, const Sched& S, const Epi& E) {
    int tid_ = threadIdx.x; asm volatile("" : "+v"(tid_));
    const int tid = tid_, wid = __builtin_amdgcn_readfirstlane(tid >> 6), lane = tid & 63, wr = wid >> 2, wc = wid & 3, fr = lane & 15, fq = lane >> 4;
    const int K = g.K, nt = K / BK;
    unsigned voffA[2], voffB[2];
#pragma unroll
    for (int i = 0; i < 2; ++i) { int R, C; stage_rc(tid * 16 + i * 8192, R, C); const int Rb = Epi::PERM ? ((R & ~31) + perm32(R & 31)) : R;
        voffA[i] = (unsigned)(R * (AGEN ? g.lda : K) + C) * 2u; voffB[i] = (unsigned)(Rb * K + C) * 2u; }
    const size_t kstep = (size_t)(BK * 2);
    const size_t hstep = (size_t)HALF * K * 2;
    const size_t tstep = 2 * hstep;
    const size_t hstepA = AGEN ? (size_t)g.hstepA : hstep, tstepA = AGEN ? g.tstepA : tstep, kpairA = AGEN ? (size_t)g.kpairA : 2 * kstep;
    const unsigned ldsw = (unsigned)wid * 1024u;
    const int aoff = lds_byte(wr * 64 + fr, fq * 8), boff = lds_byte(wc * 32 + fr, fq * 8);
#define PG8_SA(b, h) (((b) * 2 + (h)) * HTB)
#define PG8_SB(b, h) ((4 + (b) * 2 + (h)) * HTB)
#define PG8_STAGE(bufoff, gbase, voff) do { _Pragma("unroll") for (int _i = 0; _i < 2; ++_i) \
        __builtin_amdgcn_global_load_lds((const unsigned*)((const char*)(gbase) + (voff)[_i]), (PG8_LAS unsigned*)(lds + (bufoff) + ldsw + _i * 8192), 16, 0, 0); } while (0)
#define PG8_LDA(dst, b, h) do { _Pragma("unroll") for (int m = 0; m < 4; ++m) _Pragma("unroll") for (int k = 0; k < 2; ++k) dst[m][k] = *(const PG8_LAS bf16x8*)(lds + PG8_SA(b, h) + aoff + m * 2048 + k * 1024); } while (0)
#define PG8_LDB(dst, b, h) do { _Pragma("unroll") for (int n = 0; n < 2; ++n) _Pragma("unroll") for (int k = 0; k < 2; ++k) dst[n][k] = *(const PG8_LAS bf16x8*)(lds + PG8_SB(b, h) + boff + n * 2048 + k * 1024); } while (0)
#define PG8_MMA(ai, bj, At, Bt) do { __builtin_amdgcn_s_setprio(1); _Pragma("unroll") for (int m = 0; m < 4; ++m) _Pragma("unroll") for (int n = 0; n < 2; ++n) _Pragma("unroll") for (int k = 0; k < 2; ++k) \
        acc[ai][bj][m][n] = __builtin_amdgcn_mfma_f32_16x16x32_bf16(Bt[n][k], At[m][k], acc[ai][bj][m][n], 0, 0, 0); __builtin_amdgcn_s_setprio(0); } while (0)
#define PG8_WAIT_V(n) asm volatile("s_waitcnt vmcnt(" #n ")" ::: "memory")
#define PG8_WAIT_L(n) asm volatile("s_waitcnt lgkmcnt(" #n ")" ::: "memory")
#define PG8_BAR __builtin_amdgcn_s_barrier()
#define PG8_SCHED __builtin_amdgcn_sched_barrier(0)
    Unit cur, nxt; int ui = 0;
    if (!S.next(0, cur)) return;
    f32x4 acc[2][2][4][2];
#pragma unroll
    for (int a = 0; a < 2; ++a)
#pragma unroll
        for (int b = 0; b < 2; ++b)
#pragma unroll
            for (int m = 0; m < 4; ++m)
#pragma unroll
                for (int n = 0; n < 2; ++n) acc[a][b][m][n] = (f32x4){0.f, 0.f, 0.f, 0.f};
    bf16x8 At[4][2], B0[2][2], B1[2][2];
    const char* cA = (const char*)g.A + (size_t)cur.pm * tstepA; const char* cB = (const char*)g.Bt + (size_t)cur.pn * tstep;
    S.a_ready(cur);
    if constexpr (SP2) {
        PG8_STAGE(PG8_SB(0, 0), cB, voffB); PG8_STAGE(PG8_SB(0, 1), cB + hstep, voffB); PG8_STAGE(PG8_SA(0, 0), cA, voffA); PG8_STAGE(PG8_SA(0, 1), cA + hstepA, voffA);
        if (wr == 1) PG8_BAR;
        PG8_WAIT_V(2); PG8_BAR;
        PG8_STAGE(PG8_SB(1, 0), cB + kstep, voffB); PG8_STAGE(PG8_SA(1, 0), cA + kstep, voffA); PG8_STAGE(PG8_SB(1, 1), cB + hstep + kstep, voffB);
        PG8_WAIT_V(6); PG8_BAR;
    } else {
        PG8_STAGE(PG8_SB(0, 0), cB, voffB); PG8_STAGE(PG8_SA(0, 0), cA, voffA); PG8_STAGE(PG8_SB(0, 1), cB + hstep, voffB); PG8_STAGE(PG8_SA(0, 1), cA + hstepA, voffA);
        if (wr == 1) PG8_BAR;
        PG8_WAIT_V(4); PG8_BAR;
        PG8_STAGE(PG8_SB(1, 0), cB + kstep, voffB); PG8_STAGE(PG8_SA(1, 0), cA + kstep, voffA); PG8_STAGE(PG8_SB(1, 1), cB + hstep + kstep, voffB);
        PG8_WAIT_V(6); PG8_BAR;
    }
    for (;;) {
        const bool has_next = S.next(ui + 1, nxt);
        const char* nA = has_next ? (const char*)g.A + (size_t)nxt.pm * tstepA : cA; const char* nB = has_next ? (const char*)g.Bt + (size_t)nxt.pn * tstep : cB;
        for (int t = 0; t < nt; t += 2) {
            const bool last = (t == nt - 2);
            const char* a1 = cA + (size_t)(t >> 1) * kpairA + kstep;
            const char* a2 = last ? nA : cA + (size_t)((t >> 1) + 1) * kpairA; const char* b2 = last ? nB : cB + (size_t)(t + 2) * kstep;
            const char* a3 = a2 + kstep; const char* b3 = b2 + kstep;
            if (last && has_next) S.a_ready(nxt);
            if constexpr (SP2) {
            PG8_LDB(B0, 0, 0); PG8_LDB(B1, 0, 1); PG8_SCHED; PG8_LDA(At, 0, 0); PG8_STAGE(PG8_SA(1, 1), a1 + hstepA, voffA);
            PG8_WAIT_V(8); PG8_WAIT_L(0); PG8_BAR; PG8_MMA(0, 0, At, B0); PG8_MMA(0, 1, At, B1); PG8_BAR; PG8_SCHED;
            PG8_LDA(At, 0, 1); PG8_STAGE(PG8_SB(0, 0), b2, voffB); PG8_STAGE(PG8_SB(0, 1), b2 + hstep, voffB); PG8_STAGE(PG8_SA(0, 0), a2, voffA);
            PG8_WAIT_V(8); PG8_WAIT_L(0); PG8_BAR; PG8_MMA(1, 0, At, B0); PG8_MMA(1, 1, At, B1); PG8_BAR; PG8_SCHED;
            PG8_LDB(B0, 1, 0); PG8_LDB(B1, 1, 1); PG8_SCHED; PG8_LDA(At, 1, 0); PG8_STAGE(PG8_SA(0, 1), a2 + hstepA, voffA);
            PG8_WAIT_V(8); PG8_WAIT_L(0); PG8_BAR; PG8_MMA(0, 0, At, B0); PG8_MMA(0, 1, At, B1); PG8_BAR; PG8_SCHED;
            PG8_LDA(At, 1, 1); PG8_STAGE(PG8_SB(1, 0), b3, voffB); PG8_STAGE(PG8_SB(1, 1), b3 + hstep, voffB); PG8_STAGE(PG8_SA(1, 0), a3, voffA);
            PG8_WAIT_V(8); PG8_WAIT_L(0); PG8_BAR; PG8_MMA(1, 0, At, B0); PG8_MMA(1, 1, At, B1); PG8_BAR; PG8_SCHED;
            } else {
            PG8_LDB(B0, 0, 0); PG8_SCHED; PG8_LDA(At, 0, 0); PG8_STAGE(PG8_SA(1, 1), a1 + hstepA, voffA);
            PG8_WAIT_L(8); PG8_BAR; PG8_WAIT_L(0); PG8_MMA(0, 0, At, B0); PG8_BAR; PG8_SCHED;
            PG8_LDB(B1, 0, 1); PG8_STAGE(PG8_SB(0, 0), b2, voffB);
            PG8_BAR; PG8_WAIT_L(0); PG8_MMA(0, 1, At, B1); PG8_BAR;
            PG8_LDA(At, 0, 1); PG8_STAGE(PG8_SA(0, 0), a2, voffA);
            PG8_BAR; PG8_WAIT_L(0); PG8_MMA(1, 0, At, B0); PG8_BAR; PG8_SCHED;
            PG8_STAGE(PG8_SB(0, 1), b2 + hstep, voffB);
            PG8_WAIT_V(6); PG8_BAR; PG8_MMA(1, 1, At, B1); PG8_BAR;
            PG8_LDB(B0, 1, 0); PG8_SCHED; PG8_LDA(At, 1, 0); PG8_STAGE(PG8_SA(0, 1), a2 + hstepA, voffA);
            PG8_WAIT_L(8); PG8_BAR; PG8_WAIT_L(0); PG8_MMA(0, 0, At, B0); PG8_BAR; PG8_SCHED;
            PG8_LDB(B1, 1, 1); PG8_STAGE(PG8_SB(1, 0), b3, voffB);
            PG8_BAR; PG8_WAIT_L(0); PG8_MMA(0, 1, At, B1); PG8_BAR;
            PG8_LDA(At, 1, 1); PG8_STAGE(PG8_SA(1, 0), a3, voffA);
            PG8_BAR; PG8_WAIT_L(0); PG8_MMA(1, 0, At, B0); PG8_BAR; PG8_SCHED;
            PG8_STAGE(PG8_SB(1, 1), b3 + hstep, voffB);
            PG8_WAIT_V(6); PG8_BAR; PG8_MMA(1, 1, At, B1); PG8_BAR;
            }
        }
        if constexpr (ALIGN_EPI) { if (wr == 0) PG8_BAR; }
        if constexpr (!Epi::AFTER_DRAIN) { E(acc, cur, wr, wc, fr, fq); S.done(cur); }
        if (!has_next) break;
#pragma unroll
        for (int a = 0; a < 2; ++a)
#pragma unroll
            for (int b = 0; b < 2; ++b)
#pragma unroll
                for (int m = 0; m < 4; ++m)
#pragma unroll
                    for (int n = 0; n < 2; ++n) acc[a][b][m][n] = (f32x4){0.f, 0.f, 0.f, 0.f};
        cur = nxt; cA = nA; cB = nB; ++ui;
        if constexpr (ALIGN_EPI) { if (wr == 1) PG8_BAR; }
    }
    PG8_WAIT_V(0);
    if constexpr (!ALIGN_EPI) { if (wr == 0) PG8_BAR; }
    PG8_BAR;
    if constexpr (Epi::AFTER_DRAIN) { E.fused(acc, cur, wr, wc, fr, fq, lds, wid, lane); S.done(cur); }
#undef PG8_SA
#undef PG8_SB
#undef PG8_STAGE
#undef PG8_LDA
#undef PG8_LDB
#undef PG8_MMA
#undef PG8_WAIT_V
#undef PG8_WAIT_L
#undef PG8_BAR
#undef PG8_SCHED
}
}

#ifndef MK_PER_PHASE
#define MK_PER_PHASE 0
#endif
constexpr int NB = 8, SEQ = 2048, DM = 2048, MTOK = NB * SEQ, DEPTH = 4, HD = 128;
constexpr int NMIX = 12, NMEMH = 4, NMEM = 256, DFF = 5632, NGU = 2 * DFF, NGRP = 2, HPG = 6;
constexpr int SB_N = 5120, NSA_N = 3840, NSA_SRC = 3620;
constexpr int SBQ = 0, SBK = 1536, SBV = 3072, SBQM = 4608;
constexpr int NQ = 0, NKC = 1536, NVC = 1792, NKS = 2048, NVS = 2304, NKW = 2560, NVW = 2816, NQM = 3072, NGL = 3584;
constexpr int NCMP = 127, CMPROWS = NB * NGRP * NCMP;
constexpr int WINDOW = 512;
constexpr float NORM_EPS = 1e-6f;
constexpr float SCALE = 0.08838834764831845f;
constexpr float LOG2E = 1.4426950408889634f;
constexpr int NWAVES = 8, NTHR = 512;

constexpr size_t MiB = 1u << 20;
constexpr size_t WS_CTL = 0, CTL_ZERO_BYTES = 1 * MiB;
constexpr size_t WS_WIN = 2 * MiB;
constexpr size_t WS_WO = 22 * MiB;
constexpr size_t WS_WGU = 30 * MiB;
constexpr size_t WS_WD = 74 * MiB;
constexpr size_t WS_WKV = 96 * MiB;
constexpr size_t WS_CW1 = 112 * MiB;
constexpr size_t WS_CW2 = 116 * MiB;
constexpr size_t WS_MEMB = 117 * MiB;
constexpr size_t WS_MEMKV = 125 * MiB;
constexpr size_t WS_COS = 141 * MiB, WS_SIN = 145 * MiB;
constexpr size_t WS_RSTD = 149 * MiB;
constexpr size_t WS_SEL = 150 * MiB;
constexpr size_t WS_KCMP = 151 * MiB;
constexpr size_t WS_XB = 152 * MiB;
constexpr size_t WS_TMP = 216 * MiB;
constexpr size_t WS_ACT = 280 * MiB;
constexpr size_t WS_GU = 456 * MiB;
constexpr size_t WS_PROJ = 456 * MiB;
constexpr size_t WS_OCAT = 616 * MiB;
constexpr size_t WS_HG = 680 * MiB, WS_FP = 684 * MiB, WS_FU = 688 * MiB;
constexpr size_t WS_HID = 692 * MiB;
constexpr size_t WS_BIAS1 = 694 * MiB;
constexpr size_t WS_END = 808 * MiB;
constexpr int CW_BAR = 4096;

constexpr int RING_BYTES = 131072;
constexpr int LDSCTL_OFF = 143360, MISC_OFF = LDSCTL_OFF + 320;
constexpr int LDS_BYTES = 147456;
constexpr int HALO_OFF = RING_BYTES;
constexpr int SHM_T = 16384;
constexpr int A_V = 0, A_K = 2 * SHM_T, A_WS = 4 * SHM_T, A_FLAGS = A_WS + NWAVES * 64 * 4, A_STASH = 67584;

#define GAS __attribute__((address_space(1)))
#define LAS __attribute__((address_space(3)))
typedef unsigned short bf16_t;
typedef unsigned v4u __attribute__((ext_vector_type(4)));
typedef unsigned v2u __attribute__((ext_vector_type(2)));
typedef float f32x4 __attribute__((ext_vector_type(4)));
typedef float f32x16 __attribute__((ext_vector_type(16)));
typedef short bf16x8 __attribute__((ext_vector_type(8)));
typedef short s16x4 __attribute__((ext_vector_type(4)));
typedef GAS unsigned gu32;
#define RLX_AGENT __ATOMIC_RELAXED, __HIP_MEMORY_SCOPE_AGENT
#define LDS_WAIT() asm volatile("s_waitcnt lgkmcnt(0)" ::: "memory")
#define VM_WAIT() asm volatile("s_waitcnt vmcnt(0)" ::: "memory")
#define SBAR() __builtin_amdgcn_sched_barrier(0)
__device__ __forceinline__ unsigned cvtpk(float lo, float hi) { unsigned r; asm volatile("v_cvt_pk_bf16_f32 %0, %1, %2" : "=v"(r) : "v"(lo), "v"(hi)); return r; }
__device__ __forceinline__ float bf2f(unsigned short b) { return __uint_as_float((unsigned)b << 16); }
__device__ __forceinline__ float bflo(unsigned w) { return __uint_as_float(w << 16); }
__device__ __forceinline__ float bfhi(unsigned w) { return __uint_as_float(w & 0xffff0000u); }
__device__ __forceinline__ bf16x8 pack8(f32x4 a, f32x4 b) { v4u w = {cvtpk(a[0], a[1]), cvtpk(a[2], a[3]), cvtpk(b[0], b[1]), cvtpk(b[2], b[3])}; return __builtin_bit_cast(bf16x8, w); }
__device__ __forceinline__ void unpack8(bf16x8 v, f32x4& a, f32x4& b) { const v4u w = __builtin_bit_cast(v4u, v); a = (f32x4){bflo(w.x), bfhi(w.x), bflo(w.y), bfhi(w.y)}; b = (f32x4){bflo(w.z), bfhi(w.z), bflo(w.w), bfhi(w.w)}; }
__device__ __forceinline__ float wave_sum(float v) {
#pragma unroll
    for (int o = 1; o < 64; o <<= 1) v += __shfl_xor(v, o);
    return v;
}
__device__ __forceinline__ float sigmoidf_(float x) { return __builtin_amdgcn_rcpf(1.f + __builtin_amdgcn_exp2f(-x * LOG2E)); }

__device__ const float INV_FREQ[64] = {1.000000000e+00f, 8.659643531e-01f, 7.498942018e-01f, 6.493816376e-01f, 5.623413324e-01f, 4.869675338e-01f, 4.216965139e-01f, 3.651741147e-01f, 3.162277639e-01f, 2.738419771e-01f, 2.371373773e-01f, 2.053525001e-01f, 1.778279394e-01f, 1.539926529e-01f, 1.333521456e-01f, 1.154781953e-01f, 1.000000015e-01f, 8.659642935e-02f, 7.498942316e-02f, 6.493816525e-02f, 5.623413250e-02f, 4.869675264e-02f, 4.216964915e-02f, 3.651741147e-02f, 3.162277490e-02f, 2.738419548e-02f, 2.371373773e-02f, 2.053525113e-02f, 1.778279431e-02f, 1.539926510e-02f, 1.333521400e-02f, 1.154781971e-02f, 9.999999776e-03f, 8.659643121e-03f, 7.498942316e-03f, 6.493816152e-03f, 5.623413250e-03f, 4.869675264e-03f, 4.216964822e-03f, 3.651741194e-03f, 3.162277630e-03f, 2.738419687e-03f, 2.371373819e-03f, 2.053525066e-03f, 1.778279431e-03f, 1.539926510e-03f, 1.333521446e-03f, 1.154782018e-03f, 1.000000047e-03f, 8.659643354e-04f, 7.498941850e-04f, 6.493816036e-04f, 5.623413017e-04f, 4.869675322e-04f, 4.216965172e-04f, 3.651741135e-04f, 3.162277571e-04f, 2.738419571e-04f, 2.371373703e-04f, 2.053525095e-04f, 1.778279402e-04f, 1.539926598e-04f, 1.333521504e-04f, 1.154782003e-04f};
#define XB_TMO      128
#define XB_XCNT(j)  (256  + 64 * (j))
#define XB_XSUB(j)  (1280 + 64 * (j))
#define XB_XGEN(j)  (2304 + 64 * (j))
#define XB_TOP      3328
#define XB_TOPGEN   3392
#define XCD_BAR_WORDS 3456
#define XB_SPIN_CAP (1u << 18)

__device__ __forceinline__ unsigned xb_ld(unsigned* p)              { return __hip_atomic_load(p, __ATOMIC_RELAXED, __HIP_MEMORY_SCOPE_AGENT); }
__device__ __forceinline__ unsigned xb_add(unsigned* p, unsigned v) { return __hip_atomic_fetch_add(p, v, __ATOMIC_RELAXED, __HIP_MEMORY_SCOPE_AGENT); }
__device__ __forceinline__ unsigned xb_xcc_id() { return (unsigned)__builtin_amdgcn_s_getreg((3 << 11) | 20) & 0xFu; }
#define XB_SPIN(cond, bar) do { unsigned _sp = 0; while (cond) { __builtin_amdgcn_s_sleep(1); \
    if ((++_sp & 255u) == 0u) { if (xb_ld(&(bar)[XB_TMO])) break; if (_sp > XB_SPIN_CAP) { atomicAdd(&(bar)[XB_TMO], 1u); break; } } } } while (0)

struct XcdBarrier {
    unsigned* bar; unsigned x;
    volatile LAS unsigned* st;
};

__device__ __forceinline__ XcdBarrier xcd_barrier_post(unsigned* bar, volatile LAS unsigned* st) {
    XcdBarrier b; b.bar = bar; b.x = xb_xcc_id(); b.st = st;
    if (threadIdx.x == 0) (void)xb_add(&bar[XB_XCNT(b.x)], 1u);
    return b;
}
__device__ __forceinline__ void xcd_barrier_complete(unsigned* bar, unsigned x, unsigned& nloc, unsigned& nx) {
    const unsigned G = gridDim.x * gridDim.y * gridDim.z;
    unsigned sum, cnt, mine, sp = 0u;
    for (;;) {
        sum = 0u; cnt = 0u; mine = 0u;
#pragma unroll
        for (unsigned j = 0; j < 16; ++j) { const unsigned c = xb_ld(&bar[XB_XCNT(j)]); sum += c; cnt += (c > 0u) ? 1u : 0u; mine = (j == x) ? c : mine; }
        if (sum == G) break;
        __builtin_amdgcn_s_sleep(1);
        if ((++sp & 255u) == 0u) { if (xb_ld(&bar[XB_TMO])) break; if (sp > XB_SPIN_CAP) { atomicAdd(&bar[XB_TMO], 1u); break; } }
    }
    nloc = mine > 0u ? mine : 1u; nx = cnt > 0u ? cnt : 1u;
}

__device__ __forceinline__ void xcd_barrier(const XcdBarrier& b) {
    asm volatile("s_waitcnt vmcnt(0)" ::: "memory");
    __syncthreads();
    if (threadIdx.x == 0) {
        unsigned* bar = b.bar;
        __builtin_amdgcn_s_waitcnt(0);
        unsigned nloc = b.st[0], nx = b.st[1];
        if (nloc == 0u) { xcd_barrier_complete(bar, b.x, nloc, nx); b.st[0] = nloc; b.st[1] = nx; }
        const unsigned old = xb_add(&bar[XB_XSUB(b.x)], 1u);
        const unsigned gen = old / nloc;
        if (old + 1u == (gen + 1u) * nloc) {
            __builtin_amdgcn_fence(__ATOMIC_RELEASE, "agent");
            asm volatile("s_waitcnt vmcnt(0)" ::: "memory");
            const unsigned og = xb_add(&bar[XB_TOP], 1u);
            const unsigned tg = og / nx;
            if (og + 1u == (tg + 1u) * nx) xb_add(&bar[XB_TOPGEN], 1u);
            else XB_SPIN(xb_ld(&bar[XB_TOPGEN]) == tg, bar);
            __builtin_amdgcn_fence(__ATOMIC_ACQUIRE, "agent");
            xb_add(&bar[XB_XGEN(b.x)], 1u);
            asm volatile("s_waitcnt vmcnt(0)" ::: "memory");
        } else {
            XB_SPIN(xb_ld(&bar[XB_XGEN(b.x)]) == gen, bar);
            __builtin_amdgcn_fence(__ATOMIC_ACQUIRE, "agent");
            asm volatile("s_waitcnt vmcnt(0)" ::: "memory");
        }
    }
    __syncthreads();
}

#define KSWZ(row, colB) ((row) * 256 + ((colB) ^ (((row) & 7) << 4)))
__device__ __forceinline__ int v_st(int k, int c) { const int kk = (k & ~0xC) | ((k & 4) << 1) | ((k & 8) >> 1); return ((kk >> 3) * 4 + (c >> 5)) * 512 + ((kk & 7) * 32 + (c & 31)) * 2; }
__device__ __forceinline__ int v_rd_base(int lane) { return ((lane & 3) << 3) | (((lane >> 2) & 3) << 6) | (((lane >> 4) & 1) << 5) | (((lane >> 5) & 1) << 8); }
constexpr int v_rd_off(int d0, int ks, int half) { return d0 * 512 + ks * 4096 + half * 2048; }
__device__ __forceinline__ int crow(int r, int hi) { return (r & 3) + 8 * (r >> 2) + 4 * hi; }

struct ACtx {
    LAS unsigned char* lds;
    int tid, wid, lane, r32, hi, sr, sc, kws, vst0, vst1, vb0;
    LAS float* ws;
};
__device__ __forceinline__ ACtx make_actx(LAS unsigned char* lds) {
    ACtx c; c.lds = lds; { int t_ = threadIdx.x; asm volatile("" : "+v"(t_)); c.tid = t_; } c.wid = __builtin_amdgcn_readfirstlane(c.tid >> 6); c.lane = c.tid & 63; c.r32 = c.lane & 31; c.hi = c.lane >> 5;
    c.sr = c.tid >> 4; c.sc = (c.tid & 15) * 8; c.kws = KSWZ(c.sr, c.sc * 2); c.vst0 = v_st(c.sr, c.sc); c.vst1 = v_st(32 + c.sr, c.sc);
    c.vb0 = (int)(unsigned)(size_t)(lds + A_V) + v_rd_base(c.lane);
    c.ws = (LAS float*)(lds + A_WS) + c.wid * 64;
    return c;
}
struct Stage { bf16x8 k0, k1, v0, v1; };
__device__ __forceinline__ void stage_load(Stage& S, const bf16_t* Kp, const bf16_t* Vp, int pitch, int kb, const ACtx& c) {
    S.v0 = *(const bf16x8*)(Vp + (size_t)(kb + c.sr) * pitch + c.sc); S.v1 = *(const bf16x8*)(Vp + (size_t)(kb + 32 + c.sr) * pitch + c.sc);
    S.k0 = *(const bf16x8*)(Kp + (size_t)(kb + c.sr) * pitch + c.sc); S.k1 = *(const bf16x8*)(Kp + (size_t)(kb + 32 + c.sr) * pitch + c.sc);
}
__device__ __forceinline__ void stage_write(const Stage& S, int buf, const ACtx& c) {
    LAS unsigned char* Kb = c.lds + A_K + buf * SHM_T; LAS unsigned char* Vb = c.lds + A_V + buf * SHM_T;
    *(LAS bf16x8*)(Kb + c.kws) = S.k0; *(LAS bf16x8*)(Kb + c.kws + 32 * 256) = S.k1;
    *(LAS bf16x8*)(Vb + c.vst0) = S.v0; *(LAS bf16x8*)(Vb + c.vst1) = S.v1;
}
__device__ __forceinline__ void qkt(f32x16& p0, f32x16& p1, int buf, const ACtx& c, const bf16x8* qr) {
    p0 = (f32x16){}; p1 = (f32x16){};
    const LAS unsigned char* Kb = c.lds + A_K + buf * SHM_T;
    const LAS unsigned char* kb[4];
#pragma unroll
    for (int dd = 0; dd < 4; ++dd) kb[dd] = Kb + KSWZ(c.r32, (dd * 16 + c.hi * 8) * 2);
#pragma unroll
    for (int d0 = 0; d0 < 8; ++d0) { const LAS unsigned char* a = kb[d0 & 3] + (d0 >> 2) * 128;
        const bf16x8 b0 = *(const LAS bf16x8*)a; const bf16x8 b1 = *(const LAS bf16x8*)(a + 32 * 256);
        p0 = __builtin_amdgcn_mfma_f32_32x32x16_bf16(b0, qr[d0], p0, 0, 0, 0);
        p1 = __builtin_amdgcn_mfma_f32_32x32x16_bf16(b1, qr[d0], p1, 0, 0, 0); }
}
__device__ __forceinline__ void pv_tile(f32x16* o, int buf, const ACtx& c, bf16x8 pa0, bf16x8 pa1, bf16x8 pa2, bf16x8 pa3) {
    const int vb = c.vb0 + buf * SHM_T;
#define TRRD(dst, off) asm volatile("ds_read_b64_tr_b16 %0, %1 offset:%2" : "=&v"(dst) : "v"(vb), "i"(off) : "memory")
#define PV_D0(d0) do { s16x4 l0, l1, l2, l3, h0, h1, h2, h3; constexpr int b_ = v_rd_off(d0, 0, 0); \
        TRRD(l0, b_); TRRD(h0, b_ + 2048); TRRD(l1, b_ + 4096); TRRD(h1, b_ + 6144); TRRD(l2, b_ + 8192); TRRD(h2, b_ + 10240); TRRD(l3, b_ + 12288); TRRD(h3, b_ + 14336); \
        asm volatile("s_waitcnt lgkmcnt(0)" ::: "memory"); SBAR(); \
        o[d0] = __builtin_amdgcn_mfma_f32_32x32x16_bf16(pa0, (bf16x8){l0[0], l0[1], l0[2], l0[3], h0[0], h0[1], h0[2], h0[3]}, o[d0], 0, 0, 0); \
        o[d0] = __builtin_amdgcn_mfma_f32_32x32x16_bf16(pa1, (bf16x8){l1[0], l1[1], l1[2], l1[3], h1[0], h1[1], h1[2], h1[3]}, o[d0], 0, 0, 0); \
        o[d0] = __builtin_amdgcn_mfma_f32_32x32x16_bf16(pa2, (bf16x8){l2[0], l2[1], l2[2], l2[3], h2[0], h2[1], h2[2], h2[3]}, o[d0], 0, 0, 0); \
        o[d0] = __builtin_amdgcn_mfma_f32_32x32x16_bf16(pa3, (bf16x8){l3[0], l3[1], l3[2], l3[3], h3[0], h3[1], h3[2], h3[3]}, o[d0], 0, 0, 0); } while (0)
    PV_D0(0); PV_D0(1); PV_D0(2); PV_D0(3);
#undef PV_D0
#undef TRRD
}
__device__ __forceinline__ float swap_max(float v) { auto rr = __builtin_amdgcn_permlane32_swap(__float_as_uint(v), __float_as_uint(v), false, false); return fmaxf(__uint_as_float(rr[0]), __uint_as_float(rr[1])); }
__device__ __forceinline__ float swap_sum(float v) { auto rr = __builtin_amdgcn_permlane32_swap(__float_as_uint(v), __float_as_uint(v), false, false); return __uint_as_float(rr[0]) + __uint_as_float(rr[1]); }
__device__ __forceinline__ void swap_both(float v, float& lo, float& hi) { auto rr = __builtin_amdgcn_permlane32_swap(__float_as_uint(v), __float_as_uint(v), false, false); lo = __uint_as_float(rr[0]); hi = __uint_as_float(rr[1]); }
__device__ __forceinline__ void pack_p(const f32x16& p0, const f32x16& p1, bf16x8& pa0, bf16x8& pa1, bf16x8& pa2, bf16x8& pa3) {
#define PK4(P, B_, OUT) do { unsigned a0 = cvtpk(P[B_+0], P[B_+1]), a1 = cvtpk(P[B_+2], P[B_+3]); \
        unsigned b0 = cvtpk(P[B_+4], P[B_+5]), b1 = cvtpk(P[B_+6], P[B_+7]); \
        auto r0 = __builtin_amdgcn_permlane32_swap(a0, b0, false, false); auto r1 = __builtin_amdgcn_permlane32_swap(a1, b1, false, false); \
        v4u w = {r0[0], r1[0], r0[1], r1[1]}; OUT = __builtin_bit_cast(bf16x8, w); } while (0)
    PK4(p0, 0, pa0); PK4(p0, 8, pa1); PK4(p1, 0, pa2); PK4(p1, 8, pa3);
#undef PK4
}
__device__ __forceinline__ void mask_tile(f32x16& p0, f32x16& p1, int dq, unsigned W) {
    const float NEG = -__builtin_inff();
#pragma unroll
    for (int r = 0; r < 16; ++r) { const int cc = (r & 3) + 8 * (r >> 2);
        if ((unsigned)(dq - cc) >= W) p0[r] = NEG;
        if ((unsigned)(dq - cc - 32) >= W) p1[r] = NEG; }
}
constexpr float THR = 8.f;
__device__ __forceinline__ void softmax_tile(f32x16& p0, f32x16& p1, float& m_reg, float& l_reg, f32x16* o, const ACtx& c) {
    float pmax = p0[0];
#pragma unroll
    for (int r = 1; r < 16; ++r) pmax = fmaxf(pmax, p0[r]);
#pragma unroll
    for (int r = 0; r < 16; ++r) pmax = fmaxf(pmax, p1[r]);
    pmax = swap_max(pmax);
    constexpr float C2 = LOG2E * SCALE;
    float mn, alpha;
    if (__all((pmax - m_reg) * SCALE <= THR)) { mn = m_reg; alpha = 1.f; }
    else { mn = fmaxf(m_reg, pmax); alpha = __builtin_amdgcn_exp2f((m_reg - mn) * C2); m_reg = mn; }
    const float mnL = -mn * C2;
#pragma unroll
    for (int r = 0; r < 16; ++r) { p0[r] = __builtin_amdgcn_exp2f(fmaf(p0[r], C2, mnL)); p1[r] = __builtin_amdgcn_exp2f(fmaf(p1[r], C2, mnL)); }
    float ps = 0.f;
#pragma unroll
    for (int r = 0; r < 16; ++r) ps += p0[r] + p1[r];
    ps = swap_sum(ps);
    l_reg = l_reg * alpha + ps;
    if (__any(alpha < 1.f)) {
        if (c.hi == 0) c.ws[32 + c.r32] = alpha;
        LDS_WAIT();
#pragma unroll
        for (int r = 0; r < 16; ++r) { const float a = c.ws[32 + crow(r, c.hi)];
#pragma unroll
            for (int d = 0; d < 4; ++d) o[d][r] *= a; }
    }
}
__device__ __forceinline__ void row_factors(float f, float (&fr)[16], const ACtx& c) {
    LDS_WAIT();
    if (c.hi == 0) c.ws[c.r32] = f;
    LDS_WAIT();
#pragma unroll
    for (int r = 0; r < 16; ++r) fr[r] = c.ws[crow(r, c.hi)];
    LDS_WAIT();
}
template <bool ROPE>
__device__ __forceinline__ void load_q(bf16x8 (&qr)[8], const bf16_t* qrow, const float* cosr, const float* sinr, int hi) {
#pragma unroll
    for (int d0 = 0; d0 < 8; ++d0) qr[d0] = *(const bf16x8*)(qrow + d0 * 16 + hi * 8);
    if constexpr (ROPE) {
#pragma unroll
        for (int d0 = 0; d0 < 4; ++d0) {
            const int i0 = d0 * 16 + hi * 8;
            const f32x4 c0 = *(const f32x4*)(cosr + i0), c1 = *(const f32x4*)(cosr + i0 + 4), s0 = *(const f32x4*)(sinr + i0), s1 = *(const f32x4*)(sinr + i0 + 4);
            f32x4 a0, a1, b0, b1; unpack8(qr[d0], a0, a1); unpack8(qr[d0 + 4], b0, b1);
            qr[d0] = pack8(a0 * c0 - b0 * s0, a1 * c1 - b1 * s1);
            qr[d0 + 4] = pack8(b0 * c0 + a0 * s0, b1 * c1 + a1 * s1);
        }
    }
}
__device__ __forceinline__ void store_o_bf16(const f32x16* o, bf16_t* Ow  , int pitch, const ACtx& c) {
#pragma unroll
    for (int r = 0; r < 16; ++r) { const int orow = crow(r, c.hi);
#pragma unroll
        for (int d0 = 0; d0 < 4; ++d0) { const float v = o[d0][r]; const float vn = __shfl_xor(v, 1);
            if ((c.r32 & 1) == 0) *(unsigned*)(Ow + (size_t)orow * pitch + d0 * 32 + c.r32) = cvtpk(v, vn); } }
}

__device__ __forceinline__ void add_o_bf16(f32x16* o, const bf16_t* Ow, int pitch, const ACtx& c) {
#pragma unroll
    for (int r = 0; r < 16; ++r) { const int orow = crow(r, c.hi);
#pragma unroll
        for (int d0 = 0; d0 < 4; ++d0) o[d0][r] += bf2f(Ow[(size_t)orow * pitch + d0 * 32 + c.r32]); }
}
__device__ __forceinline__ int wq_next(gu32* ctr, LAS int* slot, int tid) {
    __syncthreads();
    if (tid == 0) *slot = (int)__hip_atomic_fetch_add(ctr, 1u, RLX_AGENT);
    __syncthreads();
    return *slot;
}
template <int MODE>
__device__ __forceinline__ void softmax_sweep(const ACtx& c, const bf16x8 (&qr)[8], f32x16 (&o)[4], float& l_out, const bf16_t* Kp, const bf16_t* Vp, int pitch,
                                              int j_lo, int j_hi, int qpos, int qlo, unsigned selbits) {
    float m_reg = -1e30f, l_reg = 0.f;
#pragma unroll
    for (int d = 0; d < 4; ++d) o[d] = (f32x16){};
    Stage S; stage_load(S, Kp, Vp, pitch, j_lo * 64, c);
    for (int j = j_lo; j < j_hi; ++j) {
        const int buf = (j - j_lo) & 1;
        stage_write(S, buf, c);
        __syncthreads();
        if (j + 1 < j_hi) stage_load(S, Kp, Vp, pitch, (j + 1) * 64, c);
        const int kb = j * 64;
        bool act = true;
        if (MODE == 1) act = (kb <= qlo + 31) && (kb + 63 >= qlo - (WINDOW - 1));
        if (MODE == 2) act = (kb <= qlo + 31) && __any((int)((selbits >> j) & 1u));
        if (act) {
            f32x16 p0, p1; qkt(p0, p1, buf, c, qr);
            if (MODE == 1) { if (kb + 63 > qlo || kb < qlo + 31 - (WINDOW - 1)) mask_tile(p0, p1, qpos - kb - 4 * c.hi, (unsigned)WINDOW); }
            if (MODE == 2) { if (kb + 63 > qlo) mask_tile(p0, p1, qpos - kb - 4 * c.hi, 0x7fffffffu);
                if (!__all((int)((selbits >> j) & 1u))) { if (!((selbits >> j) & 1u)) { const float NEG = -__builtin_inff();
#pragma unroll
                    for (int r = 0; r < 16; ++r) { p0[r] = NEG; p1[r] = NEG; } } } }
            softmax_tile(p0, p1, m_reg, l_reg, o, c);
            bf16x8 pa0, pa1, pa2, pa3; pack_p(p0, p1, pa0, pa1, pa2, pa3);
            pv_tile(o, buf, c, pa0, pa1, pa2, pa3);
        }
    }
    __syncthreads();
    l_out = l_reg;
}

struct Params {
    const float* x; const float* mem; const int* positions; const float* norm_g; const float* w_in_sb; const float* w_in_nsa; const float* cmp_pe; const float* cmp_w1; const float* cmp_w2;
    const float* w_mem_kv; const float* w_o; const float* w_gate; const float* w_up; const float* conv_w; const float* conv_b; const float* w_down;
    float* out; unsigned char* ws; int ph_lo, ph_hi;
};
struct Frame {
    LAS unsigned char* lds; int tid, lane, wave, G, bid;
};
#define WSP(T, off) ((T*)(p.ws + (off)))

__device__ __forceinline__ void tr_item(const float* W, int K, int Nsrc, int src_col0, int ncols, const float* gain, bf16_t* WT, int dst_row0, int mode, int item, int lane) {
    const int nblk = (ncols + 255) >> 8, kb = item / nblk, nb = item - kb * nblk, k0 = 16 * kb, n = nb * 256 + 4 * lane;
    if (n >= ncols) return;
    f32x4 v[16];
    if (W != nullptr) {
        const float* src = W + (size_t)k0 * Nsrc + src_col0 + n;
#pragma unroll
        for (int j = 0; j < 16; ++j) { const int kp = k0 + j, jj = kp & 127; const int ks = (mode & 4) ? (kp & ~127) + (jj >> 1) + 64 * (jj & 1) : kp;
            v[j] = *(const f32x4*)(W + (size_t)ks * Nsrc + src_col0 + n); }
        if (gain) {
#pragma unroll
            for (int j = 0; j < 16; ++j) v[j] = v[j] * gain[k0 + j];
        }
    } else {
#pragma unroll
        for (int j = 0; j < 16; ++j) v[j] = (f32x4){0.f, 0.f, 0.f, 0.f};
    }
#pragma unroll
    for (int e = 0; e < 4; ++e) {
        const int nn = n + e, dd = nn & 127; const int drow = dst_row0 + ((mode & 1) ? 256 * (nn >> 7) + dd : (mode & 2) ? (nn & ~127) + (dd < 64 ? 2 * dd : 2 * (dd - 64) + 1) : nn);
        v4u o0, o1;
        o0.x = cvtpk(v[0][e], v[1][e]); o0.y = cvtpk(v[2][e], v[3][e]); o0.z = cvtpk(v[4][e], v[5][e]); o0.w = cvtpk(v[6][e], v[7][e]);
        o1.x = cvtpk(v[8][e], v[9][e]); o1.y = cvtpk(v[10][e], v[11][e]); o1.z = cvtpk(v[12][e], v[13][e]); o1.w = cvtpk(v[14][e], v[15][e]);
        v4u* dst = (v4u*)(WT + (size_t)drow * K + k0); dst[0] = o0; dst[1] = o1;
    }
}
__device__ __forceinline__ void row_to_bf16_rstd(const float* xrow, bf16_t* orow, float* rstd_out, int lane) {
    const f32x4* xr = (const f32x4*)xrow + lane; f32x4 v[8]; float s = 0.f;
#pragma unroll
    for (int j = 0; j < 8; ++j) { v[j] = xr[64 * j]; s += (v[j].x * v[j].x + v[j].y * v[j].y) + (v[j].z * v[j].z + v[j].w * v[j].w); }
    s = wave_sum(s);
    v2u* o8 = (v2u*)orow + lane;
#pragma unroll
    for (int j = 0; j < 8; ++j) { v2u w; w.x = cvtpk(v[j].x, v[j].y); w.y = cvtpk(v[j].z, v[j].w); o8[64 * j] = w; }
    if (lane == 0) *rstd_out = 1.0f / sqrtf(s * (1.0f / DM) + NORM_EPS);
}
template <class PP> __device__ __forceinline__ void phase_convert(const PP& p, const Frame& F, int L) {
    const int gw = F.bid * NWAVES + F.wave, NGW = F.G * NWAVES;
    int it0 = gw;
#define TR(W, K, Nsrc, sc0, nc, gain, WT, dr0, mode) do { const int n_ = ((K) / 16) * (((nc) + 255) >> 8); for (; it0 < n_; it0 += NGW) tr_item(W, K, Nsrc, sc0, nc, gain, WT, dr0, mode, it0, F.lane); it0 -= n_; } while (0)
    const float* g = p.norm_g + (size_t)L * 5 * DM;
    const int j = L >> 1;
    bf16_t* WIN = WSP(bf16_t, WS_WIN);
    if ((L & 1) == 0) {
        TR(p.w_in_sb + (size_t)j * DM * SB_N, DM, SB_N, 0, SB_N, g, WIN, 0, 0);
    } else {
        const float* W = p.w_in_nsa + (size_t)j * DM * NSA_SRC;
        TR(W, DM, NSA_SRC, 0, 1536, g, WIN, NQ, 2);
        TR(W, DM, NSA_SRC, 1536, 256, g, WIN, NKC, 2);
        TR(W, DM, NSA_SRC, 1792, 256, g, WIN, NVC, 0);
        TR(W, DM, NSA_SRC, 2048, 256, g, WIN, NKS, 2);
        TR(W, DM, NSA_SRC, 2304, 256, g, WIN, NVS, 0);
        TR(W, DM, NSA_SRC, 2560, 256, g, WIN, NKW, 2);
        TR(W, DM, NSA_SRC, 2816, 256, g, WIN, NVW, 0);
        TR(W, DM, NSA_SRC, 3108, 512, g, WIN, NQM, 0);
        TR(W, DM, NSA_SRC, 3072, 36, g, WIN, NGL, 0);
        TR((const float*)nullptr, DM, NSA_SRC, 0, 220, (const float*)nullptr, WIN, NGL + 36, 0);
        for (int wh = 0; wh < 2; ++wh) {
            TR(p.cmp_w1 + (size_t)(j * 2 + wh) * 4096 * 256, 4096, 256, 0, 256, (const float*)nullptr, WSP(bf16_t, WS_CW1) + (size_t)wh * 256 * 4096, 0, wh == 0 ? 4 : 0);
            TR(p.cmp_w2 + (size_t)(j * 2 + wh) * 256 * 128, 256, 128, 0, 128, (const float*)nullptr, WSP(bf16_t, WS_CW2) + (size_t)wh * 128 * 256, 0, wh == 0 ? 2 : 0);
        }
    }
    if ((L & 1) && F.bid < 128) {
        const int wh = F.bid >> 6, nb = (F.bid >> 3) & 7, kq = F.bid & 7, n = 32 * nb + (F.tid & 31), kg = F.tid >> 5;
        const float* pe = p.cmp_pe + (size_t)(j * 2 + wh) * 4096; const float* w1 = p.cmp_w1 + (size_t)(j * 2 + wh) * 4096 * 256;
        float s = 0.f;
#pragma unroll 8
        for (int k = kq * 512 + kg * 32; k < kq * 512 + kg * 32 + 32; ++k) s += pe[k] * w1[(size_t)k * 256 + n];
        LAS float* red = (LAS float*)F.lds;
        red[kg * 32 + (F.tid & 31)] = s;
        __syncthreads();
        if (F.tid < 32) { float t = 0.f;
#pragma unroll
            for (int q = 0; q < 16; ++q) t += red[q * 32 + F.tid];
            WSP(float, WS_BIAS1)[(kq * 2 + wh) * 256 + n] = t; }
        __syncthreads();
    }
    TR(p.w_o + (size_t)L * DM * DM, DM, DM, 0, DM, (const float*)nullptr, WSP(bf16_t, WS_WO), 0, 0);
    TR(p.w_gate + (size_t)L * DM * DFF, DM, DFF, 0, DFF, g + 2 * DM, WSP(bf16_t, WS_WGU), 0, 1);
    TR(p.w_up + (size_t)L * DM * DFF, DM, DFF, 0, DFF, g + 2 * DM, WSP(bf16_t, WS_WGU), 128, 1);
    TR(p.w_down + (size_t)L * DFF * DM, DFF, DM, 0, DM, (const float*)nullptr, WSP(bf16_t, WS_WD), 0, 0);
    if (L == 0) {
        for (int l = 0; l < DEPTH; ++l)
            TR(p.w_mem_kv + (size_t)l * DM * 1024, DM, 1024, 0, 1024, p.norm_g + (size_t)(l * 5 + 4) * DM, WSP(bf16_t, WS_WKV), l * 1024, 0);
        float* rstd = WSP(float, WS_RSTD);
        for (int m = gw; m < MTOK; m += NGW) row_to_bf16_rstd(p.x + (size_t)m * DM, WSP(bf16_t, WS_XB) + (size_t)m * DM, rstd + m, F.lane);
        for (int m = gw; m < NB * NMEM; m += NGW) row_to_bf16_rstd(p.mem + (size_t)m * DM, WSP(bf16_t, WS_MEMB) + (size_t)m * DM, rstd + 16384 + m, F.lane);
        float* cosT = WSP(float, WS_COS); float* sinT = WSP(float, WS_SIN);
        for (int idx = F.bid * NTHR + F.tid; idx < MTOK * 64; idx += F.G * NTHR) {
            const int row = idx >> 6, i = idx & 63;
            const float ang = (float)p.positions[row] * INV_FREQ[i];
            double t = (double)ang * 0.15915494309189535; t -= __builtin_rint(t);
            const float fr = (float)t;
            cosT[idx] = __builtin_amdgcn_cosf(fr); sinT[idx] = __builtin_amdgcn_sinf(fr);
        }
    }
#undef TR
}

template <class PP> __device__ __forceinline__ void phase_resid(const PP& p, const Frame& F, const float* gpost, float* xout, const bf16_t* XBin, bf16_t* XB, float* rstd) {
    const int gw = F.bid * NWAVES + F.wave, NGW = F.G * NWAVES;
    const bf16_t* T = WSP(bf16_t, WS_TMP);
    for (int m = gw; m < MTOK; m += NGW) {
        const bf16x8* ar = (const bf16x8*)(T + (size_t)m * DM) + F.lane; const bf16x8* xr = (const bf16x8*)(XBin + (size_t)m * DM) + F.lane;
        f32x4 a[8], x[8]; float s = 0.f;
#pragma unroll
        for (int j = 0; j < 4; ++j) { unpack8(ar[64 * j], a[2 * j], a[2 * j + 1]); unpack8(xr[64 * j], x[2 * j], x[2 * j + 1]); }
#pragma unroll
        for (int j = 0; j < 8; ++j) s += (a[j].x * a[j].x + a[j].y * a[j].y) + (a[j].z * a[j].z + a[j].w * a[j].w);
        const float ra = 1.0f / sqrtf(wave_sum(s) * (1.0f / DM) + NORM_EPS);
        float s2 = 0.f;
#pragma unroll
        for (int j = 0; j < 4; ++j) {
            const int e0 = (j * 64 + F.lane) * 8;
#pragma unroll
            for (int h = 0; h < 2; ++h) {
                const f32x4 gv = *(const f32x4*)(gpost + e0 + 4 * h);
                const f32x4 y = x[2 * j + h] + a[2 * j + h] * ra * gv;
                a[2 * j + h] = y; s2 += (y.x * y.x + y.y * y.y) + (y.z * y.z + y.w * y.w);
                if (xout) *(f32x4*)(xout + (size_t)m * DM + e0 + 4 * h) = y;
            }
            *((bf16x8*)(XB + (size_t)m * DM) + 64 * j + F.lane) = pack8(a[2 * j], a[2 * j + 1]);
        }
        s2 = wave_sum(s2);
        if (F.lane == 0) rstd[m] = 1.0f / sqrtf(s2 * (1.0f / DM) + NORM_EPS);
    }
}
template <class PP> __device__ __forceinline__ void phase_convfix(const PP& p, const Frame& F, int L) {
    bf16_t* ACT = WSP(bf16_t, WS_ACT); const float* HG = WSP(float, WS_HG); const float* FP = WSP(float, WS_FP); const float* FU = WSP(float, WS_FU);
    const float* cw = p.conv_w + (size_t)L * 3 * DFF;
    constexpr int NCH = DFF / 4;
    for (int it = F.bid * NTHR + F.tid; it < 64 * 2 * NCH; it += F.G * NTHR) {
        const int pm = it / (2 * NCH), rem = it - pm * 2 * NCH, i = rem / NCH, f0 = (rem - i * NCH) * 4;
        if ((pm & 7) == 0) continue;
        const f32x4 h0 = *(const f32x4*)(HG + (size_t)((pm - 1) * 2 + 0) * DFF + f0), h1 = *(const f32x4*)(HG + (size_t)((pm - 1) * 2 + 1) * DFF + f0);
        const f32x4 w0 = *(const f32x4*)(cw + f0), w1 = *(const f32x4*)(cw + DFF + f0);
        f32x4 gc = *(const f32x4*)(FP + (size_t)(pm * 2 + i) * DFF + f0); const f32x4 uu = *(const f32x4*)(FU + (size_t)(pm * 2 + i) * DFF + f0);
        if (i == 0) gc += w0 * h0 + w1 * h1; else gc += w0 * h1;
        v2u o; o.x = cvtpk(gc[0] * sigmoidf_(gc[0]) * uu[0], gc[1] * sigmoidf_(gc[1]) * uu[1]); o.y = cvtpk(gc[2] * sigmoidf_(gc[2]) * uu[2], gc[3] * sigmoidf_(gc[3]) * uu[3]);
        *(v2u*)(ACT + (size_t)(pm * 256 + i) * DFF + f0) = o;
    }
}

template <class PP> __device__ __forceinline__ void sb_unit(const PP& p, const ACtx& c, int b, int h, int qt) {
    const bf16_t* PR = WSP(bf16_t, WS_PROJ); bf16_t* OC = WSP(bf16_t, WS_OCAT);
    const int P0 = qt * 256, qlo = P0 + c.wid * 32, qpos = qlo + c.r32;
    const size_t rowb = (size_t)b * SEQ;
    bf16x8 qr[8]; load_q<false>(qr, PR + (rowb + qpos) * SB_N + SBQ + h * HD, nullptr, nullptr, c.hi);
    const bf16_t* Kp = PR + rowb * SB_N + SBK + h * HD; const bf16_t* Vp = PR + rowb * SB_N + SBV + h * HD;
    f32x16 o[4];
#pragma unroll
    for (int d = 0; d < 4; ++d) o[d] = (f32x16){};
    float C2 = 0.f;
    const int jt = (P0 >> 6) + 3;
    LAS int* flags = (LAS int*)(c.lds + A_FLAGS);
    int done_w = 0;
    Stage S; stage_load(S, Kp, Vp, SB_N, jt * 64, c);
    constexpr float ZS = SCALE * LOG2E;
    for (int it = 0; it <= jt; ++it) {
        const int j = jt - it, buf = it & 1;
        stage_write(S, buf, c);
        if (c.lane == 0) flags[buf * 8 + c.wid] = done_w;
        __syncthreads();
        int alld = 1;
#pragma unroll
        for (int w = 0; w < 8; ++w) alld &= flags[buf * 8 + w];
        if (alld) break;
        if (j > 0) stage_load(S, Kp, Vp, SB_N, (j - 1) * 64, c);
        const int kb = j * 64;
        if (!done_w && kb <= qlo + 30) {
            f32x16 p0, p1; qkt(p0, p1, buf, c, qr);
            const int dq = qpos - kb - 4 * c.hi;
#pragma unroll
            for (int r = 0; r < 16; ++r) { const int cc = (r & 3) + 8 * (r >> 2);
                { const float z = p0[r] * ZS; const float t = __builtin_amdgcn_exp2f(-fabsf(z)); const float v = -(fmaxf(z, 0.f) + __builtin_amdgcn_logf(1.f + t)); p0[r] = (cc < dq) ? v : 0.f; }
                { const float z = p1[r] * ZS; const float t = __builtin_amdgcn_exp2f(-fabsf(z)); const float v = -(fmaxf(z, 0.f) + __builtin_amdgcn_logf(1.f + t)); p1[r] = (cc + 32 < dq) ? v : 0.f; } }
            float E[8], Od[8];
#pragma unroll
            for (int q = 0; q < 4; ++q) { const float g0 = (p0[4 * q] + p0[4 * q + 1]) + (p0[4 * q + 2] + p0[4 * q + 3]); swap_both(g0, E[q], Od[q]);
                                          const float g1 = (p1[4 * q] + p1[4 * q + 1]) + (p1[4 * q + 2] + p1[4 * q + 3]); swap_both(g1, E[4 + q], Od[4 + q]); }
            float T = 0.f, ex[8];
#pragma unroll
            for (int q = 7; q >= 0; --q) { const float to = T; T += Od[q]; const float te = T; T += E[q]; ex[q] = c.hi ? to : te; }
#pragma unroll
            for (int q = 0; q < 4; ++q) {
                { float R = C2 + ex[q]; float ep = __builtin_amdgcn_exp2f(R);
#pragma unroll
                  for (int i = 3; i >= 0; --i) { R += p0[4 * q + i]; const float e = __builtin_amdgcn_exp2f(R); p0[4 * q + i] = ep - e; ep = e; } }
                { float R = C2 + ex[4 + q]; float ep = __builtin_amdgcn_exp2f(R);
#pragma unroll
                  for (int i = 3; i >= 0; --i) { R += p1[4 * q + i]; const float e = __builtin_amdgcn_exp2f(R); p1[4 * q + i] = ep - e; ep = e; } }
            }
            C2 += T;
            bf16x8 pa0, pa1, pa2, pa3; pack_p(p0, p1, pa0, pa1, pa2, pa3);
            pv_tile(o, buf, c, pa0, pa1, pa2, pa3);
            done_w = __all(C2 < -72.f) ? 1 : 0;
        }
    }
    __syncthreads();
    store_o_bf16(o, OC + (rowb + qlo) * DM + h * HD, DM, c);
}
template <class PP> __device__ __forceinline__ void mem_unit(const PP& p, const ACtx& c, int L, int b, int hm, int qt, int projN, int qmcol) {
    const bf16_t* PR = WSP(bf16_t, WS_PROJ); bf16_t* OC = WSP(bf16_t, WS_OCAT); const bf16_t* MKV = WSP(bf16_t, WS_MEMKV);
    const int P0 = qt * 256, qlo = P0 + c.wid * 32, qpos = qlo + c.r32;
    const size_t rowb = (size_t)b * SEQ;
    bf16x8 qr[8]; load_q<false>(qr, PR + (rowb + qpos) * projN + qmcol + hm * HD, nullptr, nullptr, c.hi);
    const bf16_t* Kp = MKV + (size_t)b * NMEM * 4096 + L * 1024 + hm * HD; const bf16_t* Vp = Kp + 512;
    f32x16 o[4]; float l;
    softmax_sweep<0>(c, qr, o, l, Kp, Vp, 4096, 0, 4, qpos, qlo, 0u);
    float fr[16]; row_factors(1.0f / l, fr, c);
#pragma unroll
    for (int d = 0; d < 4; ++d)
#pragma unroll
        for (int r = 0; r < 16; ++r) o[d][r] *= fr[r];
    store_o_bf16(o, OC + (rowb + qlo) * DM + NMIX * HD + hm * HD, DM, c);
}
template <class PP> __device__ __forceinline__ void phase_attn_sb(const PP& p, const Frame& F, int L, gu32* ctr) {
    const ACtx c = make_actx(F.lds);
    LAS int* slot = (LAS int*)(F.lds + MISC_OFF) + 16;
    constexpr int NSBU = NB * NMIX * 8, NMU = NB * NMEMH * 8;
    for (;;) { const int u = wq_next(ctr, slot, c.tid); if (u >= NSBU + NMU) break;
        if (u < NSBU) { const int qt = 7 - (u / (NB * NMIX)), bh = u % (NB * NMIX); sb_unit(p, c, bh / NMIX, bh % NMIX, qt); }
        else { const int v = u - NSBU; const int qt = v % 8, bh = v / 8; mem_unit(p, c, L, bh / NMEMH, bh % NMEMH, qt, SB_N, SBQM); }
    }
}

template <class PP> __device__ __forceinline__ void phase_rope(const PP& p, const Frame& F) {
    bf16_t* PR = WSP(bf16_t, WS_PROJ); const float* cosT = WSP(float, WS_COS); const float* sinT = WSP(float, WS_SIN);
    const int lane = F.lane, gw = F.bid * NWAVES + F.wave, NGW = F.G * NWAVES;
    for (int m = gw; m < MTOK; m += NGW) {
        const float cv = cosT[(size_t)m * 64 + lane], sv = sinT[(size_t)m * 64 + lane];
        bf16_t* rowp = PR + (size_t)m * NSA_N;
        float x1[6], x2[6];
#pragma unroll
        for (int q = 0; q < 6; ++q) { const int base = ((q < 2) ? NKC : (q < 4) ? NKS : NKW) + (q & 1) * HD; x1[q] = bf2f(rowp[base + lane]); x2[q] = bf2f(rowp[base + 64 + lane]); }
#pragma unroll
        for (int q = 0; q < 6; ++q) { const int base = ((q < 2) ? NKC : (q < 4) ? NKS : NKW) + (q & 1) * HD;
            const float y1 = x1[q] * cv - x2[q] * sv, y2 = x2[q] * cv + x1[q] * sv;
            rowp[base + lane] = (bf16_t)(cvtpk(y1, y1) & 0xffffu); rowp[base + 64 + lane] = (bf16_t)(cvtpk(y2, y2) & 0xffffu); }
    }
}
template <class PP> __device__ __forceinline__ void phase_cmp_stage2(const PP& p, const Frame& F) {
    const int lane = F.lane, r32 = lane & 31, hi = lane >> 5;
    for (int u = F.bid; u < 128; u += F.G) {
        const int wh = u & 1, rt = u >> 1;
        if (F.wave < 4) {
            const bf16_t* hid = WSP(bf16_t, WS_HID) + (size_t)wh * 2048 * 256 + (size_t)(rt * 32 + r32) * 256;
            const bf16_t* w2 = WSP(bf16_t, WS_CW2) + (size_t)wh * 128 * 256 + (size_t)(F.wave * 32 + r32) * 256;
            f32x16 a2 = (f32x16){};
#pragma unroll
            for (int kk = 0; kk < 16; ++kk) { const int k = kk * 16 + hi * 8;
                a2 = __builtin_amdgcn_mfma_f32_32x32x16_bf16(*(const bf16x8*)(hid + k), *(const bf16x8*)(w2 + k), a2, 0, 0, 0); }
            bf16_t* outp = WSP(bf16_t, WS_KCMP) + (size_t)wh * 16 * 128 * 128;
#pragma unroll
            for (int r = 0; r < 16; ++r) { const int ro = rt * 32 + crow(r, hi);
                const float av_ = a2[r]; const unsigned ub = __float_as_uint(av_); const unsigned rb = (ub + 0x7fffu + ((ub >> 16) & 1u)) >> 16;
                outp[(size_t)ro * 128 + F.wave * 32 + r32] = ((ro & 127) == 127) ? (bf16_t)0 : (bf16_t)rb; }
        }
    }
}

template <class PP> __device__ __forceinline__ void cmp_unit(const PP& p, const ACtx& c, int b, int g, int qt) {
    const bf16_t* PR = WSP(bf16_t, WS_PROJ); bf16_t* OC = WSP(bf16_t, WS_OCAT); const float* cosT = WSP(float, WS_COS); const float* sinT = WSP(float, WS_SIN);
    const int P0 = qt * 256, qlo = P0 + c.wid * 32, qpos = qlo + c.r32, hi = c.hi;
    const size_t rowb = (size_t)b * SEQ, row = rowb + qpos;
    const bf16_t* Kp = WSP(bf16_t, WS_KCMP) + (size_t)(b * 2 + g) * 128 * 128; const bf16_t* Vp = Kp + (size_t)16 * 128 * 128;
    { Stage S; stage_load(S, Kp, Vp, 128, 0, c); stage_write(S, 0, c); stage_load(S, Kp, Vp, 128, 64, c); stage_write(S, 1, c); }
    __syncthreads();
    const int cmax = (qpos >= 31) ? (((qpos - 31) >> 4) < 126 ? ((qpos - 31) >> 4) : 126) : -1;
    LAS float* acc_l = (LAS float*)(c.lds + A_STASH) + c.wid * 2048 + c.lane;
    const float NEG = -__builtin_inff();
    constexpr float C2 = LOG2E * SCALE;
#pragma nounroll
    for (int hh = 0; hh < HPG; ++hh) {
        const int h = g * HPG + hh;
        bf16x8 qr[8]; load_q<false>(qr, PR + row * NSA_N + NQ + h * HD, nullptr, nullptr, hi);
        f32x16 pA0, pA1, pB0, pB1; qkt(pA0, pA1, 0, c, qr); qkt(pB0, pB1, 1, c, qr);
        float mx = NEG;
#pragma unroll
        for (int r = 0; r < 16; ++r) { const int ci = crow(r, hi);
            if (ci > cmax) pA0[r] = NEG; if (ci + 32 > cmax) pA1[r] = NEG; if (ci + 64 > cmax) pB0[r] = NEG; if (ci + 96 > cmax) pB1[r] = NEG;
            mx = fmaxf(fmaxf(mx, pA0[r]), fmaxf(pA1[r], fmaxf(pB0[r], pB1[r]))); }
        mx = swap_max(mx); if (mx == NEG) mx = 0.f;
        const float mL = -mx * C2; float ls = 0.f;
#pragma unroll
        for (int r = 0; r < 16; ++r) { pA0[r] = __builtin_amdgcn_exp2f(fmaf(pA0[r], C2, mL)); pA1[r] = __builtin_amdgcn_exp2f(fmaf(pA1[r], C2, mL));
            pB0[r] = __builtin_amdgcn_exp2f(fmaf(pB0[r], C2, mL)); pB1[r] = __builtin_amdgcn_exp2f(fmaf(pB1[r], C2, mL)); ls += (pA0[r] + pA1[r]) + (pB0[r] + pB1[r]); }
        ls = swap_sum(ls);
        const float inv = ls > 0.f ? 1.0f / ls : 0.f;
#pragma unroll
        for (int r = 0; r < 16; ++r) { pA0[r] *= inv; pA1[r] *= inv; pB0[r] *= inv; pB1[r] *= inv; }
#define ACC_AB(P, Q0) do { _Pragma("unroll") for (int q = 0; q < 4; ++q) { \
            const float a_ = 2.f * (P[4 * q] + P[4 * q + 1] + P[4 * q + 2]) + P[4 * q + 3], b_ = P[4 * q + 3]; \
            LAS float* pa_ = acc_l + (2 * (Q0 + q)) * 64; \
            if (hh == 0) { pa_[0] = a_; pa_[64] = b_; } else { pa_[0] += a_; pa_[64] += b_; } } } while (0)
        ACC_AB(pA0, 0); ACC_AB(pA1, 4); ACC_AB(pB0, 8); ACC_AB(pB1, 12);
#undef ACC_AB
        f32x16 o[4];
#pragma unroll
        for (int d = 0; d < 4; ++d) o[d] = (f32x16){};
        { bf16x8 pa0, pa1, pa2, pa3; pack_p(pA0, pA1, pa0, pa1, pa2, pa3); pv_tile(o, 0, c, pa0, pa1, pa2, pa3); }
        { bf16x8 pa0, pa1, pa2, pa3; pack_p(pB0, pB1, pa0, pa1, pa2, pa3); pv_tile(o, 1, c, pa0, pa1, pa2, pa3); }
        const float gc = sigmoidf_(bf2f(PR[row * NSA_N + NGL + h * 3 + 0]));
        float fr[16]; row_factors(gc, fr, c);
#pragma unroll
        for (int d = 0; d < 4; ++d)
#pragma unroll
            for (int r = 0; r < 16; ++r) o[d][r] *= fr[r];
        add_o_bf16(o, OC + (rowb + qlo) * DM + h * HD, DM, c);
        store_o_bf16(o, OC + (rowb + qlo) * DM + h * HD, DM, c);
    }
    float Ie[16], Io[16];
    {
        float imp[16], Bb[16];
#pragma unroll
        for (int q = 0; q < 16; ++q) { float blo, bhi; swap_both(acc_l[(2 * q + 1) * 64], blo, bhi); Bb[q] = hi ? blo : bhi; }
#pragma unroll
        for (int q = 0; q < 16; ++q) imp[q] = acc_l[(2 * q) * 64] + (hi ? Bb[q] : (q > 0 ? Bb[q - 1] : 0.f));
#pragma unroll
        for (int q = 0; q < 16; ++q) swap_both(imp[q], Ie[q], Io[q]);
    }
    const int cur = qpos >> 6;
    unsigned bits;
    if (cur < 16) bits = (2u << cur) - 1u;
    else {
#pragma unroll
        for (int q = 0; q < 16; ++q) { const int je = 2 * q, jo = 2 * q + 1;
            if (!(je >= 1 && je <= cur - 2)) Ie[q] = -1.f; if (!(jo >= 1 && jo <= cur - 2)) Io[q] = -1.f; }
        bits = 0u;
#pragma unroll
        for (int q = 0; q < 16; ++q) {
            const int jm = 2 * q + hi; const float vj = hi ? Io[q] : Ie[q];
            int rank = 0;
#pragma unroll
            for (int q2 = 0; q2 < 16; ++q2) {
                const bool lt_e = (q2 < q) || (q2 == q && hi);
                const bool lt_o = (q2 < q);
                rank += (Ie[q2] > vj || (Ie[q2] == vj && lt_e)) ? 1 : 0;
                rank += (Io[q2] > vj || (Io[q2] == vj && lt_o)) ? 1 : 0;
            }
            const bool forced = (jm == 0) || (jm == cur) || (jm == cur - 1);
            const bool sel = forced || (vj >= 0.f && rank < 13);
            bits |= sel ? (1u << jm) : 0u;
        }
        { auto rr = __builtin_amdgcn_permlane32_swap(bits, bits, false, false); bits = rr[0] | rr[1]; }
    }
    if (hi == 0) WSP(unsigned, WS_SEL)[(size_t)(b * 2 + g) * SEQ + qpos] = bits;
    __syncthreads();
}
template <class PP> __device__ __forceinline__ void phase_attn_cmp(const PP& p, const Frame& F) {
    const ACtx c = make_actx(F.lds);
    constexpr int NCU = NB * NGRP * 8;
    for (int u = F.bid; u < NCU; u += F.G) { const int qt = 7 - (u % 8), bg = u / 8; cmp_unit(p, c, bg >> 1, bg & 1, qt); }
}
template <class PP> __device__ __forceinline__ void win_unit(const PP& p, const ACtx& c, int b, int h, int qt) {
    const bf16_t* PR = WSP(bf16_t, WS_PROJ); bf16_t* OC = WSP(bf16_t, WS_OCAT); const float* cosT = WSP(float, WS_COS); const float* sinT = WSP(float, WS_SIN);
    const int P0 = qt * 256, qlo = P0 + c.wid * 32, qpos = qlo + c.r32, g = h / HPG;
    const size_t rowb = (size_t)b * SEQ, row = rowb + qpos;
    bf16x8 qr[8]; load_q<false>(qr, PR + row * NSA_N + NQ + h * HD, nullptr, nullptr, c.hi);
    const float gwn = sigmoidf_(bf2f(PR[row * NSA_N + NGL + h * 3 + 2]));
    f32x16 o[4]; float l;
    const int jlo = (P0 - (WINDOW - 1)) > 0 ? ((P0 - (WINDOW - 1)) >> 6) : 0;
    softmax_sweep<1>(c, qr, o, l, PR + rowb * NSA_N + NKW + g * HD, PR + rowb * NSA_N + NVW + g * HD, NSA_N, jlo, (P0 >> 6) + 4, qpos, qlo, 0u);
    float fr[16]; row_factors(l > 0.f ? gwn / l : 0.f, fr, c);
#pragma unroll
    for (int d = 0; d < 4; ++d)
#pragma unroll
        for (int r = 0; r < 16; ++r) o[d][r] *= fr[r];
    store_o_bf16(o, OC + (rowb + qlo) * DM + h * HD, DM, c);
}
template <class PP> __device__ __forceinline__ void nsa_win_mem_units(const PP& p, const Frame& F, int L, gu32* ctr) {
    const ACtx c = make_actx(F.lds);
    LAS int* slot = (LAS int*)(F.lds + MISC_OFF) + 16;
    constexpr int NWU = NB * NMIX * 8, NMU = NB * NMEMH * 8;
    for (;;) { const int u = wq_next(ctr, slot, c.tid); if (u >= NWU + NMU) break;
        if (u < NWU) { const int qt = 7 - (u / (NB * NMIX)), bh = u % (NB * NMIX); win_unit(p, c, bh / NMIX, bh % NMIX, qt); }
        else { const int v = u - NWU; const int qt = v % 8, bh = v / 8; mem_unit(p, c, L, bh / NMEMH, bh % NMEMH, qt, NSA_N, NQM); }
    }
}
template <class PP> __device__ __forceinline__ void sel_unit(const PP& p, const ACtx& c, int b, int h, int qt, bf16_t* OUT) {
    const bf16_t* PR = WSP(bf16_t, WS_PROJ); const bf16_t* OC = WSP(bf16_t, WS_OCAT); const float* cosT = WSP(float, WS_COS); const float* sinT = WSP(float, WS_SIN);
    const int P0 = qt * 256, qlo = P0 + c.wid * 32, qpos = qlo + c.r32, g = h / HPG;
    const size_t rowb = (size_t)b * SEQ, row = rowb + qpos;
    bf16x8 qr[8]; load_q<false>(qr, PR + row * NSA_N + NQ + h * HD, nullptr, nullptr, c.hi);
    const unsigned selbits = WSP(unsigned, WS_SEL)[(size_t)(b * 2 + g) * SEQ + qpos];
    const float gs = sigmoidf_(bf2f(PR[row * NSA_N + NGL + h * 3 + 1]));
    f32x16 o[4]; float l;
    softmax_sweep<2>(c, qr, o, l, PR + rowb * NSA_N + NKS + g * HD, PR + rowb * NSA_N + NVS + g * HD, NSA_N, 0, (P0 >> 6) + 4, qpos, qlo, selbits);
    float fr[16]; row_factors(l > 0.f ? gs / l : 0.f, fr, c);
#pragma unroll
    for (int d = 0; d < 4; ++d)
#pragma unroll
        for (int r = 0; r < 16; ++r) o[d][r] *= fr[r];
    add_o_bf16(o, OC + (rowb + qlo) * DM + h * HD, DM, c);
    store_o_bf16(o, OUT + (rowb + qlo) * DM + h * HD, DM, c);
}
template <class PP> __device__ __forceinline__ void phase_attn_sel(const PP& p, const Frame& F, bf16_t* OUT, gu32* ctr) {
    const ACtx c = make_actx(F.lds);
    LAS int* slot = (LAS int*)(F.lds + MISC_OFF) + 16;
    constexpr int NU = NB * NMIX * 8;
    for (;;) { const int u = wq_next(ctr, slot, c.tid); if (u >= NU) break;
        const int qt = 7 - (u / (NB * NMIX)), bh = u % (NB * NMIX); sel_unit(p, c, bh / NMIX, bh % NMIX, qt, OUT); }
}

#define LAST_() (rep_ == nrep_ - 1)
#define WQ_(k) ((gu32*)(p.ws + WS_CTL) + 64 * (8 + ((lp * 3 + (k)) * 2 + rep_)))
#ifndef PROBE_REPEAT
#define PROBE_REPEAT 0
#endif
constexpr int NPH = 48;
__global__ void __launch_bounds__(NTHR, 2) mk_fwd(Params p) {
    extern __shared__ __attribute__((aligned(16))) unsigned char lds_raw[];
    LAS unsigned char* const lds0 = (LAS unsigned char*)lds_raw;
typedef const Params __attribute__((address_space(4))) KParams;
#define MKFRAME() KParams* pp_ = (KParams*)__builtin_amdgcn_kernarg_segment_ptr(); asm volatile("" : "+s"(pp_)); KParams& p = *pp_; Frame F; F.lds = lds0; { int t_ = threadIdx.x; asm volatile("" : "+v"(t_)); F.tid = t_; } F.lane = F.tid & 63; F.wave = __builtin_amdgcn_readfirstlane(F.tid >> 6); F.G = gridDim.x; F.bid = blockIdx.x
    for (int u = threadIdx.x; u < (LDS_BYTES - LDSCTL_OFF) / 4; u += NTHR) ((LAS unsigned*)(lds0 + LDSCTL_OFF))[u] = 0u;
    __syncthreads();
    gu32* ctl = (gu32*)(p.ws + WS_CTL);
    XcdBarrier bar; bar.bar = (unsigned*)(ctl + CW_BAR); bar.x = 0; bar.st = nullptr;
#if !MK_PER_PHASE
    bar = xcd_barrier_post((unsigned*)(ctl + CW_BAR), (volatile LAS unsigned*)(lds0 + MISC_OFF) + 8);
#endif
    const int lo = p.ph_lo, hi = p.ph_hi;
    int ph = 0;
#define IN() (lo <= ph && ph < hi)
#if MK_PER_PHASE
#define END_PHASE() do { ++ph; } while (0)
#else
#define END_PHASE() do { if (IN() && ph + 1 < hi) { xcd_barrier(bar); if (PROBE_REPEAT & 256) xcd_barrier(bar); } ++ph; } while (0)
#endif
#define GEMM_RS(Aoff, Boff, M_, N_, K_, Ooff, ldc_, rs_) do { pg8::Gemm g{WSP(pg8::bf16_t, Aoff), WSP(pg8::bf16_t, Boff), M_, N_, K_}; pg8::StaticOrder S; S.init(M_, N_, F.G, F.bid); \
        pg8::EpiRS E{WSP(pg8::bf16_t, Ooff), ldc_, rs_}; pg8::gemm_phase<pg8::EpiRS, pg8::StaticOrder, true, true>(F.lds, g, S, E); } while (0)

#define GEMM_GU(L_) do { pg8::Gemm g{WSP(pg8::bf16_t, WS_XB), WSP(pg8::bf16_t, WS_WGU), MTOK, NGU, DM}; pg8::StaticOrder S; S.init(MTOK, NGU, F.G, F.bid); \
        pg8::EpiConv E{WSP(pg8::bf16_t, WS_ACT), WSP(float, WS_RSTD), p.conv_w + (size_t)(L_) * 3 * DFF, p.conv_b + (size_t)(L_) * DFF, WSP(float, WS_HG), WSP(float, WS_FP), WSP(float, WS_FU), (LAS float*)(F.lds + HALO_OFF), DFF}; \
        pg8::gemm_phase<pg8::EpiConv, pg8::StaticOrder, true, true>(F.lds, g, S, E); } while (0)

    for (int lp = 0; lp < 2; ++lp) {
        {
            const int L = 2 * lp;
            if (lp == 0) { if (IN()) { MKFRAME(); for (int rep_ = 0, nrep_ = ((PROBE_REPEAT & 1) ? 2 : 1); rep_ < nrep_; ++rep_) { phase_convert(p, F, L); } }
            END_PHASE(); }
            if (IN()) { MKFRAME(); for (int rep_ = 0, nrep_ = ((PROBE_REPEAT & 2) ? 2 : 1); rep_ < nrep_; ++rep_) { GEMM_RS(WS_XB, WS_WIN, MTOK, SB_N, DM, WS_PROJ, SB_N, WSP(float, WS_RSTD));
                        if (L == 0) GEMM_RS(WS_MEMB, WS_WKV, NB * NMEM, 4096, DM, WS_MEMKV, 4096, WSP(float, WS_RSTD) + 16384); } }
            END_PHASE();
            if (IN()) { MKFRAME(); for (int rep_ = 0, nrep_ = ((PROBE_REPEAT & 4) ? 2 : 1); rep_ < nrep_; ++rep_) { phase_attn_sb(p, F, L, WQ_(0)); } }
            END_PHASE();
            if (IN()) { MKFRAME(); for (int rep_ = 0, nrep_ = ((PROBE_REPEAT & 2) ? 2 : 1); rep_ < nrep_; ++rep_) { GEMM_RS(WS_OCAT, WS_WO, MTOK, DM, DM, WS_TMP, DM, (const float*)nullptr); } }
            END_PHASE();
            if (IN()) { MKFRAME(); for (int rep_ = 0, nrep_ = ((PROBE_REPEAT & 8) ? 2 : 1); rep_ < nrep_; ++rep_) { phase_resid(p, F, p.norm_g + (size_t)(L * 5 + 1) * DM, (LAST_() && false) ? p.out : (float*)nullptr, WSP(bf16_t, WS_XB), LAST_() ? WSP(bf16_t, WS_XB) : WSP(bf16_t, WS_PROJ), LAST_() ? WSP(float, WS_RSTD) : WSP(float, WS_FP)); } }
            END_PHASE();
            if (IN()) { MKFRAME(); for (int rep_ = 0, nrep_ = ((PROBE_REPEAT & 2) ? 2 : 1); rep_ < nrep_; ++rep_) { GEMM_GU(L); } }
            END_PHASE();
            if (IN()) { MKFRAME(); for (int rep_ = 0, nrep_ = ((PROBE_REPEAT & 16) ? 2 : 1); rep_ < nrep_; ++rep_) { phase_convfix(p, F, L); } }
            END_PHASE();
            if (IN()) { MKFRAME(); for (int rep_ = 0, nrep_ = ((PROBE_REPEAT & 2) ? 2 : 1); rep_ < nrep_; ++rep_) { GEMM_RS(WS_ACT, WS_WD, MTOK, DM, DFF, WS_TMP, DM, (const float*)nullptr); } }
            END_PHASE();
            if (IN()) { MKFRAME(); for (int rep_ = 0, nrep_ = ((PROBE_REPEAT & 8) ? 2 : 1); rep_ < nrep_; ++rep_) { phase_resid(p, F, p.norm_g + (size_t)(L * 5 + 3) * DM, (LAST_() && L == DEPTH - 1) ? p.out : (float*)nullptr, WSP(bf16_t, WS_XB), LAST_() ? WSP(bf16_t, WS_XB) : WSP(bf16_t, WS_PROJ), LAST_() ? WSP(float, WS_RSTD) : WSP(float, WS_FP)); }  if (L + 1 < DEPTH) phase_convert(p, F, L + 1); }
            END_PHASE();
        }
        {
            const int L = 2 * lp + 1;
            if (IN()) { MKFRAME(); for (int rep_ = 0, nrep_ = ((PROBE_REPEAT & 2) ? 2 : 1); rep_ < nrep_; ++rep_) { { pg8::Gemm g{WSP(pg8::bf16_t, WS_XB), WSP(pg8::bf16_t, WS_WIN), MTOK, NSA_N, DM}; pg8::StaticOrder S; S.init(MTOK, NSA_N, F.G, F.bid); pg8::EpiRopeRS E{WSP(pg8::bf16_t, WS_PROJ), NSA_N, WSP(float, WS_RSTD), WSP(float, WS_COS), WSP(float, WS_SIN)}; pg8::gemm_phase<pg8::EpiRopeRS, pg8::StaticOrder, true, true>(F.lds, g, S, E); } } }
            END_PHASE();
            if (IN()) { MKFRAME(); for (int rep_ = 0, nrep_ = ((PROBE_REPEAT & 32) ? 2 : 1); rep_ < nrep_; ++rep_) {
                if (F.bid < 16) { const int wh = F.bid >> 3;
                    pg8::Gemm g{WSP(pg8::bf16_t, WS_PROJ) + (wh ? NVC : NKC), WSP(pg8::bf16_t, WS_CW1) + (size_t)wh * 256 * 4096, 2048, 256, 4096, 16 * NSA_N, 256u, (unsigned)(NSA_N * 2), (size_t)SEQ * NSA_N * 2};
                    pg8::StaticOrder S; S.init(2048, 256, F.G, F.bid & 7);
                    pg8::EpiCmpMlp E{WSP(float, WS_BIAS1) + wh * 256, WSP(pg8::bf16_t, WS_CW2) + (size_t)wh * 128 * 256, WSP(pg8::bf16_t, WS_KCMP) + (size_t)wh * 16 * 128 * 128};
                    pg8::gemm_phase<pg8::EpiCmpMlp, pg8::StaticOrder, false, true, true>(F.lds, g, S, E);
                }
                nsa_win_mem_units(p, F, L, WQ_(1)); } }
            END_PHASE();
            if (IN()) { MKFRAME(); for (int rep_ = 0, nrep_ = ((PROBE_REPEAT & 64) ? 2 : 1); rep_ < nrep_; ++rep_) { phase_attn_cmp(p, F); } }
            END_PHASE();
            if (IN()) { MKFRAME(); for (int rep_ = 0, nrep_ = ((PROBE_REPEAT & 128) ? 2 : 1); rep_ < nrep_; ++rep_) { phase_attn_sel(p, F, LAST_() ? WSP(bf16_t, WS_OCAT) : WSP(bf16_t, WS_TMP), WQ_(2)); } }
            END_PHASE();
            if (IN()) { MKFRAME(); for (int rep_ = 0, nrep_ = ((PROBE_REPEAT & 2) ? 2 : 1); rep_ < nrep_; ++rep_) { GEMM_RS(WS_OCAT, WS_WO, MTOK, DM, DM, WS_TMP, DM, (const float*)nullptr); } }
            END_PHASE();
            if (IN()) { MKFRAME(); for (int rep_ = 0, nrep_ = ((PROBE_REPEAT & 8) ? 2 : 1); rep_ < nrep_; ++rep_) { phase_resid(p, F, p.norm_g + (size_t)(L * 5 + 1) * DM, (LAST_() && false) ? p.out : (float*)nullptr, WSP(bf16_t, WS_XB), LAST_() ? WSP(bf16_t, WS_XB) : WSP(bf16_t, WS_PROJ), LAST_() ? WSP(float, WS_RSTD) : WSP(float, WS_FP)); } }
            END_PHASE();
            if (IN()) { MKFRAME(); for (int rep_ = 0, nrep_ = ((PROBE_REPEAT & 2) ? 2 : 1); rep_ < nrep_; ++rep_) { GEMM_GU(L); } }
            END_PHASE();
            if (IN()) { MKFRAME(); for (int rep_ = 0, nrep_ = ((PROBE_REPEAT & 16) ? 2 : 1); rep_ < nrep_; ++rep_) { phase_convfix(p, F, L); } }
            END_PHASE();
            if (IN()) { MKFRAME(); for (int rep_ = 0, nrep_ = ((PROBE_REPEAT & 2) ? 2 : 1); rep_ < nrep_; ++rep_) { GEMM_RS(WS_ACT, WS_WD, MTOK, DM, DFF, WS_TMP, DM, (const float*)nullptr); } }
            END_PHASE();
            if (IN()) { MKFRAME(); for (int rep_ = 0, nrep_ = ((PROBE_REPEAT & 8) ? 2 : 1); rep_ < nrep_; ++rep_) { phase_resid(p, F, p.norm_g + (size_t)(L * 5 + 3) * DM, (LAST_() && L == DEPTH - 1) ? p.out : (float*)nullptr, WSP(bf16_t, WS_XB), LAST_() ? WSP(bf16_t, WS_XB) : WSP(bf16_t, WS_PROJ), LAST_() ? WSP(float, WS_RSTD) : WSP(float, WS_FP)); }  if (L + 1 < DEPTH) phase_convert(p, F, L + 1); }
            END_PHASE();
        }
    }
#undef IN
#undef END_PHASE
#undef GEMM_RS
#undef GEMM_GU
}

extern "C" void kernel_launch(void* const* d_in, const int* in_sizes, int n_in, void* d_out, int out_size, void* d_ws, size_t ws_size, hipStream_t stream) {
    static int grid = 0;
    if (grid == 0) {
        if (n_in != 16 || out_size != MTOK * DM || ws_size < WS_END) { fprintf(stderr, "kernel_launch: unexpected shapes (n_in %d, out %d, ws %zu < %zu)\n", n_in, out_size, ws_size, (size_t)WS_END); grid = -1; return; }
        int dev = 0, cus = 0, per_cu = 0;
        if (hipGetDevice(&dev) != hipSuccess || hipDeviceGetAttribute(&cus, hipDeviceAttributeMultiprocessorCount, dev) != hipSuccess) { grid = -1; return; }
        if (hipFuncSetAttribute((const void*)mk_fwd, hipFuncAttributeMaxDynamicSharedMemorySize, LDS_BYTES) != hipSuccess) { fprintf(stderr, "kernel_launch: hipFuncSetAttribute failed\n"); grid = -1; return; }
        if (hipOccupancyMaxActiveBlocksPerMultiprocessor(&per_cu, (const void*)mk_fwd, NTHR, LDS_BYTES) != hipSuccess || per_cu < 1) { fprintf(stderr, "kernel_launch: occupancy query says %d\n", per_cu); (void)hipGetLastError(); }
        grid = cus;
    }
    if (grid < 0) return;
    (void)hipMemsetAsync((char*)d_ws + WS_CTL, 0, CTL_ZERO_BYTES, stream);
    Params p{};
    p.x = (const float*)d_in[0]; p.mem = (const float*)d_in[1]; p.positions = (const int*)d_in[2]; p.norm_g = (const float*)d_in[3]; p.w_in_sb = (const float*)d_in[4]; p.w_in_nsa = (const float*)d_in[5];
    p.cmp_pe = (const float*)d_in[6]; p.cmp_w1 = (const float*)d_in[7]; p.cmp_w2 = (const float*)d_in[8]; p.w_mem_kv = (const float*)d_in[9]; p.w_o = (const float*)d_in[10];
    p.w_gate = (const float*)d_in[11]; p.w_up = (const float*)d_in[12]; p.conv_w = (const float*)d_in[13]; p.conv_b = (const float*)d_in[14]; p.w_down = (const float*)d_in[15];
    p.out = (float*)d_out; p.ws = (unsigned char*)d_ws;
#if MK_PER_PHASE
    for (int ph = 0; ph < NPH; ++ph) { p.ph_lo = ph; p.ph_hi = ph + 1; hipLaunchKernelGGL(mk_fwd, dim3(grid), dim3(NTHR), LDS_BYTES, stream, p); }
#else
    p.ph_lo = 0; p.ph_hi = NPH;
    hipLaunchKernelGGL(mk_fwd, dim3(grid), dim3(NTHR), LDS_BYTES, stream, p);
#endif
}
```
